# Optimizing an MI355X kernel written in HIP

```python
import jax, jax.numpy as jnp
from jax import lax
import numpy as np

D_MODEL = 4096
BATCH = 1
SEQ = 16384
DEPTH = 1

GRID_W = 64
CHUNK = 128
GM_WIDTH = D_MODEL // 2
GM_GROUP_DIM = 128
GM_GROUPS = GM_WIDTH // GM_GROUP_DIM
NA_WIDTH = D_MODEL // 2
NA_HEAD_DIM = 128
NA_HEADS = NA_WIDTH // NA_HEAD_DIM
NA_WIN_H_MAX = 8
NA_WIN_W = 16
D_FF = ((-(-8 * D_MODEL // 3) + 255) // 256) * 256
RMS_EPS = 1e-6
LN_EPS = 1e-5

kernel_name = "hybrid_gmlp_natten_gated_block"


def rms_norm(x, g):
    xf = x.astype(jnp.float32)
    y = xf * lax.rsqrt(jnp.mean(xf * xf, axis=-1, keepdims=True) + RMS_EPS)
    return (y * g.astype(jnp.float32)).astype(x.dtype)


def layer_norm(x, g, b):
    xf = x.astype(jnp.float32)
    mu = jnp.mean(xf, axis=-1, keepdims=True)
    xc = xf - mu
    y = xc * lax.rsqrt(jnp.mean(xc * xc, axis=-1, keepdims=True) + LN_EPS)
    return (y * g.astype(jnp.float32) + b.astype(jnp.float32)).astype(x.dtype)


def gmlp_spatial_gating(u, v, ln_g, ln_b, w_s, b_s):
    B, S, _ = u.shape
    n_chunks = S // CHUNK
    u = jax.nn.gelu(u, approximate=False)
    v = layer_norm(jax.nn.gelu(v, approximate=False), ln_g, ln_b)
    v = v.reshape(B, n_chunks, CHUNK, GM_GROUPS, GM_GROUP_DIM)
    mixed = jnp.einsum("gij,bnjgc->bnigc", w_s, v) + b_s.T[None, None, :, :, None]
    return u * mixed.reshape(B, S, GM_WIDTH)


def neighbourhood_attention(q, k, v, q_gain, k_gain, rpb):
    B, S, _ = q.shape
    rows = S // GRID_W
    kh = min(NA_WIN_H_MAX, rows)
    scale = NA_HEAD_DIM ** -0.5

    def to_grid(t):
        return t.reshape(B, rows, GRID_W, NA_HEADS, NA_HEAD_DIM)

    qg = rms_norm(to_grid(q), q_gain)
    kg = rms_norm(to_grid(k), k_gain)
    vg = to_grid(v)

    cols = np.arange(GRID_W)
    col_start = np.clip(cols - NA_WIN_W // 2, 0, GRID_W - NA_WIN_W)
    col_idx = col_start[:, None] + np.arange(NA_WIN_W)[None, :]
    col_off = col_idx - cols[:, None] + (NA_WIN_W - 1)
    rpb_cols = rpb[:, :, col_off].astype(jnp.float32)

    def one_row(args):
        r, q_row = args
        rs = jnp.clip(r - kh // 2, 0, rows - kh)
        k_band = lax.dynamic_slice_in_dim(kg, rs, kh, axis=1)
        v_band = lax.dynamic_slice_in_dim(vg, rs, kh, axis=1)
        k_win = k_band[:, :, col_idx]
        v_win = v_band[:, :, col_idx]
        s = jnp.einsum("bwhd,biwjhd->bhwij", q_row, k_win).astype(jnp.float32) * scale
        row_off = rs + jnp.arange(kh) - r + (NA_WIN_H_MAX - 1)
        bias = jnp.take(rpb_cols, row_off, axis=1)
        s = s + jnp.transpose(bias, (0, 2, 1, 3))[None]
        p = jax.nn.softmax(s, axis=(-2, -1)).astype(v_win.dtype)
        return jnp.einsum("bhwij,biwjhd->bwhd", p, v_win)

    q_rows = jnp.moveaxis(qg, 1, 0)
    out = lax.map(one_row, (jnp.arange(rows, dtype=jnp.int32), q_rows))
    return jnp.moveaxis(out, 0, 1).reshape(B, S, NA_WIDTH)


def swiglu(h, w_gate, w_up, w_down):
    return (jax.nn.silu(h @ w_gate) * (h @ w_up)) @ w_down


def setup_inputs(seed: int = 0) -> dict:
    key = jax.random.key(seed)
    ks = jax.random.split(key, 17)
    L = DEPTH
    in_cols = 2 * GM_WIDTH + 3 * NA_WIDTH + 2 * D_MODEL

    def nrm(k, shape, scale):
        return jax.random.normal(k, shape, jnp.float32) * scale

    return {
        "x": nrm(ks[0], (BATCH, SEQ, D_MODEL), 1.0),
        "norm1_g": 1.0 + nrm(ks[1], (L, D_MODEL), 0.02),
        "w_in": nrm(ks[2], (L, D_MODEL, in_cols), D_MODEL ** -0.5),
        "gm_ln_g": 1.0 + nrm(ks[3], (L, GM_WIDTH), 0.02),
        "gm_ln_b": nrm(ks[4], (L, GM_WIDTH), 0.02),
        "gm_w_s": nrm(ks[5], (L, GM_GROUPS, CHUNK, CHUNK), CHUNK ** -0.5),
        "gm_b_s": 1.0 + nrm(ks[6], (L, GM_GROUPS, CHUNK), 0.02),
        "q_gain": 1.0 + nrm(ks[7], (L, NA_HEAD_DIM), 0.02),
        "k_gain": 1.0 + nrm(ks[8], (L, NA_HEAD_DIM), 0.02),
        "na_rpb": nrm(ks[9], (L, NA_HEADS, 2 * NA_WIN_H_MAX - 1, 2 * NA_WIN_W - 1), 0.02),
        "w_o_gm": nrm(ks[10], (L, GM_WIDTH, D_MODEL), GM_WIDTH ** -0.5),
        "w_o_na": nrm(ks[11], (L, NA_WIDTH, D_MODEL), NA_WIDTH ** -0.5),
        "w_out": nrm(ks[12], (L, D_MODEL, D_MODEL), D_MODEL ** -0.5),
        "norm2_g": 1.0 + nrm(ks[13], (L, D_MODEL), 0.02),
        "w_ff_gate": nrm(ks[14], (L, D_MODEL, D_FF), D_MODEL ** -0.5),
        "w_ff_up": nrm(ks[15], (L, D_MODEL, D_FF), D_MODEL ** -0.5),
        "w_ff_down": nrm(ks[16], (L, D_FF, D_MODEL), D_FF ** -0.5),
    }


def reference(x, norm1_g, w_in, gm_ln_g, gm_ln_b, gm_w_s, gm_b_s, q_gain, k_gain, na_rpb,
              w_o_gm, w_o_na, w_out, norm2_g, w_ff_gate, w_ff_up, w_ff_down):
    split_at = list(np.cumsum([GM_WIDTH, GM_WIDTH, NA_WIDTH, NA_WIDTH, NA_WIDTH, D_MODEL]))
    h = x
    for layer in range(DEPTH):
        xn = rms_norm(h, norm1_g[layer])
        proj = xn @ w_in[layer]
        u_a, v_a, q, k, v, g_a, g_b = jnp.split(proj, split_at, axis=-1)
        y_a = gmlp_spatial_gating(u_a, v_a, gm_ln_g[layer], gm_ln_b[layer],
                                  gm_w_s[layer], gm_b_s[layer])
        y_b = neighbourhood_attention(q, k, v, q_gain[layer], k_gain[layer], na_rpb[layer])
        merged = (jax.nn.sigmoid(g_a) * (y_a @ w_o_gm[layer])
                  + jax.nn.sigmoid(g_b) * (y_b @ w_o_na[layer]))
        h = h + merged @ w_out[layer]
        h = h + swiglu(rms_norm(h, norm2_g[layer]), w_ff_gate[layer], w_ff_up[layer], w_ff_down[layer])
    return h
```

```cpp
#include <hip/hip_runtime.h>
#include <cstdio>
#include <cstdint>

#ifndef MK_N_LAUNCHES
#define MK_N_LAUNCHES 1
#endif
#ifndef MK_STOP_AFTER
#define MK_STOP_AFTER 7
#endif

namespace pg8 {
#define PG8_LAS __attribute__((address_space(3)))
typedef unsigned short bf16_t;
typedef short bf16x8 __attribute__((ext_vector_type(8)));
typedef float f32x4 __attribute__((ext_vector_type(4)));
typedef float f32x2 __attribute__((ext_vector_type(2)));
typedef unsigned u32x4 __attribute__((ext_vector_type(4)));
typedef unsigned u32x2 __attribute__((ext_vector_type(2)));
constexpr int BM = 256, BK = 64, HALF = 128, HTB = HALF * BK * 2  , STAGE_BYTES = 8 * HTB, NXCD = 8, WGM = 8;

__host__ __device__ __forceinline__ int lds_byte(int r, int c) { const int st = (r >> 4) * 2 + (c >> 5), rr = r & 15, cc = c & 31, ob = rr * 64 + cc * 2; return st * 1024 + (ob ^ (((ob >> 9) & 1) << 5)); }
__host__ __device__ __forceinline__ void stage_rc(int b, int& R, int& C) { const int st = b / 1024, sb = b % 1024, swz = sb ^ (((sb >> 9) & 1) << 5); R = (st >> 1) * 16 + swz / 64; C = (st & 1) * 32 + (swz % 64) / 2; }
__host__ __device__ __forceinline__ int perm32(int rho) { const int n = rho >> 4, i = rho & 15; return 8 * (i >> 2) + 4 * n + (i & 3); }

struct Unit { int pm, pn, sub; };

struct StaticOrder {
    int nM, nN, nwg, G, c;
    __host__ __device__ void init(int M, int N, int G_, int c_) { nM = M / BM; nN = N / BM; nwg = nM * nN; G = G_; c = c_; }
    __host__ __device__ bool tile(int i, Unit& u) const {
        const long L = (long)i * G + c; if (L >= nwg) return false;
        int wgid = (int)L; { const int q = nwg / NXCD, r = nwg % NXCD, xcd = wgid % NXCD, off = wgid / NXCD; wgid = (xcd < r ? xcd * (q + 1) : r * (q + 1) + (xcd - r) * q) + off; }
        const int nig = WGM * nN, gid = wgid / nig, fm = gid * WGM, gsz = (nM - fm) < WGM ? (nM - fm) : WGM;
        u.pm = fm + ((wgid % nig) % gsz); u.pn = (wgid % nig) / gsz; u.sub = 0; return true;
    }
};
struct SchedPlain {
    StaticOrder o; const char* A; const char* B; size_t tstep;
    __device__ __forceinline__ bool next(int i, Unit& u) const { return o.tile(i, u); }
    __device__ __forceinline__ void ptrs(const Unit& u, const char*& a, const char*& b) const { a = A + (size_t)u.pm * tstep; b = B + (size_t)u.pn * tstep; }
};
struct SchedMerge {
    StaticOrder o; const char* A0; const char* B0; const char* A1; const char* B1; size_t tstep;
    __device__ __forceinline__ bool next(int i, Unit& u) const { const bool ok = o.tile(i >> 1, u); u.sub = i & 1; return ok; }
    __device__ __forceinline__ void ptrs(const Unit& u, const char*& a, const char*& b) const { a = (u.sub ? A1 : A0) + (size_t)u.pm * tstep; b = (u.sub ? B1 : B0) + (size_t)u.pn * tstep; }
};

typedef __bf16 bf16x2v __attribute__((ext_vector_type(2)));
__device__ __forceinline__ unsigned cvt_pk_bf16(float lo, float hi) { const bf16x2v v = __builtin_convertvector((f32x2){lo, hi}, bf16x2v); return __builtin_bit_cast(unsigned, v); }
__device__ __forceinline__ float bf_lo(unsigned w) { return __uint_as_float(w << 16); }
__device__ __forceinline__ float bf_hi(unsigned w) { return __uint_as_float(w & 0xffff0000u); }
__device__ __forceinline__ f32x2 gelu_pk(f32x2 v) {
    const f32x2 av = __builtin_elementwise_abs(v), d = av * 0.2316418882f + 1.0f;
    f32x2 t; t.x = __builtin_amdgcn_rcpf(d.x); t.y = __builtin_amdgcn_rcpf(d.y);
    f32x2 q = t * 0.5307027145f + (-0.7265760135f); q = q * t + 0.7107068705f; q = q * t + (-0.142248368f); q = q * t + 0.127414796f; q = q * t;
    const f32x2 s = (v * v) * (-0.72134752044f);
    f32x2 e; e.x = __builtin_amdgcn_exp2f(s.x); e.y = __builtin_amdgcn_exp2f(s.y);
    const f32x2 m = v * (q * e), r = v - m;
    f32x2 o; o.x = v.x < 0.f ? m.x : r.x; o.y = v.y < 0.f ? m.y : r.y; return o;
}
__device__ __forceinline__ float sigmoid_f(float x) { return __builtin_amdgcn_rcpf(1.0f + __builtin_amdgcn_exp2f(x * -1.44269504089f)); }
__device__ __forceinline__ f32x4 gelu4(f32x4 v) { const f32x2 a = gelu_pk((f32x2){v[0], v[1]}), b = gelu_pk((f32x2){v[2], v[3]}); return (f32x4){a.x, a.y, b.x, b.y}; }
__device__ __forceinline__ f32x4 sigm4(f32x4 v) { return (f32x4){sigmoid_f(v[0]), sigmoid_f(v[1]), sigmoid_f(v[2]), sigmoid_f(v[3])}; }
__device__ __forceinline__ u32x4 pack8(f32x4 v0, f32x4 v1) { u32x4 w; w.x = cvt_pk_bf16(v0[0], v0[1]); w.y = cvt_pk_bf16(v0[2], v0[3]); w.z = cvt_pk_bf16(v1[0], v1[1]); w.w = cvt_pk_bf16(v1[2], v1[3]); return w; }

struct EpiProj {
    static constexpr bool PERM = true;
    bf16_t* base; int M;
    __device__ __forceinline__ bool keep(const Unit&) const { return false; }
    template <int ACT> __device__ __forceinline__ void store(const f32x4 (&acc)[2][2][4][2], bf16_t* O, int ldc, int row0, int col0) const {
#pragma unroll
        for (int ai = 0; ai < 2; ++ai)
#pragma unroll
            for (int m = 0; m < 4; ++m) { bf16_t* rowp = O + (size_t)(row0 + ai * HALF + m * 16) * ldc + col0;
#pragma unroll
                for (int bj = 0; bj < 2; ++bj) { f32x4 v0 = acc[ai][bj][m][0], v1 = acc[ai][bj][m][1];
                    if (ACT == 1) { v0 = gelu4(v0); v1 = gelu4(v1); }
                    if (ACT == 2) { v0 = sigm4(v0); v1 = sigm4(v1); }
                    *(u32x4*)(rowp + bj * HALF) = pack8(v0, v1); } }
    }
    __device__ __forceinline__ void operator()(f32x4 (&acc)[2][2][4][2], const Unit& u, int wr, int wc, int fr, int fq) const {
        const int row0 = u.pm * BM + wr * 64 + fr, pn = u.pn;
        if (pn < 40) { const int t = pn >> 3; bf16_t* O = base + (size_t)t * M * 2048; const int col0 = (pn & 7) * BM + wc * 32 + 8 * fq;
            if (t < 2) store<1>(acc, O, 2048, row0, col0); else store<0>(acc, O, 2048, row0, col0); }
        else { const int t = (pn - 40) >> 4; bf16_t* O = base + (size_t)5 * M * 2048 + (size_t)t * M * 4096; const int col0 = ((pn - 40) & 15) * BM + wc * 32 + 8 * fq;
            store<2>(acc, O, 4096, row0, col0); }
    }
};
struct EpiMerge {
    static constexpr bool PERM = true;
    const bf16_t* GA; const bf16_t* GB; bf16_t* O;
    __device__ __forceinline__ bool keep(const Unit& u) const { return u.sub == 0; }
    __device__ __forceinline__ void operator()(f32x4 (&acc)[2][2][4][2], const Unit& u, int wr, int wc, int fr, int fq) const {
        const int row0 = u.pm * BM + wr * 64 + fr, col0 = u.pn * BM + wc * 32 + 8 * fq;
        if (u.sub == 0) {
#pragma unroll
            for (int ai = 0; ai < 2; ++ai)
#pragma unroll
                for (int m = 0; m < 4; ++m) { const size_t off = (size_t)(row0 + ai * HALF + m * 16) * 4096 + col0;
#pragma unroll
                    for (int bj = 0; bj < 2; ++bj) { const u32x4 a = *(const u32x4*)(GA + off + bj * HALF), b = *(const u32x4*)(GB + off + bj * HALF);
                        f32x4 r0, r1;
                        r0[0] = bf_lo(a.x) * __builtin_amdgcn_rcpf(bf_lo(b.x)); r0[1] = bf_hi(a.x) * __builtin_amdgcn_rcpf(bf_hi(b.x));
                        r0[2] = bf_lo(a.y) * __builtin_amdgcn_rcpf(bf_lo(b.y)); r0[3] = bf_hi(a.y) * __builtin_amdgcn_rcpf(bf_hi(b.y));
                        r1[0] = bf_lo(a.z) * __builtin_amdgcn_rcpf(bf_lo(b.z)); r1[1] = bf_hi(a.z) * __builtin_amdgcn_rcpf(bf_hi(b.z));
                        r1[2] = bf_lo(a.w) * __builtin_amdgcn_rcpf(bf_lo(b.w)); r1[3] = bf_hi(a.w) * __builtin_amdgcn_rcpf(bf_hi(b.w));
                        acc[ai][bj][m][0] *= r0; acc[ai][bj][m][1] *= r1; } }
        } else {
#pragma unroll
            for (int ai = 0; ai < 2; ++ai)
#pragma unroll
                for (int m = 0; m < 4; ++m) { const size_t off = (size_t)(row0 + ai * HALF + m * 16) * 4096 + col0;
#pragma unroll
                    for (int bj = 0; bj < 2; ++bj) { const u32x4 b = *(const u32x4*)(GB + off + bj * HALF);
                        const f32x4 s0 = (f32x4){bf_lo(b.x), bf_hi(b.x), bf_lo(b.y), bf_hi(b.y)}, s1 = (f32x4){bf_lo(b.z), bf_hi(b.z), bf_lo(b.w), bf_hi(b.w)};
                        *(u32x4*)(O + off + bj * HALF) = pack8(acc[ai][bj][m][0] * s0, acc[ai][bj][m][1] * s1); } }
        }
    }
};
struct EpiResF32 {
    static constexpr bool PERM = false;
    const float* res; float* out;
    __device__ __forceinline__ bool keep(const Unit&) const { return false; }
    __device__ __forceinline__ void operator()(f32x4 (&acc)[2][2][4][2], const Unit& u, int wr, int wc, int fr, int fq) const {
        const int row0 = u.pm * BM + wr * 64 + fr, col0 = u.pn * BM + wc * 32 + 4 * fq;
#pragma unroll
        for (int ai = 0; ai < 2; ++ai)
#pragma unroll
            for (int m = 0; m < 4; ++m) { const size_t off = (size_t)(row0 + ai * HALF + m * 16) * 4096 + col0;
#pragma unroll
                for (int bj = 0; bj < 2; ++bj)
#pragma unroll
                    for (int n = 0; n < 2; ++n) { const f32x4 r = *(const f32x4*)(res + off + bj * HALF + n * 16); *(f32x4*)(out + off + bj * HALF + n * 16) = r + acc[ai][bj][m][n]; } }
    }
};
struct EpiSwiglu {
    static constexpr bool PERM = true;
    bf16_t* O; int ldc;
    __device__ __forceinline__ bool keep(const Unit&) const { return false; }
    __device__ __forceinline__ void operator()(f32x4 (&acc)[2][2][4][2], const Unit& u, int wr, int wc, int fr, int fq) const {
        const int row0 = u.pm * BM + wr * 64 + fr, col0 = u.pn * HALF + wc * 32 + 8 * fq;
#pragma unroll
        for (int ai = 0; ai < 2; ++ai)
#pragma unroll
            for (int m = 0; m < 4; ++m) { bf16_t* rowp = O + (size_t)(row0 + ai * HALF + m * 16) * ldc + col0;
                const f32x4 g0 = acc[ai][0][m][0], g1 = acc[ai][0][m][1];
                const f32x4 v0 = g0 * sigm4(g0) * acc[ai][1][m][0], v1 = g1 * sigm4(g1) * acc[ai][1][m][1];
                *(u32x4*)rowp = pack8(v0, v1); }
    }
};

template <class Epi, class Sched, bool ALIGN_EPI, bool SP2>
__device__ __forceinline__ void gemm_phase(PG8_LAS unsigned char* lds, const int K, const Sched& S, const Epi& E) {
    const int tid = threadIdx.x, wid = __builtin_amdgcn_readfirstlane(tid >> 6), lane = tid & 63, wr = wid >> 2, wc = wid & 3, fr = lane & 15, fq = lane >> 4;
    const int nt = K / BK;
    unsigned voffA[2], voffB[2];
#pragma unroll
    for (int i = 0; i < 2; ++i) { int R, C; stage_rc(tid * 16 + i * 8192, R, C); const int Rb = Epi::PERM ? ((R & ~31) + perm32(R & 31)) : R;
        voffA[i] = (unsigned)(R * K + C) * 2u; voffB[i] = (unsigned)(Rb * K + C) * 2u; }
    const size_t kstep = (size_t)(BK * 2);
    const size_t hstep = (size_t)HALF * K * 2;
    const unsigned ldsw = (unsigned)wid * 1024u;
    const int aoff = lds_byte(wr * 64 + fr, fq * 8), boff = lds_byte(wc * 32 + fr, fq * 8);
#define PG8_SA(b, h) (((b) * 2 + (h)) * HTB)
#define PG8_SB(b, h) ((4 + (b) * 2 + (h)) * HTB)
#define PG8_STAGE(bufoff, gbase, voff) do { _Pragma("unroll") for (int _i = 0; _i < 2; ++_i) \
        __builtin_amdgcn_global_load_lds((const unsigned*)((const char*)(gbase) + (voff)[_i]), (PG8_LAS unsigned*)(lds + (bufoff) + ldsw + _i * 8192), 16, 0, 0); } while (0)
#define PG8_LDA(dst, b, h) do { _Pragma("unroll") for (int m = 0; m < 4; ++m) _Pragma("unroll") for (int k = 0; k < 2; ++k) dst[m][k] = *(const PG8_LAS bf16x8*)(lds + PG8_SA(b, h) + aoff + m * 2048 + k * 1024); } while (0)
#define PG8_LDB(dst, b, h) do { _Pragma("unroll") for (int n = 0; n < 2; ++n) _Pragma("unroll") for (int k = 0; k < 2; ++k) dst[n][k] = *(const PG8_LAS bf16x8*)(lds + PG8_SB(b, h) + boff + n * 2048 + k * 1024); } while (0)
#define PG8_MMA(ai, bj, At, Bt) do { __builtin_amdgcn_s_setprio(1); _Pragma("unroll") for (int m = 0; m < 4; ++m) _Pragma("unroll") for (int n = 0; n < 2; ++n) _Pragma("unroll") for (int k = 0; k < 2; ++k) \
        acc[ai][bj][m][n] = __builtin_amdgcn_mfma_f32_16x16x32_bf16(Bt[n][k], At[m][k], acc[ai][bj][m][n], 0, 0, 0); __builtin_amdgcn_s_setprio(0); } while (0)
#define PG8_WAIT_V(n) asm volatile("s_waitcnt vmcnt(" #n ")" ::: "memory")
#define PG8_WAIT_L(n) asm volatile("s_waitcnt lgkmcnt(" #n ")" ::: "memory")
#define PG8_BAR __builtin_amdgcn_s_barrier()
#define PG8_SCHED __builtin_amdgcn_sched_barrier(0)
    Unit cur, nxt; int ui = 0;
    if (!S.next(0, cur)) return;
    f32x4 acc[2][2][4][2];
#pragma unroll
    for (int a = 0; a < 2; ++a)
#pragma unroll
        for (int b = 0; b < 2; ++b)
#pragma unroll
            for (int m = 0; m < 4; ++m)
#pragma unroll
                for (int n = 0; n < 2; ++n) acc[a][b][m][n] = (f32x4){0.f, 0.f, 0.f, 0.f};
    bf16x8 At[4][2], B0[2][2], B1[2][2];
    const char* cA; const char* cB; S.ptrs(cur, cA, cB);
    if constexpr (SP2) {
        PG8_STAGE(PG8_SB(0, 0), cB, voffB); PG8_STAGE(PG8_SB(0, 1), cB + hstep, voffB); PG8_STAGE(PG8_SA(0, 0), cA, voffA); PG8_STAGE(PG8_SA(0, 1), cA + hstep, voffA);
        if (wr == 1) PG8_BAR;
        PG8_WAIT_V(2); PG8_BAR;
        PG8_STAGE(PG8_SB(1, 0), cB + kstep, voffB); PG8_STAGE(PG8_SA(1, 0), cA + kstep, voffA); PG8_STAGE(PG8_SB(1, 1), cB + hstep + kstep, voffB);
        PG8_WAIT_V(6); PG8_BAR;
    } else {
        PG8_STAGE(PG8_SB(0, 0), cB, voffB); PG8_STAGE(PG8_SA(0, 0), cA, voffA); PG8_STAGE(PG8_SB(0, 1), cB + hstep, voffB); PG8_STAGE(PG8_SA(0, 1), cA + hstep, voffA);
        if (wr == 1) PG8_BAR;
        PG8_WAIT_V(4); PG8_BAR;
        PG8_STAGE(PG8_SB(1, 0), cB + kstep, voffB); PG8_STAGE(PG8_SA(1, 0), cA + kstep, voffA); PG8_STAGE(PG8_SB(1, 1), cB + hstep + kstep, voffB);
        PG8_WAIT_V(6); PG8_BAR;
    }
    for (;;) {
        const bool has_next = S.next(ui + 1, nxt);
        const char* nA = cA; const char* nB = cB; if (has_next) S.ptrs(nxt, nA, nB);
        for (int t = 0; t < nt; t += 2) {
            const bool last = (t == nt - 2);
            const char* a1 = cA + (size_t)(t + 1) * kstep;
            const char* a2 = last ? nA : cA + (size_t)(t + 2) * kstep; const char* b2 = last ? nB : cB + (size_t)(t + 2) * kstep;
            const char* a3 = a2 + kstep; const char* b3 = b2 + kstep;
            if constexpr (SP2) {
            PG8_LDB(B0, 0, 0); PG8_LDB(B1, 0, 1); PG8_SCHED; PG8_LDA(At, 0, 0); PG8_STAGE(PG8_SA(1, 1), a1 + hstep, voffA);
            PG8_WAIT_V(8); PG8_WAIT_L(0); PG8_BAR; PG8_MMA(0, 0, At, B0); PG8_MMA(0, 1, At, B1); PG8_BAR; PG8_SCHED;
            PG8_LDA(At, 0, 1); PG8_STAGE(PG8_SB(0, 0), b2, voffB); PG8_STAGE(PG8_SB(0, 1), b2 + hstep, voffB); PG8_STAGE(PG8_SA(0, 0), a2, voffA);
            PG8_WAIT_V(8); PG8_WAIT_L(0); PG8_BAR; PG8_MMA(1, 0, At, B0); PG8_MMA(1, 1, At, B1); PG8_BAR; PG8_SCHED;
            PG8_LDB(B0, 1, 0); PG8_LDB(B1, 1, 1); PG8_SCHED; PG8_LDA(At, 1, 0); PG8_STAGE(PG8_SA(0, 1), a2 + hstep, voffA);
            PG8_WAIT_V(8); PG8_WAIT_L(0); PG8_BAR; PG8_MMA(0, 0, At, B0); PG8_MMA(0, 1, At, B1); PG8_BAR; PG8_SCHED;
            PG8_LDA(At, 1, 1); PG8_STAGE(PG8_SB(1, 0), b3, voffB); PG8_STAGE(PG8_SB(1, 1), b3 + hstep, voffB); PG8_STAGE(PG8_SA(1, 0), a3, voffA);
            PG8_WAIT_V(8); PG8_WAIT_L(0); PG8_BAR; PG8_MMA(1, 0, At, B0); PG8_MMA(1, 1, At, B1); PG8_BAR; PG8_SCHED;
            } else {
            PG8_LDB(B0, 0, 0); PG8_SCHED; PG8_LDA(At, 0, 0); PG8_STAGE(PG8_SA(1, 1), a1 + hstep, voffA);
            PG8_WAIT_L(8); PG8_BAR; PG8_WAIT_L(0); PG8_MMA(0, 0, At, B0); PG8_BAR; PG8_SCHED;
            PG8_LDB(B1, 0, 1); PG8_STAGE(PG8_SB(0, 0), b2, voffB);
            PG8_BAR; PG8_WAIT_L(0); PG8_MMA(0, 1, At, B1); PG8_BAR;
            PG8_LDA(At, 0, 1); PG8_STAGE(PG8_SA(0, 0), a2, voffA);
            PG8_BAR; PG8_WAIT_L(0); PG8_MMA(1, 0, At, B0); PG8_BAR; PG8_SCHED;
            PG8_STAGE(PG8_SB(0, 1), b2 + hstep, voffB);
            PG8_WAIT_V(6); PG8_BAR; PG8_MMA(1, 1, At, B1); PG8_BAR;
            PG8_LDB(B0, 1, 0); PG8_SCHED; PG8_LDA(At, 1, 0); PG8_STAGE(PG8_SA(0, 1), a2 + hstep, voffA);
            PG8_WAIT_L(8); PG8_BAR; PG8_WAIT_L(0); PG8_MMA(0, 0, At, B0); PG8_BAR; PG8_SCHED;
            PG8_LDB(B1, 1, 1); PG8_STAGE(PG8_SB(1, 0), b3, voffB);
            PG8_BAR; PG8_WAIT_L(0); PG8_MMA(0, 1, At, B1); PG8_BAR;
            PG8_LDA(At, 1, 1); PG8_STAGE(PG8_SA(1, 0), a3, voffA);
            PG8_BAR; PG8_WAIT_L(0); PG8_MMA(1, 0, At, B0); PG8_BAR; PG8_SCHED;
            PG8_STAGE(PG8_SB(1, 1), b3 + hstep, voffB);
            PG8_WAIT_V(6); PG8_BAR; PG8_MMA(1, 1, At, B1); PG8_BAR;
            }
        }
        if constexpr (ALIGN_EPI) { if (wr == 0) PG8_BAR; }
        E(acc, cur, wr, wc, fr, fq);
        if (!has_next) break;
        if (!E.keep(cur)) {
#pragma unroll
            for (int a = 0; a < 2; ++a)
#pragma unroll
                for (int b = 0; b < 2; ++b)
#pragma unroll
                    for (int m = 0; m < 4; ++m)
#pragma unroll
                        for (int n = 0; n < 2; ++n) acc[a][b][m][n] = (f32x4){0.f, 0.f, 0.f, 0.f};
        }
        cur = nxt; cA = nA; cB = nB; ++ui;
        if constexpr (ALIGN_EPI) { if (wr == 1) PG8_BAR; }
    }
    PG8_WAIT_V(0);
    if constexpr (!ALIGN_EPI) { if (wr == 0) PG8_BAR; }
    PG8_BAR;
#undef PG8_SA
#undef PG8_SB
#undef PG8_STAGE
#undef PG8_LDA
#undef PG8_LDB
#undef PG8_MMA
#undef PG8_WAIT_V
#undef PG8_WAIT_L
#undef PG8_BAR
#undef PG8_SCHED
}
}

constexpr int NWAVES = 8;
constexpr int N_LAUNCHES = MK_N_LAUNCHES;
constexpr int PER_PHASE = 8;
constexpr int M = 16384, D = 4096, NIN = 18432, GMW = 2048, NAW = 2048, DFF = 11008, NGU = 2 * DFF;
constexpr int GRID_W = 64, GRID_H = M / GRID_W, NHEAD = 16, HD = 128, CHUNK = 128, NGROUP = 16;
constexpr float RMS_EPS = 1e-6f, LN_EPS = 1e-5f;

constexpr size_t MiB = 1u << 20;
constexpr size_t WS_CTL = 0, CTL_ZERO_BYTES = 1 * MiB;
constexpr size_t WS_WSB = 1 * MiB;
constexpr size_t WS_WIN = 4 * MiB;
constexpr size_t WS_WOA = 148 * MiB, WS_WOB = 164 * MiB;
constexpr size_t WS_WOUT = 180 * MiB;
constexpr size_t WS_RA = 212 * MiB;
constexpr size_t WS_YA = WS_RA, WS_YB = WS_RA + 64 * MiB;
constexpr size_t WS_RB = 340 * MiB;
constexpr size_t WS_U = WS_RB, WS_V = WS_RB + 64 * MiB, WS_Q = WS_RB + 128 * MiB, WS_K = WS_RB + 192 * MiB, WS_VV = WS_RB + 256 * MiB, WS_GA = WS_RB + 320 * MiB, WS_GB = WS_RB + 448 * MiB;
constexpr size_t WS_MRG = WS_RB;
constexpr size_t WS_ACT = WS_RB;
constexpr size_t WS_WGU = WS_WIN;
constexpr size_t WS_WD = WS_GB;
constexpr size_t WS_END = 916 * MiB;
static_assert(WS_WGU + (size_t)NGU * D * 2 <= WS_WOUT && WS_ACT + (size_t)M * DFF * 2 <= WS_WD && WS_WD + (size_t)D * DFF * 2 <= WS_END && WS_GB + (size_t)M * D * 2 == WS_END, "d_ws map");
constexpr int CW_BAR = 4096;
constexpr int RING_BYTES = 131072;
constexpr int LDSCTL_OFF = RING_BYTES, MISC_OFF = LDSCTL_OFF + 320;
constexpr int LDS_BYTES = 147456;

#define GAS __attribute__((address_space(1)))
#define LAS __attribute__((address_space(3)))
typedef unsigned short bf16;
typedef unsigned v4u __attribute__((ext_vector_type(4)));
typedef unsigned v2u __attribute__((ext_vector_type(2)));
typedef float f32x4 __attribute__((ext_vector_type(4)));
typedef float f32x2 __attribute__((ext_vector_type(2)));
typedef short bf16x8 __attribute__((ext_vector_type(8)));
typedef GAS unsigned gu32;
#define RLX_AGENT __ATOMIC_RELAXED, __HIP_MEMORY_SCOPE_AGENT
#define LDS_WAIT() asm volatile("s_waitcnt lgkmcnt(0)" ::: "memory")
#define VM_WAIT() asm volatile("s_waitcnt vmcnt(0)" ::: "memory")
__device__ __forceinline__ unsigned f2bf(float f) { unsigned u = __builtin_bit_cast(unsigned, f); return (u + 0x7fffu + ((u >> 16) & 1u)) >> 16; }
__device__ __forceinline__ unsigned pk2(float lo, float hi) { return f2bf(lo) | (f2bf(hi) << 16); }
__device__ __forceinline__ float bflo(unsigned w) { return __uint_as_float(w << 16); }
__device__ __forceinline__ float bfhi(unsigned w) { return __uint_as_float(w & 0xffff0000u); }

#define XB_TMO      128
#define XB_XCNT(j)  (256  + 64 * (j))
#define XB_XSUB(j)  (1280 + 64 * (j))
#define XB_XGEN(j)  (2304 + 64 * (j))
#define XB_TOP      3328
#define XB_TOPGEN   3392
#define XCD_BAR_WORDS 3456
#define XB_SPIN_CAP (1u << 20)

__device__ __forceinline__ unsigned xb_ld(unsigned* p)              { return __hip_atomic_load(p, __ATOMIC_RELAXED, __HIP_MEMORY_SCOPE_AGENT); }
__device__ __forceinline__ unsigned xb_add(unsigned* p, unsigned v) { return __hip_atomic_fetch_add(p, v, __ATOMIC_RELAXED, __HIP_MEMORY_SCOPE_AGENT); }
__device__ __forceinline__ unsigned xb_xcc_id() { return (unsigned)__builtin_amdgcn_s_getreg((3 << 11) | 20) & 0xFu; }
#define XB_SPIN(cond, bar) do { unsigned _sp = 0; while (cond) { __builtin_amdgcn_s_sleep(1); \
    if ((++_sp & 255u) == 0u) { if (xb_ld(&(bar)[XB_TMO])) break; if (_sp > XB_SPIN_CAP) { atomicAdd(&(bar)[XB_TMO], 1u); break; } } } } while (0)

struct XcdBarrier {
    unsigned* bar; unsigned x;
    volatile LAS unsigned* st;
};
__device__ __forceinline__ XcdBarrier xcd_barrier_post(unsigned* bar, volatile LAS unsigned* st) {
    XcdBarrier b; b.bar = bar; b.x = xb_xcc_id(); b.st = st;
    if (threadIdx.x == 0) (void)xb_add(&bar[XB_XCNT(b.x)], 1u);
    return b;
}
__device__ __forceinline__ void xcd_barrier_complete(unsigned* bar, unsigned x, unsigned& nloc, unsigned& nx) {
    const unsigned G = gridDim.x * gridDim.y * gridDim.z;
    unsigned sum, cnt, mine, sp = 0u;
    for (;;) {
        sum = 0u; cnt = 0u; mine = 0u;
#pragma unroll
        for (unsigned j = 0; j < 16; ++j) { const unsigned c = xb_ld(&bar[XB_XCNT(j)]); sum += c; cnt += (c > 0u) ? 1u : 0u; mine = (j == x) ? c : mine; }
        if (sum == G) break;
        __builtin_amdgcn_s_sleep(1);
        if ((++sp & 255u) == 0u) { if (xb_ld(&bar[XB_TMO])) break; if (sp > XB_SPIN_CAP) { atomicAdd(&bar[XB_TMO], 1u); break; } }
    }
    nloc = mine > 0u ? mine : 1u; nx = cnt > 0u ? cnt : 1u;
}
__device__ __forceinline__ void xcd_barrier(const XcdBarrier& b) {
    asm volatile("s_waitcnt vmcnt(0)" ::: "memory");
    __syncthreads();
    if (threadIdx.x == 0) {
        unsigned* bar = b.bar;
        __builtin_amdgcn_s_waitcnt(0);
        unsigned nloc = b.st[0], nx = b.st[1];
        if (nloc == 0u) { xcd_barrier_complete(bar, b.x, nloc, nx); b.st[0] = nloc; b.st[1] = nx; }
        const unsigned old = xb_add(&bar[XB_XSUB(b.x)], 1u);
        const unsigned gen = old / nloc;
        if (old + 1u == (gen + 1u) * nloc) {
            __builtin_amdgcn_fence(__ATOMIC_RELEASE, "agent");
            asm volatile("s_waitcnt vmcnt(0)" ::: "memory");
            const unsigned og = xb_add(&bar[XB_TOP], 1u);
            const unsigned tg = og / nx;
            if (og + 1u == (tg + 1u) * nx) xb_add(&bar[XB_TOPGEN], 1u);
            else XB_SPIN(xb_ld(&bar[XB_TOPGEN]) == tg, bar);
            __builtin_amdgcn_fence(__ATOMIC_ACQUIRE, "agent");
            xb_add(&bar[XB_XGEN(b.x)], 1u);
            asm volatile("s_waitcnt vmcnt(0)" ::: "memory");
        } else {
            XB_SPIN(xb_ld(&bar[XB_XGEN(b.x)]) == gen, bar);
            __builtin_amdgcn_fence(__ATOMIC_ACQUIRE, "agent");
            asm volatile("s_waitcnt vmcnt(0)" ::: "memory");
        }
    }
    __syncthreads();
}

struct Frame {
    LAS unsigned char* lds;
    volatile LAS unsigned* MISC;
    gu32* ctl;
    int tid, lane, wave;
    int vcu, G;
    unsigned char* ws;
    const float *x, *norm1_g, *w_in, *gm_ln_g, *gm_ln_b, *gm_w_s, *gm_b_s, *q_gain, *k_gain, *na_rpb, *w_o_gm, *w_o_na, *w_out, *norm2_g, *w_ff_gate, *w_ff_up, *w_ff_down;
    float* out;
};
__device__ __forceinline__ float wave_sum(float v) {
#pragma unroll
    for (int o = 1; o < 64; o <<= 1) v += __shfl_xor(v, o);
    return v;
}
__device__ __forceinline__ float wave_max(float v) {
#pragma unroll
    for (int o = 1; o < 64; o <<= 1) v = fmaxf(v, __shfl_xor(v, o));
    return v;
}
__device__ __forceinline__ void tr_item(const float* W, int ldw, int k0, int n0, bf16* dst, int ldk, LAS float* scr, int lane) {
#pragma unroll 8
    for (int i = 0; i < 32; ++i) { const int kk = 2 * i + (lane >> 5); scr[kk * 33 + (lane & 31)] = W[(size_t)(k0 + kk) * ldw + n0 + (lane & 31)]; }
    LDS_WAIT(); asm volatile("" ::: "memory");
    const int c = lane & 7;
#pragma unroll
    for (int j = 0; j < 4; ++j) { const int n = (lane >> 3) + 8 * j; const LAS float* s = scr + (8 * c) * 33 + n;
        v4u o; o.x = pk2(s[0 * 33], s[1 * 33]); o.y = pk2(s[2 * 33], s[3 * 33]); o.z = pk2(s[4 * 33], s[5 * 33]); o.w = pk2(s[6 * 33], s[7 * 33]);
        *(GAS v4u*)(dst + (size_t)n * ldk + 8 * c) = o; }
    LDS_WAIT(); asm volatile("" ::: "memory");
}
__device__ __forceinline__ void tr_matrix(Frame& F, const float* W, int K, int N, bf16* WT, LAS float* scr) {
    const int gw = F.vcu * NWAVES + F.wave, NGW = F.G * NWAVES, nblk = N / 32, nitems = (K / 64) * nblk;
    for (int it = gw; it < nitems; it += NGW) { const int kb = it / nblk, nb = it % nblk; tr_item(W, N, 64 * kb, 32 * nb, WT + (size_t)(32 * nb) * K + 64 * kb, K, scr, F.lane); }
}
__device__ __forceinline__ void rms_row_to_bf16(Frame& F, const float* xrow, const float* gain, bf16* orow) {
    const GAS f32x4* xr = (const GAS f32x4*)xrow + F.lane;
    f32x4 v[16]; float s = 0.f;
#pragma unroll
    for (int j = 0; j < 16; ++j) { v[j] = xr[64 * j]; s += (v[j].x * v[j].x + v[j].y * v[j].y) + (v[j].z * v[j].z + v[j].w * v[j].w); }
    const float rstd = 1.f / sqrtf(wave_sum(s) * (1.f / D) + RMS_EPS);
    const GAS f32x4* gr = (const GAS f32x4*)gain + F.lane;
    GAS v2u* o8 = (GAS v2u*)orow + F.lane;
#pragma unroll
    for (int j = 0; j < 16; ++j) { const f32x4 g = gr[64 * j]; v2u o; o.x = pk2(v[j].x * rstd * g.x, v[j].y * rstd * g.y); o.y = pk2(v[j].z * rstd * g.z, v[j].w * rstd * g.w); o8[64 * j] = o; }
}

__device__ __forceinline__ void p0_prologue(Frame& F) {
    LAS float* scr = (LAS float*)(F.lds + F.wave * 16384);
    tr_matrix(F, F.w_in, D, NIN, (bf16*)(F.ws + WS_WIN), scr);
    tr_matrix(F, F.w_o_gm, GMW, D, (bf16*)(F.ws + WS_WOA), scr);
    tr_matrix(F, F.w_o_na, NAW, D, (bf16*)(F.ws + WS_WOB), scr);
    tr_matrix(F, F.w_out, D, D, (bf16*)(F.ws + WS_WOUT), scr);
    const int gw = F.vcu * NWAVES + F.wave, NGW = F.G * NWAVES;
    { bf16* wsb = (bf16*)(F.ws + WS_WSB);
      for (int i = gw * 64 + F.lane; i < NGROUP * CHUNK * CHUNK / 4; i += NGW * 64) { const f32x4 v = ((const GAS f32x4*)F.gm_w_s)[i]; v2u o; o.x = pk2(v.x, v.y); o.y = pk2(v.z, v.w); ((GAS v2u*)wsb)[i] = o; } }
    bf16* XN = (bf16*)(F.ws + WS_RA);
    for (int m = gw; m < M; m += NGW) rms_row_to_bf16(F, F.x + (size_t)m * D, F.norm1_g, XN + (size_t)m * D);
}
__device__ __forceinline__ void p5_norm_and_ffn_weights(Frame& F) {
    LAS float* scr = (LAS float*)(F.lds + F.wave * 16384);
    const int gw = F.vcu * NWAVES + F.wave, NGW = F.G * NWAVES;
    bf16* WGU = (bf16*)(F.ws + WS_WGU);
    { const int nblk = DFF / 32, nitems = (D / 64) * nblk;
      for (int it = gw; it < 2 * nitems; it += NGW) { const int up = it >= nitems, r = up ? it - nitems : it, kb = r / nblk, nb = r % nblk, n0 = 32 * nb;
          const int drow = 256 * (n0 >> 7) + (n0 & 127) + (up ? 128 : 0);
          tr_item(up ? F.w_ff_up : F.w_ff_gate, DFF, 64 * kb, n0, WGU + (size_t)drow * D + 64 * kb, D, scr, F.lane); } }
    tr_matrix(F, F.w_ff_down, DFF, D, (bf16*)(F.ws + WS_WD), scr);
    bf16* HN = (bf16*)(F.ws + WS_RA);
    for (int m = gw; m < M; m += NGW) rms_row_to_bf16(F, F.out + (size_t)m * D, F.norm2_g, HN + (size_t)m * D);
}

constexpr int GM_LDW = 272;
__device__ __forceinline__ void gmlp_unit(Frame& F, int chunk) {
    LAS unsigned char* Wl = F.lds; LAS unsigned char* Vt = F.lds + 34816; LAS f32x2* st = (LAS f32x2*)(F.lds + 69632);
    const bf16* U = (const bf16*)(F.ws + WS_U); const bf16* V = (const bf16*)(F.ws + WS_V); bf16* YA = (bf16*)(F.ws + WS_YA); const bf16* WSB = (const bf16*)(F.ws + WS_WSB);
    const int tok0 = chunk * CHUNK, lane = F.lane, tid = F.tid, fr = lane & 15, fq = lane >> 4;
    __syncthreads();
    for (int t = 0; t < 16; ++t) { const int j = F.wave * 16 + t; const GAS v4u* vr = (const GAS v4u*)(V + (size_t)(tok0 + j) * GMW) + lane;
        float x[32]; float s = 0.f;
#pragma unroll
        for (int q = 0; q < 4; ++q) { const v4u w = vr[64 * q]; x[8 * q + 0] = bflo(w.x); x[8 * q + 1] = bfhi(w.x); x[8 * q + 2] = bflo(w.y); x[8 * q + 3] = bfhi(w.y); x[8 * q + 4] = bflo(w.z); x[8 * q + 5] = bfhi(w.z); x[8 * q + 6] = bflo(w.w); x[8 * q + 7] = bfhi(w.w); }
#pragma unroll
        for (int e = 0; e < 32; ++e) s += x[e];
        const float mean = wave_sum(s) * (1.f / GMW); float s2 = 0.f;
#pragma unroll
        for (int e = 0; e < 32; ++e) { const float d = x[e] - mean; s2 += d * d; }
        const float rstd = 1.f / sqrtf(wave_sum(s2) * (1.f / GMW) + LN_EPS);
        if (lane == 0) st[j] = (f32x2){mean, rstd}; }
    const int wi = F.wave >> 1, wc2 = F.wave & 1;
    for (int g = 0; g < NGROUP; ++g) {
        __syncthreads();
#pragma unroll
        for (int q = 0; q < 4; ++q) { const int idx = tid + 512 * q, row = idx >> 4, ch = idx & 15;
            *(LAS v4u*)(Wl + row * GM_LDW + ch * 16) = *(const GAS v4u*)(WSB + (size_t)g * CHUNK * CHUNK + row * CHUNK + ch * 8); }
#pragma unroll
        for (int q = 0; q < 4; ++q) { const int idx = tid + 512 * q, j = idx >> 4, ch = idx & 15, c0 = g * 128 + ch * 8;
            const v4u w = *(const GAS v4u*)(V + (size_t)(tok0 + j) * GMW + c0); const f32x2 ms = st[j];
            const f32x4 g0 = *(const GAS f32x4*)(F.gm_ln_g + c0), g1 = *(const GAS f32x4*)(F.gm_ln_g + c0 + 4), b0 = *(const GAS f32x4*)(F.gm_ln_b + c0), b1 = *(const GAS f32x4*)(F.gm_ln_b + c0 + 4);
            float y[8];
            y[0] = (bflo(w.x) - ms.x) * ms.y * g0.x + b0.x; y[1] = (bfhi(w.x) - ms.x) * ms.y * g0.y + b0.y; y[2] = (bflo(w.y) - ms.x) * ms.y * g0.z + b0.z; y[3] = (bfhi(w.y) - ms.x) * ms.y * g0.w + b0.w;
            y[4] = (bflo(w.z) - ms.x) * ms.y * g1.x + b1.x; y[5] = (bfhi(w.z) - ms.x) * ms.y * g1.y + b1.y; y[6] = (bflo(w.w) - ms.x) * ms.y * g1.z + b1.z; y[7] = (bfhi(w.w) - ms.x) * ms.y * g1.w + b1.w;
#pragma unroll
            for (int e = 0; e < 8; ++e) *(LAS unsigned short*)(Vt + (ch * 8 + e) * GM_LDW + j * 2) = (unsigned short)f2bf(y[e]); }
        __syncthreads();
        f32x4 acc[2][4];
#pragma unroll
        for (int mi = 0; mi < 2; ++mi)
#pragma unroll
            for (int ni = 0; ni < 4; ++ni) acc[mi][ni] = (f32x4){0.f, 0.f, 0.f, 0.f};
#pragma unroll
        for (int ks = 0; ks < 4; ++ks) { bf16x8 a[2], b[4];
#pragma unroll
            for (int mi = 0; mi < 2; ++mi) a[mi] = *(const LAS bf16x8*)(Wl + (32 * wi + 16 * mi + fr) * GM_LDW + (32 * ks + 8 * fq) * 2);
#pragma unroll
            for (int ni = 0; ni < 4; ++ni) b[ni] = *(const LAS bf16x8*)(Vt + (64 * wc2 + 16 * ni + fr) * GM_LDW + (32 * ks + 8 * fq) * 2);
#pragma unroll
            for (int mi = 0; mi < 2; ++mi)
#pragma unroll
                for (int ni = 0; ni < 4; ++ni) acc[mi][ni] = __builtin_amdgcn_mfma_f32_16x16x32_bf16(b[ni], a[mi], acc[mi][ni], 0, 0, 0); }
#pragma unroll
        for (int mi = 0; mi < 2; ++mi) { const int i = 32 * wi + 16 * mi + fr; const float bs = F.gm_b_s[g * CHUNK + i]; const size_t rowoff = (size_t)(tok0 + i) * GMW + g * 128;
#pragma unroll
            for (int ni = 0; ni < 4; ++ni) { const int c = 64 * wc2 + 16 * ni + 4 * fq; const v2u uu = *(const GAS v2u*)(U + rowoff + c);
                v2u o; o.x = pk2((acc[mi][ni][0] + bs) * bflo(uu.x), (acc[mi][ni][1] + bs) * bfhi(uu.x)); o.y = pk2((acc[mi][ni][2] + bs) * bflo(uu.y), (acc[mi][ni][3] + bs) * bfhi(uu.y));
                *(GAS v2u*)(YA + rowoff + c) = o; } }
    }
    __syncthreads();
}

__device__ __forceinline__ void na_unit_valu(Frame& F, int r, int h) {
    LAS float* qs = (LAS float*)(F.lds + 80 * 1024 + F.wave * 1024); LAS float* pp = qs + 128;
    const bf16* Q = (const bf16*)(F.ws + WS_Q); const bf16* Kt = (const bf16*)(F.ws + WS_K); const bf16* Vv = (const bf16*)(F.ws + WS_VV); bf16* YB = (bf16*)(F.ws + WS_YB);
    const int lane = F.lane; int rs = r - 4; rs = rs < 0 ? 0 : (rs > GRID_H - 8 ? GRID_H - 8 : rs);
    const float gq0 = F.q_gain[2 * lane], gq1 = F.q_gain[2 * lane + 1], gk0 = F.k_gain[2 * lane], gk1 = F.k_gain[2 * lane + 1];
    for (int qi = 0; qi < 8; ++qi) { const int c = F.wave * 8 + qi, tq = r * GRID_W + c; int cs = c - 8; cs = cs < 0 ? 0 : (cs > GRID_W - 16 ? GRID_W - 16 : cs);
        const unsigned qw = *(const GAS unsigned*)(Q + (size_t)tq * NAW + h * HD + 2 * lane); const float q0 = bflo(qw), q1 = bfhi(qw);
        const float rq = 1.f / sqrtf(wave_sum(q0 * q0 + q1 * q1) * (1.f / HD) + RMS_EPS);
        LDS_WAIT(); asm volatile("" ::: "memory");
        qs[2 * lane] = q0 * rq * gq0 * gk0 * 0.08838834764831845f; qs[2 * lane + 1] = q1 * rq * gq1 * gk1 * 0.08838834764831845f;
        LDS_WAIT(); asm volatile("" ::: "memory");
        float sc[2];
#pragma unroll
        for (int t = 0; t < 2; ++t) { const int kk = lane + 64 * t, i = kk >> 4, j = kk & 15, tk = (rs + i) * GRID_W + cs + j; const GAS v4u* kr = (const GAS v4u*)(Kt + (size_t)tk * NAW + h * HD);
            float dot = 0.f, ss = 0.f;
#pragma unroll 4
            for (int d8 = 0; d8 < 16; ++d8) { const v4u w = kr[d8]; const f32x4 qa = *(const LAS f32x4*)(qs + 8 * d8), qb = *(const LAS f32x4*)(qs + 8 * d8 + 4);
                const float k0 = bflo(w.x), k1 = bfhi(w.x), k2 = bflo(w.y), k3 = bfhi(w.y), k4 = bflo(w.z), k5 = bfhi(w.z), k6 = bflo(w.w), k7 = bfhi(w.w);
                dot += k0 * qa.x + k1 * qa.y + k2 * qa.z + k3 * qa.w + k4 * qb.x + k5 * qb.y + k6 * qb.z + k7 * qb.w;
                ss += k0 * k0 + k1 * k1 + k2 * k2 + k3 * k3 + k4 * k4 + k5 * k5 + k6 * k6 + k7 * k7; }
            const float rk = 1.f / sqrtf(ss * (1.f / HD) + RMS_EPS);
            sc[t] = dot * rk + F.na_rpb[(h * 15 + (rs + i - r + 7)) * 31 + (cs + j - c + 15)]; }
        const float mx = wave_max(fmaxf(sc[0], sc[1]));
        const float e0 = __expf(sc[0] - mx), e1 = __expf(sc[1] - mx);
        const float inv = 1.f / wave_sum(e0 + e1);
        pp[lane] = e0 * inv; pp[lane + 64] = e1 * inv;
        LDS_WAIT(); asm volatile("" ::: "memory");
        float o0 = 0.f, o1 = 0.f;
#pragma unroll 8
        for (int kk = 0; kk < 128; ++kk) { const int i = kk >> 4, j = kk & 15, tk = (rs + i) * GRID_W + cs + j; const unsigned vw = *(const GAS unsigned*)(Vv + (size_t)tk * NAW + h * HD + 2 * lane);
            const float p = pp[kk]; o0 += p * bflo(vw); o1 += p * bfhi(vw); }
        *(GAS unsigned*)(YB + (size_t)tq * NAW + h * HD + 2 * lane) = pk2(o0, o1);
    }
}

struct Args { const float* in[17]; float* out; unsigned char* ws; int ph_lo, ph_hi, li, pad; };
__global__ void __launch_bounds__(NWAVES * 64, 2) fwd_kernel(Args args) {
    extern __shared__ __attribute__((aligned(16))) unsigned char lds[];
    Frame F;
    F.lds = (LAS unsigned char*)lds;
    F.MISC = (volatile LAS unsigned*)(F.lds + MISC_OFF);
    F.tid = threadIdx.x; F.lane = F.tid & 63; F.wave = __builtin_amdgcn_readfirstlane(F.tid >> 6);
    F.G = gridDim.x; { const int bx = blockIdx.x; F.vcu = (F.G % 8 == 0) ? (bx % 8) * (F.G / 8) + bx / 8 : bx; }
    F.ws = args.ws; F.ctl = (gu32*)(args.ws + WS_CTL);
    F.x = args.in[0]; F.norm1_g = args.in[1]; F.w_in = args.in[2]; F.gm_ln_g = args.in[3]; F.gm_ln_b = args.in[4]; F.gm_w_s = args.in[5]; F.gm_b_s = args.in[6];
    F.q_gain = args.in[7]; F.k_gain = args.in[8]; F.na_rpb = args.in[9]; F.w_o_gm = args.in[10]; F.w_o_na = args.in[11]; F.w_out = args.in[12]; F.norm2_g = args.in[13];
    F.w_ff_gate = args.in[14]; F.w_ff_up = args.in[15]; F.w_ff_down = args.in[16]; F.out = args.out;
    for (int u = F.tid; u < (LDS_BYTES - LDSCTL_OFF) / 4; u += NWAVES * 64) ((LAS unsigned*)(F.lds + LDSCTL_OFF))[u] = 0u;
    __syncthreads();
    XcdBarrier bar; bar.bar = (unsigned*)(F.ctl + CW_BAR); bar.x = 0; bar.st = nullptr;
    if (N_LAUNCHES != PER_PHASE) bar = xcd_barrier_post((unsigned*)(F.ctl + CW_BAR), F.MISC + 8);
#define GRID_BAR() do { if (N_LAUNCHES != PER_PHASE) xcd_barrier(bar); } while (0)
    const int lo = args.ph_lo, hi = args.ph_hi < MK_STOP_AFTER + 1 ? args.ph_hi : MK_STOP_AFTER + 1;
#define IN(k) (lo <= (k) && (k) < hi)
#define BOTH(k) (IN(k) && IN((k) + 1))
    const int bx = (int)blockIdx.x;

    if (IN(0)) { p0_prologue(F); if (BOTH(0)) GRID_BAR(); }

    if (IN(1)) {
        pg8::SchedPlain S; S.o.init(M, NIN, F.G, bx); S.A = (const char*)(F.ws + WS_RA); S.B = (const char*)(F.ws + WS_WIN); S.tstep = (size_t)256 * D * 2;
        pg8::EpiProj E{(bf16*)(F.ws + WS_RB), M};
        pg8::gemm_phase<pg8::EpiProj, pg8::SchedPlain, true, true>(F.lds, D, S, E);
        if (BOTH(1)) GRID_BAR();
    }
    if (IN(2)) {
        for (int u = bx; u < M / CHUNK; u += F.G) gmlp_unit(F, u);
        for (int u = F.vcu; u < GRID_H * NHEAD; u += F.G) na_unit_valu(F, u & (GRID_H - 1), u >> 8);
        if (BOTH(2)) GRID_BAR();
    }
    if (IN(3)) {
        pg8::SchedMerge S; S.o.init(M, D, F.G, bx); S.A0 = (const char*)(F.ws + WS_YA); S.B0 = (const char*)(F.ws + WS_WOA); S.A1 = (const char*)(F.ws + WS_YB); S.B1 = (const char*)(F.ws + WS_WOB); S.tstep = (size_t)256 * GMW * 2;
        pg8::EpiMerge E{(const bf16*)(F.ws + WS_GA), (const bf16*)(F.ws + WS_GB), (bf16*)(F.ws + WS_MRG)};
        pg8::gemm_phase<pg8::EpiMerge, pg8::SchedMerge, true, true>(F.lds, GMW, S, E);
        if (BOTH(3)) GRID_BAR();
    }
    if (IN(4)) {
        pg8::SchedPlain S; S.o.init(M, D, F.G, bx); S.A = (const char*)(F.ws + WS_MRG); S.B = (const char*)(F.ws + WS_WOUT); S.tstep = (size_t)256 * D * 2;
        pg8::EpiResF32 E{F.x, F.out};
        pg8::gemm_phase<pg8::EpiResF32, pg8::SchedPlain, true, true>(F.lds, D, S, E);
        if (BOTH(4)) GRID_BAR();
    }
    if (IN(5)) { p5_norm_and_ffn_weights(F); if (BOTH(5)) GRID_BAR(); }
    if (IN(6)) {
        pg8::SchedPlain S; S.o.init(M, NGU, F.G, bx); S.A = (const char*)(F.ws + WS_RA); S.B = (const char*)(F.ws + WS_WGU); S.tstep = (size_t)256 * D * 2;
        pg8::EpiSwiglu E{(bf16*)(F.ws + WS_ACT), DFF};
        pg8::gemm_phase<pg8::EpiSwiglu, pg8::SchedPlain, true, true>(F.lds, D, S, E);
        if (BOTH(6)) GRID_BAR();
    }
    if (IN(7)) {
        pg8::SchedPlain S; S.o.init(M, D, F.G, bx); S.A = (const char*)(F.ws + WS_ACT); S.B = (const char*)(F.ws + WS_WD); S.tstep = (size_t)256 * DFF * 2;
        pg8::EpiResF32 E{F.out, F.out};
        pg8::gemm_phase<pg8::EpiResF32, pg8::SchedPlain, true, true>(F.lds, DFF, S, E);
    }

#if MK_STOP_AFTER < 4
    {
        GRID_BAR();
        const bf16* pU = (const bf16*)(F.ws + WS_U); const bf16* pV = (const bf16*)(F.ws + WS_V); const bf16* pQ = (const bf16*)(F.ws + WS_Q); const bf16* pK = (const bf16*)(F.ws + WS_K); const bf16* pVV = (const bf16*)(F.ws + WS_VV);
        const bf16* pGA = (const bf16*)(F.ws + WS_GA); const bf16* pGB = (const bf16*)(F.ws + WS_GB); const bf16* pYA = (const bf16*)(F.ws + WS_YA); const bf16* pYB = (const bf16*)(F.ws + WS_YB); const bf16* pM = (const bf16*)(F.ws + WS_MRG);
        for (size_t i = (size_t)bx * 512 + F.tid; i < (size_t)M * D; i += (size_t)F.G * 512) { const size_t m = i >> 12; const int c = (int)(i & 4095), c2 = c & 2047; float v;
            if (MK_STOP_AFTER == 1) v = 0.f * bflo(pGA[i]) + 0.f * bflo(pGB[i]) + 8.f * bflo(((const bf16*)(F.ws + WS_WOA))[(m & 4095) * 2048 + c2]) + 9.f * bflo(((const bf16*)(F.ws + WS_WOB))[(m & 4095) * 2048 + c2]) + 10.f * bflo(((const bf16*)(F.ws + WS_WOUT))[(m & 4095) * 4096 + c]);
            else if (MK_STOP_AFTER == 2) v = c < 2048 ? bflo(pYA[m * 2048 + c2]) : bflo(pYB[m * 2048 + c2]);
            else if (MK_STOP_AFTER == 3) v = bflo(pM[i]);
            else v = F.x[i];
            F.out[i] = v; }
    }
#endif
#undef IN
#undef BOTH
#undef GRID_BAR
}

extern "C" void kernel_launch(void* const* d_in, const int* in_sizes, int n_in, void* d_out, int out_size, void* d_ws, size_t ws_size, hipStream_t stream) {
    static int grid = 0;
    if (grid == 0) {
        if (n_in != 17 || in_sizes[0] != M * D || out_size != M * D || ws_size < WS_END) { fprintf(stderr, "kernel_launch: unexpected shapes/workspace (n_in %d, in0 %d, out %d, ws %zu < %zu); nothing launched\n", n_in, n_in > 0 ? in_sizes[0] : -1, out_size, ws_size, (size_t)WS_END); grid = -1; return; }
        int dev = 0, cus = 0, per_cu = 0;
        if (hipGetDevice(&dev) != hipSuccess || hipDeviceGetAttribute(&cus, hipDeviceAttributeMultiprocessorCount, dev) != hipSuccess) { grid = -1; return; }
        if (hipFuncSetAttribute((const void*)fwd_kernel, hipFuncAttributeMaxDynamicSharedMemorySize, LDS_BYTES) != hipSuccess) { fprintf(stderr, "kernel_launch: hipFuncSetAttribute failed\n"); grid = -1; return; }
        if (hipOccupancyMaxActiveBlocksPerMultiprocessor(&per_cu, (const void*)fwd_kernel, NWAVES * 64, LDS_BYTES) != hipSuccess || per_cu < 1) fprintf(stderr, "kernel_launch: occupancy query reports %d\n", per_cu);
        (void)hipGetLastError();
        grid = cus;
    }
    if (grid < 0) return;
    if (hipMemsetAsync((char*)d_ws + WS_CTL, 0, CTL_ZERO_BYTES, stream) != hipSuccess) return;
    Args a{};
    for (int i = 0; i < 17; ++i) a.in[i] = (const float*)d_in[i];
    a.out = (float*)d_out; a.ws = (unsigned char*)d_ws;
    for (int li = 0; li < N_LAUNCHES; ++li) {
        if (N_LAUNCHES == PER_PHASE) { a.ph_lo = li; a.ph_hi = li + 1; } else { a.ph_lo = 0; a.ph_hi = PER_PHASE; }
        a.li = li; a.pad = 0;
        hipLaunchKernelGGL(fwd_kernel, dim3(grid), dim3(NWAVES * 64), LDS_BYTES, stream, a);
        const hipError_t le = hipPeekAtLastError();
        if (le != hipSuccess) { fprintf(stderr, "kernel_launch: launch %d failed: %s\n", li, hipGetErrorName(le)); break; }
    }
}
```

```cpp
#include <hip/hip_runtime.h>
#include <cstdio>
#include <cstdint>

#ifndef MK_N_LAUNCHES
#define MK_N_LAUNCHES 1
#endif
#ifndef MK_STOP_AFTER
#define MK_STOP_AFTER 7
#endif

namespace pg8 {
#define PG8_LAS __attribute__((address_space(3)))
typedef unsigned short bf16_t;
typedef short bf16x8 __attribute__((ext_vector_type(8)));
typedef float f32x4 __attribute__((ext_vector_type(4)));
typedef float f32x2 __attribute__((ext_vector_type(2)));
typedef unsigned u32x4 __attribute__((ext_vector_type(4)));
typedef unsigned u32x2 __attribute__((ext_vector_type(2)));
constexpr int BM = 256, BK = 64, HALF = 128, HTB = HALF * BK * 2  , STAGE_BYTES = 8 * HTB, NXCD = 8, WGM = 8;

__host__ __device__ __forceinline__ int lds_byte(int r, int c) { const int st = (r >> 4) * 2 + (c >> 5), rr = r & 15, cc = c & 31, ob = rr * 64 + cc * 2; return st * 1024 + (ob ^ (((ob >> 9) & 1) << 5)); }
__host__ __device__ __forceinline__ void stage_rc(int b, int& R, int& C) { const int st = b / 1024, sb = b % 1024, swz = sb ^ (((sb >> 9) & 1) << 5); R = (st >> 1) * 16 + swz / 64; C = (st & 1) * 32 + (swz % 64) / 2; }
__host__ __device__ __forceinline__ int perm32(int rho) { const int n = rho >> 4, i = rho & 15; return 8 * (i >> 2) + 4 * n + (i & 3); }

struct Unit { int pm, pn, sub; };

struct StaticOrder {
    int nM, nN, nwg, G, c;
    __host__ __device__ void init(int M, int N, int G_, int c_) { nM = M / BM; nN = N / BM; nwg = nM * nN; G = G_; c = c_; }
    __host__ __device__ bool tile(int i, Unit& u) const {
        const long L = (long)i * G + c; if (L >= nwg) return false;
        int wgid = (int)L; { const int q = nwg / NXCD, r = nwg % NXCD, xcd = wgid % NXCD, off = wgid / NXCD; wgid = (xcd < r ? xcd * (q + 1) : r * (q + 1) + (xcd - r) * q) + off; }
        const int nig = WGM * nN, gid = wgid / nig, fm = gid * WGM, gsz = (nM - fm) < WGM ? (nM - fm) : WGM;
        u.pm = fm + ((wgid % nig) % gsz); u.pn = (wgid % nig) / gsz; u.sub = 0; return true;
    }
};
struct SchedPlain {
    StaticOrder o; const char* A; const char* B; size_t tstep;
    __device__ __forceinline__ bool next(int i, Unit& u) const { return o.tile(i, u); }
    __device__ __forceinline__ void ptrs(const Unit& u, const char*& a, const char*& b) const { a = A + (size_t)u.pm * tstep; b = B + (size_t)u.pn * tstep; }
};
struct SchedMerge {
    StaticOrder o; const char* A0; const char* B0; const char* A1; const char* B1; size_t tstep;
    __device__ __forceinline__ bool next(int i, Unit& u) const { const bool ok = o.tile(i >> 1, u); u.sub = i & 1; return ok; }
    __device__ __forceinline__ void ptrs(const Unit& u, const char*& a, const char*& b) const { a = (u.sub ? A1 : A0) + (size_t)u.pm * tstep; b = (u.sub ? B1 : B0) + (size_t)u.pn * tstep; }
};

typedef __bf16 bf16x2v __attribute__((ext_vector_type(2)));
__device__ __forceinline__ unsigned cvt_pk_bf16(float lo, float hi) { const bf16x2v v = __builtin_convertvector((f32x2){lo, hi}, bf16x2v); return __builtin_bit_cast(unsigned, v); }
__device__ __forceinline__ float bf_lo(unsigned w) { return __uint_as_float(w << 16); }
__device__ __forceinline__ float bf_hi(unsigned w) { return __uint_as_float(w & 0xffff0000u); }
__device__ __forceinline__ f32x2 gelu_pk(f32x2 v) {
    const f32x2 av = __builtin_elementwise_abs(v), d = av * 0.2316418882f + 1.0f;
    f32x2 t; t.x = __builtin_amdgcn_rcpf(d.x); t.y = __builtin_amdgcn_rcpf(d.y);
    f32x2 q = t * 0.5307027145f + (-0.7265760135f); q = q * t + 0.7107068705f; q = q * t + (-0.142248368f); q = q * t + 0.127414796f; q = q * t;
    const f32x2 s = (v * v) * (-0.72134752044f);
    f32x2 e; e.x = __builtin_amdgcn_exp2f(s.x); e.y = __builtin_amdgcn_exp2f(s.y);
    const f32x2 m = v * (q * e), r = v - m;
    f32x2 o; o.x = v.x < 0.f ? m.x : r.x; o.y = v.y < 0.f ? m.y : r.y; return o;
}
__device__ __forceinline__ float sigmoid_f(float x) { return __builtin_amdgcn_rcpf(1.0f + __builtin_amdgcn_exp2f(x * -1.44269504089f)); }
__device__ __forceinline__ f32x4 gelu4(f32x4 v) { const f32x2 a = gelu_pk((f32x2){v[0], v[1]}), b = gelu_pk((f32x2){v[2], v[3]}); return (f32x4){a.x, a.y, b.x, b.y}; }
__device__ __forceinline__ f32x4 sigm4(f32x4 v) { return (f32x4){sigmoid_f(v[0]), sigmoid_f(v[1]), sigmoid_f(v[2]), sigmoid_f(v[3])}; }
__device__ __forceinline__ u32x4 pack8(f32x4 v0, f32x4 v1) { u32x4 w; w.x = cvt_pk_bf16(v0[0], v0[1]); w.y = cvt_pk_bf16(v0[2], v0[3]); w.z = cvt_pk_bf16(v1[0], v1[1]); w.w = cvt_pk_bf16(v1[2], v1[3]); return w; }

struct EpiProj {
    static constexpr bool PERM = true;
    bf16_t* base; int M;
    __device__ __forceinline__ bool keep(const Unit&) const { return false; }
    template <int ACT> __device__ __forceinline__ void store(const f32x4 (&acc)[2][2][4][2], bf16_t* O, int ldc, int row0, int col0) const {
#pragma unroll
        for (int ai = 0; ai < 2; ++ai)
#pragma unroll
            for (int m = 0; m < 4; ++m) { bf16_t* rowp = O + (size_t)(row0 + ai * HALF + m * 16) * ldc + col0;
#pragma unroll
                for (int bj = 0; bj < 2; ++bj) { f32x4 v0 = acc[ai][bj][m][0], v1 = acc[ai][bj][m][1];
                    if (ACT == 1) { v0 = gelu4(v0); v1 = gelu4(v1); }
                    if (ACT == 2) { v0 = sigm4(v0); v1 = sigm4(v1); }
                    *(u32x4*)(rowp + bj * HALF) = pack8(v0, v1); } }
    }
    __device__ __forceinline__ void operator()(f32x4 (&acc)[2][2][4][2], const Unit& u, int wr, int wc, int fr, int fq) const {
        const int row0 = u.pm * BM + wr * 64 + fr, pn = u.pn;
        if (pn < 40) { const int t = pn >> 3; bf16_t* O = base + (size_t)t * M * 2048; const int col0 = (pn & 7) * BM + wc * 32 + 8 * fq;
            if (t < 2) store<1>(acc, O, 2048, row0, col0); else store<0>(acc, O, 2048, row0, col0); }
        else { const int t = (pn - 40) >> 4; bf16_t* O = base + (size_t)5 * M * 2048 + (size_t)t * M * 4096; const int col0 = ((pn - 40) & 15) * BM + wc * 32 + 8 * fq;
            store<2>(acc, O, 4096, row0, col0); }
    }
};
struct EpiMerge {
    static constexpr bool PERM = true;
    const bf16_t* GA; const bf16_t* GB; bf16_t* O;
    __device__ __forceinline__ bool keep(const Unit& u) const { return u.sub == 0; }
    __device__ __forceinline__ void operator()(f32x4 (&acc)[2][2][4][2], const Unit& u, int wr, int wc, int fr, int fq) const {
        const int row0 = u.pm * BM + wr * 64 + fr, col0 = u.pn * BM + wc * 32 + 8 * fq;
        if (u.sub == 0) {
#pragma unroll
            for (int ai = 0; ai < 2; ++ai)
#pragma unroll
                for (int m = 0; m < 4; ++m) { const size_t off = (size_t)(row0 + ai * HALF + m * 16) * 4096 + col0;
#pragma unroll
                    for (int bj = 0; bj < 2; ++bj) { const u32x4 a = *(const u32x4*)(GA + off + bj * HALF), b = *(const u32x4*)(GB + off + bj * HALF);
                        f32x4 r0, r1;
                        r0[0] = bf_lo(a.x) * __builtin_amdgcn_rcpf(bf_lo(b.x)); r0[1] = bf_hi(a.x) * __builtin_amdgcn_rcpf(bf_hi(b.x));
                        r0[2] = bf_lo(a.y) * __builtin_amdgcn_rcpf(bf_lo(b.y)); r0[3] = bf_hi(a.y) * __builtin_amdgcn_rcpf(bf_hi(b.y));
                        r1[0] = bf_lo(a.z) * __builtin_amdgcn_rcpf(bf_lo(b.z)); r1[1] = bf_hi(a.z) * __builtin_amdgcn_rcpf(bf_hi(b.z));
                        r1[2] = bf_lo(a.w) * __builtin_amdgcn_rcpf(bf_lo(b.w)); r1[3] = bf_hi(a.w) * __builtin_amdgcn_rcpf(bf_hi(b.w));
                        acc[ai][bj][m][0] *= r0; acc[ai][bj][m][1] *= r1; } }
        } else {
#pragma unroll
            for (int ai = 0; ai < 2; ++ai)
#pragma unroll
                for (int m = 0; m < 4; ++m) { const size_t off = (size_t)(row0 + ai * HALF + m * 16) * 4096 + col0;
#pragma unroll
                    for (int bj = 0; bj < 2; ++bj) { const u32x4 b = *(const u32x4*)(GB + off + bj * HALF);
                        const f32x4 s0 = (f32x4){bf_lo(b.x), bf_hi(b.x), bf_lo(b.y), bf_hi(b.y)}, s1 = (f32x4){bf_lo(b.z), bf_hi(b.z), bf_lo(b.w), bf_hi(b.w)};
                        *(u32x4*)(O + off + bj * HALF) = pack8(acc[ai][bj][m][0] * s0, acc[ai][bj][m][1] * s1); } }
        }
    }
};
struct EpiResF32 {
    static constexpr bool PERM = false;
    const float* res; float* out;
    __device__ __forceinline__ bool keep(const Unit&) const { return false; }
    __device__ __forceinline__ void operator()(f32x4 (&acc)[2][2][4][2], const Unit& u, int wr, int wc, int fr, int fq) const {
        const int row0 = u.pm * BM + wr * 64 + fr, col0 = u.pn * BM + wc * 32 + 4 * fq;
#pragma unroll
        for (int ai = 0; ai < 2; ++ai)
#pragma unroll
            for (int m = 0; m < 4; ++m) { const size_t off = (size_t)(row0 + ai * HALF + m * 16) * 4096 + col0;
#pragma unroll
                for (int bj = 0; bj < 2; ++bj)
#pragma unroll
                    for (int n = 0; n < 2; ++n) { const f32x4 r = *(const f32x4*)(res + off + bj * HALF + n * 16); *(f32x4*)(out + off + bj * HALF + n * 16) = r + acc[ai][bj][m][n]; } }
    }
};
struct EpiSwiglu {
    static constexpr bool PERM = true;
    bf16_t* O; int ldc;
    __device__ __forceinline__ bool keep(const Unit&) const { return false; }
    __device__ __forceinline__ void operator()(f32x4 (&acc)[2][2][4][2], const Unit& u, int wr, int wc, int fr, int fq) const {
        const int row0 = u.pm * BM + wr * 64 + fr, col0 = u.pn * HALF + wc * 32 + 8 * fq;
#pragma unroll
        for (int ai = 0; ai < 2; ++ai)
#pragma unroll
            for (int m = 0; m < 4; ++m) { bf16_t* rowp = O + (size_t)(row0 + ai * HALF + m * 16) * ldc + col0;
                const f32x4 g0 = acc[ai][0][m][0], g1 = acc[ai][0][m][1];
                const f32x4 v0 = g0 * sigm4(g0) * acc[ai][1][m][0], v1 = g1 * sigm4(g1) * acc[ai][1][m][1];
                *(u32x4*)rowp = pack8(v0, v1); }
    }
};

template <class Epi, class Sched, bool ALIGN_EPI, bool SP2>
__device__ __forceinline__ void gemm_phase(PG8_LAS unsigned char* lds, const int K, const Sched& S, const Epi& E) {
    const int tid = threadIdx.x, wid = __builtin_amdgcn_readfirstlane(tid >> 6), lane = tid & 63, wr = wid >> 2, wc = wid & 3, fr = lane & 15, fq = lane >> 4;
    const int nt = K / BK;
    unsigned voffA[2], voffB[2];
#pragma unroll
    for (int i = 0; i < 2; ++i) { int R, C; stage_rc(tid * 16 + i * 8192, R, C); const int Rb = Epi::PERM ? ((R & ~31) + perm32(R & 31)) : R;
        voffA[i] = (unsigned)(R * K + C) * 2u; voffB[i] = (unsigned)(Rb * K + C) * 2u; }
    const size_t kstep = (size_t)(BK * 2);
    const size_t hstep = (size_t)HALF * K * 2;
    const unsigned ldsw = (unsigned)wid * 1024u;
    const int aoff = lds_byte(wr * 64 + fr, fq * 8), boff = lds_byte(wc * 32 + fr, fq * 8);
#define PG8_SA(b, h) (((b) * 2 + (h)) * HTB)
#define PG8_SB(b, h) ((4 + (b) * 2 + (h)) * HTB)
#define PG8_STAGE(bufoff, gbase, voff) do { _Pragma("unroll") for (int _i = 0; _i < 2; ++_i) \
        __builtin_amdgcn_global_load_lds((const unsigned*)((const char*)(gbase) + (voff)[_i]), (PG8_LAS unsigned*)(lds + (bufoff) + ldsw + _i * 8192), 16, 0, 0); } while (0)
#define PG8_LDA(dst, b, h) do { _Pragma("unroll") for (int m = 0; m < 4; ++m) _Pragma("unroll") for (int k = 0; k < 2; ++k) dst[m][k] = *(const PG8_LAS bf16x8*)(lds + PG8_SA(b, h) + aoff + m * 2048 + k * 1024); } while (0)
#define PG8_LDB(dst, b, h) do { _Pragma("unroll") for (int n = 0; n < 2; ++n) _Pragma("unroll") for (int k = 0; k < 2; ++k) dst[n][k] = *(const PG8_LAS bf16x8*)(lds + PG8_SB(b, h) + boff + n * 2048 + k * 1024); } while (0)
#define PG8_MMA(ai, bj, At, Bt) do { __builtin_amdgcn_s_setprio(1); _Pragma("unroll") for (int m = 0; m < 4; ++m) _Pragma("unroll") for (int n = 0; n < 2; ++n) _Pragma("unroll") for (int k = 0; k < 2; ++k) \
        acc[ai][bj][m][n] = __builtin_amdgcn_mfma_f32_16x16x32_bf16(Bt[n][k], At[m][k], acc[ai][bj][m][n], 0, 0, 0); __builtin_amdgcn_s_setprio(0); } while (0)
#define PG8_WAIT_V(n) asm volatile("s_waitcnt vmcnt(" #n ")" ::: "memory")
#define PG8_WAIT_L(n) asm volatile("s_waitcnt lgkmcnt(" #n ")" ::: "memory")
#define PG8_BAR __builtin_amdgcn_s_barrier()
#define PG8_SCHED __builtin_amdgcn_sched_barrier(0)
    Unit cur, nxt; int ui = 0;
    if (!S.next(0, cur)) return;
    f32x4 acc[2][2][4][2];
#pragma unroll
    for (int a = 0; a < 2; ++a)
#pragma unroll
        for (int b = 0; b < 2; ++b)
#pragma unroll
            for (int m = 0; m < 4; ++m)
#pragma unroll
                for (int n = 0; n < 2; ++n) acc[a][b][m][n] = (f32x4){0.f, 0.f, 0.f, 0.f};
    bf16x8 At[4][2], B0[2][2], B1[2][2];
    const char* cA; const char* cB; S.ptrs(cur, cA, cB);
    if constexpr (SP2) {
        PG8_STAGE(PG8_SB(0, 0), cB, voffB); PG8_STAGE(PG8_SB(0, 1), cB + hstep, voffB); PG8_STAGE(PG8_SA(0, 0), cA, voffA); PG8_STAGE(PG8_SA(0, 1), cA + hstep, voffA);
        if (wr == 1) PG8_BAR;
        PG8_WAIT_V(2); PG8_BAR;
        PG8_STAGE(PG8_SB(1, 0), cB + kstep, voffB); PG8_STAGE(PG8_SA(1, 0), cA + kstep, voffA); PG8_STAGE(PG8_SB(1, 1), cB + hstep + kstep, voffB);
        PG8_WAIT_V(6); PG8_BAR;
    } else {
        PG8_STAGE(PG8_SB(0, 0), cB, voffB); PG8_STAGE(PG8_SA(0, 0), cA, voffA); PG8_STAGE(PG8_SB(0, 1), cB + hstep, voffB); PG8_STAGE(PG8_SA(0, 1), cA + hstep, voffA);
        if (wr == 1) PG8_BAR;
        PG8_WAIT_V(4); PG8_BAR;
        PG8_STAGE(PG8_SB(1, 0), cB + kstep, voffB); PG8_STAGE(PG8_SA(1, 0), cA + kstep, voffA); PG8_STAGE(PG8_SB(1, 1), cB + hstep + kstep, voffB);
        PG8_WAIT_V(6); PG8_BAR;
    }
    for (;;) {
        const bool has_next = S.next(ui + 1, nxt);
        const char* nA = cA; const char* nB = cB; if (has_next) S.ptrs(nxt, nA, nB);
        for (int t = 0; t < nt; t += 2) {
            const bool last = (t == nt - 2);
            const char* a1 = cA + (size_t)(t + 1) * kstep;
            const char* a2 = last ? nA : cA + (size_t)(t + 2) * kstep; const char* b2 = last ? nB : cB + (size_t)(t + 2) * kstep;
            const char* a3 = a2 + kstep; const char* b3 = b2 + kstep;
            if constexpr (SP2) {
            PG8_LDB(B0, 0, 0); PG8_LDB(B1, 0, 1); PG8_SCHED; PG8_LDA(At, 0, 0); PG8_STAGE(PG8_SA(1, 1), a1 + hstep, voffA);
            PG8_WAIT_V(8); PG8_WAIT_L(0); PG8_BAR; PG8_MMA(0, 0, At, B0); PG8_MMA(0, 1, At, B1); PG8_BAR; PG8_SCHED;
            PG8_LDA(At, 0, 1); PG8_STAGE(PG8_SB(0, 0), b2, voffB); PG8_STAGE(PG8_SB(0, 1), b2 + hstep, voffB); PG8_STAGE(PG8_SA(0, 0), a2, voffA);
            PG8_WAIT_V(8); PG8_WAIT_L(0); PG8_BAR; PG8_MMA(1, 0, At, B0); PG8_MMA(1, 1, At, B1); PG8_BAR; PG8_SCHED;
            PG8_LDB(B0, 1, 0); PG8_LDB(B1, 1, 1); PG8_SCHED; PG8_LDA(At, 1, 0); PG8_STAGE(PG8_SA(0, 1), a2 + hstep, voffA);
            PG8_WAIT_V(8); PG8_WAIT_L(0); PG8_BAR; PG8_MMA(0, 0, At, B0); PG8_MMA(0, 1, At, B1); PG8_BAR; PG8_SCHED;
            PG8_LDA(At, 1, 1); PG8_STAGE(PG8_SB(1, 0), b3, voffB); PG8_STAGE(PG8_SB(1, 1), b3 + hstep, voffB); PG8_STAGE(PG8_SA(1, 0), a3, voffA);
            PG8_WAIT_V(8); PG8_WAIT_L(0); PG8_BAR; PG8_MMA(1, 0, At, B0); PG8_MMA(1, 1, At, B1); PG8_BAR; PG8_SCHED;
            } else {
            PG8_LDB(B0, 0, 0); PG8_SCHED; PG8_LDA(At, 0, 0); PG8_STAGE(PG8_SA(1, 1), a1 + hstep, voffA);
            PG8_WAIT_L(8); PG8_BAR; PG8_WAIT_L(0); PG8_MMA(0, 0, At, B0); PG8_BAR; PG8_SCHED;
            PG8_LDB(B1, 0, 1); PG8_STAGE(PG8_SB(0, 0), b2, voffB);
            PG8_BAR; PG8_WAIT_L(0); PG8_MMA(0, 1, At, B1); PG8_BAR;
            PG8_LDA(At, 0, 1); PG8_STAGE(PG8_SA(0, 0), a2, voffA);
            PG8_BAR; PG8_WAIT_L(0); PG8_MMA(1, 0, At, B0); PG8_BAR; PG8_SCHED;
            PG8_STAGE(PG8_SB(0, 1), b2 + hstep, voffB);
            PG8_WAIT_V(6); PG8_BAR; PG8_MMA(1, 1, At, B1); PG8_BAR;
            PG8_LDB(B0, 1, 0); PG8_SCHED; PG8_LDA(At, 1, 0); PG8_STAGE(PG8_SA(0, 1), a2 + hstep, voffA);
            PG8_WAIT_L(8); PG8_BAR; PG8_WAIT_L(0); PG8_MMA(0, 0, At, B0); PG8_BAR; PG8_SCHED;
            PG8_LDB(B1, 1, 1); PG8_STAGE(PG8_SB(1, 0), b3, voffB);
            PG8_BAR; PG8_WAIT_L(0); PG8_MMA(0, 1, At, B1); PG8_BAR;
            PG8_LDA(At, 1, 1); PG8_STAGE(PG8_SA(1, 0), a3, voffA);
            PG8_BAR; PG8_WAIT_L(0); PG8_MMA(1, 0, At, B0); PG8_BAR; PG8_SCHED;
            PG8_STAGE(PG8_SB(1, 1), b3 + hstep, voffB);
            PG8_WAIT_V(6); PG8_BAR; PG8_MMA(1, 1, At, B1); PG8_BAR;
            }
        }
        if constexpr (ALIGN_EPI) { if (wr == 0) PG8_BAR; }
        E(acc, cur, wr, wc, fr, fq);
        if (!has_next) break;
        if (!E.keep(cur)) {
#pragma unroll
            for (int a = 0; a < 2; ++a)
#pragma unroll
                for (int b = 0; b < 2; ++b)
#pragma unroll
                    for (int m = 0; m < 4; ++m)
#pragma unroll
                        for (int n = 0; n < 2; ++n) acc[a][b][m][n] = (f32x4){0.f, 0.f, 0.f, 0.f};
        }
        cur = nxt; cA = nA; cB = nB; ++ui;
        if constexpr (ALIGN_EPI) { if (wr == 1) PG8_BAR; }
    }
    PG8_WAIT_V(0);
    if constexpr (!ALIGN_EPI) { if (wr == 0) PG8_BAR; }
    PG8_BAR;
#undef PG8_SA
#undef PG8_SB
#undef PG8_STAGE
#undef PG8_LDA
#undef PG8_LDB
#undef PG8_MMA
#undef PG8_WAIT_V
#undef PG8_WAIT_L
#undef PG8_BAR
#undef PG8_SCHED
}
}

constexpr int NWAVES = 8;
constexpr int N_LAUNCHES = MK_N_LAUNCHES;
constexpr int PER_PHASE = 8;
constexpr int M = 16384, D = 4096, NIN = 18432, GMW = 2048, NAW = 2048, DFF = 11008, NGU = 2 * DFF;
constexpr int GRID_W = 64, GRID_H = M / GRID_W, NHEAD = 16, HD = 128, CHUNK = 128, NGROUP = 16;
constexpr float RMS_EPS = 1e-6f, LN_EPS = 1e-5f;

constexpr size_t MiB = 1u << 20;
constexpr size_t WS_CTL = 0, CTL_ZERO_BYTES = 1 * MiB;
constexpr size_t WS_WSB = 1 * MiB;
constexpr size_t WS_WIN = 4 * MiB;
constexpr size_t WS_WOA = 148 * MiB, WS_WOB = 164 * MiB;
constexpr size_t WS_WOUT = 180 * MiB;
constexpr size_t WS_RA = 212 * MiB;
constexpr size_t WS_YA = WS_RA, WS_YB = WS_RA + 64 * MiB;
constexpr size_t WS_RB = 340 * MiB;
constexpr size_t WS_U = WS_RB, WS_V = WS_RB + 64 * MiB, WS_Q = WS_RB + 128 * MiB, WS_K = WS_RB + 192 * MiB, WS_VV = WS_RB + 256 * MiB, WS_GA = WS_RB + 320 * MiB, WS_GB = WS_RB + 448 * MiB;
constexpr size_t WS_MRG = WS_RB;
constexpr size_t WS_ACT = WS_RB;
constexpr size_t WS_WGU = WS_WIN;
constexpr size_t WS_WD = WS_GB;
constexpr size_t WS_END = 916 * MiB;
static_assert(WS_WGU + (size_t)NGU * D * 2 <= WS_WOUT && WS_ACT + (size_t)M * DFF * 2 <= WS_WD && WS_WD + (size_t)D * DFF * 2 <= WS_END && WS_GB + (size_t)M * D * 2 == WS_END, "d_ws map");
constexpr int CW_BAR = 4096;
constexpr int RING_BYTES = 131072;
constexpr int LDSCTL_OFF = RING_BYTES, MISC_OFF = LDSCTL_OFF + 320;
constexpr int LDS_BYTES = 147456;

#define GAS __attribute__((address_space(1)))
#define LAS __attribute__((address_space(3)))
typedef unsigned short bf16;
typedef unsigned v4u __attribute__((ext_vector_type(4)));
typedef unsigned v2u __attribute__((ext_vector_type(2)));
typedef float f32x4 __attribute__((ext_vector_type(4)));
typedef float f32x2 __attribute__((ext_vector_type(2)));
typedef short bf16x8 __attribute__((ext_vector_type(8)));
typedef GAS unsigned gu32;
#define RLX_AGENT __ATOMIC_RELAXED, __HIP_MEMORY_SCOPE_AGENT
#define LDS_WAIT() asm volatile("s_waitcnt lgkmcnt(0)" ::: "memory")
#define VM_WAIT() asm volatile("s_waitcnt vmcnt(0)" ::: "memory")
__device__ __forceinline__ unsigned f2bf(float f) { unsigned u = __builtin_bit_cast(unsigned, f); return (u + 0x7fffu + ((u >> 16) & 1u)) >> 16; }
__device__ __forceinline__ unsigned pk2(float lo, float hi) { return f2bf(lo) | (f2bf(hi) << 16); }
__device__ __forceinline__ float bflo(unsigned w) { return __uint_as_float(w << 16); }
__device__ __forceinline__ float bfhi(unsigned w) { return __uint_as_float(w & 0xffff0000u); }

#define XB_TMO      128
#define XB_XCNT(j)  (256  + 64 * (j))
#define XB_XSUB(j)  (1280 + 64 * (j))
#define XB_XGEN(j)  (2304 + 64 * (j))
#define XB_TOP      3328
#define XB_TOPGEN   3392
#define XCD_BAR_WORDS 3456
#define XB_SPIN_CAP (1u << 20)

__device__ __forceinline__ unsigned xb_ld(unsigned* p)              { return __hip_atomic_load(p, __ATOMIC_RELAXED, __HIP_MEMORY_SCOPE_AGENT); }
__device__ __forceinline__ unsigned xb_add(unsigned* p, unsigned v) { return __hip_atomic_fetch_add(p, v, __ATOMIC_RELAXED, __HIP_MEMORY_SCOPE_AGENT); }
__device__ __forceinline__ unsigned xb_xcc_id() { return (unsigned)__builtin_amdgcn_s_getreg((3 << 11) | 20) & 0xFu; }
#define XB_SPIN(cond, bar) do { unsigned _sp = 0; while (cond) { __builtin_amdgcn_s_sleep(1); \
    if ((++_sp & 255u) == 0u) { if (xb_ld(&(bar)[XB_TMO])) break; if (_sp > XB_SPIN_CAP) { atomicAdd(&(bar)[XB_TMO], 1u); break; } } } } while (0)

struct XcdBarrier {
    unsigned* bar; unsigned x;
    volatile LAS unsigned* st;
};
__device__ __forceinline__ XcdBarrier xcd_barrier_post(unsigned* bar, volatile LAS unsigned* st) {
    XcdBarrier b; b.bar = bar; b.x = xb_xcc_id(); b.st = st;
    if (threadIdx.x == 0) (void)xb_add(&bar[XB_XCNT(b.x)], 1u);
    return b;
}
__device__ __forceinline__ void xcd_barrier_complete(unsigned* bar, unsigned x, unsigned& nloc, unsigned& nx) {
    const unsigned G = gridDim.x * gridDim.y * gridDim.z;
    unsigned sum, cnt, mine, sp = 0u;
    for (;;) {
        sum = 0u; cnt = 0u; mine = 0u;
#pragma unroll
        for (unsigned j = 0; j < 16; ++j) { const unsigned c = xb_ld(&bar[XB_XCNT(j)]); sum += c; cnt += (c > 0u) ? 1u : 0u; mine = (j == x) ? c : mine; }
        if (sum == G) break;
        __builtin_amdgcn_s_sleep(1);
        if ((++sp & 255u) == 0u) { if (xb_ld(&bar[XB_TMO])) break; if (sp > XB_SPIN_CAP) { atomicAdd(&bar[XB_TMO], 1u); break; } }
    }
    nloc = mine > 0u ? mine : 1u; nx = cnt > 0u ? cnt : 1u;
}
__device__ __forceinline__ void xcd_barrier(const XcdBarrier& b) {
    asm volatile("s_waitcnt vmcnt(0)" ::: "memory");
    __syncthreads();
    if (threadIdx.x == 0) {
        unsigned* bar = b.bar;
        __builtin_amdgcn_s_waitcnt(0);
        unsigned nloc = b.st[0], nx = b.st[1];
        if (nloc == 0u) { xcd_barrier_complete(bar, b.x, nloc, nx); b.st[0] = nloc; b.st[1] = nx; }
        const unsigned old = xb_add(&bar[XB_XSUB(b.x)], 1u);
        const unsigned gen = old / nloc;
        if (old + 1u == (gen + 1u) * nloc) {
            __builtin_amdgcn_fence(__ATOMIC_RELEASE, "agent");
            asm volatile("s_waitcnt vmcnt(0)" ::: "memory");
            const unsigned og = xb_add(&bar[XB_TOP], 1u);
            const unsigned tg = og / nx;
            if (og + 1u == (tg + 1u) * nx) xb_add(&bar[XB_TOPGEN], 1u);
            else XB_SPIN(xb_ld(&bar[XB_TOPGEN]) == tg, bar);
            __builtin_amdgcn_fence(__ATOMIC_ACQUIRE, "agent");
            xb_add(&bar[XB_XGEN(b.x)], 1u);
            asm volatile("s_waitcnt vmcnt(0)" ::: "memory");
        } else {
            XB_SPIN(xb_ld(&bar[XB_XGEN(b.x)]) == gen, bar);
            __builtin_amdgcn_fence(__ATOMIC_ACQUIRE, "agent");
            asm volatile("s_waitcnt vmcnt(0)" ::: "memory");
        }
    }
    __syncthreads();
}

struct Frame {
    LAS unsigned char* lds;
    volatile LAS unsigned* MISC;
    gu32* ctl;
    int tid, lane, wave;
    int vcu, G;
    unsigned char* ws;
    const float *x, *norm1_g, *w_in, *gm_ln_g, *gm_ln_b, *gm_w_s, *gm_b_s, *q_gain, *k_gain, *na_rpb, *w_o_gm, *w_o_na, *w_out, *norm2_g, *w_ff_gate, *w_ff_up, *w_ff_down;
    float* out;
};
__device__ __forceinline__ float wave_sum(float v) {
#pragma unroll
    for (int o = 1; o < 64; o <<= 1) v += __shfl_xor(v, o);
    return v;
}
__device__ __forceinline__ float wave_max(float v) {
#pragma unroll
    for (int o = 1; o < 64; o <<= 1) v = fmaxf(v, __shfl_xor(v, o));
    return v;
}
__device__ __forceinline__ void tr_item(const float* W, int ldw, int k0, int n0, bf16* dst, int ldk, LAS float* scr, int lane) {
#pragma unroll 8
    for (int i = 0; i < 32; ++i) { const int kk = 2 * i + (lane >> 5); scr[kk * 33 + (lane & 31)] = W[(size_t)(k0 + kk) * ldw + n0 + (lane & 31)]; }
    LDS_WAIT(); asm volatile("" ::: "memory");
    const int c = lane & 7;
#pragma unroll
    for (int j = 0; j < 4; ++j) { const int n = (lane >> 3) + 8 * j; const LAS float* s = scr + (8 * c) * 33 + n;
        v4u o; o.x = pk2(s[0 * 33], s[1 * 33]); o.y = pk2(s[2 * 33], s[3 * 33]); o.z = pk2(s[4 * 33], s[5 * 33]); o.w = pk2(s[6 * 33], s[7 * 33]);
        *(GAS v4u*)(dst + (size_t)n * ldk + 8 * c) = o; }
    LDS_WAIT(); asm volatile("" ::: "memory");
}
__device__ __forceinline__ void tr_matrix(Frame& F, const float* W, int K, int N, bf16* WT, LAS float* scr) {
    const int gw = F.vcu * NWAVES + F.wave, NGW = F.G * NWAVES, nblk = N / 32, nitems = (K / 64) * nblk;
    for (int it = gw; it < nitems; it += NGW) { const int kb = it / nblk, nb = it % nblk; tr_item(W, N, 64 * kb, 32 * nb, WT + (size_t)(32 * nb) * K + 64 * kb, K, scr, F.lane); }
}
__device__ __forceinline__ void rms_row_to_bf16(Frame& F, const float* xrow, const float* gain, bf16* orow) {
    const GAS f32x4* xr = (const GAS f32x4*)xrow + F.lane;
    f32x4 v[16]; float s = 0.f;
#pragma unroll
    for (int j = 0; j < 16; ++j) { v[j] = xr[64 * j]; s += (v[j].x * v[j].x + v[j].y * v[j].y) + (v[j].z * v[j].z + v[j].w * v[j].w); }
    const float rstd = 1.f / sqrtf(wave_sum(s) * (1.f / D) + RMS_EPS);
    const GAS f32x4* gr = (const GAS f32x4*)gain + F.lane;
    GAS v2u* o8 = (GAS v2u*)orow + F.lane;
#pragma unroll
    for (int j = 0; j < 16; ++j) { const f32x4 g = gr[64 * j]; v2u o; o.x = pk2(v[j].x * rstd * g.x, v[j].y * rstd * g.y); o.y = pk2(v[j].z * rstd * g.z, v[j].w * rstd * g.w); o8[64 * j] = o; }
}

__device__ __forceinline__ void p0_prologue(Frame& F) {
    LAS float* scr = (LAS float*)(F.lds + F.wave * 16384);
    tr_matrix(F, F.w_in, D, NIN, (bf16*)(F.ws + WS_WIN), scr);
    tr_matrix(F, F.w_o_gm, GMW, D, (bf16*)(F.ws + WS_WOA), scr);
    tr_matrix(F, F.w_o_na, NAW, D, (bf16*)(F.ws + WS_WOB), scr);
    tr_matrix(F, F.w_out, D, D, (bf16*)(F.ws + WS_WOUT), scr);
    const int gw = F.vcu * NWAVES + F.wave, NGW = F.G * NWAVES;
    { bf16* wsb = (bf16*)(F.ws + WS_WSB);
      for (int i = gw * 64 + F.lane; i < NGROUP * CHUNK * CHUNK / 4; i += NGW * 64) { const f32x4 v = ((const GAS f32x4*)F.gm_w_s)[i]; v2u o; o.x = pk2(v.x, v.y); o.y = pk2(v.z, v.w); ((GAS v2u*)wsb)[i] = o; } }
    bf16* XN = (bf16*)(F.ws + WS_RA);
    for (int m = gw; m < M; m += NGW) rms_row_to_bf16(F, F.x + (size_t)m * D, F.norm1_g, XN + (size_t)m * D);
}
__device__ __forceinline__ void p5_norm_and_ffn_weights(Frame& F) {
    LAS float* scr = (LAS float*)(F.lds + F.wave * 16384);
    const int gw = F.vcu * NWAVES + F.wave, NGW = F.G * NWAVES;
    bf16* WGU = (bf16*)(F.ws + WS_WGU);
    { const int nblk = DFF / 32, nitems = (D / 64) * nblk;
      for (int it = gw; it < 2 * nitems; it += NGW) { const int up = it >= nitems, r = up ? it - nitems : it, kb = r / nblk, nb = r % nblk, n0 = 32 * nb;
          const int drow = 256 * (n0 >> 7) + (n0 & 127) + (up ? 128 : 0);
          tr_item(up ? F.w_ff_up : F.w_ff_gate, DFF, 64 * kb, n0, WGU + (size_t)drow * D + 64 * kb, D, scr, F.lane); } }
    tr_matrix(F, F.w_ff_down, DFF, D, (bf16*)(F.ws + WS_WD), scr);
    bf16* HN = (bf16*)(F.ws + WS_RA);
    for (int m = gw; m < M; m += NGW) rms_row_to_bf16(F, F.out + (size_t)m * D, F.norm2_g, HN + (size_t)m * D);
}

typedef short s16x4 __attribute__((ext_vector_type(4)));
constexpr int GM_WP = 272, GM_VP = 288;
constexpr int GM_V_OFF = 128 * GM_WP, GM_ST_OFF = GM_V_OFF + 128 * GM_VP;
__device__ __forceinline__ void gmlp_unit(Frame& F, int chunk, int half) {
    LAS unsigned char* Wl = F.lds; LAS unsigned char* Vt = F.lds + GM_V_OFF; LAS f32x2* st = (LAS f32x2*)(F.lds + GM_ST_OFF);
    const bf16* U = (const bf16*)(F.ws + WS_U); const bf16* V = (const bf16*)(F.ws + WS_V); bf16* YA = (bf16*)(F.ws + WS_YA); const bf16* WSB = (const bf16*)(F.ws + WS_WSB);
    const int tok0 = chunk * CHUNK, lane = F.lane, tid = F.tid, fr = lane & 15, fq = lane >> 4, q4 = fr >> 2, p4 = lane & 3;
    __syncthreads();
    for (int t = 0; t < 16; ++t) { const int j = F.wave * 16 + t; const GAS v4u* vr = (const GAS v4u*)(V + (size_t)(tok0 + j) * GMW) + lane;
        float x[32]; float s = 0.f;
#pragma unroll
        for (int q = 0; q < 4; ++q) { const v4u w = vr[64 * q]; x[8 * q + 0] = bflo(w.x); x[8 * q + 1] = bfhi(w.x); x[8 * q + 2] = bflo(w.y); x[8 * q + 3] = bfhi(w.y); x[8 * q + 4] = bflo(w.z); x[8 * q + 5] = bfhi(w.z); x[8 * q + 6] = bflo(w.w); x[8 * q + 7] = bfhi(w.w); }
#pragma unroll
        for (int e = 0; e < 32; ++e) s += x[e];
        const float mean = wave_sum(s) * (1.f / GMW); float s2 = 0.f;
#pragma unroll
        for (int e = 0; e < 32; ++e) { const float d = x[e] - mean; s2 += d * d; }
        const float rstd = 1.f / sqrtf(wave_sum(s2) * (1.f / GMW) + LN_EPS);
        if (lane == 0) st[j] = (f32x2){mean, rstd}; }
    const int wi = F.wave >> 1, wc2 = F.wave & 1;
    for (int gi = 0; gi < NGROUP / 2; ++gi) { const int g = half * (NGROUP / 2) + gi;
        __syncthreads();
#pragma unroll
        for (int q = 0; q < 4; ++q) { const int idx = tid + 512 * q, row = idx >> 4, ch = idx & 15;
            *(LAS v4u*)(Wl + row * GM_WP + ch * 16) = *(const GAS v4u*)(WSB + (size_t)g * CHUNK * CHUNK + row * CHUNK + ch * 8); }
#pragma unroll
        for (int q = 0; q < 4; ++q) { const int idx = tid + 512 * q, j = idx >> 4, ch = idx & 15, c0 = g * 128 + ch * 8;
            const v4u w = *(const GAS v4u*)(V + (size_t)(tok0 + j) * GMW + c0); const f32x2 ms = st[j];
            const f32x4 g0 = *(const GAS f32x4*)(F.gm_ln_g + c0), g1 = *(const GAS f32x4*)(F.gm_ln_g + c0 + 4), b0 = *(const GAS f32x4*)(F.gm_ln_b + c0), b1 = *(const GAS f32x4*)(F.gm_ln_b + c0 + 4);
            v4u o;
            o.x = pk2((bflo(w.x) - ms.x) * ms.y * g0.x + b0.x, (bfhi(w.x) - ms.x) * ms.y * g0.y + b0.y); o.y = pk2((bflo(w.y) - ms.x) * ms.y * g0.z + b0.z, (bfhi(w.y) - ms.x) * ms.y * g0.w + b0.w);
            o.z = pk2((bflo(w.z) - ms.x) * ms.y * g1.x + b1.x, (bfhi(w.z) - ms.x) * ms.y * g1.y + b1.y); o.w = pk2((bflo(w.w) - ms.x) * ms.y * g1.z + b1.z, (bfhi(w.w) - ms.x) * ms.y * g1.w + b1.w);
            *(LAS v4u*)(Vt + j * GM_VP + ch * 16) = o; }
        __syncthreads();
        f32x4 acc[4][2];
#pragma unroll
        for (int ct = 0; ct < 4; ++ct)
#pragma unroll
            for (int it = 0; it < 2; ++it) acc[ct][it] = (f32x4){0.f, 0.f, 0.f, 0.f};
#pragma unroll
        for (int kk = 0; kk < 8; ++kk) { s16x4 vf[4], wf[2];
#pragma unroll
            for (int ct = 0; ct < 4; ++ct) vf[ct] = __builtin_amdgcn_ds_read_tr16_b64_v4i16((LAS s16x4*)(Vt + (16 * kk + 4 * fq + q4) * GM_VP + (64 * wc2 + 16 * ct) * 2 + 8 * p4));
#pragma unroll
            for (int it = 0; it < 2; ++it) wf[it] = *(const LAS s16x4*)(Wl + (32 * wi + 16 * it + fr) * GM_WP + (16 * kk + 4 * fq) * 2);
#pragma unroll
            for (int ct = 0; ct < 4; ++ct)
#pragma unroll
                for (int it = 0; it < 2; ++it) acc[ct][it] = __builtin_amdgcn_mfma_f32_16x16x16bf16_1k(vf[ct], wf[it], acc[ct][it], 0, 0, 0); }
#pragma unroll
        for (int it = 0; it < 2; ++it) { const int i = 32 * wi + 16 * it + fr; const float bs = F.gm_b_s[g * CHUNK + i]; const size_t rowoff = (size_t)(tok0 + i) * GMW + g * 128;
#pragma unroll
            for (int ct = 0; ct < 4; ++ct) { const int c = 64 * wc2 + 16 * ct + 4 * fq; const v2u uu = *(const GAS v2u*)(U + rowoff + c);
                v2u o; o.x = pk2((acc[ct][it][0] + bs) * bflo(uu.x), (acc[ct][it][1] + bs) * bfhi(uu.x)); o.y = pk2((acc[ct][it][2] + bs) * bflo(uu.y), (acc[ct][it][3] + bs) * bfhi(uu.y));
                *(GAS v2u*)(YA + rowoff + c) = o; } }
    }
    __syncthreads();
}

constexpr int NA_KP = 272, NA_VP = 288;
constexpr int NA_SLOT = 64 * NA_VP, NA_RPB_OFF = 2 * NA_SLOT;
constexpr float LOG2E = 1.4426950408889634f;
__device__ __forceinline__ void na_unit(Frame& F, int p, int h) {
    LAS unsigned char* ring = F.lds; LAS float* rpbL = (LAS float*)(F.lds + NA_RPB_OFF);
    const bf16* Q = (const bf16*)(F.ws + WS_Q); const bf16* Kt = (const bf16*)(F.ws + WS_K); const bf16* Vv = (const bf16*)(F.ws + WS_VV); bf16* YB = (bf16*)(F.ws + WS_YB);
    const int lane = F.lane, tid = F.tid, fr = lane & 15, g = lane >> 4, q4 = fr >> 2, p4 = lane & 3;
    const int r0 = 2 * p, r = r0 + (F.wave >> 2), t = F.wave & 3, c = 16 * t + fr, kb0 = t >> 1;
    int b0 = r0 - 4; b0 = b0 < 0 ? 0 : (b0 > GRID_H - 8 ? GRID_H - 8 : b0);
    int rs = r - 4; rs = rs < 0 ? 0 : (rs > GRID_H - 8 ? GRID_H - 8 : rs);
    int cs = c - 8; cs = cs < 0 ? 0 : (cs > GRID_W - 16 ? GRID_W - 16 : cs);
    const int skey = tid >> 4, sdch = tid & 15;
    __syncthreads();
    for (int i = tid; i < 15 * 31; i += 512) rpbL[i] = F.na_rpb[h * 465 + i] * LOG2E;
    v4u R[2][2];
#define NA_LOAD(T, s_) do { int kr_ = b0 + (s_); kr_ = kr_ > GRID_H - 1 ? GRID_H - 1 : kr_; _Pragma("unroll") for (int q2 = 0; q2 < 2; ++q2) \
        R[(s_) & 1][q2] = *(const GAS v4u*)((T) + (size_t)(kr_ * GRID_W + skey + 32 * q2) * NAW + h * HD + sdch * 8); } while (0)
    NA_LOAD(Kt, 0); NA_LOAD(Kt, 1);
    bf16x8 Qf[4];
    { const size_t tq = (size_t)(r * GRID_W + c); v4u qw[4]; float ss = 0.f;
#pragma unroll
      for (int ks = 0; ks < 4; ++ks) { qw[ks] = *(const GAS v4u*)(Q + tq * NAW + h * HD + 32 * ks + 8 * g);
          const float a0 = bflo(qw[ks].x), a1 = bfhi(qw[ks].x), a2 = bflo(qw[ks].y), a3 = bfhi(qw[ks].y), a4 = bflo(qw[ks].z), a5 = bfhi(qw[ks].z), a6 = bflo(qw[ks].w), a7 = bfhi(qw[ks].w);
          ss += (a0 * a0 + a1 * a1) + (a2 * a2 + a3 * a3) + (a4 * a4 + a5 * a5) + (a6 * a6 + a7 * a7); }
      ss += __shfl_xor(ss, 16); ss += __shfl_xor(ss, 32);
      const float rq = (1.f / sqrtf(ss * (1.f / HD) + RMS_EPS)) * 0.08838834764831845f * LOG2E;
#pragma unroll
      for (int ks = 0; ks < 4; ++ks) { const f32x4 g0 = *(const GAS f32x4*)(F.q_gain + 32 * ks + 8 * g), g1 = *(const GAS f32x4*)(F.q_gain + 32 * ks + 8 * g + 4);
          v4u o; o.x = pk2(bflo(qw[ks].x) * rq * g0.x, bfhi(qw[ks].x) * rq * g0.y); o.y = pk2(bflo(qw[ks].y) * rq * g0.z, bfhi(qw[ks].y) * rq * g0.w);
          o.z = pk2(bflo(qw[ks].z) * rq * g1.x, bfhi(qw[ks].z) * rq * g1.y); o.w = pk2(bflo(qw[ks].w) * rq * g1.z, bfhi(qw[ks].w) * rq * g1.w);
          Qf[ks] = __builtin_bit_cast(bf16x8, o); } }
    const f32x4 kg0 = *(const GAS f32x4*)(F.k_gain + sdch * 8), kg1 = *(const GAS f32x4*)(F.k_gain + sdch * 8 + 4);
    f32x4 S[9][3];
#pragma unroll
    for (int s = 0; s < 9; ++s)
#pragma unroll
        for (int b = 0; b < 3; ++b) S[s][b] = (f32x4){0.f, 0.f, 0.f, 0.f};
#pragma unroll
    for (int s = 0; s < 9; ++s) { LAS unsigned char* slot = ring + (s & 1) * NA_SLOT;
#pragma unroll
        for (int q2 = 0; q2 < 2; ++q2) { const v4u w = R[s & 1][q2];
            const float a0 = bflo(w.x), a1 = bfhi(w.x), a2 = bflo(w.y), a3 = bfhi(w.y), a4 = bflo(w.z), a5 = bfhi(w.z), a6 = bflo(w.w), a7 = bfhi(w.w);
            float ss = (a0 * a0 + a1 * a1) + (a2 * a2 + a3 * a3) + (a4 * a4 + a5 * a5) + (a6 * a6 + a7 * a7);
            ss += __shfl_xor(ss, 1); ss += __shfl_xor(ss, 2); ss += __shfl_xor(ss, 4); ss += __shfl_xor(ss, 8);
            const float rk = 1.f / sqrtf(ss * (1.f / HD) + RMS_EPS);
            v4u o; o.x = pk2(a0 * rk * kg0.x, a1 * rk * kg0.y); o.y = pk2(a2 * rk * kg0.z, a3 * rk * kg0.w); o.z = pk2(a4 * rk * kg1.x, a5 * rk * kg1.y); o.w = pk2(a6 * rk * kg1.z, a7 * rk * kg1.w);
            *(LAS v4u*)(slot + (skey + 32 * q2) * NA_KP + sdch * 16) = o; }
        if (s + 2 < 9) NA_LOAD(Kt, s + 2);
        __syncthreads();
#pragma unroll
        for (int b = 0; b < 3; ++b)
#pragma unroll
            for (int ks = 0; ks < 4; ++ks) { const bf16x8 a = *(const LAS bf16x8*)(slot + (16 * (kb0 + b) + fr) * NA_KP + (32 * ks + 8 * g) * 2);
                S[s][b] = __builtin_amdgcn_mfma_f32_16x16x32_bf16(a, Qf[ks], S[s][b], 0, 0, 0); }
    }
    NA_LOAD(Vv, 0); NA_LOAD(Vv, 1);
    float mx = -1e30f;
#pragma unroll
    for (int s = 0; s < 9; ++s) { const int kr = b0 + s; const bool rowok = (kr >= rs) && (kr <= rs + 7); const int rbase = (kr - r + 7) * 31 + 15 - c;
#pragma unroll
        for (int b = 0; b < 3; ++b)
#pragma unroll
            for (int i = 0; i < 4; ++i) { const int kc = 16 * (kb0 + b) + 4 * g + i; const bool ok = rowok && (kc >= cs) && (kc <= cs + 15);
                int idx = rbase + kc; idx = ok ? idx : 0; const float v = ok ? S[s][b][i] + rpbL[idx] : -1e30f; S[s][b][i] = v; mx = fmaxf(mx, v); } }
    mx = fmaxf(mx, __shfl_xor(mx, 16)); mx = fmaxf(mx, __shfl_xor(mx, 32));
    float lsum = 0.f;
#pragma unroll
    for (int s = 0; s < 9; ++s)
#pragma unroll
        for (int b = 0; b < 3; ++b)
#pragma unroll
            for (int i = 0; i < 4; ++i) { const float e = __builtin_amdgcn_exp2f(S[s][b][i] - mx); S[s][b][i] = e; lsum += e; }
    lsum += __shfl_xor(lsum, 16); lsum += __shfl_xor(lsum, 32);
    const float inv = 1.f / lsum;
    f32x4 O[8];
#pragma unroll
    for (int db = 0; db < 8; ++db) O[db] = (f32x4){0.f, 0.f, 0.f, 0.f};
    __syncthreads();
#pragma unroll
    for (int s = 0; s < 9; ++s) { LAS unsigned char* slot = ring + (s & 1) * NA_SLOT;
#pragma unroll
        for (int q2 = 0; q2 < 2; ++q2) *(LAS v4u*)(slot + (skey + 32 * q2) * NA_VP + sdch * 16) = R[s & 1][q2];
        if (s + 2 < 9) NA_LOAD(Vv, s + 2);
        __syncthreads();
#pragma unroll
        for (int b = 0; b < 3; ++b) { v2u pw; pw.x = pk2(S[s][b][0], S[s][b][1]); pw.y = pk2(S[s][b][2], S[s][b][3]); const s16x4 pf = __builtin_bit_cast(s16x4, pw);
#pragma unroll
            for (int db = 0; db < 8; ++db) { const s16x4 vf = __builtin_amdgcn_ds_read_tr16_b64_v4i16((LAS s16x4*)(slot + (16 * (kb0 + b) + 4 * g + q4) * NA_VP + db * 32 + 8 * p4));
                O[db] = __builtin_amdgcn_mfma_f32_16x16x16bf16_1k(vf, pf, O[db], 0, 0, 0); } }
    }
#undef NA_LOAD
    bf16* orow = YB + (size_t)(r * GRID_W + c) * NAW + h * HD + 4 * g;
#pragma unroll
    for (int db = 0; db < 8; ++db) { v2u o; o.x = pk2(O[db][0] * inv, O[db][1] * inv); o.y = pk2(O[db][2] * inv, O[db][3] * inv); *(GAS v2u*)(orow + 16 * db) = o; }
}

struct Args { const float* in[17]; float* out; unsigned char* ws; int ph_lo, ph_hi, li, pad; };
__global__ void __launch_bounds__(NWAVES * 64, 2) fwd_kernel(Args args) {
    extern __shared__ __attribute__((aligned(16))) unsigned char lds[];
    Frame F;
    F.lds = (LAS unsigned char*)lds;
    F.MISC = (volatile LAS unsigned*)(F.lds + MISC_OFF);
    F.tid = threadIdx.x; F.lane = F.tid & 63; F.wave = __builtin_amdgcn_readfirstlane(F.tid >> 6);
    F.G = gridDim.x; { const int bx = blockIdx.x; F.vcu = (F.G % 8 == 0) ? (bx % 8) * (F.G / 8) + bx / 8 : bx; }
    F.ws = args.ws; F.ctl = (gu32*)(args.ws + WS_CTL);
    F.x = args.in[0]; F.norm1_g = args.in[1]; F.w_in = args.in[2]; F.gm_ln_g = args.in[3]; F.gm_ln_b = args.in[4]; F.gm_w_s = args.in[5]; F.gm_b_s = args.in[6];
    F.q_gain = args.in[7]; F.k_gain = args.in[8]; F.na_rpb = args.in[9]; F.w_o_gm = args.in[10]; F.w_o_na = args.in[11]; F.w_out = args.in[12]; F.norm2_g = args.in[13];
    F.w_ff_gate = args.in[14]; F.w_ff_up = args.in[15]; F.w_ff_down = args.in[16]; F.out = args.out;
    for (int u = F.tid; u < (LDS_BYTES - LDSCTL_OFF) / 4; u += NWAVES * 64) ((LAS unsigned*)(F.lds + LDSCTL_OFF))[u] = 0u;
    __syncthreads();
    XcdBarrier bar; bar.bar = (unsigned*)(F.ctl + CW_BAR); bar.x = 0; bar.st = nullptr;
    if (N_LAUNCHES != PER_PHASE) bar = xcd_barrier_post((unsigned*)(F.ctl + CW_BAR), F.MISC + 8);
#define GRID_BAR() do { if (N_LAUNCHES != PER_PHASE) xcd_barrier(bar); } while (0)
    const int lo = args.ph_lo, hi = args.ph_hi < MK_STOP_AFTER + 1 ? args.ph_hi : MK_STOP_AFTER + 1;
#define IN(k) (lo <= (k) && (k) < hi)
#define BOTH(k) (IN(k) && IN((k) + 1))
    const int bx = (int)blockIdx.x;

    if (IN(0)) { p0_prologue(F); if (BOTH(0)) GRID_BAR(); }

    if (IN(1)) {
        pg8::SchedPlain S; S.o.init(M, NIN, F.G, bx); S.A = (const char*)(F.ws + WS_RA); S.B = (const char*)(F.ws + WS_WIN); S.tstep = (size_t)256 * D * 2;
        pg8::EpiProj E{(bf16*)(F.ws + WS_RB), M};
        pg8::gemm_phase<pg8::EpiProj, pg8::SchedPlain, true, true>(F.lds, D, S, E);
        if (BOTH(1)) GRID_BAR();
    }
    if (IN(2)) {
        for (int u = bx; u < 2 * (M / CHUNK); u += F.G) gmlp_unit(F, u >> 1, u & 1);
        for (int u = F.vcu; u < (GRID_H / 2) * NHEAD; u += F.G) na_unit(F, u & (GRID_H / 2 - 1), u >> 7);
        if (BOTH(2)) GRID_BAR();
    }
    if (IN(3)) {
        pg8::SchedMerge S; S.o.init(M, D, F.G, bx); S.A0 = (const char*)(F.ws + WS_YA); S.B0 = (const char*)(F.ws + WS_WOA); S.A1 = (const char*)(F.ws + WS_YB); S.B1 = (const char*)(F.ws + WS_WOB); S.tstep = (size_t)256 * GMW * 2;
        pg8::EpiMerge E{(const bf16*)(F.ws + WS_GA), (const bf16*)(F.ws + WS_GB), (bf16*)(F.ws + WS_MRG)};
        pg8::gemm_phase<pg8::EpiMerge, pg8::SchedMerge, true, true>(F.lds, GMW, S, E);
        if (BOTH(3)) GRID_BAR();
    }
    if (IN(4)) {
        pg8::SchedPlain S; S.o.init(M, D, F.G, bx); S.A = (const char*)(F.ws + WS_MRG); S.B = (const char*)(F.ws + WS_WOUT); S.tstep = (size_t)256 * D * 2;
        pg8::EpiResF32 E{F.x, F.out};
        pg8::gemm_phase<pg8::EpiResF32, pg8::SchedPlain, true, true>(F.lds, D, S, E);
        if (BOTH(4)) GRID_BAR();
    }
    if (IN(5)) { p5_norm_and_ffn_weights(F); if (BOTH(5)) GRID_BAR(); }
    if (IN(6)) {
        pg8::SchedPlain S; S.o.init(M, NGU, F.G, bx); S.A = (const char*)(F.ws + WS_RA); S.B = (const char*)(F.ws + WS_WGU); S.tstep = (size_t)256 * D * 2;
        pg8::EpiSwiglu E{(bf16*)(F.ws + WS_ACT), DFF};
        pg8::gemm_phase<pg8::EpiSwiglu, pg8::SchedPlain, true, true>(F.lds, D, S, E);
        if (BOTH(6)) GRID_BAR();
    }
    if (IN(7)) {
        pg8::SchedPlain S; S.o.init(M, D, F.G, bx); S.A = (const char*)(F.ws + WS_ACT); S.B = (const char*)(F.ws + WS_WD); S.tstep = (size_t)256 * DFF * 2;
        pg8::EpiResF32 E{F.out, F.out};
        pg8::gemm_phase<pg8::EpiResF32, pg8::SchedPlain, true, true>(F.lds, DFF, S, E);
    }

#if MK_STOP_AFTER < 4
    {
        GRID_BAR();
        const bf16* pU = (const bf16*)(F.ws + WS_U); const bf16* pV = (const bf16*)(F.ws + WS_V); const bf16* pQ = (const bf16*)(F.ws + WS_Q); const bf16* pK = (const bf16*)(F.ws + WS_K); const bf16* pVV = (const bf16*)(F.ws + WS_VV);
        const bf16* pGA = (const bf16*)(F.ws + WS_GA); const bf16* pGB = (const bf16*)(F.ws + WS_GB); const bf16* pYA = (const bf16*)(F.ws + WS_YA); const bf16* pYB = (const bf16*)(F.ws + WS_YB); const bf16* pM = (const bf16*)(F.ws + WS_MRG);
        for (size_t i = (size_t)bx * 512 + F.tid; i < (size_t)M * D; i += (size_t)F.G * 512) { const size_t m = i >> 12; const int c = (int)(i & 4095), c2 = c & 2047; float v;
            if (MK_STOP_AFTER == 1) v = 0.f * bflo(pGA[i]) + 0.f * bflo(pGB[i]) + 8.f * bflo(((const bf16*)(F.ws + WS_WOA))[(m & 4095) * 2048 + c2]) + 9.f * bflo(((const bf16*)(F.ws + WS_WOB))[(m & 4095) * 2048 + c2]) + 10.f * bflo(((const bf16*)(F.ws + WS_WOUT))[(m & 4095) * 4096 + c]);
            else if (MK_STOP_AFTER == 2) v = c < 2048 ? bflo(pYA[m * 2048 + c2]) : bflo(pYB[m * 2048 + c2]);
            else if (MK_STOP_AFTER == 3) v = bflo(pM[i]);
            else v = F.x[i];
            F.out[i] = v; }
    }
#endif
#undef IN
#undef BOTH
#undef GRID_BAR
}

extern "C" void kernel_launch(void* const* d_in, const int* in_sizes, int n_in, void* d_out, int out_size, void* d_ws, size_t ws_size, hipStream_t stream) {
    static int grid = 0;
    if (grid == 0) {
        if (n_in != 17 || in_sizes[0] != M * D || out_size != M * D || ws_size < WS_END) { fprintf(stderr, "kernel_launch: unexpected shapes/workspace (n_in %d, in0 %d, out %d, ws %zu < %zu); nothing launched\n", n_in, n_in > 0 ? in_sizes[0] : -1, out_size, ws_size, (size_t)WS_END); grid = -1; return; }
        int dev = 0, cus = 0, per_cu = 0;
        if (hipGetDevice(&dev) != hipSuccess || hipDeviceGetAttribute(&cus, hipDeviceAttributeMultiprocessorCount, dev) != hipSuccess) { grid = -1; return; }
        if (hipFuncSetAttribute((const void*)fwd_kernel, hipFuncAttributeMaxDynamicSharedMemorySize, LDS_BYTES) != hipSuccess) { fprintf(stderr, "kernel_launch: hipFuncSetAttribute failed\n"); grid = -1; return; }
        if (hipOccupancyMaxActiveBlocksPerMultiprocessor(&per_cu, (const void*)fwd_kernel, NWAVES * 64, LDS_BYTES) != hipSuccess || per_cu < 1) fprintf(stderr, "kernel_launch: occupancy query reports %d\n", per_cu);
        (void)hipGetLastError();
        grid = cus;
    }
    if (grid < 0) return;
    if (hipMemsetAsync((char*)d_ws + WS_CTL, 0, CTL_ZERO_BYTES, stream) != hipSuccess) return;
    Args a{};
    for (int i = 0; i < 17; ++i) a.in[i] = (const float*)d_in[i];
    a.out = (float*)d_out; a.ws = (unsigned char*)d_ws;
    for (int li = 0; li < N_LAUNCHES; ++li) {
        if (N_LAUNCHES == PER_PHASE) { a.ph_lo = li; a.ph_hi = li + 1; } else { a.ph_lo = 0; a.ph_hi = PER_PHASE; }
        a.li = li; a.pad = 0;
        hipLaunchKernelGGL(fwd_kernel, dim3(grid), dim3(NWAVES * 64), LDS_BYTES, stream, a);
        const hipError_t le = hipPeekAtLastError();
        if (le != hipSuccess) { fprintf(stderr, "kernel_launch: launch %d failed: %s\n", li, hipGetErrorName(le)); break; }
    }
}
```

```cpp
#include <hip/hip_runtime.h>
#include <cstdio>
#include <cstdint>

#ifndef MK_N_LAUNCHES
#define MK_N_LAUNCHES 1
#endif
#ifndef MK_REPEAT
#define MK_REPEAT 0
#endif
#define NREP(k) (((MK_REPEAT >> (k)) & 1) + 1)
#ifndef MK_STOP_AFTER
#define MK_STOP_AFTER 7
#endif

__device__ __forceinline__ int opaque_tid() { int t = (int)threadIdx.x; asm volatile("" : "+v"(t)); return t; }
namespace pg8 {
#define PG8_LAS __attribute__((address_space(3)))
typedef unsigned short bf16_t;
typedef short bf16x8 __attribute__((ext_vector_type(8)));
typedef float f32x4 __attribute__((ext_vector_type(4)));
typedef float f32x2 __attribute__((ext_vector_type(2)));
typedef unsigned u32x4 __attribute__((ext_vector_type(4)));
typedef unsigned u32x2 __attribute__((ext_vector_type(2)));
constexpr int BM = 256, BK = 64, HALF = 128, HTB = HALF * BK * 2  , STAGE_BYTES = 8 * HTB, NXCD = 8, WGM = 8;

__host__ __device__ __forceinline__ int lds_byte(int r, int c) { const int st = (r >> 4) * 2 + (c >> 5), rr = r & 15, cc = c & 31, ob = rr * 64 + cc * 2; return st * 1024 + (ob ^ (((ob >> 9) & 1) << 5)); }
__host__ __device__ __forceinline__ void stage_rc(int b, int& R, int& C) { const int st = b / 1024, sb = b % 1024, swz = sb ^ (((sb >> 9) & 1) << 5); R = (st >> 1) * 16 + swz / 64; C = (st & 1) * 32 + (swz % 64) / 2; }
__host__ __device__ __forceinline__ int perm32(int rho) { const int n = rho >> 4, i = rho & 15; return 8 * (i >> 2) + 4 * n + (i & 3); }

struct Unit { int pm, pn, sub; };

struct StaticOrder {
    int nM, nN, nwg, G, c;
    __host__ __device__ void init(int M, int N, int G_, int c_) { nM = M / BM; nN = N / BM; nwg = nM * nN; G = G_; c = c_; }
    __host__ __device__ bool tile(int i, Unit& u) const {
        const long L = (long)i * G + c; if (L >= nwg) return false;
        int wgid = (int)L; { const int q = nwg / NXCD, r = nwg % NXCD, xcd = wgid % NXCD, off = wgid / NXCD; wgid = (xcd < r ? xcd * (q + 1) : r * (q + 1) + (xcd - r) * q) + off; }
        const int nig = WGM * nN, gid = wgid / nig, fm = gid * WGM, gsz = (nM - fm) < WGM ? (nM - fm) : WGM;
        u.pm = fm + ((wgid % nig) % gsz); u.pn = (wgid % nig) / gsz; u.sub = 0; return true;
    }
};
struct SchedPlain {
    StaticOrder o; const char* A; const char* B; size_t tstep;
    __device__ __forceinline__ bool next(int i, Unit& u) const { return o.tile(i, u); }
    __device__ __forceinline__ void ptrs(const Unit& u, const char*& a, const char*& b) const { a = A + (size_t)u.pm * tstep; b = B + (size_t)u.pn * tstep; }
};
struct SchedP1a {
    StaticOrder o; const char* A; const char* B; size_t tstep;
    __device__ __forceinline__ bool next(int i, Unit& u) const { const bool ok = o.tile(i, u); u.pn = u.pn < 16 ? u.pn : u.pn + 24; return ok; }
    __device__ __forceinline__ void ptrs(const Unit& u, const char*& a, const char*& b) const { a = A + (size_t)u.pm * tstep; b = B + (size_t)u.pn * tstep; }
};
struct SchedP1b {
    StaticOrder o; const char* A8; const char* B8; size_t tstep8;
    __device__ __forceinline__ bool next(int i, Unit& u) const { const bool ok = o.tile(i, u); u.sub = u.pn; u.pn = u.pn + 16; return ok; }
    __device__ __forceinline__ void ptrs(const Unit& u, const char*& a, const char*& b) const { a = A8 + (size_t)u.pm * tstep8; b = B8 + (size_t)u.sub * tstep8; }
};
struct SchedMerge {
    StaticOrder o; const char* A0; const char* B0; const char* A1; const char* B1; size_t tstep;
    __device__ __forceinline__ bool next(int i, Unit& u) const { const bool ok = o.tile(i >> 1, u); u.sub = i & 1; return ok; }
    __device__ __forceinline__ void ptrs(const Unit& u, const char*& a, const char*& b) const { a = (u.sub ? A1 : A0) + (size_t)u.pm * tstep; b = (u.sub ? B1 : B0) + (size_t)u.pn * tstep; }
};

typedef __bf16 bf16x2v __attribute__((ext_vector_type(2)));
__device__ __forceinline__ unsigned cvt_pk_bf16(float lo, float hi) { const bf16x2v v = __builtin_convertvector((f32x2){lo, hi}, bf16x2v); return __builtin_bit_cast(unsigned, v); }
__device__ __forceinline__ float bf_lo(unsigned w) { return __uint_as_float(w << 16); }
__device__ __forceinline__ float bf_hi(unsigned w) { return __uint_as_float(w & 0xffff0000u); }
__device__ __forceinline__ f32x2 gelu_pk(f32x2 v) {
    const f32x2 av = __builtin_elementwise_abs(v), d = av * 0.2316418882f + 1.0f;
    f32x2 t; t.x = __builtin_amdgcn_rcpf(d.x); t.y = __builtin_amdgcn_rcpf(d.y);
    f32x2 q = t * 0.5307027145f + (-0.7265760135f); q = q * t + 0.7107068705f; q = q * t + (-0.142248368f); q = q * t + 0.127414796f; q = q * t;
    const f32x2 s = (v * v) * (-0.72134752044f);
    f32x2 e; e.x = __builtin_amdgcn_exp2f(s.x); e.y = __builtin_amdgcn_exp2f(s.y);
    const f32x2 m = v * (q * e), r = v - m;
    f32x2 o; o.x = v.x < 0.f ? m.x : r.x; o.y = v.y < 0.f ? m.y : r.y; return o;
}
__device__ __forceinline__ float sigmoid_f(float x) { return __builtin_amdgcn_rcpf(1.0f + __builtin_amdgcn_exp2f(x * -1.44269504089f)); }
__device__ __forceinline__ f32x4 gelu4(f32x4 v) { const f32x2 a = gelu_pk((f32x2){v[0], v[1]}), b = gelu_pk((f32x2){v[2], v[3]}); return (f32x4){a.x, a.y, b.x, b.y}; }
__device__ __forceinline__ f32x4 sigm4(f32x4 v) { return (f32x4){sigmoid_f(v[0]), sigmoid_f(v[1]), sigmoid_f(v[2]), sigmoid_f(v[3])}; }
__device__ __forceinline__ u32x4 pack8(f32x4 v0, f32x4 v1) { u32x4 w; w.x = cvt_pk_bf16(v0[0], v0[1]); w.y = cvt_pk_bf16(v0[2], v0[3]); w.z = cvt_pk_bf16(v1[0], v1[1]); w.w = cvt_pk_bf16(v1[2], v1[3]); return w; }

__device__ __forceinline__ unsigned pack_u8x4(f32x4 v) { const f32x4 q = v * 255.f + 0.5f; return (unsigned)q[0] | ((unsigned)q[1] << 8) | ((unsigned)q[2] << 16) | ((unsigned)q[3] << 24); }
__device__ __forceinline__ f32x4 unpack_u8x4(unsigned w) { return (f32x4){(float)(w & 0xffu), (float)((w >> 8) & 0xffu), (float)((w >> 16) & 0xffu), (float)(w >> 24)}; }
struct EpiProj {
    static constexpr bool PERM = true;
    bf16_t* base; int M; float qkv_scale;
    float* vstat;
    __device__ __forceinline__ void store_v(const f32x4 (&acc)[2][2][4][2], bf16_t* O, int row0, int col0, int slice, int fq) const {
#pragma unroll
        for (int ai = 0; ai < 2; ++ai)
#pragma unroll
            for (int m = 0; m < 4; ++m) { const int row = row0 + ai * HALF + m * 16; bf16_t* rowp = O + (size_t)row * 2048 + col0; float s = 0.f, s2 = 0.f;
#pragma unroll
                for (int bj = 0; bj < 2; ++bj) { const f32x4 v0 = gelu4(acc[ai][bj][m][0]), v1 = gelu4(acc[ai][bj][m][1]);
                    s += ((v0[0] + v0[1]) + (v0[2] + v0[3])) + ((v1[0] + v1[1]) + (v1[2] + v1[3]));
                    s2 += ((v0[0] * v0[0] + v0[1] * v0[1]) + (v0[2] * v0[2] + v0[3] * v0[3])) + ((v1[0] * v1[0] + v1[1] * v1[1]) + (v1[2] * v1[2] + v1[3] * v1[3]));
                    *(u32x4*)(rowp + bj * HALF) = pack8(v0, v1); }
                s += __shfl_xor(s, 16); s += __shfl_xor(s, 32); s2 += __shfl_xor(s2, 16); s2 += __shfl_xor(s2, 32);
                if (fq == 0) *(f32x2*)(vstat + (size_t)row * 64 + 2 * slice) = (f32x2){s, s2}; }
    }
    __device__ __forceinline__ bool keep(const Unit&) const { return false; }
    template <int ACT> __device__ __forceinline__ void store(const f32x4 (&acc)[2][2][4][2], bf16_t* O, int ldc, int row0, int col0) const {
#pragma unroll
        for (int ai = 0; ai < 2; ++ai)
#pragma unroll
            for (int m = 0; m < 4; ++m) { bf16_t* rowp = O + (size_t)(row0 + ai * HALF + m * 16) * ldc + col0;
#pragma unroll
                for (int bj = 0; bj < 2; ++bj) { f32x4 v0 = acc[ai][bj][m][0], v1 = acc[ai][bj][m][1];
                    if (ACT == 0) { v0 = v0 * qkv_scale; v1 = v1 * qkv_scale; }
                    if (ACT == 1) { v0 = gelu4(v0); v1 = gelu4(v1); }
                    if (ACT == 2) { v0 = sigm4(v0); v1 = sigm4(v1); }
                    *(u32x4*)(rowp + bj * HALF) = pack8(v0, v1); } }
    }
    __device__ __forceinline__ void operator()(f32x4 (&acc)[2][2][4][2], const Unit& u, int wr, int wc, int fr, int fq) const {
        const int row0 = u.pm * BM + wr * 64 + fr, pn = u.pn;
        if (pn < 40) { const int t = pn >> 3; bf16_t* O = base + (size_t)t * M * 2048; const int col0 = (pn & 7) * BM + wc * 32 + 8 * fq;
            if (t == 0) store<1>(acc, O, 2048, row0, col0); else if (t == 1) store_v(acc, O, row0, col0, (pn & 7) * 4 + wc, fq); else store<0>(acc, O, 2048, row0, col0); }
        else { const int t = (pn - 40) >> 4; bf16_t* O = base + (size_t)5 * M * 2048 + (size_t)t * M * 4096; const int col0 = ((pn - 40) & 15) * BM + wc * 32 + 8 * fq;
            store<2>(acc, O, 4096, row0, col0); }
    }
};
struct EpiQKV {
    static constexpr bool PERM = true;
    bf16_t* base; int M; float sc; unsigned char* ga8; unsigned char* gb8;
    __device__ __forceinline__ void store_gate(const f32x4 (&acc)[2][2][4][2], unsigned char* O8, int row0, int col0) const {
#pragma unroll
        for (int ai = 0; ai < 2; ++ai)
#pragma unroll
            for (int m = 0; m < 4; ++m) { unsigned char* rowp = O8 + (size_t)(row0 + ai * HALF + m * 16) * 4096 + col0;
#pragma unroll
                for (int bj = 0; bj < 2; ++bj) { const f32x4 v0 = sigm4(acc[ai][bj][m][0] * sc), v1 = sigm4(acc[ai][bj][m][1] * sc);
                    *(u32x2*)(rowp + bj * HALF) = (u32x2){pack_u8x4(v0), pack_u8x4(v1)}; } }
    }
    __device__ __forceinline__ bool keep(const Unit&) const { return false; }
    template <int ACT> __device__ __forceinline__ void store(const f32x4 (&acc)[2][2][4][2], bf16_t* O, int ldc, int row0, int col0) const {
#pragma unroll
        for (int ai = 0; ai < 2; ++ai)
#pragma unroll
            for (int m = 0; m < 4; ++m) { bf16_t* rowp = O + (size_t)(row0 + ai * HALF + m * 16) * ldc + col0;
#pragma unroll
                for (int bj = 0; bj < 2; ++bj) { f32x4 v0 = acc[ai][bj][m][0] * sc, v1 = acc[ai][bj][m][1] * sc;
                    if (ACT == 2) { v0 = sigm4(v0); v1 = sigm4(v1); }
                    *(u32x4*)(rowp + bj * HALF) = pack8(v0, v1); } }
    }
    __device__ __forceinline__ void operator()(f32x4 (&acc)[2][2][4][2], const Unit& u, int wr, int wc, int fr, int fq) const {
        const int row0 = u.pm * BM + wr * 64 + fr;
        if (u.pn < 40) store<0>(acc, base + (size_t)(u.pn >> 3) * M * 2048, 2048, row0, (u.pn & 7) * BM + wc * 32 + 8 * fq);
        else store_gate(acc, u.pn < 56 ? ga8 : gb8, row0, ((u.pn - 40) & 15) * BM + wc * 32 + 8 * fq);
    }
};
struct EpiTB {
    static constexpr bool PERM = true;
    const unsigned char* GB; bf16_t* T; float sc;
    __device__ __forceinline__ bool keep(const Unit&) const { return false; }
    __device__ __forceinline__ void operator()(f32x4 (&acc)[2][2][4][2], const Unit& u, int wr, int wc, int fr, int fq) const {
        const int row0 = u.pm * BM + wr * 64 + fr, col0 = u.pn * BM + wc * 32 + 8 * fq;
#pragma unroll
        for (int ai = 0; ai < 2; ++ai)
#pragma unroll
            for (int m = 0; m < 4; ++m) { const size_t off = (size_t)(row0 + ai * HALF + m * 16) * 4096 + col0;
#pragma unroll
                for (int bj = 0; bj < 2; ++bj) { const u32x2 b = *(const u32x2*)(GB + off + bj * HALF);
                    const f32x4 s0 = unpack_u8x4(b.x) * sc, s1 = unpack_u8x4(b.y) * sc;
                    *(u32x4*)(T + off + bj * HALF) = pack8(acc[ai][bj][m][0] * s0, acc[ai][bj][m][1] * s1); } }
    }
};
struct EpiMergeA {
    static constexpr bool PERM = true;
    const unsigned char* GA; const bf16_t* T; bf16_t* O;
    __device__ __forceinline__ bool keep(const Unit&) const { return false; }
    __device__ __forceinline__ void operator()(f32x4 (&acc)[2][2][4][2], const Unit& u, int wr, int wc, int fr, int fq) const {
        const int row0 = u.pm * BM + wr * 64 + fr, col0 = u.pn * BM + wc * 32 + 8 * fq;
#pragma unroll
        for (int ai = 0; ai < 2; ++ai)
#pragma unroll
            for (int m = 0; m < 4; ++m) { const size_t off = (size_t)(row0 + ai * HALF + m * 16) * 4096 + col0;
#pragma unroll
                for (int bj = 0; bj < 2; ++bj) { const u32x2 a = *(const u32x2*)(GA + off + bj * HALF); const u32x4 t = *(const u32x4*)(T + off + bj * HALF);
                    const f32x4 s0 = unpack_u8x4(a.x) * (1.f / 255.f), s1 = unpack_u8x4(a.y) * (1.f / 255.f);
                    const f32x4 t0 = (f32x4){bf_lo(t.x), bf_hi(t.x), bf_lo(t.y), bf_hi(t.y)}, t1 = (f32x4){bf_lo(t.z), bf_hi(t.z), bf_lo(t.w), bf_hi(t.w)};
                    *(u32x4*)(O + off + bj * HALF) = pack8(acc[ai][bj][m][0] * s0 + t0, acc[ai][bj][m][1] * s1 + t1); } }
    }
};
struct EpiMix {
    static constexpr bool PERM = true;
    const unsigned char* GA; const unsigned char* GB; bf16_t* O; float c;
    __device__ __forceinline__ bool keep(const Unit& u) const { return u.sub == 0; }
    __device__ __forceinline__ void operator()(f32x4 (&acc)[2][2][4][2], const Unit& u, int wr, int wc, int fr, int fq) const {
        const int row0 = u.pm * BM + wr * 64 + fr, col0 = u.pn * BM + wc * 32 + 8 * fq;
        if (u.sub == 0) {
#pragma unroll
            for (int ai = 0; ai < 2; ++ai)
#pragma unroll
                for (int m = 0; m < 4; ++m) { const size_t off = (size_t)(row0 + ai * HALF + m * 16) * 4096 + col0;
#pragma unroll
                    for (int bj = 0; bj < 2; ++bj) { const u32x2 a = *(const u32x2*)(GA + off + bj * HALF), b = *(const u32x2*)(GB + off + bj * HALF);
                        f32x4 a0 = __builtin_elementwise_max(unpack_u8x4(a.x), (f32x4){9.5367431640625e-7f, 9.5367431640625e-7f, 9.5367431640625e-7f, 9.5367431640625e-7f});
                        f32x4 a1 = __builtin_elementwise_max(unpack_u8x4(a.y), (f32x4){9.5367431640625e-7f, 9.5367431640625e-7f, 9.5367431640625e-7f, 9.5367431640625e-7f});
                        const f32x4 r0 = (f32x4){__builtin_amdgcn_rcpf(a0[0]), __builtin_amdgcn_rcpf(a0[1]), __builtin_amdgcn_rcpf(a0[2]), __builtin_amdgcn_rcpf(a0[3])};
                        const f32x4 r1 = (f32x4){__builtin_amdgcn_rcpf(a1[0]), __builtin_amdgcn_rcpf(a1[1]), __builtin_amdgcn_rcpf(a1[2]), __builtin_amdgcn_rcpf(a1[3])};
                        acc[ai][bj][m][0] = acc[ai][bj][m][0] * (unpack_u8x4(b.x) * c) * r0; acc[ai][bj][m][1] = acc[ai][bj][m][1] * (unpack_u8x4(b.y) * c) * r1; } }
        } else {
#pragma unroll
            for (int ai = 0; ai < 2; ++ai)
#pragma unroll
                for (int m = 0; m < 4; ++m) { const size_t off = (size_t)(row0 + ai * HALF + m * 16) * 4096 + col0;
#pragma unroll
                    for (int bj = 0; bj < 2; ++bj) { const u32x2 a = *(const u32x2*)(GA + off + bj * HALF);
                        const f32x4 a0 = __builtin_elementwise_max(unpack_u8x4(a.x), (f32x4){9.5367431640625e-7f, 9.5367431640625e-7f, 9.5367431640625e-7f, 9.5367431640625e-7f}) * (1.f / 255.f);
                        const f32x4 a1 = __builtin_elementwise_max(unpack_u8x4(a.y), (f32x4){9.5367431640625e-7f, 9.5367431640625e-7f, 9.5367431640625e-7f, 9.5367431640625e-7f}) * (1.f / 255.f);
                        *(u32x4*)(O + off + bj * HALF) = pack8(acc[ai][bj][m][0] * a0, acc[ai][bj][m][1] * a1); } }
        }
    }
};
__device__ __forceinline__ float sb_lo(unsigned w) { return fmaxf(bf_lo(w), 8.673617379884035e-19f); }
__device__ __forceinline__ float sb_hi(unsigned w) { return fmaxf(bf_hi(w), 8.673617379884035e-19f); }
struct EpiMerge {
    static constexpr bool PERM = true;
    const bf16_t* GA; const bf16_t* GB; bf16_t* O;
    __device__ __forceinline__ bool keep(const Unit& u) const { return u.sub == 0; }
    __device__ __forceinline__ void operator()(f32x4 (&acc)[2][2][4][2], const Unit& u, int wr, int wc, int fr, int fq) const {
        const int row0 = u.pm * BM + wr * 64 + fr, col0 = u.pn * BM + wc * 32 + 8 * fq;
        if (u.sub == 0) {
#pragma unroll
            for (int ai = 0; ai < 2; ++ai)
#pragma unroll
                for (int m = 0; m < 4; ++m) { const size_t off = (size_t)(row0 + ai * HALF + m * 16) * 4096 + col0;
#pragma unroll
                    for (int bj = 0; bj < 2; ++bj) { const u32x4 a = *(const u32x4*)(GA + off + bj * HALF), b = *(const u32x4*)(GB + off + bj * HALF);
                        f32x4 r0, r1;
                        r0[0] = bf_lo(a.x) * __builtin_amdgcn_rcpf(sb_lo(b.x)); r0[1] = bf_hi(a.x) * __builtin_amdgcn_rcpf(sb_hi(b.x));
                        r0[2] = bf_lo(a.y) * __builtin_amdgcn_rcpf(sb_lo(b.y)); r0[3] = bf_hi(a.y) * __builtin_amdgcn_rcpf(sb_hi(b.y));
                        r1[0] = bf_lo(a.z) * __builtin_amdgcn_rcpf(sb_lo(b.z)); r1[1] = bf_hi(a.z) * __builtin_amdgcn_rcpf(sb_hi(b.z));
                        r1[2] = bf_lo(a.w) * __builtin_amdgcn_rcpf(sb_lo(b.w)); r1[3] = bf_hi(a.w) * __builtin_amdgcn_rcpf(sb_hi(b.w));
                        acc[ai][bj][m][0] *= r0; acc[ai][bj][m][1] *= r1; } }
        } else {
#pragma unroll
            for (int ai = 0; ai < 2; ++ai)
#pragma unroll
                for (int m = 0; m < 4; ++m) { const size_t off = (size_t)(row0 + ai * HALF + m * 16) * 4096 + col0;
#pragma unroll
                    for (int bj = 0; bj < 2; ++bj) { const u32x4 b = *(const u32x4*)(GB + off + bj * HALF);
                        const f32x4 s0 = (f32x4){sb_lo(b.x), sb_hi(b.x), sb_lo(b.y), sb_hi(b.y)}, s1 = (f32x4){sb_lo(b.z), sb_hi(b.z), sb_lo(b.w), sb_hi(b.w)};
                        *(u32x4*)(O + off + bj * HALF) = pack8(acc[ai][bj][m][0] * s0, acc[ai][bj][m][1] * s1); } }
        }
    }
};
struct EpiResF32 {
    static constexpr bool PERM = false;
    const float* res; float* out;
    __device__ __forceinline__ bool keep(const Unit&) const { return false; }
    __device__ __forceinline__ void operator()(f32x4 (&acc)[2][2][4][2], const Unit& u, int wr, int wc, int fr, int fq) const {
        const int row0 = u.pm * BM + wr * 64 + fr, col0 = u.pn * BM + wc * 32 + 4 * fq;
#pragma unroll
        for (int ai = 0; ai < 2; ++ai)
#pragma unroll
            for (int m = 0; m < 4; ++m) { const size_t off = (size_t)(row0 + ai * HALF + m * 16) * 4096 + col0;
#pragma unroll
                for (int bj = 0; bj < 2; ++bj)
#pragma unroll
                    for (int n = 0; n < 2; ++n) { const f32x4 r = *(const f32x4*)(res + off + bj * HALF + n * 16); *(f32x4*)(out + off + bj * HALF + n * 16) = r + acc[ai][bj][m][n]; } }
    }
};
struct EpiResH16 {
    static constexpr bool PERM = true;
    const bf16_t* h16; float* out;
    __device__ __forceinline__ bool keep(const Unit&) const { return false; }
    __device__ __forceinline__ void operator()(f32x4 (&acc)[2][2][4][2], const Unit& u, int wr, int wc, int fr, int fq) const {
        const int row0 = u.pm * BM + wr * 64 + fr, col0 = u.pn * BM + wc * 32 + 8 * fq;
#pragma unroll
        for (int ai = 0; ai < 2; ++ai)
#pragma unroll
            for (int m = 0; m < 4; ++m) { const size_t off = (size_t)(row0 + ai * HALF + m * 16) * 4096 + col0;
#pragma unroll
                for (int bj = 0; bj < 2; ++bj) { const u32x4 hb = *(const u32x4*)(h16 + off + bj * HALF);
                    const f32x4 h0 = (f32x4){bf_lo(hb.x), bf_hi(hb.x), bf_lo(hb.y), bf_hi(hb.y)}, h1 = (f32x4){bf_lo(hb.z), bf_hi(hb.z), bf_lo(hb.w), bf_hi(hb.w)};
                    __builtin_nontemporal_store(h0 + acc[ai][bj][m][0], (f32x4*)(out + off + bj * HALF)); __builtin_nontemporal_store(h1 + acc[ai][bj][m][1], (f32x4*)(out + off + bj * HALF + 4)); } }
    }
};
struct EpiOutNorm {
    static constexpr bool PERM = true;
    const float* x; bf16_t* h16; bf16_t* HN; const float* g2; float* part;
    __device__ __forceinline__ bool keep(const Unit&) const { return false; }
    __device__ __forceinline__ void operator()(f32x4 (&acc)[2][2][4][2], const Unit& u, int wr, int wc, int fr, int fq) const {
        const int row0 = u.pm * BM + wr * 64 + fr, col0 = u.pn * BM + wc * 32 + 8 * fq;
        f32x4 gg[2][2];
#pragma unroll
        for (int bj = 0; bj < 2; ++bj)
#pragma unroll
            for (int n = 0; n < 2; ++n) gg[bj][n] = *(const f32x4*)(g2 + col0 + bj * HALF + 4 * n);
#pragma unroll
        for (int ai = 0; ai < 2; ++ai)
#pragma unroll
            for (int m = 0; m < 4; ++m) { const int row = row0 + ai * HALF + m * 16; const size_t off = (size_t)row * 4096 + col0; float ss = 0.f;
#pragma unroll
                for (int bj = 0; bj < 2; ++bj) { const f32x4 x0 = *(const f32x4*)(x + off + bj * HALF), x1 = *(const f32x4*)(x + off + bj * HALF + 4);
                    const f32x4 h0 = x0 + acc[ai][bj][m][0], h1 = x1 + acc[ai][bj][m][1];
                    __builtin_nontemporal_store(pack8(h0, h1), (u32x4*)(h16 + off + bj * HALF));
                    ss += ((h0[0] * h0[0] + h0[1] * h0[1]) + (h0[2] * h0[2] + h0[3] * h0[3])) + ((h1[0] * h1[0] + h1[1] * h1[1]) + (h1[2] * h1[2] + h1[3] * h1[3]));
                    *(u32x4*)(HN + off + bj * HALF) = pack8(h0 * gg[bj][0], h1 * gg[bj][1]); }
                ss += __shfl_xor(ss, 16); ss += __shfl_xor(ss, 32);
                if (fq == 0) part[(size_t)row * 64 + u.pn * 4 + wc] = ss; }
    }
};
struct EpiSwiglu {
    static constexpr bool PERM = true; static constexpr int NST = 4;
    bf16_t* O; int ldc; const PG8_LAS float* rstd; int fm;
    __device__ __forceinline__ bool keep(const Unit&) const { return false; }
    template <int AI> __device__ __forceinline__ void half(const f32x4 (&acc)[2][2][4][2], const Unit& u, int wr, int wc, int fr, int fq) const {
        const int row0 = u.pm * BM + wr * 64 + fr, col0 = u.pn * HALF + wc * 32 + 8 * fq, rl0 = (u.pm - fm) * BM + wr * 64 + fr;
#pragma unroll
        for (int m = 0; m < 4; ++m) { bf16_t* rowp = O + (size_t)(row0 + AI * HALF + m * 16) * ldc + col0; const float r = rstd[rl0 + AI * HALF + m * 16];
            const f32x4 g0 = acc[AI][0][m][0] * r, g1 = acc[AI][0][m][1] * r;
            const f32x4 v0 = g0 * sigm4(g0) * (acc[AI][1][m][0] * r), v1 = g1 * sigm4(g1) * (acc[AI][1][m][1] * r);
            __builtin_nontemporal_store(pack8(v0, v1), (u32x4*)rowp); }
    }
    __device__ __forceinline__ void operator()(f32x4 (&acc)[2][2][4][2], const Unit& u, int wr, int wc, int fr, int fq) const { half<0>(acc, u, wr, wc, fr, fq); half<1>(acc, u, wr, wc, fr, fq); }
};

template <class Epi, class Sched, bool ALIGN_EPI, bool SP2>
__device__ __forceinline__ void gemm_phase(PG8_LAS unsigned char* lds, const int K, const Sched& S, const Epi& E) {
    const int tid = opaque_tid(), wid = __builtin_amdgcn_readfirstlane(tid >> 6), lane = tid & 63, wr = wid >> 2, wc = wid & 3, fr = lane & 15, fq = lane >> 4;
    const int nt = K / BK;
    unsigned voffA[2], voffB[2];
#pragma unroll
    for (int i = 0; i < 2; ++i) { int R, C; stage_rc(tid * 16 + i * 8192, R, C); const int Rb = Epi::PERM ? ((R & ~31) + perm32(R & 31)) : R;
        voffA[i] = (unsigned)(R * K + C) * 2u; voffB[i] = (unsigned)(Rb * K + C) * 2u; }
    const size_t kstep = (size_t)(BK * 2);
    const size_t hstep = (size_t)HALF * K * 2;
    const unsigned ldsw = (unsigned)wid * 1024u;
    const int aoff = lds_byte(wr * 64 + fr, fq * 8), boff = lds_byte(wc * 32 + fr, fq * 8);
#define PG8_SA(b, h) (((b) * 2 + (h)) * HTB)
#define PG8_SB(b, h) ((4 + (b) * 2 + (h)) * HTB)
#define PG8_STAGE(bufoff, gbase, voff) do { _Pragma("unroll") for (int _i = 0; _i < 2; ++_i) \
        __builtin_amdgcn_global_load_lds((const unsigned*)((const char*)(gbase) + (voff)[_i]), (PG8_LAS unsigned*)(lds + (bufoff) + ldsw + _i * 8192), 16, 0, 0); } while (0)
#define PG8_LDA(dst, b, h) do { _Pragma("unroll") for (int m = 0; m < 4; ++m) _Pragma("unroll") for (int k = 0; k < 2; ++k) dst[m][k] = *(const PG8_LAS bf16x8*)(lds + PG8_SA(b, h) + aoff + m * 2048 + k * 1024); } while (0)
#define PG8_LDB(dst, b, h) do { _Pragma("unroll") for (int n = 0; n < 2; ++n) _Pragma("unroll") for (int k = 0; k < 2; ++k) dst[n][k] = *(const PG8_LAS bf16x8*)(lds + PG8_SB(b, h) + boff + n * 2048 + k * 1024); } while (0)
#define PG8_MMA(ai, bj, At, Bt) do { __builtin_amdgcn_s_setprio(1); _Pragma("unroll") for (int m = 0; m < 4; ++m) _Pragma("unroll") for (int n = 0; n < 2; ++n) _Pragma("unroll") for (int k = 0; k < 2; ++k) \
        acc[ai][bj][m][n] = __builtin_amdgcn_mfma_f32_16x16x32_bf16(Bt[n][k], At[m][k], acc[ai][bj][m][n], 0, 0, 0); __builtin_amdgcn_s_setprio(0); } while (0)
#define PG8_WAIT_V(n) asm volatile("s_waitcnt vmcnt(" #n ")" ::: "memory")
#define PG8_WAIT_L(n) asm volatile("s_waitcnt lgkmcnt(" #n ")" ::: "memory")
#define PG8_BAR __builtin_amdgcn_s_barrier()
#define PG8_SCHED __builtin_amdgcn_sched_barrier(0)
    Unit cur, nxt; int ui = 0;
    if (!S.next(0, cur)) return;
    f32x4 acc[2][2][4][2];
#pragma unroll
    for (int a = 0; a < 2; ++a)
#pragma unroll
        for (int b = 0; b < 2; ++b)
#pragma unroll
            for (int m = 0; m < 4; ++m)
#pragma unroll
                for (int n = 0; n < 2; ++n) acc[a][b][m][n] = (f32x4){0.f, 0.f, 0.f, 0.f};
    bf16x8 At[4][2], B0[2][2], B1[2][2];
    const char* cA; const char* cB; S.ptrs(cur, cA, cB);
    if constexpr (SP2) {
        PG8_STAGE(PG8_SB(0, 0), cB, voffB); PG8_STAGE(PG8_SB(0, 1), cB + hstep, voffB); PG8_STAGE(PG8_SA(0, 0), cA, voffA); PG8_STAGE(PG8_SA(0, 1), cA + hstep, voffA);
        if (wr == 1) PG8_BAR;
        PG8_WAIT_V(2); PG8_BAR;
        PG8_STAGE(PG8_SB(1, 0), cB + kstep, voffB); PG8_STAGE(PG8_SA(1, 0), cA + kstep, voffA); PG8_STAGE(PG8_SB(1, 1), cB + hstep + kstep, voffB);
        PG8_WAIT_V(6); PG8_BAR;
    } else {
        PG8_STAGE(PG8_SB(0, 0), cB, voffB); PG8_STAGE(PG8_SA(0, 0), cA, voffA); PG8_STAGE(PG8_SB(0, 1), cB + hstep, voffB); PG8_STAGE(PG8_SA(0, 1), cA + hstep, voffA);
        if (wr == 1) PG8_BAR;
        PG8_WAIT_V(4); PG8_BAR;
        PG8_STAGE(PG8_SB(1, 0), cB + kstep, voffB); PG8_STAGE(PG8_SA(1, 0), cA + kstep, voffA); PG8_STAGE(PG8_SB(1, 1), cB + hstep + kstep, voffB);
        PG8_WAIT_V(6); PG8_BAR;
    }
    for (;;) {
        const bool has_next = S.next(ui + 1, nxt);
        const char* nA = cA; const char* nB = cB; if (has_next) S.ptrs(nxt, nA, nB);
        for (int t = 0; t < nt; t += 2) {
            const bool last = (t == nt - 2);
            const char* a1 = cA + (size_t)(t + 1) * kstep;
            const char* a2 = last ? nA : cA + (size_t)(t + 2) * kstep; const char* b2 = last ? nB : cB + (size_t)(t + 2) * kstep;
            const char* a3 = a2 + kstep; const char* b3 = b2 + kstep;
            if constexpr (SP2) {
            PG8_LDB(B0, 0, 0); PG8_LDB(B1, 0, 1); PG8_SCHED; PG8_LDA(At, 0, 0); PG8_STAGE(PG8_SA(1, 1), a1 + hstep, voffA);
            PG8_WAIT_V(8); PG8_WAIT_L(0); PG8_BAR; PG8_MMA(0, 0, At, B0); PG8_MMA(0, 1, At, B1); PG8_BAR; PG8_SCHED;
            PG8_LDA(At, 0, 1); PG8_STAGE(PG8_SB(0, 0), b2, voffB); PG8_STAGE(PG8_SB(0, 1), b2 + hstep, voffB); PG8_STAGE(PG8_SA(0, 0), a2, voffA);
            PG8_WAIT_V(8); PG8_WAIT_L(0); PG8_BAR; PG8_MMA(1, 0, At, B0); PG8_MMA(1, 1, At, B1); PG8_BAR; PG8_SCHED;
            PG8_LDB(B0, 1, 0); PG8_LDB(B1, 1, 1); PG8_SCHED; PG8_LDA(At, 1, 0); PG8_STAGE(PG8_SA(0, 1), a2 + hstep, voffA);
            PG8_WAIT_V(8); PG8_WAIT_L(0); PG8_BAR; PG8_MMA(0, 0, At, B0); PG8_MMA(0, 1, At, B1); PG8_BAR; PG8_SCHED;
            PG8_LDA(At, 1, 1); PG8_STAGE(PG8_SB(1, 0), b3, voffB); PG8_STAGE(PG8_SB(1, 1), b3 + hstep, voffB); PG8_STAGE(PG8_SA(1, 0), a3, voffA);
            PG8_WAIT_V(8); PG8_WAIT_L(0); PG8_BAR; PG8_MMA(1, 0, At, B0); PG8_MMA(1, 1, At, B1); PG8_BAR; PG8_SCHED;
            } else {
            PG8_LDB(B0, 0, 0); PG8_SCHED; PG8_LDA(At, 0, 0); PG8_STAGE(PG8_SA(1, 1), a1 + hstep, voffA);
            PG8_WAIT_L(8); PG8_BAR; PG8_WAIT_L(0); PG8_MMA(0, 0, At, B0); PG8_BAR; PG8_SCHED;
            PG8_LDB(B1, 0, 1); PG8_STAGE(PG8_SB(0, 0), b2, voffB);
            PG8_BAR; PG8_WAIT_L(0); PG8_MMA(0, 1, At, B1); PG8_BAR;
            PG8_LDA(At, 0, 1); PG8_STAGE(PG8_SA(0, 0), a2, voffA);
            PG8_BAR; PG8_WAIT_L(0); PG8_MMA(1, 0, At, B0); PG8_BAR; PG8_SCHED;
            PG8_STAGE(PG8_SB(0, 1), b2 + hstep, voffB);
            PG8_WAIT_V(6); PG8_BAR; PG8_MMA(1, 1, At, B1); PG8_BAR;
            PG8_LDB(B0, 1, 0); PG8_SCHED; PG8_LDA(At, 1, 0); PG8_STAGE(PG8_SA(0, 1), a2 + hstep, voffA);
            PG8_WAIT_L(8); PG8_BAR; PG8_WAIT_L(0); PG8_MMA(0, 0, At, B0); PG8_BAR; PG8_SCHED;
            PG8_LDB(B1, 1, 1); PG8_STAGE(PG8_SB(1, 0), b3, voffB);
            PG8_BAR; PG8_WAIT_L(0); PG8_MMA(0, 1, At, B1); PG8_BAR;
            PG8_LDA(At, 1, 1); PG8_STAGE(PG8_SA(1, 0), a3, voffA);
            PG8_BAR; PG8_WAIT_L(0); PG8_MMA(1, 0, At, B0); PG8_BAR; PG8_SCHED;
            PG8_STAGE(PG8_SB(1, 1), b3 + hstep, voffB);
            PG8_WAIT_V(6); PG8_BAR; PG8_MMA(1, 1, At, B1); PG8_BAR;
            }
        }
        if constexpr (ALIGN_EPI) { if (wr == 0) PG8_BAR; }
        E(acc, cur, wr, wc, fr, fq);
        if (!has_next) break;
        if (!E.keep(cur)) {
#pragma unroll
            for (int a = 0; a < 2; ++a)
#pragma unroll
                for (int b = 0; b < 2; ++b)
#pragma unroll
                    for (int m = 0; m < 4; ++m)
#pragma unroll
                        for (int n = 0; n < 2; ++n) acc[a][b][m][n] = (f32x4){0.f, 0.f, 0.f, 0.f};
        }
        cur = nxt; cA = nA; cB = nB; ++ui;
        if constexpr (ALIGN_EPI) { if (wr == 1) PG8_BAR; }
    }
    PG8_WAIT_V(0);
    if constexpr (!ALIGN_EPI) { if (wr == 0) PG8_BAR; }
    PG8_BAR;
#undef PG8_SA
#undef PG8_SB
#undef PG8_STAGE
#undef PG8_LDA
#undef PG8_LDB
#undef PG8_MMA
#undef PG8_WAIT_V
#undef PG8_WAIT_L
#undef PG8_BAR
#undef PG8_SCHED
}

typedef int i32x4 __attribute__((ext_vector_type(4)));
typedef int i32x8 __attribute__((ext_vector_type(8)));
template <class Epi, class Sched>
__device__ __forceinline__ void gemm_phase_f8(PG8_LAS unsigned char* lds, const int K, const Sched& S, const Epi& E) {
    const int tid = opaque_tid(), wid = __builtin_amdgcn_readfirstlane(tid >> 6), lane = tid & 63, wr = wid >> 2, wc = wid & 3, fr = lane & 15, fq = lane >> 4;
    const int nt = K / 128;
    unsigned voffA[2], voffB[2];
#pragma unroll
    for (int i = 0; i < 2; ++i) { int R, C; stage_rc(tid * 16 + i * 8192, R, C); const int Rb = Epi::PERM ? ((R & ~31) + perm32(R & 31)) : R;
        voffA[i] = (unsigned)(R * K + 2 * C); voffB[i] = (unsigned)(Rb * K + 2 * C); }
    const size_t kstep = 128;
    const size_t hstep = (size_t)HALF * K;
    const unsigned ldsw = (unsigned)wid * 1024u;
    const int aoff = lds_byte(wr * 64 + fr, fq * 16), boff = lds_byte(wc * 32 + fr, fq * 16);
#define PG8_SA(b, h) (((b) * 2 + (h)) * HTB)
#define PG8_SB(b, h) ((4 + (b) * 2 + (h)) * HTB)
#define PG8_STAGE(bufoff, gbase, voff) do { _Pragma("unroll") for (int _i = 0; _i < 2; ++_i) \
        __builtin_amdgcn_global_load_lds((const unsigned*)((const char*)(gbase) + (voff)[_i]), (PG8_LAS unsigned*)(lds + (bufoff) + ldsw + _i * 8192), 16, 0, 0); } while (0)
#define PG8_LD8(dst, off) do { const i32x4 _lo = *(const PG8_LAS i32x4*)(lds + (off)), _hi = *(const PG8_LAS i32x4*)(lds + (off) + 16); dst = __builtin_shufflevector(_lo, _hi, 0, 1, 2, 3, 4, 5, 6, 7); } while (0)
#define PG8_LDA(dst, b, h) do { _Pragma("unroll") for (int m = 0; m < 4; ++m) PG8_LD8(dst[m], PG8_SA(b, h) + aoff + m * 2048); } while (0)
#define PG8_LDB(dst, b, h) do { _Pragma("unroll") for (int n = 0; n < 2; ++n) PG8_LD8(dst[n], PG8_SB(b, h) + boff + n * 2048); } while (0)
#define PG8_MMA(ai, bj, At, Bt) do { __builtin_amdgcn_s_setprio(1); _Pragma("unroll") for (int m = 0; m < 4; ++m) _Pragma("unroll") for (int n = 0; n < 2; ++n) \
        asm volatile("v_mfma_scale_f32_16x16x128_f8f6f4 %0, %1, %2, %0, %3, %3 op_sel_hi:[0,0,0]" : "+v"(acc[ai][bj][m][n]) : "v"(Bt[n]), "v"(At[m]), "v"(f8_unit_scale)); __builtin_amdgcn_s_setprio(0); } while (0)
#define PG8_WAIT_V(n) asm volatile("s_waitcnt vmcnt(" #n ")" ::: "memory")
#define PG8_WAIT_L(n) asm volatile("s_waitcnt lgkmcnt(" #n ")" ::: "memory")
#define PG8_BAR __builtin_amdgcn_s_barrier()
#define PG8_SCHED __builtin_amdgcn_sched_barrier(0)
    Unit cur, nxt; int ui = 0;
    if (!S.next(0, cur)) return;
    f32x4 acc[2][2][4][2];
#pragma unroll
    for (int a = 0; a < 2; ++a)
#pragma unroll
        for (int b = 0; b < 2; ++b)
#pragma unroll
            for (int m = 0; m < 4; ++m)
#pragma unroll
                for (int n = 0; n < 2; ++n) acc[a][b][m][n] = (f32x4){0.f, 0.f, 0.f, 0.f};
    i32x8 At[4], B0[2], B1[2];
    const int f8_unit_scale = 0x7f7f7f7f;
    const char* cA; const char* cB; S.ptrs(cur, cA, cB);
    PG8_STAGE(PG8_SB(0, 0), cB, voffB); PG8_STAGE(PG8_SB(0, 1), cB + hstep, voffB); PG8_STAGE(PG8_SA(0, 0), cA, voffA); PG8_STAGE(PG8_SA(0, 1), cA + hstep, voffA);
    if (wr == 1) PG8_BAR;
    PG8_WAIT_V(2); PG8_BAR;
    PG8_STAGE(PG8_SB(1, 0), cB + kstep, voffB); PG8_STAGE(PG8_SA(1, 0), cA + kstep, voffA); PG8_STAGE(PG8_SB(1, 1), cB + hstep + kstep, voffB);
    PG8_WAIT_V(6); PG8_BAR;
    for (;;) {
        const bool has_next = S.next(ui + 1, nxt);
        const char* nA = cA; const char* nB = cB; if (has_next) S.ptrs(nxt, nA, nB);
        for (int t = 0; t < nt; t += 2) {
            const bool last = (t == nt - 2);
            const char* a1 = cA + (size_t)(t + 1) * kstep;
            const char* a2 = last ? nA : cA + (size_t)(t + 2) * kstep; const char* b2 = last ? nB : cB + (size_t)(t + 2) * kstep;
            const char* a3 = a2 + kstep; const char* b3 = b2 + kstep;
            PG8_LDB(B0, 0, 0); PG8_LDB(B1, 0, 1); PG8_SCHED; PG8_LDA(At, 0, 0); PG8_STAGE(PG8_SA(1, 1), a1 + hstep, voffA);
            PG8_WAIT_V(8); PG8_WAIT_L(0); PG8_BAR; PG8_MMA(0, 0, At, B0); PG8_MMA(0, 1, At, B1); PG8_BAR; PG8_SCHED;
            PG8_LDA(At, 0, 1); PG8_STAGE(PG8_SB(0, 0), b2, voffB); PG8_STAGE(PG8_SB(0, 1), b2 + hstep, voffB); PG8_STAGE(PG8_SA(0, 0), a2, voffA);
            PG8_WAIT_V(8); PG8_WAIT_L(0); PG8_BAR; PG8_MMA(1, 0, At, B0); PG8_MMA(1, 1, At, B1); PG8_BAR; PG8_SCHED;
            PG8_LDB(B0, 1, 0); PG8_LDB(B1, 1, 1); PG8_SCHED; PG8_LDA(At, 1, 0); PG8_STAGE(PG8_SA(0, 1), a2 + hstep, voffA);
            PG8_WAIT_V(8); PG8_WAIT_L(0); PG8_BAR; PG8_MMA(0, 0, At, B0); PG8_MMA(0, 1, At, B1); PG8_BAR; PG8_SCHED;
            PG8_LDA(At, 1, 1); PG8_STAGE(PG8_SB(1, 0), b3, voffB); PG8_STAGE(PG8_SB(1, 1), b3 + hstep, voffB); PG8_STAGE(PG8_SA(1, 0), a3, voffA);
            PG8_WAIT_V(8); PG8_WAIT_L(0); PG8_BAR; PG8_MMA(1, 0, At, B0); PG8_MMA(1, 1, At, B1); PG8_BAR; PG8_SCHED;
        }
        if (wr == 0) PG8_BAR;
        { const int t2 = opaque_tid(), w2 = __builtin_amdgcn_readfirstlane(t2 >> 6); E(acc, cur, w2 >> 2, w2 & 3, t2 & 15, (t2 & 63) >> 4); }
        if (!has_next) break;
#pragma unroll
        for (int a = 0; a < 2; ++a)
#pragma unroll
            for (int b = 0; b < 2; ++b)
#pragma unroll
                for (int m = 0; m < 4; ++m)
#pragma unroll
                    for (int n = 0; n < 2; ++n) acc[a][b][m][n] = (f32x4){0.f, 0.f, 0.f, 0.f};
        cur = nxt; cA = nA; cB = nB; ++ui;
        if (wr == 1) PG8_BAR;
    }
    PG8_WAIT_V(0);
    PG8_BAR;
#undef PG8_SA
#undef PG8_SB
#undef PG8_STAGE
#undef PG8_LD8
#undef PG8_LDA
#undef PG8_LDB
#undef PG8_MMA
#undef PG8_WAIT_V
#undef PG8_WAIT_L
#undef PG8_BAR
#undef PG8_SCHED
}

template <class Epi, class Sched>
__device__ __forceinline__ void gemm_phase_mix(PG8_LAS unsigned char* lds, const int P, const int nt8, const int nt16, const Sched& S, const Epi& E) {
    const int tid = opaque_tid(), wid = __builtin_amdgcn_readfirstlane(tid >> 6), lane = tid & 63, wr = wid >> 2, wc = wid & 3, fr = lane & 15, fq = lane >> 4;
    unsigned voffA[2], voffB[2];
#pragma unroll
    for (int i = 0; i < 2; ++i) { int R, C; stage_rc(tid * 16 + i * 8192, R, C); const int Rb = Epi::PERM ? ((R & ~31) + perm32(R & 31)) : R;
        voffA[i] = (unsigned)(R * P + 2 * C); voffB[i] = (unsigned)(Rb * P + 2 * C); }
    const size_t kstep = 128;
    const size_t hstep = (size_t)HALF * P;
    const unsigned ldsw = (unsigned)wid * 1024u;
#define PG8_SA(b, h) (((b) * 2 + (h)) * HTB)
#define PG8_SB(b, h) ((4 + (b) * 2 + (h)) * HTB)
#define PG8_STAGE(bufoff, gbase, voff) do { _Pragma("unroll") for (int _i = 0; _i < 2; ++_i) \
        __builtin_amdgcn_global_load_lds((const unsigned*)((const char*)(gbase) + (voff)[_i]), (PG8_LAS unsigned*)(lds + (bufoff) + ldsw + _i * 8192), 16, 0, 0); } while (0)
#define PG8_LD8(dst, off) do { const i32x4 _lo = *(const PG8_LAS i32x4*)(lds + (off)), _hi = *(const PG8_LAS i32x4*)(lds + (off) + 16); dst = __builtin_shufflevector(_lo, _hi, 0, 1, 2, 3, 4, 5, 6, 7); } while (0)
#define PG8_LDA8(dst, b, h) do { _Pragma("unroll") for (int m = 0; m < 4; ++m) PG8_LD8(dst[m], PG8_SA(b, h) + aoff8 + m * 2048); } while (0)
#define PG8_LDB8(dst, b, h) do { _Pragma("unroll") for (int n = 0; n < 2; ++n) PG8_LD8(dst[n], (PG8_SB(b, h) - 65536) + boff8 + n * 2048); } while (0)
#define PG8_MMA8(ai, bj, At, Bt) do { __builtin_amdgcn_s_setprio(1); _Pragma("unroll") for (int m = 0; m < 4; ++m) _Pragma("unroll") for (int n = 0; n < 2; ++n) \
        asm volatile("v_mfma_scale_f32_16x16x128_f8f6f4 %0, %1, %2, %0, %3, %3 op_sel_hi:[0,0,0]" : "+v"(acc[ai][bj][m][n]) : "v"(Bt[n]), "v"(At[m]), "v"(f8_unit_scale)); __builtin_amdgcn_s_setprio(0); } while (0)
#define PG8_LDA16(dst, b, h) do { _Pragma("unroll") for (int m = 0; m < 4; ++m) _Pragma("unroll") for (int k = 0; k < 2; ++k) dst[m][k] = *(const PG8_LAS bf16x8*)(lds + PG8_SA(b, h) + aoff16 + m * 2048 + k * 1024); } while (0)
#define PG8_LDB16(dst, b, h) do { _Pragma("unroll") for (int n = 0; n < 2; ++n) _Pragma("unroll") for (int k = 0; k < 2; ++k) dst[n][k] = *(const PG8_LAS bf16x8*)(lds + (PG8_SB(b, h) - 65536) + boff16 + n * 2048 + k * 1024); } while (0)
#define PG8_MMA16(ai, bj, At, Bt) do { __builtin_amdgcn_s_setprio(1); _Pragma("unroll") for (int k = 0; k < 2; ++k) _Pragma("unroll") for (int m = 0; m < 4; ++m) _Pragma("unroll") for (int n = 0; n < 2; ++n) \
        asm volatile("v_mfma_f32_16x16x32_bf16 %0, %1, %2, %0" : "+v"(acc[ai][bj][m][n]) : "v"(Bt[n][k]), "v"(At[m][k])); __builtin_amdgcn_s_setprio(0); } while (0)
#define PG8_WAIT_V(n) asm volatile("s_waitcnt vmcnt(" #n ")" ::: "memory")
#define PG8_WAIT_L(n) asm volatile("s_waitcnt lgkmcnt(" #n ")" ::: "memory")
#define PG8_BAR __builtin_amdgcn_s_barrier()
#define PG8_SCHED __builtin_amdgcn_sched_barrier(0)
#define PG8_KPAIR(LDA_, LDB_, MMA_, At_, B0_, B1_) do { \
            LDB_(B0_, 0, 0); LDB_(B1_, 0, 1); PG8_SCHED; LDA_(At_, 0, 0); PG8_STAGE(PG8_SA(1, 1), a1 + hstep, voffA); \
            PG8_WAIT_V(8); PG8_WAIT_L(0); PG8_BAR; MMA_(0, 0, At_, B0_); MMA_(0, 1, At_, B1_); PG8_BAR; PG8_SCHED; \
            LDA_(At_, 0, 1); PG8_STAGE(PG8_SB(0, 0), b2, voffB); PG8_STAGE(PG8_SB(0, 1), b2 + hstep, voffB); PG8_STAGE(PG8_SA(0, 0), a2, voffA); \
            PG8_WAIT_V(8); PG8_WAIT_L(0); PG8_BAR; MMA_(1, 0, At_, B0_); MMA_(1, 1, At_, B1_); PG8_BAR; PG8_SCHED; \
            LDB_(B0_, 1, 0); LDB_(B1_, 1, 1); PG8_SCHED; LDA_(At_, 1, 0); PG8_STAGE(PG8_SA(0, 1), a2 + hstep, voffA); \
            PG8_WAIT_V(8); PG8_WAIT_L(0); PG8_BAR; MMA_(0, 0, At_, B0_); MMA_(0, 1, At_, B1_); PG8_BAR; PG8_SCHED; \
            LDA_(At_, 1, 1); PG8_STAGE(PG8_SB(1, 0), b3, voffB); PG8_STAGE(PG8_SB(1, 1), b3 + hstep, voffB); PG8_STAGE(PG8_SA(1, 0), a3, voffA); \
            PG8_WAIT_V(8); PG8_WAIT_L(0); PG8_BAR; MMA_(1, 0, At_, B0_); MMA_(1, 1, At_, B1_); PG8_BAR; PG8_SCHED; } while (0)
    Unit cur, nxt; int ui = 0;
    if (!S.o.tile(0, cur)) return;
    f32x4 acc[2][2][4][2];
#pragma unroll
    for (int a = 0; a < 2; ++a)
#pragma unroll
        for (int b = 0; b < 2; ++b)
#pragma unroll
            for (int m = 0; m < 4; ++m)
#pragma unroll
                for (int n = 0; n < 2; ++n) acc[a][b][m][n] = (f32x4){0.f, 0.f, 0.f, 0.f};
    const int f8_unit_scale = 0x7f7f7f7f;
    const char* c8A = S.A0 + (size_t)cur.pm * S.tstep; const char* c8B = S.B0 + (size_t)cur.pn * S.tstep;
    PG8_STAGE(PG8_SB(0, 0), c8B, voffB); PG8_STAGE(PG8_SB(0, 1), c8B + hstep, voffB); PG8_STAGE(PG8_SA(0, 0), c8A, voffA); PG8_STAGE(PG8_SA(0, 1), c8A + hstep, voffA);
    if (wr == 1) PG8_BAR;
    PG8_WAIT_V(2); PG8_BAR;
    PG8_STAGE(PG8_SB(1, 0), c8B + kstep, voffB); PG8_STAGE(PG8_SA(1, 0), c8A + kstep, voffA); PG8_STAGE(PG8_SB(1, 1), c8B + hstep + kstep, voffB);
    PG8_WAIT_V(6); PG8_BAR;
    for (;;) {
        const bool has_next = S.o.tile(ui + 1, nxt);
        const char* c16A = S.A1 + (size_t)cur.pm * S.tstep; const char* c16B = S.B1 + (size_t)cur.pn * S.tstep;
        {   i32x8 At[4], B0[2], B1[2];
            const int t8 = opaque_tid(); int aoff8 = lds_byte(((t8 >> 8) & 1) * 64 + (t8 & 15), ((t8 & 63) >> 4) * 16), boff8 = lds_byte(((t8 >> 6) & 3) * 32 + (t8 & 15), ((t8 & 63) >> 4) * 16) + 65536;
            asm volatile("" : "+v"(aoff8), "+v"(boff8));
            for (int t = 0; t < nt8; t += 2) { const bool last = (t == nt8 - 2);
                const char* a1 = c8A + (size_t)(t + 1) * kstep;
                const char* a2 = last ? c16A : c8A + (size_t)(t + 2) * kstep; const char* b2 = last ? c16B : c8B + (size_t)(t + 2) * kstep;
                const char* a3 = a2 + kstep; const char* b3 = b2 + kstep;
                PG8_KPAIR(PG8_LDA8, PG8_LDB8, PG8_MMA8, At, B0, B1); } }
        if (wr == 0) PG8_BAR;
        { const int t2 = opaque_tid(), w2 = __builtin_amdgcn_readfirstlane(t2 >> 6); cur.sub = 0; E(acc, cur, w2 >> 2, w2 & 3, t2 & 15, (t2 & 63) >> 4); }
        if (wr == 1) PG8_BAR;
        const char* n8A = c8A; const char* n8B = c8B; if (has_next) { n8A = S.A0 + (size_t)nxt.pm * S.tstep; n8B = S.B0 + (size_t)nxt.pn * S.tstep; }
        {   bf16x8 At[4][2], B0[2][2], B1[2][2];
            const int t6 = opaque_tid(); int aoff16 = lds_byte(((t6 >> 8) & 1) * 64 + (t6 & 15), ((t6 & 63) >> 4) * 8), boff16 = lds_byte(((t6 >> 6) & 3) * 32 + (t6 & 15), ((t6 & 63) >> 4) * 8) + 65536;
            asm volatile("" : "+v"(aoff16), "+v"(boff16));
            for (int t = 0; t < nt16; t += 2) { const bool last = (t == nt16 - 2);
                const char* a1 = c16A + (size_t)(t + 1) * kstep;
                const char* a2 = last ? n8A : c16A + (size_t)(t + 2) * kstep; const char* b2 = last ? n8B : c16B + (size_t)(t + 2) * kstep;
                const char* a3 = a2 + kstep; const char* b3 = b2 + kstep;
                PG8_KPAIR(PG8_LDA16, PG8_LDB16, PG8_MMA16, At, B0, B1); } }
        if (wr == 0) PG8_BAR;
        { const int t2 = opaque_tid(), w2 = __builtin_amdgcn_readfirstlane(t2 >> 6); cur.sub = 1; E(acc, cur, w2 >> 2, w2 & 3, t2 & 15, (t2 & 63) >> 4); }
        if (!has_next) break;
#pragma unroll
        for (int a = 0; a < 2; ++a)
#pragma unroll
            for (int b = 0; b < 2; ++b)
#pragma unroll
                for (int m = 0; m < 4; ++m)
#pragma unroll
                    for (int n = 0; n < 2; ++n) acc[a][b][m][n] = (f32x4){0.f, 0.f, 0.f, 0.f};
        cur = nxt; c8A = n8A; c8B = n8B; ++ui;
        if (wr == 1) PG8_BAR;
    }
    PG8_WAIT_V(0);
    PG8_BAR;
#undef PG8_SA
#undef PG8_SB
#undef PG8_STAGE
#undef PG8_LD8
#undef PG8_LDA8
#undef PG8_LDB8
#undef PG8_MMA8
#undef PG8_LDA16
#undef PG8_LDB16
#undef PG8_MMA16
#undef PG8_KPAIR
#undef PG8_WAIT_V
#undef PG8_WAIT_L
#undef PG8_BAR
#undef PG8_SCHED
}
}

constexpr int NWAVES = 8;
constexpr int N_LAUNCHES = MK_N_LAUNCHES;
constexpr int PER_PHASE = 8;
constexpr int M = 16384, D = 4096, NIN = 18432, GMW = 2048, NAW = 2048, DFF = 11008, NGU = 2 * DFF;
constexpr float F8_ASCALE = 16.f, F8_WSCALE = 1024.f, F8_UNSCALE = 1.f / (16.f * 1024.f), F8_YSCALE = 64.f, F8_YUNSCALE = 1.f / (64.f * 1024.f);
constexpr int GRID_W = 64, GRID_H = M / GRID_W, NHEAD = 16, HD = 128, CHUNK = 128, NGROUP = 16;
constexpr float RMS_EPS = 1e-6f, LN_EPS = 1e-5f;
constexpr int F8P = 4096;

constexpr size_t MiB = 1u << 20;
constexpr size_t WS_CTL = 0, CTL_ZERO_BYTES = 1 * MiB;
constexpr size_t WS_WSB = 1 * MiB;
constexpr size_t WS_WIN = 4 * MiB;
constexpr size_t WS_WOA = 148 * MiB, WS_WOB = 164 * MiB;
constexpr size_t WS_WOUT = 180 * MiB;
constexpr size_t WS_RA = 212 * MiB;
constexpr size_t WS_YA = WS_RA, WS_YB = WS_RA + 64 * MiB;
constexpr size_t WS_RB = 340 * MiB;
constexpr size_t WS_U = WS_RB, WS_V = WS_RB + 64 * MiB, WS_Q = WS_RB + 128 * MiB, WS_K = WS_RB + 192 * MiB, WS_VV = WS_RB + 256 * MiB, WS_GA = WS_RB + 320 * MiB, WS_GB = WS_RB + 448 * MiB;
constexpr size_t WS_TB = WS_Q;
constexpr size_t WS_MRG = WS_RB;
constexpr size_t WS_ACT = WS_RB;
constexpr size_t WS_H16 = WS_WIN;
constexpr size_t WS_WQKV8 = WS_WIN + 32 * MiB;
constexpr size_t WS_XN8 = 916 * MiB;
constexpr size_t WS_WGU = 916 * MiB;
constexpr size_t WS_WD = 1088 * MiB;
constexpr size_t WS_PART = 1174 * MiB;
constexpr size_t WS_END = 1178 * MiB;
static_assert(WS_GB + (size_t)M * D * 2 == WS_WGU && WS_WGU + (size_t)NGU * D * 2 == WS_WD && WS_WD + (size_t)D * DFF * 2 == WS_PART && WS_PART + (size_t)M * 64 * 4 == WS_END && WS_ACT + (size_t)M * DFF * 2 <= WS_WGU, "d_ws map");
constexpr int CW_BAR = 4096;
constexpr int RING_BYTES = 131072;
constexpr int LDSCTL_OFF = RING_BYTES, MISC_OFF = LDSCTL_OFF + 320;
constexpr int LDS_BYTES = 147456;

#define GAS __attribute__((address_space(1)))
#define LAS __attribute__((address_space(3)))
typedef unsigned short bf16;
typedef unsigned v4u __attribute__((ext_vector_type(4)));
typedef unsigned v2u __attribute__((ext_vector_type(2)));
typedef float f32x4 __attribute__((ext_vector_type(4)));
typedef float f32x2 __attribute__((ext_vector_type(2)));
typedef short bf16x8 __attribute__((ext_vector_type(8)));
typedef GAS unsigned gu32;
#define RLX_AGENT __ATOMIC_RELAXED, __HIP_MEMORY_SCOPE_AGENT
#define LDS_WAIT() asm volatile("s_waitcnt lgkmcnt(0)" ::: "memory")
#define VM_WAIT() asm volatile("s_waitcnt vmcnt(0)" ::: "memory")
__device__ __forceinline__ unsigned f2bf(float f) { unsigned u = __builtin_bit_cast(unsigned, f); return (u + 0x7fffu + ((u >> 16) & 1u)) >> 16; }
__device__ __forceinline__ unsigned pk2(float lo, float hi) { return pg8::cvt_pk_bf16(lo, hi); }
__device__ __forceinline__ float bflo(unsigned w) { return __uint_as_float(w << 16); }
__device__ __forceinline__ float bfhi(unsigned w) { return __uint_as_float(w & 0xffff0000u); }

#define XB_TMO      128
#define XB_XCNT(j)  (256  + 64 * (j))
#define XB_XSUB(j)  (1280 + 64 * (j))
#define XB_XGEN(j)  (2304 + 64 * (j))
#define XB_TOP      3328
#define XB_TOPGEN   3392
#define XCD_BAR_WORDS 3456
#define XB_SPIN_CAP (1u << 20)

__device__ __forceinline__ unsigned xb_ld(unsigned* p)              { return __hip_atomic_load(p, __ATOMIC_RELAXED, __HIP_MEMORY_SCOPE_AGENT); }
__device__ __forceinline__ unsigned xb_add(unsigned* p, unsigned v) { return __hip_atomic_fetch_add(p, v, __ATOMIC_RELAXED, __HIP_MEMORY_SCOPE_AGENT); }
__device__ __forceinline__ unsigned xb_xcc_id() { return (unsigned)__builtin_amdgcn_s_getreg((3 << 11) | 20) & 0xFu; }
#define XB_SPIN(cond, bar) do { unsigned _sp = 0; while (cond) { __builtin_amdgcn_s_sleep(1); \
    if ((++_sp & 255u) == 0u) { if (xb_ld(&(bar)[XB_TMO])) break; if (_sp > XB_SPIN_CAP) { atomicAdd(&(bar)[XB_TMO], 1u); break; } } } } while (0)

struct XcdBarrier {
    unsigned* bar; unsigned x;
    volatile LAS unsigned* st;
};
__device__ __forceinline__ XcdBarrier xcd_barrier_post(unsigned* bar, volatile LAS unsigned* st) {
    XcdBarrier b; b.bar = bar; b.x = xb_xcc_id(); b.st = st;
    if (threadIdx.x == 0) (void)xb_add(&bar[XB_XCNT(b.x)], 1u);
    return b;
}
__device__ __forceinline__ void xcd_barrier_complete(unsigned* bar, unsigned x, unsigned& nloc, unsigned& nx) {
    const unsigned G = gridDim.x * gridDim.y * gridDim.z;
    unsigned sum, cnt, mine, sp = 0u;
    for (;;) {
        sum = 0u; cnt = 0u; mine = 0u;
#pragma unroll
        for (unsigned j = 0; j < 16; ++j) { const unsigned c = xb_ld(&bar[XB_XCNT(j)]); sum += c; cnt += (c > 0u) ? 1u : 0u; mine = (j == x) ? c : mine; }
        if (sum == G) break;
        __builtin_amdgcn_s_sleep(1);
        if ((++sp & 255u) == 0u) { if (xb_ld(&bar[XB_TMO])) break; if (sp > XB_SPIN_CAP) { atomicAdd(&bar[XB_TMO], 1u); break; } }
    }
    nloc = mine > 0u ? mine : 1u; nx = cnt > 0u ? cnt : 1u;
}
__device__ __forceinline__ void xcd_barrier(const XcdBarrier& b) {
    asm volatile("s_waitcnt vmcnt(0)" ::: "memory");
    __syncthreads();
    if (threadIdx.x == 0) {
        unsigned* bar = b.bar;
        __builtin_amdgcn_s_waitcnt(0);
        unsigned nloc = b.st[0], nx = b.st[1];
        if (nloc == 0u) { xcd_barrier_complete(bar, b.x, nloc, nx); b.st[0] = nloc; b.st[1] = nx; }
        const unsigned old = xb_add(&bar[XB_XSUB(b.x)], 1u);
        const unsigned gen = old / nloc;
        if (old + 1u == (gen + 1u) * nloc) {
            __builtin_amdgcn_fence(__ATOMIC_RELEASE, "agent");
            asm volatile("s_waitcnt vmcnt(0)" ::: "memory");
            const unsigned og = xb_add(&bar[XB_TOP], 1u);
            const unsigned tg = og / nx;
            if (og + 1u == (tg + 1u) * nx) xb_add(&bar[XB_TOPGEN], 1u);
            else XB_SPIN(xb_ld(&bar[XB_TOPGEN]) == tg, bar);
            __builtin_amdgcn_fence(__ATOMIC_ACQUIRE, "agent");
            xb_add(&bar[XB_XGEN(b.x)], 1u);
            asm volatile("s_waitcnt vmcnt(0)" ::: "memory");
        } else {
            XB_SPIN(xb_ld(&bar[XB_XGEN(b.x)]) == gen, bar);
            __builtin_amdgcn_fence(__ATOMIC_ACQUIRE, "agent");
            asm volatile("s_waitcnt vmcnt(0)" ::: "memory");
        }
    }
    __syncthreads();
}

struct Frame {
    LAS unsigned char* lds;
    volatile LAS unsigned* MISC;
    gu32* ctl;
    int tid, lane, wave;
    int vcu, G;
    unsigned char* ws;
    const float *x, *norm1_g, *w_in, *gm_ln_g, *gm_ln_b, *gm_w_s, *gm_b_s, *q_gain, *k_gain, *na_rpb, *w_o_gm, *w_o_na, *w_out, *norm2_g, *w_ff_gate, *w_ff_up, *w_ff_down;
    float* out;
};
template <int O> __device__ __forceinline__ float xor_lane(float v) {
    if constexpr (O < 32) return __builtin_bit_cast(float, __builtin_amdgcn_ds_swizzle(__builtin_bit_cast(int, v), (O << 10) | 0x1f));
    else return __shfl_xor(v, 32);
}
__device__ __forceinline__ float wave_sum(float v) {
    v += xor_lane<1>(v); v += xor_lane<2>(v); v += xor_lane<4>(v); v += xor_lane<8>(v); v += xor_lane<16>(v); v += xor_lane<32>(v);
    return v;
}
struct TrRegs { f32x4 v[8]; };
__device__ __forceinline__ void tr_load(TrRegs& R, const float* W, int ldw, int k0, int n0, int lane) {
    const GAS float* src = (const GAS float*)W + (size_t)(k0 + 8 * (lane >> 3)) * ldw + n0 + 4 * (lane & 7);
#pragma unroll
    for (int e = 0; e < 8; ++e) R.v[e] = *(const GAS f32x4*)(src + (size_t)e * ldw);
}
__device__ __forceinline__ void tr_store(const TrRegs& R, bf16* dst, int ldk, int lane) {
    GAS bf16* d = (GAS bf16*)dst + (size_t)(4 * (lane & 7)) * ldk + 8 * (lane >> 3);
#pragma unroll
    for (int i = 0; i < 4; ++i) { v4u o; o.x = pk2(R.v[0][i], R.v[1][i]); o.y = pk2(R.v[2][i], R.v[3][i]); o.z = pk2(R.v[4][i], R.v[5][i]); o.w = pk2(R.v[6][i], R.v[7][i]);
        *(GAS v4u*)(d + (size_t)i * ldk) = o; }
}
__device__ __forceinline__ unsigned pk4_fp8(float a, float b, float c, float d) {
    a = fminf(fmaxf(a, -448.f), 448.f); b = fminf(fmaxf(b, -448.f), 448.f); c = fminf(fmaxf(c, -448.f), 448.f); d = fminf(fmaxf(d, -448.f), 448.f);
    unsigned w = 0u; w = __builtin_amdgcn_cvt_pk_fp8_f32(a, b, w, false); w = __builtin_amdgcn_cvt_pk_fp8_f32(c, d, w, true); return w;
}
__device__ __forceinline__ void tr_store8(const TrRegs& R, unsigned char* dst8, int ldk, int lane, float sc) {
    GAS unsigned char* d = (GAS unsigned char*)dst8 + (size_t)(4 * (lane & 7)) * ldk + 8 * (lane >> 3);
#pragma unroll
    for (int i = 0; i < 4; ++i) { v2u o; o.x = pk4_fp8(R.v[0][i] * sc, R.v[1][i] * sc, R.v[2][i] * sc, R.v[3][i] * sc); o.y = pk4_fp8(R.v[4][i] * sc, R.v[5][i] * sc, R.v[6][i] * sc, R.v[7][i] * sc);
        *(GAS v2u*)(d + (size_t)i * ldk) = o; }
}
__device__ __forceinline__ void tr_matrix(Frame& F, int lane, const float* W, int K, int N, bf16* WT) {
    const int gw = F.vcu * NWAVES + F.wave, NGW = F.G * NWAVES, nblk = N / 32, nitems = (K / 64) * nblk;
    for (int it = gw; it < nitems; it += 2 * NGW) { const int it2 = it + NGW; const bool two = it2 < nitems; TrRegs A, B;
        const int kb = it / nblk, nb = it % nblk, kb2 = two ? it2 / nblk : kb, nb2 = two ? it2 % nblk : nb;
        tr_load(A, W, N, 64 * kb, 32 * nb, lane); tr_load(B, W, N, 64 * kb2, 32 * nb2, lane);
        tr_store(A, WT + (size_t)(32 * nb) * K + 64 * kb, K, lane); if (two) tr_store(B, WT + (size_t)(32 * nb2) * K + 64 * kb2, K, lane); }
}
constexpr int FF_ITEMS_GU = (D / 64) * (DFF / 32), FF_ITEMS_D = (DFF / 64) * (D / 32), FF_ITEMS = 2 * FF_ITEMS_GU + FF_ITEMS_D;
constexpr int FF_ITEMS_P2 = 2 * FF_ITEMS_GU;
struct FillItem { const float* src; bf16* dst; int ldw, ldk, k0, n0; };
__device__ __forceinline__ FillItem ff_item(Frame& F, int it) {
    it = it < FF_ITEMS ? it : FF_ITEMS - 1; FillItem I;
    if (it < 2 * FF_ITEMS_GU) { const int up = it >= FF_ITEMS_GU, r = up ? it - FF_ITEMS_GU : it, nblk = DFF / 32, kb = r / nblk, n0 = 32 * (r - kb * nblk);
        I.src = up ? F.w_ff_up : F.w_ff_gate; I.ldw = DFF; I.k0 = 64 * kb; I.n0 = n0; I.ldk = D;
        I.dst = (bf16*)(F.ws + WS_WGU) + (size_t)(256 * (n0 >> 7) + (n0 & 127) + (up ? 128 : 0)) * D + 64 * kb; }
    else { const int r = it - 2 * FF_ITEMS_GU, nblk = D / 32, kb = r / nblk, n0 = 32 * (r - kb * nblk);
        I.src = F.w_ff_down; I.ldw = D; I.k0 = 64 * kb; I.n0 = n0; I.ldk = DFF; I.dst = (bf16*)(F.ws + WS_WD) + (size_t)n0 * DFF + 64 * kb; }
    return I;
}
__device__ __forceinline__ void rms_row_to_bf16(int lane, const float* xrow, const float* gain, bf16* orow, unsigned char* orow8 = nullptr) {
    const GAS f32x4* xr = (const GAS f32x4*)xrow + lane;
    f32x4 v[16]; float s = 0.f;
#pragma unroll
    for (int j = 0; j < 16; ++j) { v[j] = xr[64 * j]; s += (v[j].x * v[j].x + v[j].y * v[j].y) + (v[j].z * v[j].z + v[j].w * v[j].w); }
    const float rstd = 1.f / sqrtf(wave_sum(s) * (1.f / D) + RMS_EPS);
    const GAS f32x4* gr = (const GAS f32x4*)gain + lane;
    GAS v2u* o8 = (GAS v2u*)orow + lane;
#pragma unroll
    for (int j = 0; j < 16; ++j) { const f32x4 g = gr[64 * j]; const float y0 = v[j].x * rstd * g.x, y1 = v[j].y * rstd * g.y, y2 = v[j].z * rstd * g.z, y3 = v[j].w * rstd * g.w;
        v2u o; o.x = pk2(y0, y1); o.y = pk2(y2, y3); o8[64 * j] = o;
        if (orow8) ((GAS unsigned*)orow8)[lane + 64 * j] = pk4_fp8(y0 * F8_ASCALE, y1 * F8_ASCALE, y2 * F8_ASCALE, y3 * F8_ASCALE); }
}

#ifndef MK_STAGGER_US
#define MK_STAGGER_US 0
#endif
__device__ __forceinline__ void stagger(int us_per_group) {
    const int grp = ((int)blockIdx.x >> 3) & 3;
    if (grp && us_per_group) { const unsigned long long t0 = __builtin_amdgcn_s_memrealtime(), dt = (unsigned long long)(grp * us_per_group) * 100ull;
        while (__builtin_amdgcn_s_memrealtime() - t0 < dt) __builtin_amdgcn_s_sleep(16); }
}
__device__ __forceinline__ void p0_prologue(Frame& F) {
    const int lane = opaque_tid() & 63;
    {
        const int gw0 = F.vcu * NWAVES + F.wave, NGW0 = F.G * NWAVES, nblk = NIN / 32, nitems = (D / 64) * nblk; bf16* WT = (bf16*)(F.ws + WS_WIN); unsigned char* W8 = F.ws + WS_WQKV8;
        for (int it = gw0; it < nitems; it += NGW0) { const int kb = it / nblk, n0 = 32 * (it - kb * nblk); TrRegs R; tr_load(R, F.w_in, NIN, 64 * kb, n0, lane);
            if (n0 >= 4096) tr_store8(R, W8 + (size_t)(n0 - 4096) * D + 64 * kb, D, lane, F8_WSCALE);
            else tr_store(R, WT + (size_t)n0 * D + 64 * kb, D, lane); } }
    tr_matrix(F, lane, F.w_o_gm, GMW, D, (bf16*)(F.ws + WS_WOA));
    {
        const int gw0 = F.vcu * NWAVES + F.wave, NGW0 = F.G * NWAVES, nblk = D / 32, nitems = (NAW / 64) * nblk; unsigned char* W8 = F.ws + WS_WOB;
        for (int it = gw0; it < nitems; it += NGW0) { const int kb = it / nblk, n0 = 32 * (it - kb * nblk); TrRegs R; tr_load(R, F.w_o_na, D, 64 * kb, n0, lane);
            tr_store8(R, W8 + (size_t)n0 * F8P + 64 * kb, F8P, lane, F8_WSCALE); } }
    tr_matrix(F, lane, F.w_out, D, D, (bf16*)(F.ws + WS_WOUT));
    const int gw = F.vcu * NWAVES + F.wave, NGW = F.G * NWAVES;
    { bf16* wsb = (bf16*)(F.ws + WS_WSB);
      for (int i = gw * 64 + lane; i < NGROUP * CHUNK * CHUNK / 4; i += NGW * 64) { const f32x4 v = ((const GAS f32x4*)F.gm_w_s)[i]; v2u o; o.x = pk2(v.x, v.y); o.y = pk2(v.z, v.w); ((GAS v2u*)wsb)[i] = o; } }
    bf16* XN = (bf16*)(F.ws + WS_RA);
    for (int m = gw; m < M; m += NGW) rms_row_to_bf16(lane, F.x + (size_t)m * D, F.norm1_g, XN + (size_t)m * D, F.ws + WS_XN8 + (size_t)m * D);
}
__device__ __forceinline__ void p5_norm_and_ffn_weights(Frame& F) {
    const int lane = opaque_tid() & 63;
    const int gw = F.vcu * NWAVES + F.wave, NGW = F.G * NWAVES;
    bf16* HN = (bf16*)(F.ws + WS_RA);
    for (int m = gw; m < M; m += NGW) rms_row_to_bf16(lane, F.out + (size_t)m * D, F.norm2_g, HN + (size_t)m * D);
}

typedef short s16x4 __attribute__((ext_vector_type(4)));
constexpr int GM_WP = 272, GM_VP = 288;
constexpr int GM_V_OFF = 128 * GM_WP, GM_ST_OFF = GM_V_OFF + 128 * GM_VP;
__device__ __forceinline__ void gmlp_unit(Frame& F, int chunk, int half) {
    LAS unsigned char* Wl = F.lds; LAS unsigned char* Vt = F.lds + GM_V_OFF; LAS f32x2* st = (LAS f32x2*)(F.lds + GM_ST_OFF);
    const bf16* U = (const bf16*)(F.ws + WS_U); const bf16* V = (const bf16*)(F.ws + WS_V); bf16* YA = (bf16*)(F.ws + WS_YA); const bf16* WSB = (const bf16*)(F.ws + WS_WSB);
    const int tid = opaque_tid();
    const int tok0 = chunk * CHUNK, lane = tid & 63, fr = lane & 15, fq = lane >> 4, q4 = fr >> 2, p4 = lane & 3;
    const int srow = tid >> 4, sch = tid & 15;
    const int g_first = half * (NGROUP / 2);
    v4u Wr[4], Vr[4]; f32x4 lg[2], lb[2];
#define GM_PREFETCH(g_) do { _Pragma("unroll") for (int q = 0; q < 4; ++q) { Wr[q] = *(const GAS v4u*)(WSB + (size_t)(g_) * CHUNK * CHUNK + (srow + 32 * q) * CHUNK + sch * 8); \
        Vr[q] = *(const GAS v4u*)(V + (size_t)(tok0 + srow + 32 * q) * GMW + (g_) * 128 + sch * 8); } \
        lg[0] = *(const GAS f32x4*)(F.gm_ln_g + (g_) * 128 + sch * 8); lg[1] = *(const GAS f32x4*)(F.gm_ln_g + (g_) * 128 + sch * 8 + 4); \
        lb[0] = *(const GAS f32x4*)(F.gm_ln_b + (g_) * 128 + sch * 8); lb[1] = *(const GAS f32x4*)(F.gm_ln_b + (g_) * 128 + sch * 8 + 4); } while (0)
    GM_PREFETCH(g_first);
    __syncthreads();
    { const GAS f32x4* p = (const GAS f32x4*)((const float*)(F.ws + WS_PART) + (size_t)(tok0 + (tid >> 2)) * 64 + (tid & 3) * 16); float sm = 0.f, sq = 0.f;
#pragma unroll
      for (int i = 0; i < 4; ++i) { const f32x4 v = p[i]; sm += v.x + v.z; sq += v.y + v.w; }
      sm += xor_lane<1>(sm); sm += xor_lane<2>(sm); sq += xor_lane<1>(sq); sq += xor_lane<2>(sq);
      const float mean = sm * (1.f / GMW), var = fmaxf(sq * (1.f / GMW) - mean * mean, 0.f);
      if ((tid & 3) == 0) st[tid >> 2] = (f32x2){mean, 1.f / sqrtf(var + LN_EPS)}; }
    const int wi = F.wave >> 1, wc2 = F.wave & 1;
#pragma unroll 1
    for (int gi = 0; gi < NGROUP / 2; ++gi) { const int g = g_first + gi;
        __syncthreads();
#pragma unroll
        for (int q = 0; q < 4; ++q) { const int row = srow + 32 * q;
            *(LAS v4u*)(Wl + row * GM_WP + sch * 16) = Wr[q];
            const v4u w = Vr[q]; const f32x2 ms = st[row]; v4u o;
            o.x = pk2((bflo(w.x) - ms.x) * ms.y * lg[0].x + lb[0].x, (bfhi(w.x) - ms.x) * ms.y * lg[0].y + lb[0].y); o.y = pk2((bflo(w.y) - ms.x) * ms.y * lg[0].z + lb[0].z, (bfhi(w.y) - ms.x) * ms.y * lg[0].w + lb[0].w);
            o.z = pk2((bflo(w.z) - ms.x) * ms.y * lg[1].x + lb[1].x, (bfhi(w.z) - ms.x) * ms.y * lg[1].y + lb[1].y); o.w = pk2((bflo(w.w) - ms.x) * ms.y * lg[1].z + lb[1].z, (bfhi(w.w) - ms.x) * ms.y * lg[1].w + lb[1].w);
            *(LAS v4u*)(Vt + row * GM_VP + sch * 16) = o; }
        if (gi + 1 < NGROUP / 2) GM_PREFETCH(g + 1);
        v4u uu[2][2]; float bs[2];
#pragma unroll
        for (int it = 0; it < 2; ++it) { const int i = 32 * wi + 16 * it + fr; bs[it] = F.gm_b_s[g * CHUNK + i];
#pragma unroll
            for (int t = 0; t < 2; ++t) uu[it][t] = *(const GAS v4u*)(U + (size_t)(tok0 + i) * GMW + g * 128 + 64 * wc2 + 32 * t + 8 * fq); }
        __syncthreads();
        f32x4 acc[4][2];
#pragma unroll
        for (int ct = 0; ct < 4; ++ct)
#pragma unroll
            for (int it = 0; it < 2; ++it) acc[ct][it] = (f32x4){0.f, 0.f, 0.f, 0.f};
#pragma unroll
        for (int kk = 0; kk < 8; ++kk) { s16x4 vf[4], wf[2];
#pragma unroll
            for (int ct = 0; ct < 4; ++ct) vf[ct] = __builtin_amdgcn_ds_read_tr16_b64_v4i16((LAS s16x4*)(Vt + (16 * kk + 4 * fq + q4) * GM_VP + (64 * wc2 + 32 * (ct >> 1) + 8 * p4 + 4 * (ct & 1)) * 2));
#pragma unroll
            for (int it = 0; it < 2; ++it) wf[it] = *(const LAS s16x4*)(Wl + (32 * wi + 16 * it + fr) * GM_WP + (16 * kk + 4 * fq) * 2);
#pragma unroll
            for (int ct = 0; ct < 4; ++ct)
#pragma unroll
                for (int it = 0; it < 2; ++it) acc[ct][it] = __builtin_amdgcn_mfma_f32_16x16x16bf16_1k(vf[ct], wf[it], acc[ct][it], 0, 0, 0); }
#pragma unroll
        for (int it = 0; it < 2; ++it) { const int i = 32 * wi + 16 * it + fr;
#pragma unroll
            for (int t = 0; t < 2; ++t) { const v4u u4 = uu[it][t]; const f32x4 a0 = acc[2 * t][it], a1 = acc[2 * t + 1][it]; const float b = bs[it]; v4u o;
                o.x = pk2((a0[0] + b) * bflo(u4.x), (a0[1] + b) * bfhi(u4.x)); o.y = pk2((a0[2] + b) * bflo(u4.y), (a0[3] + b) * bfhi(u4.y));
                o.z = pk2((a1[0] + b) * bflo(u4.z), (a1[1] + b) * bfhi(u4.z)); o.w = pk2((a1[2] + b) * bflo(u4.w), (a1[3] + b) * bfhi(u4.w));
                *(GAS v4u*)(YA + (size_t)(tok0 + i) * GMW + g * 128 + 64 * wc2 + 32 * t + 8 * fq) = o; } }
    }
#undef GM_PREFETCH
    __syncthreads();
}

constexpr int NA_KP = 272, NA_VP = 288;
constexpr int NA_KS = 64 * NA_KP, NA_SLOT = NA_KS + 64 * NA_VP, NA_RPB_OFF = 2 * NA_SLOT, NA_ROWS = 11;
constexpr float LOG2E = 1.4426950408889634f;
template <bool FILL> __device__ __forceinline__ void na_unit(Frame& F, int pq, int h, float cbound, int fill_it, int fill_stride) {
    LAS unsigned char* ring = F.lds; LAS float* rpbL = (LAS float*)(F.lds + NA_RPB_OFF);
    const bf16* Q = (const bf16*)(F.ws + WS_Q); const bf16* Kt = (const bf16*)(F.ws + WS_K); const bf16* Vv = (const bf16*)(F.ws + WS_VV);
    const int tid = opaque_tid();
    const int lane = tid & 63, wave = __builtin_amdgcn_readfirstlane(tid >> 6), fr = lane & 15, g = lane >> 4, q4 = fr >> 2, p4 = lane & 3;
    const int R0 = 4 * pq, r = R0 + (wave >> 1), half = wave & 1, kb0 = half;
    int b0 = R0 - 4; b0 = b0 < 0 ? 0 : (b0 > GRID_H - 8 ? GRID_H - 8 : b0);
    int rs = r - 4; rs = rs < 0 ? 0 : (rs > GRID_H - 8 ? GRID_H - 8 : rs);
    int c[2], cs[2];
#pragma unroll
    for (int tt = 0; tt < 2; ++tt) { c[tt] = 32 * half + 16 * tt + fr; int x = c[tt] - 8; cs[tt] = x < 0 ? 0 : (x > GRID_W - 16 ? GRID_W - 16 : x); }
    const int skey = tid >> 4, sdch = tid & 15;
    __syncthreads();
    for (int i = tid; i < 15 * 31; i += 512) rpbL[i] = __builtin_amdgcn_exp2f(F.na_rpb[h * 465 + i] * LOG2E);
    v4u RK[2][2], RV[2][2];
    TrRegs FR; FillItem FI;
#define NA_LOAD(s_) do { int kr_ = b0 + (s_); kr_ = kr_ > GRID_H - 1 ? GRID_H - 1 : kr_; _Pragma("unroll") for (int q2 = 0; q2 < 2; ++q2) { \
        const size_t o_ = (size_t)(kr_ * GRID_W + skey + 32 * q2) * NAW + h * HD + sdch * 8; RK[(s_) & 1][q2] = *(const GAS v4u*)(Kt + o_); RV[(s_) & 1][q2] = *(const GAS v4u*)(Vv + o_); } } while (0)
    NA_LOAD(0); NA_LOAD(1);
    bf16x8 Qf[2][4];
#pragma unroll
    for (int tt = 0; tt < 2; ++tt) { const size_t tq = (size_t)(r * GRID_W + c[tt]); v4u qw[4]; float ss = 0.f;
#pragma unroll
      for (int ks = 0; ks < 4; ++ks) { qw[ks] = *(const GAS v4u*)(Q + tq * NAW + h * HD + 32 * ks + 8 * g);
          const float a0 = bflo(qw[ks].x), a1 = bfhi(qw[ks].x), a2 = bflo(qw[ks].y), a3 = bfhi(qw[ks].y), a4 = bflo(qw[ks].z), a5 = bfhi(qw[ks].z), a6 = bflo(qw[ks].w), a7 = bfhi(qw[ks].w);
          ss += (a0 * a0 + a1 * a1) + (a2 * a2 + a3 * a3) + (a4 * a4 + a5 * a5) + (a6 * a6 + a7 * a7); }
      ss += xor_lane<16>(ss); ss += xor_lane<32>(ss);
      const float rq = (1.f / sqrtf(ss * (1.f / HD) + RMS_EPS)) * 0.08838834764831845f * LOG2E;
#pragma unroll
      for (int ks = 0; ks < 4; ++ks) { const f32x4 g0 = *(const GAS f32x4*)(F.q_gain + 32 * ks + 8 * g), g1 = *(const GAS f32x4*)(F.q_gain + 32 * ks + 8 * g + 4);
          v4u o; o.x = pk2(bflo(qw[ks].x) * rq * g0.x, bfhi(qw[ks].x) * rq * g0.y); o.y = pk2(bflo(qw[ks].y) * rq * g0.z, bfhi(qw[ks].y) * rq * g0.w);
          o.z = pk2(bflo(qw[ks].z) * rq * g1.x, bfhi(qw[ks].z) * rq * g1.y); o.w = pk2(bflo(qw[ks].w) * rq * g1.z, bfhi(qw[ks].w) * rq * g1.w);
          Qf[tt][ks] = __builtin_bit_cast(bf16x8, o); } }
    const f32x4 kg0 = *(const GAS f32x4*)(F.k_gain + sdch * 8), kg1 = *(const GAS f32x4*)(F.k_gain + sdch * 8 + 4);
    f32x4 O[2][8]; float lsum[2] = {0.f, 0.f};
#pragma unroll
    for (int tt = 0; tt < 2; ++tt)
#pragma unroll
        for (int db = 0; db < 8; ++db) O[tt][db] = (f32x4){0.f, 0.f, 0.f, 0.f};
#pragma unroll
    for (int s = 0; s < NA_ROWS; ++s) { LAS unsigned char* slot = ring + (s & 1) * NA_SLOT;
#pragma unroll
        for (int q2 = 0; q2 < 2; ++q2) { const v4u w = RK[s & 1][q2];
            const float a0 = bflo(w.x), a1 = bfhi(w.x), a2 = bflo(w.y), a3 = bfhi(w.y), a4 = bflo(w.z), a5 = bfhi(w.z), a6 = bflo(w.w), a7 = bfhi(w.w);
            float ss = (a0 * a0 + a1 * a1) + (a2 * a2 + a3 * a3) + (a4 * a4 + a5 * a5) + (a6 * a6 + a7 * a7);
            ss += xor_lane<1>(ss); ss += xor_lane<2>(ss); ss += xor_lane<4>(ss); ss += xor_lane<8>(ss);
            const float rk = 1.f / sqrtf(ss * (1.f / HD) + RMS_EPS);
            v4u o; o.x = pk2(a0 * rk * kg0.x, a1 * rk * kg0.y); o.y = pk2(a2 * rk * kg0.z, a3 * rk * kg0.w); o.z = pk2(a4 * rk * kg1.x, a5 * rk * kg1.y); o.w = pk2(a6 * rk * kg1.z, a7 * rk * kg1.w);
            *(LAS v4u*)(slot + (skey + 32 * q2) * NA_KP + sdch * 16) = o;
            *(LAS v4u*)(slot + NA_KS + (skey + 32 * q2) * NA_VP + sdch * 16) = RV[s & 1][q2]; }
        if (s + 2 < NA_ROWS) NA_LOAD(s + 2);
        if constexpr (FILL) { if (s > 0) tr_store(FR, FI.dst, FI.ldk, lane); FI = ff_item(F, fill_it + s * fill_stride); tr_load(FR, FI.src, FI.ldw, FI.k0, FI.n0, lane); }
        __syncthreads();
        const int kr = b0 + s;
        if (kr >= rs && kr <= rs + 7) {
            f32x4 S[2][3];
#pragma unroll
            for (int tt = 0; tt < 2; ++tt)
#pragma unroll
                for (int b = 0; b < 3; ++b) S[tt][b] = (f32x4){-cbound, -cbound, -cbound, -cbound};
#pragma unroll
            for (int b = 0; b < 3; ++b)
#pragma unroll
                for (int ks = 0; ks < 4; ++ks) { const bf16x8 a = *(const LAS bf16x8*)(slot + (16 * (kb0 + b) + fr) * NA_KP + (32 * ks + 8 * g) * 2);
#pragma unroll
                    for (int tt = 0; tt < 2; ++tt) S[tt][b] = __builtin_amdgcn_mfma_f32_16x16x32_bf16(a, Qf[tt][ks], S[tt][b], 0, 0, 0); }
            s16x4 pf[2][3];
#pragma unroll
            for (int tt = 0; tt < 2; ++tt) { const int rbase = (kr - r + 7) * 31 + 15 - c[tt];
#pragma unroll
                for (int b = 0; b < 3; ++b) { float pv[4];
#pragma unroll
                    for (int i = 0; i < 4; ++i) { const int kc = 16 * (kb0 + b) + 4 * g + i; const bool ok = (kc >= cs[tt]) && (kc <= cs[tt] + 15);
                        int idx = rbase + kc; idx = ok ? idx : 0; const float e = __builtin_amdgcn_exp2f(S[tt][b][i]) * rpbL[idx]; pv[i] = ok ? e : 0.f; lsum[tt] += pv[i]; }
                    v2u pw; pw.x = pk2(pv[0], pv[1]); pw.y = pk2(pv[2], pv[3]); pf[tt][b] = __builtin_bit_cast(s16x4, pw); } }
#pragma unroll
            for (int b = 0; b < 3; ++b)
#pragma unroll
                for (int db = 0; db < 8; ++db) { const s16x4 vf = __builtin_amdgcn_ds_read_tr16_b64_v4i16((LAS s16x4*)(slot + NA_KS + (16 * (kb0 + b) + 4 * g + q4) * NA_VP + (32 * (db >> 1) + 8 * p4 + 4 * (db & 1)) * 2));
#pragma unroll
                    for (int tt = 0; tt < 2; ++tt) O[tt][db] = __builtin_amdgcn_mfma_f32_16x16x16bf16_1k(vf, pf[tt][b], O[tt][db], 0, 0, 0); }
        }
    }
#undef NA_LOAD
    if constexpr (FILL) tr_store(FR, FI.dst, FI.ldk, lane);
#pragma unroll
    for (int tt = 0; tt < 2; ++tt) { float l = lsum[tt]; l += xor_lane<16>(l); l += xor_lane<32>(l); const float inv = 1.f / l;
        const float inv8 = inv * F8_YSCALE;
        GAS unsigned char* orow = (GAS unsigned char*)(F.ws + WS_YB) + (size_t)(r * GRID_W + c[tt]) * F8P + h * HD + 8 * g;
#pragma unroll
        for (int t = 0; t < 4; ++t) { const f32x4 a0 = O[tt][2 * t], a1 = O[tt][2 * t + 1]; v2u o;
            o.x = pk4_fp8(a0[0] * inv8, a0[1] * inv8, a0[2] * inv8, a0[3] * inv8); o.y = pk4_fp8(a1[0] * inv8, a1[1] * inv8, a1[2] * inv8, a1[3] * inv8);
            *(GAS v2u*)(orow + 32 * t) = o; } }
}

struct Args { const float* in[17]; float* out; unsigned char* ws; int ph_lo, ph_hi, li, pad; };
__global__ void __launch_bounds__(NWAVES * 64, 2) fwd_kernel(Args args) {
    extern __shared__ __attribute__((aligned(16))) unsigned char lds[];
    Frame F;
    F.lds = (LAS unsigned char*)lds;
    F.MISC = (volatile LAS unsigned*)(F.lds + MISC_OFF);
    F.tid = threadIdx.x; F.lane = F.tid & 63; F.wave = __builtin_amdgcn_readfirstlane(F.tid >> 6);
    F.G = gridDim.x; { const int bx = blockIdx.x; F.vcu = (F.G % 8 == 0) ? (bx % 8) * (F.G / 8) + bx / 8 : bx; }
    F.ws = args.ws; F.ctl = (gu32*)(args.ws + WS_CTL);
    F.x = args.in[0]; F.norm1_g = args.in[1]; F.w_in = args.in[2]; F.gm_ln_g = args.in[3]; F.gm_ln_b = args.in[4]; F.gm_w_s = args.in[5]; F.gm_b_s = args.in[6];
    F.q_gain = args.in[7]; F.k_gain = args.in[8]; F.na_rpb = args.in[9]; F.w_o_gm = args.in[10]; F.w_o_na = args.in[11]; F.w_out = args.in[12]; F.norm2_g = args.in[13];
    F.w_ff_gate = args.in[14]; F.w_ff_up = args.in[15]; F.w_ff_down = args.in[16]; F.out = args.out;
    for (int u = F.tid; u < (LDS_BYTES - LDSCTL_OFF) / 4; u += NWAVES * 64) ((LAS unsigned*)(F.lds + LDSCTL_OFF))[u] = 0u;
    __syncthreads();
    XcdBarrier bar; bar.bar = (unsigned*)(F.ctl + CW_BAR); bar.x = 0; bar.st = nullptr;
    if (N_LAUNCHES != PER_PHASE) bar = xcd_barrier_post((unsigned*)(F.ctl + CW_BAR), F.MISC + 8);
#define GRID_BAR() do { if (N_LAUNCHES != PER_PHASE) xcd_barrier(bar); } while (0)
    const int lo = args.ph_lo, hi = args.ph_hi < MK_STOP_AFTER + 1 ? args.ph_hi : MK_STOP_AFTER + 1;
#define IN(k) (lo <= (k) && (k) < hi)
#define BOTH(k) (IN(k) && IN((k) + 1))
    const int bx = (int)blockIdx.x;

    if (IN(0)) { _Pragma("unroll") for (int rep = 0; rep < NREP(0); ++rep) { p0_prologue(F); if (BOTH(0)) GRID_BAR(); } }

    if (IN(1)) _Pragma("unroll") for (int rep = 0; rep < NREP(1); ++rep) {
        { pg8::SchedP1a S; S.o.init(M, 16 * 256, F.G, bx); S.A = (const char*)(F.ws + WS_RA); S.B = (const char*)(F.ws + WS_WIN); S.tstep = (size_t)256 * D * 2;
          pg8::EpiProj E{(bf16*)(F.ws + WS_RB), M, 1.f, (float*)(F.ws + WS_PART)};
          stagger(MK_STAGGER_US); pg8::gemm_phase<pg8::EpiProj, pg8::SchedP1a, true, true>(F.lds, D, S, E); }
        { pg8::SchedP1b S; S.o.init(M, 56 * 256, F.G, bx); S.A8 = (const char*)(F.ws + WS_XN8); S.B8 = (const char*)(F.ws + WS_WQKV8); S.tstep8 = (size_t)256 * D;
          pg8::EpiQKV E{(bf16*)(F.ws + WS_RB), M, F8_UNSCALE, F.ws + WS_GA, F.ws + WS_GB};
          pg8::gemm_phase_f8<pg8::EpiQKV, pg8::SchedP1b>(F.lds, D, S, E); }
        if (BOTH(1)) GRID_BAR();
    }
    if (IN(2)) _Pragma("unroll") for (int rep = 0; rep < NREP(2); ++rep) {
        for (int u = bx; u < 2 * (M / CHUNK); u += F.G) gmlp_unit(F, u >> 1, u & 1);
#if defined(MK_PROBE_NA)
        for (int rep = 0; rep < args.pad + 2; ++rep)
#endif
        float cbound;
        { const int ln = opaque_tid() & 63; float mq = fmaxf(fabsf(F.q_gain[2 * ln]), fabsf(F.q_gain[2 * ln + 1])), mk = fmaxf(fabsf(F.k_gain[2 * ln]), fabsf(F.k_gain[2 * ln + 1]));
          mq = fmaxf(mq, xor_lane<1>(mq)); mq = fmaxf(mq, xor_lane<2>(mq)); mq = fmaxf(mq, xor_lane<4>(mq)); mq = fmaxf(mq, xor_lane<8>(mq)); mq = fmaxf(mq, xor_lane<16>(mq)); mq = fmaxf(mq, xor_lane<32>(mq));
          mk = fmaxf(mk, xor_lane<1>(mk)); mk = fmaxf(mk, xor_lane<2>(mk)); mk = fmaxf(mk, xor_lane<4>(mk)); mk = fmaxf(mk, xor_lane<8>(mk)); mk = fmaxf(mk, xor_lane<16>(mk)); mk = fmaxf(mk, xor_lane<32>(mk));
          cbound = 11.313708498984761f * 1.01f * LOG2E * mq * mk; }
        {
            const int gwv = F.vcu * NWAVES + F.wave, NGW = F.G * NWAVES, per_wave = (FF_ITEMS_P2 + NGW - 1) / NGW, nfill = (per_wave + NA_ROWS - 1) / NA_ROWS; int ui = 0, done = 0;
            for (int u = F.vcu; u < (GRID_H / 4) * NHEAD; u += F.G, ++ui) {
                if (ui < nfill) { na_unit<true>(F, u & (GRID_H / 4 - 1), u >> 6, cbound, gwv + done * NGW, NGW); done += NA_ROWS; }
                else na_unit<false>(F, u & (GRID_H / 4 - 1), u >> 6, cbound, 0, 0); }
            const int ln = opaque_tid() & 63;
            for (int it = gwv + done * NGW; it < FF_ITEMS_P2; it += NGW) { TrRegs R; const FillItem I = ff_item(F, it); tr_load(R, I.src, I.ldw, I.k0, I.n0, ln); tr_store(R, I.dst, I.ldk, ln); }
        }
        if (BOTH(2)) GRID_BAR();
    }
    if (IN(3)) _Pragma("unroll") for (int rep = 0; rep < NREP(3); ++rep) {
        { pg8::SchedMerge S; S.o.init(M, D, F.G, bx); S.A0 = (const char*)(F.ws + WS_YB); S.B0 = (const char*)(F.ws + WS_WOB); S.A1 = (const char*)(F.ws + WS_YA); S.B1 = (const char*)(F.ws + WS_WOA); S.tstep = (size_t)256 * F8P;
          pg8::EpiMix E{F.ws + WS_GA, F.ws + WS_GB, (bf16*)(F.ws + WS_MRG), F8_YUNSCALE};
          stagger(MK_STAGGER_US); pg8::gemm_phase_mix<pg8::EpiMix, pg8::SchedMerge>(F.lds, F8P, NAW / 128, GMW / 64, S, E); }
        if (BOTH(3)) GRID_BAR();
    }
    if (IN(4)) _Pragma("unroll") for (int rep = 0; rep < NREP(4); ++rep) {
        pg8::SchedPlain S; S.o.init(M, D, F.G, bx); S.A = (const char*)(F.ws + WS_MRG); S.B = (const char*)(F.ws + WS_WOUT); S.tstep = (size_t)256 * D * 2;
        pg8::EpiOutNorm E{F.x, (bf16*)(F.ws + WS_H16), (bf16*)(F.ws + WS_RA), F.norm2_g, (float*)(F.ws + WS_PART)};
        stagger(MK_STAGGER_US); pg8::gemm_phase<pg8::EpiOutNorm, pg8::SchedPlain, true, true>(F.lds, D, S, E);
        if (BOTH(4)) GRID_BAR();
    }
    if (IN(6)) _Pragma("unroll") for (int rep = 0; rep < NREP(6); ++rep) {
        pg8::SchedPlain S; S.o.init(M, NGU, F.G, bx); S.A = (const char*)(F.ws + WS_RA); S.B = (const char*)(F.ws + WS_WGU); S.tstep = (size_t)256 * D * 2;
        LAS float* rtab = (LAS float*)(F.lds + 135168); const int fm = 8 * (bx & 7);
        { const int t5 = opaque_tid(); const float* part = (const float*)(F.ws + WS_PART);
          for (int r = t5; r < 2048; r += NWAVES * 64) { const GAS f32x4* p = (const GAS f32x4*)(part + (size_t)(fm * 256 + r) * 64); float sacc = 0.f;
#pragma unroll
              for (int j = 0; j < 16; ++j) { const f32x4 v = p[j]; sacc += (v.x + v.y) + (v.z + v.w); }
              rtab[r] = 1.f / sqrtf(sacc * (1.f / D) + RMS_EPS); }
          __syncthreads(); }
        pg8::EpiSwiglu E{(bf16*)(F.ws + WS_ACT), DFF, rtab, fm};
        stagger(MK_STAGGER_US); pg8::gemm_phase<pg8::EpiSwiglu, pg8::SchedPlain, true, true>(F.lds, D, S, E);
        {
            const int rem = S.o.nwg % F.G, first = rem, nidle = rem ? F.G - rem : F.G;
            if (bx >= first || rem == 0) { const int ln = opaque_tid() & 63, w0 = ((rem ? bx - first : bx) * NWAVES + F.wave), NW = nidle * NWAVES;
                for (int it = FF_ITEMS_P2 + w0; it < FF_ITEMS; it += 2 * NW) { const int it2 = it + NW; TrRegs Ra, Rb; const FillItem Ia = ff_item(F, it), Ib = ff_item(F, it2);
                    tr_load(Ra, Ia.src, Ia.ldw, Ia.k0, Ia.n0, ln); tr_load(Rb, Ib.src, Ib.ldw, Ib.k0, Ib.n0, ln); tr_store(Ra, Ia.dst, Ia.ldk, ln); tr_store(Rb, Ib.dst, Ib.ldk, ln); } } }
        if (BOTH(6)) GRID_BAR();
    }
    if (IN(7)) {
        pg8::SchedPlain S; S.o.init(M, D, F.G, bx); S.A = (const char*)(F.ws + WS_ACT); S.B = (const char*)(F.ws + WS_WD); S.tstep = (size_t)256 * DFF * 2;
        pg8::EpiResH16 E{(const bf16*)(F.ws + WS_H16), F.out};
        stagger(MK_STAGGER_US); pg8::gemm_phase<pg8::EpiResH16, pg8::SchedPlain, true, true>(F.lds, DFF, S, E);
    }

#if MK_STOP_AFTER < 4
    {
        GRID_BAR();
        const bf16* pU = (const bf16*)(F.ws + WS_U); const bf16* pV = (const bf16*)(F.ws + WS_V); const bf16* pQ = (const bf16*)(F.ws + WS_Q); const bf16* pK = (const bf16*)(F.ws + WS_K); const bf16* pVV = (const bf16*)(F.ws + WS_VV);
        const bf16* pGA = (const bf16*)(F.ws + WS_GA); const bf16* pGB = (const bf16*)(F.ws + WS_GB); const bf16* pYA = (const bf16*)(F.ws + WS_YA); const bf16* pYB = (const bf16*)(F.ws + WS_YB); const bf16* pM = (const bf16*)(F.ws + WS_MRG);
        for (size_t i = (size_t)bx * 512 + F.tid; i < (size_t)M * D; i += (size_t)F.G * 512) { const size_t m = i >> 12; const int c = (int)(i & 4095), c2 = c & 2047; float v;
            if (MK_STOP_AFTER == 1) v = 0.f * bflo(pGA[i]) + 0.f * bflo(pGB[i]) + 8.f * bflo(((const bf16*)(F.ws + WS_WOA))[(m & 4095) * 2048 + c2]) + 9.f * bflo(((const bf16*)(F.ws + WS_WOB))[(m & 4095) * 2048 + c2]) + 10.f * bflo(((const bf16*)(F.ws + WS_WOUT))[(m & 4095) * 4096 + c]);
            else if (MK_STOP_AFTER == 2) v = c < 2048 ? bflo(pYA[m * 2048 + c2]) : bflo(pYB[m * 2048 + c2]);
            else if (MK_STOP_AFTER == 3) v = bflo(pM[i]);
            else v = F.x[i];
            F.out[i] = v; }
    }
#endif
#if defined(MK_PROBE_P7)
    {
        GRID_BAR();
        pg8::SchedPlain S; S.o.init(M, D, F.G, bx); S.A = (const char*)(F.ws + WS_ACT); S.B = (const char*)(F.ws + WS_WD); S.tstep = (size_t)256 * DFF * 2;
        pg8::EpiResF32 E{F.out, (float*)(F.ws + WS_END)};
        pg8::gemm_phase<pg8::EpiResF32, pg8::SchedPlain, true, true>(F.lds, DFF, S, E);
    }
#endif
#undef IN
#undef BOTH
#undef GRID_BAR
}

extern "C" void kernel_launch(void* const* d_in, const int* in_sizes, int n_in, void* d_out, int out_size, void* d_ws, size_t ws_size, hipStream_t stream) {
    static int grid = 0;
    if (grid == 0) {
        if (n_in != 17 || in_sizes[0] != M * D || out_size != M * D || ws_size < WS_END) { fprintf(stderr, "kernel_launch: unexpected shapes/workspace (n_in %d, in0 %d, out %d, ws %zu < %zu); nothing launched\n", n_in, n_in > 0 ? in_sizes[0] : -1, out_size, ws_size, (size_t)WS_END); grid = -1; return; }
        int dev = 0, cus = 0, per_cu = 0;
        if (hipGetDevice(&dev) != hipSuccess || hipDeviceGetAttribute(&cus, hipDeviceAttributeMultiprocessorCount, dev) != hipSuccess) { grid = -1; return; }
        if (hipFuncSetAttribute((const void*)fwd_kernel, hipFuncAttributeMaxDynamicSharedMemorySize, LDS_BYTES) != hipSuccess) { fprintf(stderr, "kernel_launch: hipFuncSetAttribute failed\n"); grid = -1; return; }
        if (hipOccupancyMaxActiveBlocksPerMultiprocessor(&per_cu, (const void*)fwd_kernel, NWAVES * 64, LDS_BYTES) != hipSuccess || per_cu < 1) fprintf(stderr, "kernel_launch: occupancy query reports %d\n", per_cu);
        (void)hipGetLastError();
        grid = cus - cus % 8;
    }
    if (grid < 0) return;
    if (hipMemsetAsync((char*)d_ws + WS_CTL, 0, CTL_ZERO_BYTES, stream) != hipSuccess) return;
    Args a{};
    for (int i = 0; i < 17; ++i) a.in[i] = (const float*)d_in[i];
    a.out = (float*)d_out; a.ws = (unsigned char*)d_ws;
    for (int li = 0; li < N_LAUNCHES; ++li) {
        if (N_LAUNCHES == PER_PHASE) { a.ph_lo = li; a.ph_hi = li + 1; } else { a.ph_lo = 0; a.ph_hi = PER_PHASE; }
        a.li = li; a.pad = 0;
        hipLaunchKernelGGL(fwd_kernel, dim3(grid), dim3(NWAVES * 64), LDS_BYTES, stream, a);
        const hipError_t le = hipPeekAtLastError();
        if (le != hipSuccess) { fprintf(stderr, "kernel_launch: launch %d failed: %s\n", li, hipGetErrorName(le)); break; }
    }
}
```

```cpp
#include <hip/hip_runtime.h>
#include <cstdio>
#include <cstdint>

#ifndef MK_N_LAUNCHES
#define MK_N_LAUNCHES 1
#endif
#ifndef MK_REPEAT
#define MK_REPEAT 0
#endif
#define NREP(k) (((MK_REPEAT >> (k)) & 1) + 1)
#ifndef MK_STOP_AFTER
#define MK_STOP_AFTER 7
#endif

__device__ __forceinline__ int opaque_tid() { int t = (int)threadIdx.x; asm volatile("" : "+v"(t)); return t; }
namespace pg8 {
#define PG8_LAS __attribute__((address_space(3)))
typedef unsigned short bf16_t;
typedef short bf16x8 __attribute__((ext_vector_type(8)));
typedef float f32x4 __attribute__((ext_vector_type(4)));
typedef float f32x2 __attribute__((ext_vector_type(2)));
typedef unsigned u32x4 __attribute__((ext_vector_type(4)));
typedef unsigned u32x2 __attribute__((ext_vector_type(2)));
constexpr int BM = 256, BK = 64, HALF = 128, HTB = HALF * BK * 2  , STAGE_BYTES = 8 * HTB, NXCD = 8, WGM = 8;

__host__ __device__ __forceinline__ int lds_byte(int r, int c) { const int st = (r >> 4) * 2 + (c >> 5), rr = r & 15, cc = c & 31, ob = rr * 64 + cc * 2; return st * 1024 + (ob ^ (((ob >> 9) & 1) << 5)); }
__host__ __device__ __forceinline__ void stage_rc(int b, int& R, int& C) { const int st = b / 1024, sb = b % 1024, swz = sb ^ (((sb >> 9) & 1) << 5); R = (st >> 1) * 16 + swz / 64; C = (st & 1) * 32 + (swz % 64) / 2; }
__host__ __device__ __forceinline__ int perm32(int rho) { const int n = rho >> 4, i = rho & 15; return 8 * (i >> 2) + 4 * n + (i & 3); }

struct Unit { int pm, pn, sub; };

struct StaticOrder {
    int nM, nN, nwg, G, c;
    __host__ __device__ void init(int M, int N, int G_, int c_) { nM = M / BM; nN = N / BM; nwg = nM * nN; G = G_; c = c_; }
    __host__ __device__ bool tile(int i, Unit& u) const {
        const long L = (long)i * G + c; if (L >= nwg) return false;
        int wgid = (int)L; { const int q = nwg / NXCD, r = nwg % NXCD, xcd = wgid % NXCD, off = wgid / NXCD; wgid = (xcd < r ? xcd * (q + 1) : r * (q + 1) + (xcd - r) * q) + off; }
        const int nig = WGM * nN, gid = wgid / nig, fm = gid * WGM, gsz = (nM - fm) < WGM ? (nM - fm) : WGM;
        u.pm = fm + ((wgid % nig) % gsz); u.pn = (wgid % nig) / gsz; u.sub = 0; return true;
    }
};
struct SchedPlain {
    StaticOrder o; const char* A; const char* B; size_t tstep;
    __device__ __forceinline__ bool next(int i, Unit& u) const { return o.tile(i, u); }
    __device__ __forceinline__ void ptrs(const Unit& u, const char*& a, const char*& b) const { a = A + (size_t)u.pm * tstep; b = B + (size_t)u.pn * tstep; }
};
struct SchedP1a {
    StaticOrder o; const char* A; const char* B; size_t tstep;
    __device__ __forceinline__ bool next(int i, Unit& u) const { const bool ok = o.tile(i, u); u.pn = u.pn < 16 ? u.pn : u.pn + 24; return ok; }
    __device__ __forceinline__ void ptrs(const Unit& u, const char*& a, const char*& b) const { a = A + (size_t)u.pm * tstep; b = B + (size_t)u.pn * tstep; }
};
struct SchedP1b {
    StaticOrder o; const char* A8; const char* B8; size_t tstep8;
    __device__ __forceinline__ bool next(int i, Unit& u) const { const bool ok = o.tile(i, u); u.sub = u.pn; u.pn = u.pn + 16; return ok; }
    __device__ __forceinline__ void ptrs(const Unit& u, const char*& a, const char*& b) const { a = A8 + (size_t)u.pm * tstep8; b = B8 + (size_t)u.sub * tstep8; }
};
struct SchedMerge {
    StaticOrder o; const char* A0; const char* B0; const char* A1; const char* B1; size_t tstep;
    __device__ __forceinline__ bool next(int i, Unit& u) const { const bool ok = o.tile(i >> 1, u); u.sub = i & 1; return ok; }
    __device__ __forceinline__ void ptrs(const Unit& u, const char*& a, const char*& b) const { a = (u.sub ? A1 : A0) + (size_t)u.pm * tstep; b = (u.sub ? B1 : B0) + (size_t)u.pn * tstep; }
};

typedef __bf16 bf16x2v __attribute__((ext_vector_type(2)));
__device__ __forceinline__ unsigned cvt_pk_bf16(float lo, float hi) { const bf16x2v v = __builtin_convertvector((f32x2){lo, hi}, bf16x2v); return __builtin_bit_cast(unsigned, v); }
__device__ __forceinline__ float bf_lo(unsigned w) { return __uint_as_float(w << 16); }
__device__ __forceinline__ float bf_hi(unsigned w) { return __uint_as_float(w & 0xffff0000u); }
__device__ __forceinline__ f32x2 gelu_pk(f32x2 v) {
    const f32x2 av = __builtin_elementwise_abs(v), d = av * 0.2316418882f + 1.0f;
    f32x2 t; t.x = __builtin_amdgcn_rcpf(d.x); t.y = __builtin_amdgcn_rcpf(d.y);
    f32x2 q = t * 0.5307027145f + (-0.7265760135f); q = q * t + 0.7107068705f; q = q * t + (-0.142248368f); q = q * t + 0.127414796f; q = q * t;
    const f32x2 s = (v * v) * (-0.72134752044f);
    f32x2 e; e.x = __builtin_amdgcn_exp2f(s.x); e.y = __builtin_amdgcn_exp2f(s.y);
    const f32x2 m = v * (q * e), r = v - m;
    f32x2 o; o.x = v.x < 0.f ? m.x : r.x; o.y = v.y < 0.f ? m.y : r.y; return o;
}
__device__ __forceinline__ float sigmoid_f(float x) { return __builtin_amdgcn_rcpf(1.0f + __builtin_amdgcn_exp2f(x * -1.44269504089f)); }
__device__ __forceinline__ f32x4 gelu4(f32x4 v) { const f32x2 a = gelu_pk((f32x2){v[0], v[1]}), b = gelu_pk((f32x2){v[2], v[3]}); return (f32x4){a.x, a.y, b.x, b.y}; }
__device__ __forceinline__ f32x4 sigm4(f32x4 v) { return (f32x4){sigmoid_f(v[0]), sigmoid_f(v[1]), sigmoid_f(v[2]), sigmoid_f(v[3])}; }
__device__ __forceinline__ u32x4 pack8(f32x4 v0, f32x4 v1) { u32x4 w; w.x = cvt_pk_bf16(v0[0], v0[1]); w.y = cvt_pk_bf16(v0[2], v0[3]); w.z = cvt_pk_bf16(v1[0], v1[1]); w.w = cvt_pk_bf16(v1[2], v1[3]); return w; }

__device__ __forceinline__ size_t lane_tile_idx(int T, int wr, int wc, int fr, int fq, int ai, int m, int bj) { return ((size_t)T * 128 + (((wr * 4 + wc) * 2 + ai) * 4 + m) * 2 + bj) * 64 + fr + 16 * fq; }
__device__ __forceinline__ unsigned pack_u8x4(f32x4 v) { const f32x4 q = v * 255.f + 0.5f; return (unsigned)q[0] | ((unsigned)q[1] << 8) | ((unsigned)q[2] << 16) | ((unsigned)q[3] << 24); }
__device__ __forceinline__ f32x4 unpack_u8x4(unsigned w) { return (f32x4){(float)(w & 0xffu), (float)((w >> 8) & 0xffu), (float)((w >> 16) & 0xffu), (float)(w >> 24)}; }
struct EpiProj {
    static constexpr bool PERM = true;
    bf16_t* base; int M; float qkv_scale;
    float* vstat;
    __device__ __forceinline__ void store_v(const f32x4 (&acc)[2][2][4][2], bf16_t* O, int row0, int col0, int slice, int fq) const {
#pragma unroll
        for (int ai = 0; ai < 2; ++ai)
#pragma unroll
            for (int m = 0; m < 4; ++m) { const int row = row0 + ai * HALF + m * 16; bf16_t* rowp = O + (size_t)row * 2048 + col0; float s = 0.f, s2 = 0.f;
#pragma unroll
                for (int bj = 0; bj < 2; ++bj) { const f32x4 v0 = gelu4(acc[ai][bj][m][0]), v1 = gelu4(acc[ai][bj][m][1]);
                    s += ((v0[0] + v0[1]) + (v0[2] + v0[3])) + ((v1[0] + v1[1]) + (v1[2] + v1[3]));
                    s2 += ((v0[0] * v0[0] + v0[1] * v0[1]) + (v0[2] * v0[2] + v0[3] * v0[3])) + ((v1[0] * v1[0] + v1[1] * v1[1]) + (v1[2] * v1[2] + v1[3] * v1[3]));
                    *(u32x4*)(rowp + bj * HALF) = pack8(v0, v1); }
                s += __shfl_xor(s, 16); s += __shfl_xor(s, 32); s2 += __shfl_xor(s2, 16); s2 += __shfl_xor(s2, 32);
                if (fq == 0) *(f32x2*)(vstat + (size_t)row * 64 + 2 * slice) = (f32x2){s, s2}; }
    }
    __device__ __forceinline__ bool keep(const Unit&) const { return false; }
    template <int ACT> __device__ __forceinline__ void store(const f32x4 (&acc)[2][2][4][2], bf16_t* O, int ldc, int row0, int col0) const {
#pragma unroll
        for (int ai = 0; ai < 2; ++ai)
#pragma unroll
            for (int m = 0; m < 4; ++m) { bf16_t* rowp = O + (size_t)(row0 + ai * HALF + m * 16) * ldc + col0;
#pragma unroll
                for (int bj = 0; bj < 2; ++bj) { f32x4 v0 = acc[ai][bj][m][0], v1 = acc[ai][bj][m][1];
                    if (ACT == 0) { v0 = v0 * qkv_scale; v1 = v1 * qkv_scale; }
                    if (ACT == 1) { v0 = gelu4(v0); v1 = gelu4(v1); }
                    if (ACT == 2) { v0 = sigm4(v0); v1 = sigm4(v1); }
                    *(u32x4*)(rowp + bj * HALF) = pack8(v0, v1); } }
    }
    __device__ __forceinline__ void operator()(f32x4 (&acc)[2][2][4][2], const Unit& u, int wr, int wc, int fr, int fq) const {
        const int row0 = u.pm * BM + wr * 64 + fr, pn = u.pn;
        if (pn < 40) { const int t = pn >> 3; bf16_t* O = base + (size_t)t * M * 2048; const int col0 = (pn & 7) * BM + wc * 32 + 8 * fq;
            if (t == 0) store<1>(acc, O, 2048, row0, col0); else if (t == 1) store_v(acc, O, row0, col0, (pn & 7) * 4 + wc, fq); else store<0>(acc, O, 2048, row0, col0); }
        else { const int t = (pn - 40) >> 4; bf16_t* O = base + (size_t)5 * M * 2048 + (size_t)t * M * 4096; const int col0 = ((pn - 40) & 15) * BM + wc * 32 + 8 * fq;
            store<2>(acc, O, 4096, row0, col0); }
    }
};
struct EpiQKV {
    static constexpr bool PERM = true;
    bf16_t* base; int M; float sc; unsigned char* ga8; unsigned char* gb8;
    __device__ __forceinline__ void store_gate(const f32x4 (&acc)[2][2][4][2], unsigned char* O8, int T, int wr, int wc, int fr, int fq) const {
#pragma unroll
        for (int ai = 0; ai < 2; ++ai)
#pragma unroll
            for (int m = 0; m < 4; ++m)
#pragma unroll
                for (int bj = 0; bj < 2; ++bj) { const f32x4 v0 = sigm4(acc[ai][bj][m][0] * sc), v1 = sigm4(acc[ai][bj][m][1] * sc);
                    *(u32x2*)(O8 + lane_tile_idx(T, wr, wc, fr, fq, ai, m, bj) * 8) = (u32x2){pack_u8x4(v0), pack_u8x4(v1)}; }
    }
    __device__ __forceinline__ bool keep(const Unit&) const { return false; }
    template <int ACT> __device__ __forceinline__ void store(const f32x4 (&acc)[2][2][4][2], bf16_t* O, int ldc, int row0, int col0) const {
#pragma unroll
        for (int ai = 0; ai < 2; ++ai)
#pragma unroll
            for (int m = 0; m < 4; ++m) { bf16_t* rowp = O + (size_t)(row0 + ai * HALF + m * 16) * ldc + col0;
#pragma unroll
                for (int bj = 0; bj < 2; ++bj) { f32x4 v0 = acc[ai][bj][m][0] * sc, v1 = acc[ai][bj][m][1] * sc;
                    if (ACT == 2) { v0 = sigm4(v0); v1 = sigm4(v1); }
                    *(u32x4*)(rowp + bj * HALF) = pack8(v0, v1); } }
    }
    __device__ __forceinline__ void operator()(f32x4 (&acc)[2][2][4][2], const Unit& u, int wr, int wc, int fr, int fq) const {
        const int row0 = u.pm * BM + wr * 64 + fr;
        if (u.pn < 40) store<0>(acc, base + (size_t)(u.pn >> 3) * M * 2048, 2048, row0, (u.pn & 7) * BM + wc * 32 + 8 * fq);
        else store_gate(acc, u.pn < 56 ? ga8 : gb8, u.pm * 16 + ((u.pn - 40) & 15), wr, wc, fr, fq);
    }
};
struct EpiTB {
    static constexpr bool PERM = true;
    const unsigned char* GB; bf16_t* T; float sc;
    __device__ __forceinline__ bool keep(const Unit&) const { return false; }
    __device__ __forceinline__ void operator()(f32x4 (&acc)[2][2][4][2], const Unit& u, int wr, int wc, int fr, int fq) const {
        const int row0 = u.pm * BM + wr * 64 + fr, col0 = u.pn * BM + wc * 32 + 8 * fq;
#pragma unroll
        for (int ai = 0; ai < 2; ++ai)
#pragma unroll
            for (int m = 0; m < 4; ++m) { const size_t off = (size_t)(row0 + ai * HALF + m * 16) * 4096 + col0;
#pragma unroll
                for (int bj = 0; bj < 2; ++bj) { const u32x2 b = *(const u32x2*)(GB + off + bj * HALF);
                    const f32x4 s0 = unpack_u8x4(b.x) * sc, s1 = unpack_u8x4(b.y) * sc;
                    *(u32x4*)(T + off + bj * HALF) = pack8(acc[ai][bj][m][0] * s0, acc[ai][bj][m][1] * s1); } }
    }
};
struct EpiMergeA {
    static constexpr bool PERM = true;
    const unsigned char* GA; const bf16_t* T; bf16_t* O;
    __device__ __forceinline__ bool keep(const Unit&) const { return false; }
    __device__ __forceinline__ void operator()(f32x4 (&acc)[2][2][4][2], const Unit& u, int wr, int wc, int fr, int fq) const {
        const int row0 = u.pm * BM + wr * 64 + fr, col0 = u.pn * BM + wc * 32 + 8 * fq;
#pragma unroll
        for (int ai = 0; ai < 2; ++ai)
#pragma unroll
            for (int m = 0; m < 4; ++m) { const size_t off = (size_t)(row0 + ai * HALF + m * 16) * 4096 + col0;
#pragma unroll
                for (int bj = 0; bj < 2; ++bj) { const u32x2 a = *(const u32x2*)(GA + off + bj * HALF); const u32x4 t = *(const u32x4*)(T + off + bj * HALF);
                    const f32x4 s0 = unpack_u8x4(a.x) * (1.f / 255.f), s1 = unpack_u8x4(a.y) * (1.f / 255.f);
                    const f32x4 t0 = (f32x4){bf_lo(t.x), bf_hi(t.x), bf_lo(t.y), bf_hi(t.y)}, t1 = (f32x4){bf_lo(t.z), bf_hi(t.z), bf_lo(t.w), bf_hi(t.w)};
                    *(u32x4*)(O + off + bj * HALF) = pack8(acc[ai][bj][m][0] * s0 + t0, acc[ai][bj][m][1] * s1 + t1); } }
    }
};
struct EpiMix {
    static constexpr bool PERM = true;
    const unsigned char* GA; const unsigned char* GB; bf16_t* O; float c;
    __device__ __forceinline__ bool keep(const Unit& u) const { return u.sub == 0; }
    __device__ __forceinline__ void operator()(f32x4 (&acc)[2][2][4][2], const Unit& u, int wr, int wc, int fr, int fq) const {
        const int row0 = u.pm * BM + wr * 64 + fr, col0 = u.pn * BM + wc * 32 + 8 * fq;
        if (u.sub == 0) {
#pragma unroll
            for (int ai = 0; ai < 2; ++ai)
#pragma unroll
                for (int m = 0; m < 4; ++m) { const size_t off = (size_t)(row0 + ai * HALF + m * 16) * 4096 + col0;
#pragma unroll
                    for (int bj = 0; bj < 2; ++bj) { const size_t gi = lane_tile_idx(u.pm * 16 + u.pn, wr, wc, fr, fq, ai, m, bj) * 8; (void)off; const u32x2 a = *(const u32x2*)(GA + gi), b = *(const u32x2*)(GB + gi);
                        f32x4 a0 = __builtin_elementwise_max(unpack_u8x4(a.x), (f32x4){9.5367431640625e-7f, 9.5367431640625e-7f, 9.5367431640625e-7f, 9.5367431640625e-7f});
                        f32x4 a1 = __builtin_elementwise_max(unpack_u8x4(a.y), (f32x4){9.5367431640625e-7f, 9.5367431640625e-7f, 9.5367431640625e-7f, 9.5367431640625e-7f});
                        const f32x4 r0 = (f32x4){__builtin_amdgcn_rcpf(a0[0]), __builtin_amdgcn_rcpf(a0[1]), __builtin_amdgcn_rcpf(a0[2]), __builtin_amdgcn_rcpf(a0[3])};
                        const f32x4 r1 = (f32x4){__builtin_amdgcn_rcpf(a1[0]), __builtin_amdgcn_rcpf(a1[1]), __builtin_amdgcn_rcpf(a1[2]), __builtin_amdgcn_rcpf(a1[3])};
                        acc[ai][bj][m][0] = acc[ai][bj][m][0] * (unpack_u8x4(b.x) * c) * r0; acc[ai][bj][m][1] = acc[ai][bj][m][1] * (unpack_u8x4(b.y) * c) * r1; } }
        } else {
#pragma unroll
            for (int ai = 0; ai < 2; ++ai)
#pragma unroll
                for (int m = 0; m < 4; ++m) { const size_t off = (size_t)(row0 + ai * HALF + m * 16) * 4096 + col0;
#pragma unroll
                    for (int bj = 0; bj < 2; ++bj) { const u32x2 a = *(const u32x2*)(GA + lane_tile_idx(u.pm * 16 + u.pn, wr, wc, fr, fq, ai, m, bj) * 8);
                        const f32x4 a0 = __builtin_elementwise_max(unpack_u8x4(a.x), (f32x4){9.5367431640625e-7f, 9.5367431640625e-7f, 9.5367431640625e-7f, 9.5367431640625e-7f}) * (1.f / 255.f);
                        const f32x4 a1 = __builtin_elementwise_max(unpack_u8x4(a.y), (f32x4){9.5367431640625e-7f, 9.5367431640625e-7f, 9.5367431640625e-7f, 9.5367431640625e-7f}) * (1.f / 255.f);
                        *(u32x4*)(O + off + bj * HALF) = pack8(acc[ai][bj][m][0] * a0, acc[ai][bj][m][1] * a1); } }
        }
    }
};
__device__ __forceinline__ float sb_lo(unsigned w) { return fmaxf(bf_lo(w), 8.673617379884035e-19f); }
__device__ __forceinline__ float sb_hi(unsigned w) { return fmaxf(bf_hi(w), 8.673617379884035e-19f); }
struct EpiMerge {
    static constexpr bool PERM = true;
    const bf16_t* GA; const bf16_t* GB; bf16_t* O;
    __device__ __forceinline__ bool keep(const Unit& u) const { return u.sub == 0; }
    __device__ __forceinline__ void operator()(f32x4 (&acc)[2][2][4][2], const Unit& u, int wr, int wc, int fr, int fq) const {
        const int row0 = u.pm * BM + wr * 64 + fr, col0 = u.pn * BM + wc * 32 + 8 * fq;
        if (u.sub == 0) {
#pragma unroll
            for (int ai = 0; ai < 2; ++ai)
#pragma unroll
                for (int m = 0; m < 4; ++m) { const size_t off = (size_t)(row0 + ai * HALF + m * 16) * 4096 + col0;
#pragma unroll
                    for (int bj = 0; bj < 2; ++bj) { const u32x4 a = *(const u32x4*)(GA + off + bj * HALF), b = *(const u32x4*)(GB + off + bj * HALF);
                        f32x4 r0, r1;
                        r0[0] = bf_lo(a.x) * __builtin_amdgcn_rcpf(sb_lo(b.x)); r0[1] = bf_hi(a.x) * __builtin_amdgcn_rcpf(sb_hi(b.x));
                        r0[2] = bf_lo(a.y) * __builtin_amdgcn_rcpf(sb_lo(b.y)); r0[3] = bf_hi(a.y) * __builtin_amdgcn_rcpf(sb_hi(b.y));
                        r1[0] = bf_lo(a.z) * __builtin_amdgcn_rcpf(sb_lo(b.z)); r1[1] = bf_hi(a.z) * __builtin_amdgcn_rcpf(sb_hi(b.z));
                        r1[2] = bf_lo(a.w) * __builtin_amdgcn_rcpf(sb_lo(b.w)); r1[3] = bf_hi(a.w) * __builtin_amdgcn_rcpf(sb_hi(b.w));
                        acc[ai][bj][m][0] *= r0; acc[ai][bj][m][1] *= r1; } }
        } else {
#pragma unroll
            for (int ai = 0; ai < 2; ++ai)
#pragma unroll
                for (int m = 0; m < 4; ++m) { const size_t off = (size_t)(row0 + ai * HALF + m * 16) * 4096 + col0;
#pragma unroll
                    for (int bj = 0; bj < 2; ++bj) { const u32x4 b = *(const u32x4*)(GB + off + bj * HALF);
                        const f32x4 s0 = (f32x4){sb_lo(b.x), sb_hi(b.x), sb_lo(b.y), sb_hi(b.y)}, s1 = (f32x4){sb_lo(b.z), sb_hi(b.z), sb_lo(b.w), sb_hi(b.w)};
                        *(u32x4*)(O + off + bj * HALF) = pack8(acc[ai][bj][m][0] * s0, acc[ai][bj][m][1] * s1); } }
        }
    }
};
struct EpiResF32 {
    static constexpr bool PERM = false;
    const float* res; float* out;
    __device__ __forceinline__ bool keep(const Unit&) const { return false; }
    __device__ __forceinline__ void operator()(f32x4 (&acc)[2][2][4][2], const Unit& u, int wr, int wc, int fr, int fq) const {
        const int row0 = u.pm * BM + wr * 64 + fr, col0 = u.pn * BM + wc * 32 + 4 * fq;
#pragma unroll
        for (int ai = 0; ai < 2; ++ai)
#pragma unroll
            for (int m = 0; m < 4; ++m) { const size_t off = (size_t)(row0 + ai * HALF + m * 16) * 4096 + col0;
#pragma unroll
                for (int bj = 0; bj < 2; ++bj)
#pragma unroll
                    for (int n = 0; n < 2; ++n) { const f32x4 r = *(const f32x4*)(res + off + bj * HALF + n * 16); *(f32x4*)(out + off + bj * HALF + n * 16) = r + acc[ai][bj][m][n]; } }
    }
};
struct EpiResH16 {
    static constexpr bool PERM = true;
    const bf16_t* h16; float* out;
    __device__ __forceinline__ bool keep(const Unit&) const { return false; }
    __device__ __forceinline__ void operator()(f32x4 (&acc)[2][2][4][2], const Unit& u, int wr, int wc, int fr, int fq) const {
        const int row0 = u.pm * BM + wr * 64 + fr, col0 = u.pn * BM + wc * 32 + 8 * fq;
#pragma unroll
        for (int ai = 0; ai < 2; ++ai)
#pragma unroll
            for (int m = 0; m < 4; ++m) { const size_t off = (size_t)(row0 + ai * HALF + m * 16) * 4096 + col0;
#pragma unroll
                for (int bj = 0; bj < 2; ++bj) { const u32x4 hb = *(const u32x4*)(h16 + lane_tile_idx(u.pm * 16 + u.pn, wr, wc, fr, fq, ai, m, bj) * 8);
                    const f32x4 h0 = (f32x4){bf_lo(hb.x), bf_hi(hb.x), bf_lo(hb.y), bf_hi(hb.y)}, h1 = (f32x4){bf_lo(hb.z), bf_hi(hb.z), bf_lo(hb.w), bf_hi(hb.w)};
                    *(f32x4*)(out + off + bj * HALF) = h0 + acc[ai][bj][m][0]; *(f32x4*)(out + off + bj * HALF + 4) = h1 + acc[ai][bj][m][1]; } }
    }
};
struct EpiOutNorm {
    static constexpr bool PERM = true;
    const float* x; bf16_t* h16; bf16_t* HN; const float* g2; float* part;
    __device__ __forceinline__ bool keep(const Unit&) const { return false; }
    __device__ __forceinline__ void operator()(f32x4 (&acc)[2][2][4][2], const Unit& u, int wr, int wc, int fr, int fq) const {
        const int row0 = u.pm * BM + wr * 64 + fr, col0 = u.pn * BM + wc * 32 + 8 * fq;
        f32x4 gg[2][2];
#pragma unroll
        for (int bj = 0; bj < 2; ++bj)
#pragma unroll
            for (int n = 0; n < 2; ++n) gg[bj][n] = *(const f32x4*)(g2 + col0 + bj * HALF + 4 * n);
#pragma unroll
        for (int ai = 0; ai < 2; ++ai)
#pragma unroll
            for (int m = 0; m < 4; ++m) { const int row = row0 + ai * HALF + m * 16; const size_t off = (size_t)row * 4096 + col0; float ss = 0.f;
#pragma unroll
                for (int bj = 0; bj < 2; ++bj) { const f32x4 x0 = *(const f32x4*)(x + off + bj * HALF), x1 = *(const f32x4*)(x + off + bj * HALF + 4);
                    const f32x4 h0 = x0 + acc[ai][bj][m][0], h1 = x1 + acc[ai][bj][m][1];
                    *(u32x4*)(h16 + lane_tile_idx(u.pm * 16 + u.pn, wr, wc, fr, fq, ai, m, bj) * 8) = pack8(h0, h1);
                    ss += ((h0[0] * h0[0] + h0[1] * h0[1]) + (h0[2] * h0[2] + h0[3] * h0[3])) + ((h1[0] * h1[0] + h1[1] * h1[1]) + (h1[2] * h1[2] + h1[3] * h1[3]));
                    *(u32x4*)(HN + off + bj * HALF) = pack8(h0 * gg[bj][0], h1 * gg[bj][1]); }
                ss += __shfl_xor(ss, 16); ss += __shfl_xor(ss, 32);
                if (fq == 0) part[(size_t)row * 64 + u.pn * 4 + wc] = ss; }
    }
};
struct EpiSwiglu {
    static constexpr bool PERM = true; static constexpr int NST = 4;
    bf16_t* O; int ldc; const PG8_LAS float* rstd; int fm;
    __device__ __forceinline__ bool keep(const Unit&) const { return false; }
    template <int AI> __device__ __forceinline__ void half(const f32x4 (&acc)[2][2][4][2], const Unit& u, int wr, int wc, int fr, int fq) const {
        const int row0 = u.pm * BM + wr * 64 + fr, col0 = u.pn * HALF + wc * 32 + 8 * fq, rl0 = (u.pm - fm) * BM + wr * 64 + fr;
#pragma unroll
        for (int m = 0; m < 4; ++m) { bf16_t* rowp = O + (size_t)(row0 + AI * HALF + m * 16) * ldc + col0; const float r = rstd[rl0 + AI * HALF + m * 16];
            const f32x4 g0 = acc[AI][0][m][0] * r, g1 = acc[AI][0][m][1] * r;
            const f32x4 v0 = g0 * sigm4(g0) * (acc[AI][1][m][0] * r), v1 = g1 * sigm4(g1) * (acc[AI][1][m][1] * r);
            *(u32x4*)rowp = pack8(v0, v1); }
    }
    __device__ __forceinline__ void operator()(f32x4 (&acc)[2][2][4][2], const Unit& u, int wr, int wc, int fr, int fq) const { half<0>(acc, u, wr, wc, fr, fq); half<1>(acc, u, wr, wc, fr, fq); }
};

template <class Epi, class Sched, bool ALIGN_EPI, bool SP2>
__device__ __forceinline__ void gemm_phase(PG8_LAS unsigned char* lds, const int K, const Sched& S, const Epi& E) {
    const int tid = opaque_tid(), wid = __builtin_amdgcn_readfirstlane(tid >> 6), lane = tid & 63, wr = wid >> 2, wc = wid & 3, fr = lane & 15, fq = lane >> 4;
    const int nt = K / BK;
    unsigned voffA[2], voffB[2];
#pragma unroll
    for (int i = 0; i < 2; ++i) { int R, C; stage_rc(tid * 16 + i * 8192, R, C); const int Rb = Epi::PERM ? ((R & ~31) + perm32(R & 31)) : R;
        voffA[i] = (unsigned)(R * K + C) * 2u; voffB[i] = (unsigned)(Rb * K + C) * 2u; }
    const size_t kstep = (size_t)(BK * 2);
    const size_t hstep = (size_t)HALF * K * 2;
    const unsigned ldsw = (unsigned)wid * 1024u;
    const int aoff = lds_byte(wr * 64 + fr, fq * 8), boff = lds_byte(wc * 32 + fr, fq * 8);
#define PG8_SA(b, h) (((b) * 2 + (h)) * HTB)
#define PG8_SB(b, h) ((4 + (b) * 2 + (h)) * HTB)
#define PG8_STAGE(bufoff, gbase, voff) do { _Pragma("unroll") for (int _i = 0; _i < 2; ++_i) \
        __builtin_amdgcn_global_load_lds((const unsigned*)((const char*)(gbase) + (voff)[_i]), (PG8_LAS unsigned*)(lds + (bufoff) + ldsw + _i * 8192), 16, 0, 0); } while (0)
#define PG8_LDA(dst, b, h) do { _Pragma("unroll") for (int m = 0; m < 4; ++m) _Pragma("unroll") for (int k = 0; k < 2; ++k) dst[m][k] = *(const PG8_LAS bf16x8*)(lds + PG8_SA(b, h) + aoff + m * 2048 + k * 1024); } while (0)
#define PG8_LDB(dst, b, h) do { _Pragma("unroll") for (int n = 0; n < 2; ++n) _Pragma("unroll") for (int k = 0; k < 2; ++k) dst[n][k] = *(const PG8_LAS bf16x8*)(lds + PG8_SB(b, h) + boff + n * 2048 + k * 1024); } while (0)
#define PG8_MMA(ai, bj, At, Bt) do { __builtin_amdgcn_s_setprio(1); _Pragma("unroll") for (int m = 0; m < 4; ++m) _Pragma("unroll") for (int n = 0; n < 2; ++n) _Pragma("unroll") for (int k = 0; k < 2; ++k) \
        acc[ai][bj][m][n] = __builtin_amdgcn_mfma_f32_16x16x32_bf16(Bt[n][k], At[m][k], acc[ai][bj][m][n], 0, 0, 0); __builtin_amdgcn_s_setprio(0); } while (0)
#define PG8_WAIT_V(n) asm volatile("s_waitcnt vmcnt(" #n ")" ::: "memory")
#define PG8_WAIT_L(n) asm volatile("s_waitcnt lgkmcnt(" #n ")" ::: "memory")
#define PG8_BAR __builtin_amdgcn_s_barrier()
#define PG8_SCHED __builtin_amdgcn_sched_barrier(0)
    Unit cur, nxt; int ui = 0;
    if (!S.next(0, cur)) return;
    f32x4 acc[2][2][4][2];
#pragma unroll
    for (int a = 0; a < 2; ++a)
#pragma unroll
        for (int b = 0; b < 2; ++b)
#pragma unroll
            for (int m = 0; m < 4; ++m)
#pragma unroll
                for (int n = 0; n < 2; ++n) acc[a][b][m][n] = (f32x4){0.f, 0.f, 0.f, 0.f};
    bf16x8 At[4][2], B0[2][2], B1[2][2];
    const char* cA; const char* cB; S.ptrs(cur, cA, cB);
    if constexpr (SP2) {
        PG8_STAGE(PG8_SB(0, 0), cB, voffB); PG8_STAGE(PG8_SB(0, 1), cB + hstep, voffB); PG8_STAGE(PG8_SA(0, 0), cA, voffA); PG8_STAGE(PG8_SA(0, 1), cA + hstep, voffA);
        if (wr == 1) PG8_BAR;
        PG8_WAIT_V(2); PG8_BAR;
        PG8_STAGE(PG8_SB(1, 0), cB + kstep, voffB); PG8_STAGE(PG8_SA(1, 0), cA + kstep, voffA); PG8_STAGE(PG8_SB(1, 1), cB + hstep + kstep, voffB);
        PG8_WAIT_V(6); PG8_BAR;
    } else {
        PG8_STAGE(PG8_SB(0, 0), cB, voffB); PG8_STAGE(PG8_SA(0, 0), cA, voffA); PG8_STAGE(PG8_SB(0, 1), cB + hstep, voffB); PG8_STAGE(PG8_SA(0, 1), cA + hstep, voffA);
        if (wr == 1) PG8_BAR;
        PG8_WAIT_V(4); PG8_BAR;
        PG8_STAGE(PG8_SB(1, 0), cB + kstep, voffB); PG8_STAGE(PG8_SA(1, 0), cA + kstep, voffA); PG8_STAGE(PG8_SB(1, 1), cB + hstep + kstep, voffB);
        PG8_WAIT_V(6); PG8_BAR;
    }
    for (;;) {
        const bool has_next = S.next(ui + 1, nxt);
        const char* nA = cA; const char* nB = cB; if (has_next) S.ptrs(nxt, nA, nB);
        for (int t = 0; t < nt; t += 2) {
            const bool last = (t == nt - 2);
            const char* a1 = cA + (size_t)(t + 1) * kstep;
            const char* a2 = last ? nA : cA + (size_t)(t + 2) * kstep; const char* b2 = last ? nB : cB + (size_t)(t + 2) * kstep;
            const char* a3 = a2 + kstep; const char* b3 = b2 + kstep;
            if constexpr (SP2) {
            PG8_LDB(B0, 0, 0); PG8_LDB(B1, 0, 1); PG8_SCHED; PG8_LDA(At, 0, 0); PG8_STAGE(PG8_SA(1, 1), a1 + hstep, voffA);
            PG8_WAIT_V(8); PG8_WAIT_L(0); PG8_BAR; PG8_MMA(0, 0, At, B0); PG8_MMA(0, 1, At, B1); PG8_BAR; PG8_SCHED;
            PG8_LDA(At, 0, 1); PG8_STAGE(PG8_SB(0, 0), b2, voffB); PG8_STAGE(PG8_SB(0, 1), b2 + hstep, voffB); PG8_STAGE(PG8_SA(0, 0), a2, voffA);
            PG8_WAIT_V(8); PG8_WAIT_L(0); PG8_BAR; PG8_MMA(1, 0, At, B0); PG8_MMA(1, 1, At, B1); PG8_BAR; PG8_SCHED;
            PG8_LDB(B0, 1, 0); PG8_LDB(B1, 1, 1); PG8_SCHED; PG8_LDA(At, 1, 0); PG8_STAGE(PG8_SA(0, 1), a2 + hstep, voffA);
            PG8_WAIT_V(8); PG8_WAIT_L(0); PG8_BAR; PG8_MMA(0, 0, At, B0); PG8_MMA(0, 1, At, B1); PG8_BAR; PG8_SCHED;
            PG8_LDA(At, 1, 1); PG8_STAGE(PG8_SB(1, 0), b3, voffB); PG8_STAGE(PG8_SB(1, 1), b3 + hstep, voffB); PG8_STAGE(PG8_SA(1, 0), a3, voffA);
            PG8_WAIT_V(8); PG8_WAIT_L(0); PG8_BAR; PG8_MMA(1, 0, At, B0); PG8_MMA(1, 1, At, B1); PG8_BAR; PG8_SCHED;
            } else {
            PG8_LDB(B0, 0, 0); PG8_SCHED; PG8_LDA(At, 0, 0); PG8_STAGE(PG8_SA(1, 1), a1 + hstep, voffA);
            PG8_WAIT_L(8); PG8_BAR; PG8_WAIT_L(0); PG8_MMA(0, 0, At, B0); PG8_BAR; PG8_SCHED;
            PG8_LDB(B1, 0, 1); PG8_STAGE(PG8_SB(0, 0), b2, voffB);
            PG8_BAR; PG8_WAIT_L(0); PG8_MMA(0, 1, At, B1); PG8_BAR;
            PG8_LDA(At, 0, 1); PG8_STAGE(PG8_SA(0, 0), a2, voffA);
            PG8_BAR; PG8_WAIT_L(0); PG8_MMA(1, 0, At, B0); PG8_BAR; PG8_SCHED;
            PG8_STAGE(PG8_SB(0, 1), b2 + hstep, voffB);
            PG8_WAIT_V(6); PG8_BAR; PG8_MMA(1, 1, At, B1); PG8_BAR;
            PG8_LDB(B0, 1, 0); PG8_SCHED; PG8_LDA(At, 1, 0); PG8_STAGE(PG8_SA(0, 1), a2 + hstep, voffA);
            PG8_WAIT_L(8); PG8_BAR; PG8_WAIT_L(0); PG8_MMA(0, 0, At, B0); PG8_BAR; PG8_SCHED;
            PG8_LDB(B1, 1, 1); PG8_STAGE(PG8_SB(1, 0), b3, voffB);
            PG8_BAR; PG8_WAIT_L(0); PG8_MMA(0, 1, At, B1); PG8_BAR;
            PG8_LDA(At, 1, 1); PG8_STAGE(PG8_SA(1, 0), a3, voffA);
            PG8_BAR; PG8_WAIT_L(0); PG8_MMA(1, 0, At, B0); PG8_BAR; PG8_SCHED;
            PG8_STAGE(PG8_SB(1, 1), b3 + hstep, voffB);
            PG8_WAIT_V(6); PG8_BAR; PG8_MMA(1, 1, At, B1); PG8_BAR;
            }
        }
        if constexpr (ALIGN_EPI) { if (wr == 0) PG8_BAR; }
        E(acc, cur, wr, wc, fr, fq);
        if (!has_next) break;
        if (!E.keep(cur)) {
#pragma unroll
            for (int a = 0; a < 2; ++a)
#pragma unroll
                for (int b = 0; b < 2; ++b)
#pragma unroll
                    for (int m = 0; m < 4; ++m)
#pragma unroll
                        for (int n = 0; n < 2; ++n) acc[a][b][m][n] = (f32x4){0.f, 0.f, 0.f, 0.f};
        }
        cur = nxt; cA = nA; cB = nB; ++ui;
        if constexpr (ALIGN_EPI) { if (wr == 1) PG8_BAR; }
    }
    PG8_WAIT_V(0);
    if constexpr (!ALIGN_EPI) { if (wr == 0) PG8_BAR; }
    PG8_BAR;
#undef PG8_SA
#undef PG8_SB
#undef PG8_STAGE
#undef PG8_LDA
#undef PG8_LDB
#undef PG8_MMA
#undef PG8_WAIT_V
#undef PG8_WAIT_L
#undef PG8_BAR
#undef PG8_SCHED
}

typedef int i32x4 __attribute__((ext_vector_type(4)));
typedef int i32x8 __attribute__((ext_vector_type(8)));
template <class Epi, class Sched>
__device__ __forceinline__ void gemm_phase_f8(PG8_LAS unsigned char* lds, const int K, const Sched& S, const Epi& E) {
    const int tid = opaque_tid(), wid = __builtin_amdgcn_readfirstlane(tid >> 6), lane = tid & 63, wr = wid >> 2, wc = wid & 3, fr = lane & 15, fq = lane >> 4;
    const int nt = K / 128;
    unsigned voffA[2], voffB[2];
#pragma unroll
    for (int i = 0; i < 2; ++i) { int R, C; stage_rc(tid * 16 + i * 8192, R, C); const int Rb = Epi::PERM ? ((R & ~31) + perm32(R & 31)) : R;
        voffA[i] = (unsigned)(R * K + 2 * C); voffB[i] = (unsigned)(Rb * K + 2 * C); }
    const size_t kstep = 128;
    const size_t hstep = (size_t)HALF * K;
    const unsigned ldsw = (unsigned)wid * 1024u;
    const int aoff = lds_byte(wr * 64 + fr, fq * 16), boff = lds_byte(wc * 32 + fr, fq * 16);
#define PG8_SA(b, h) (((b) * 2 + (h)) * HTB)
#define PG8_SB(b, h) ((4 + (b) * 2 + (h)) * HTB)
#define PG8_STAGE(bufoff, gbase, voff) do { _Pragma("unroll") for (int _i = 0; _i < 2; ++_i) \
        __builtin_amdgcn_global_load_lds((const unsigned*)((const char*)(gbase) + (voff)[_i]), (PG8_LAS unsigned*)(lds + (bufoff) + ldsw + _i * 8192), 16, 0, 0); } while (0)
#define PG8_LD8(dst, off) do { const i32x4 _lo = *(const PG8_LAS i32x4*)(lds + (off)), _hi = *(const PG8_LAS i32x4*)(lds + (off) + 16); dst = __builtin_shufflevector(_lo, _hi, 0, 1, 2, 3, 4, 5, 6, 7); } while (0)
#define PG8_LDA(dst, b, h) do { _Pragma("unroll") for (int m = 0; m < 4; ++m) PG8_LD8(dst[m], PG8_SA(b, h) + aoff + m * 2048); } while (0)
#define PG8_LDB(dst, b, h) do { _Pragma("unroll") for (int n = 0; n < 2; ++n) PG8_LD8(dst[n], PG8_SB(b, h) + boff + n * 2048); } while (0)
#define PG8_MMA(ai, bj, At, Bt) do { __builtin_amdgcn_s_setprio(1); _Pragma("unroll") for (int m = 0; m < 4; ++m) _Pragma("unroll") for (int n = 0; n < 2; ++n) \
        asm volatile("v_mfma_scale_f32_16x16x128_f8f6f4 %0, %1, %2, %0, %3, %3 op_sel_hi:[0,0,0]" : "+v"(acc[ai][bj][m][n]) : "v"(Bt[n]), "v"(At[m]), "v"(f8_unit_scale)); __builtin_amdgcn_s_setprio(0); } while (0)
#define PG8_WAIT_V(n) asm volatile("s_waitcnt vmcnt(" #n ")" ::: "memory")
#define PG8_WAIT_L(n) asm volatile("s_waitcnt lgkmcnt(" #n ")" ::: "memory")
#define PG8_BAR __builtin_amdgcn_s_barrier()
#define PG8_SCHED __builtin_amdgcn_sched_barrier(0)
    Unit cur, nxt; int ui = 0;
    if (!S.next(0, cur)) return;
    f32x4 acc[2][2][4][2];
#pragma unroll
    for (int a = 0; a < 2; ++a)
#pragma unroll
        for (int b = 0; b < 2; ++b)
#pragma unroll
            for (int m = 0; m < 4; ++m)
#pragma unroll
                for (int n = 0; n < 2; ++n) acc[a][b][m][n] = (f32x4){0.f, 0.f, 0.f, 0.f};
    i32x8 At[4], B0[2], B1[2];
    const int f8_unit_scale = 0x7f7f7f7f;
    const char* cA; const char* cB; S.ptrs(cur, cA, cB);
    PG8_STAGE(PG8_SB(0, 0), cB, voffB); PG8_STAGE(PG8_SB(0, 1), cB + hstep, voffB); PG8_STAGE(PG8_SA(0, 0), cA, voffA); PG8_STAGE(PG8_SA(0, 1), cA + hstep, voffA);
    if (wr == 1) PG8_BAR;
    PG8_WAIT_V(2); PG8_BAR;
    PG8_STAGE(PG8_SB(1, 0), cB + kstep, voffB); PG8_STAGE(PG8_SA(1, 0), cA + kstep, voffA); PG8_STAGE(PG8_SB(1, 1), cB + hstep + kstep, voffB);
    PG8_WAIT_V(6); PG8_BAR;
    for (;;) {
        const bool has_next = S.next(ui + 1, nxt);
        const char* nA = cA; const char* nB = cB; if (has_next) S.ptrs(nxt, nA, nB);
        for (int t = 0; t < nt; t += 2) {
            const bool last = (t == nt - 2);
            const char* a1 = cA + (size_t)(t + 1) * kstep;
            const char* a2 = last ? nA : cA + (size_t)(t + 2) * kstep; const char* b2 = last ? nB : cB + (size_t)(t + 2) * kstep;
            const char* a3 = a2 + kstep; const char* b3 = b2 + kstep;
            PG8_LDB(B0, 0, 0); PG8_LDB(B1, 0, 1); PG8_SCHED; PG8_LDA(At, 0, 0); PG8_STAGE(PG8_SA(1, 1), a1 + hstep, voffA);
            PG8_WAIT_V(8); PG8_WAIT_L(0); PG8_BAR; PG8_MMA(0, 0, At, B0); PG8_MMA(0, 1, At, B1); PG8_BAR; PG8_SCHED;
            PG8_LDA(At, 0, 1); PG8_STAGE(PG8_SB(0, 0), b2, voffB); PG8_STAGE(PG8_SB(0, 1), b2 + hstep, voffB); PG8_STAGE(PG8_SA(0, 0), a2, voffA);
            PG8_WAIT_V(8); PG8_WAIT_L(0); PG8_BAR; PG8_MMA(1, 0, At, B0); PG8_MMA(1, 1, At, B1); PG8_BAR; PG8_SCHED;
            PG8_LDB(B0, 1, 0); PG8_LDB(B1, 1, 1); PG8_SCHED; PG8_LDA(At, 1, 0); PG8_STAGE(PG8_SA(0, 1), a2 + hstep, voffA);
            PG8_WAIT_V(8); PG8_WAIT_L(0); PG8_BAR; PG8_MMA(0, 0, At, B0); PG8_MMA(0, 1, At, B1); PG8_BAR; PG8_SCHED;
            PG8_LDA(At, 1, 1); PG8_STAGE(PG8_SB(1, 0), b3, voffB); PG8_STAGE(PG8_SB(1, 1), b3 + hstep, voffB); PG8_STAGE(PG8_SA(1, 0), a3, voffA);
            PG8_WAIT_V(8); PG8_WAIT_L(0); PG8_BAR; PG8_MMA(1, 0, At, B0); PG8_MMA(1, 1, At, B1); PG8_BAR; PG8_SCHED;
        }
        if (wr == 0) PG8_BAR;
        { const int t2 = opaque_tid(), w2 = __builtin_amdgcn_readfirstlane(t2 >> 6); E(acc, cur, w2 >> 2, w2 & 3, t2 & 15, (t2 & 63) >> 4); }
        if (!has_next) break;
#pragma unroll
        for (int a = 0; a < 2; ++a)
#pragma unroll
            for (int b = 0; b < 2; ++b)
#pragma unroll
                for (int m = 0; m < 4; ++m)
#pragma unroll
                    for (int n = 0; n < 2; ++n) acc[a][b][m][n] = (f32x4){0.f, 0.f, 0.f, 0.f};
        cur = nxt; cA = nA; cB = nB; ++ui;
        if (wr == 1) PG8_BAR;
    }
    PG8_WAIT_V(0);
    PG8_BAR;
#undef PG8_SA
#undef PG8_SB
#undef PG8_STAGE
#undef PG8_LD8
#undef PG8_LDA
#undef PG8_LDB
#undef PG8_MMA
#undef PG8_WAIT_V
#undef PG8_WAIT_L
#undef PG8_BAR
#undef PG8_SCHED
}

template <class Epi, class Sched>
__device__ __forceinline__ void gemm_phase_mix(PG8_LAS unsigned char* lds, const int P, const int nt8, const int nt16, const Sched& S, const Epi& E) {
    const int tid = opaque_tid(), wid = __builtin_amdgcn_readfirstlane(tid >> 6), lane = tid & 63, wr = wid >> 2, wc = wid & 3, fr = lane & 15, fq = lane >> 4;
    unsigned voffA[2], voffB[2];
#pragma unroll
    for (int i = 0; i < 2; ++i) { int R, C; stage_rc(tid * 16 + i * 8192, R, C); const int Rb = Epi::PERM ? ((R & ~31) + perm32(R & 31)) : R;
        voffA[i] = (unsigned)(R * P + 2 * C); voffB[i] = (unsigned)(Rb * P + 2 * C); }
    const size_t kstep = 128;
    const size_t hstep = (size_t)HALF * P;
    const unsigned ldsw = (unsigned)wid * 1024u;
#define PG8_SA(b, h) (((b) * 2 + (h)) * HTB)
#define PG8_SB(b, h) ((4 + (b) * 2 + (h)) * HTB)
#define PG8_STAGE(bufoff, gbase, voff) do { _Pragma("unroll") for (int _i = 0; _i < 2; ++_i) \
        __builtin_amdgcn_global_load_lds((const unsigned*)((const char*)(gbase) + (voff)[_i]), (PG8_LAS unsigned*)(lds + (bufoff) + ldsw + _i * 8192), 16, 0, 0); } while (0)
#define PG8_LD8(dst, off) do { const i32x4 _lo = *(const PG8_LAS i32x4*)(lds + (off)), _hi = *(const PG8_LAS i32x4*)(lds + (off) + 16); dst = __builtin_shufflevector(_lo, _hi, 0, 1, 2, 3, 4, 5, 6, 7); } while (0)
#define PG8_LDA8(dst, b, h) do { _Pragma("unroll") for (int m = 0; m < 4; ++m) PG8_LD8(dst[m], PG8_SA(b, h) + aoff8 + m * 2048); } while (0)
#define PG8_LDB8(dst, b, h) do { _Pragma("unroll") for (int n = 0; n < 2; ++n) PG8_LD8(dst[n], (PG8_SB(b, h) - 65536) + boff8 + n * 2048); } while (0)
#define PG8_MMA8(ai, bj, At, Bt) do { __builtin_amdgcn_s_setprio(1); _Pragma("unroll") for (int m = 0; m < 4; ++m) _Pragma("unroll") for (int n = 0; n < 2; ++n) \
        asm volatile("v_mfma_scale_f32_16x16x128_f8f6f4 %0, %1, %2, %0, %3, %3 op_sel_hi:[0,0,0]" : "+v"(acc[ai][bj][m][n]) : "v"(Bt[n]), "v"(At[m]), "v"(f8_unit_scale)); __builtin_amdgcn_s_setprio(0); } while (0)
#define PG8_LDA16(dst, b, h) do { _Pragma("unroll") for (int m = 0; m < 4; ++m) _Pragma("unroll") for (int k = 0; k < 2; ++k) dst[m][k] = *(const PG8_LAS bf16x8*)(lds + PG8_SA(b, h) + aoff16 + m * 2048 + k * 1024); } while (0)
#define PG8_LDB16(dst, b, h) do { _Pragma("unroll") for (int n = 0; n < 2; ++n) _Pragma("unroll") for (int k = 0; k < 2; ++k) dst[n][k] = *(const PG8_LAS bf16x8*)(lds + (PG8_SB(b, h) - 65536) + boff16 + n * 2048 + k * 1024); } while (0)
#define PG8_MMA16(ai, bj, At, Bt) do { __builtin_amdgcn_s_setprio(1); _Pragma("unroll") for (int k = 0; k < 2; ++k) _Pragma("unroll") for (int m = 0; m < 4; ++m) _Pragma("unroll") for (int n = 0; n < 2; ++n) \
        asm volatile("v_mfma_f32_16x16x32_bf16 %0, %1, %2, %0" : "+v"(acc[ai][bj][m][n]) : "v"(Bt[n][k]), "v"(At[m][k])); __builtin_amdgcn_s_setprio(0); } while (0)
#define PG8_WAIT_V(n) asm volatile("s_waitcnt vmcnt(" #n ")" ::: "memory")
#define PG8_WAIT_L(n) asm volatile("s_waitcnt lgkmcnt(" #n ")" ::: "memory")
#define PG8_BAR __builtin_amdgcn_s_barrier()
#define PG8_SCHED __builtin_amdgcn_sched_barrier(0)
#define PG8_KPAIR(LDA_, LDB_, MMA_, At_, B0_, B1_) do { \
            LDB_(B0_, 0, 0); LDB_(B1_, 0, 1); PG8_SCHED; LDA_(At_, 0, 0); PG8_STAGE(PG8_SA(1, 1), a1 + hstep, voffA); \
            PG8_WAIT_V(8); PG8_WAIT_L(0); PG8_BAR; MMA_(0, 0, At_, B0_); MMA_(0, 1, At_, B1_); PG8_BAR; PG8_SCHED; \
            LDA_(At_, 0, 1); PG8_STAGE(PG8_SB(0, 0), b2, voffB); PG8_STAGE(PG8_SB(0, 1), b2 + hstep, voffB); PG8_STAGE(PG8_SA(0, 0), a2, voffA); \
            PG8_WAIT_V(8); PG8_WAIT_L(0); PG8_BAR; MMA_(1, 0, At_, B0_); MMA_(1, 1, At_, B1_); PG8_BAR; PG8_SCHED; \
            LDB_(B0_, 1, 0); LDB_(B1_, 1, 1); PG8_SCHED; LDA_(At_, 1, 0); PG8_STAGE(PG8_SA(0, 1), a2 + hstep, voffA); \
            PG8_WAIT_V(8); PG8_WAIT_L(0); PG8_BAR; MMA_(0, 0, At_, B0_); MMA_(0, 1, At_, B1_); PG8_BAR; PG8_SCHED; \
            LDA_(At_, 1, 1); PG8_STAGE(PG8_SB(1, 0), b3, voffB); PG8_STAGE(PG8_SB(1, 1), b3 + hstep, voffB); PG8_STAGE(PG8_SA(1, 0), a3, voffA); \
            PG8_WAIT_V(8); PG8_WAIT_L(0); PG8_BAR; MMA_(1, 0, At_, B0_); MMA_(1, 1, At_, B1_); PG8_BAR; PG8_SCHED; } while (0)
    Unit cur, nxt; int ui = 0;
    if (!S.o.tile(0, cur)) return;
    f32x4 acc[2][2][4][2];
#pragma unroll
    for (int a = 0; a < 2; ++a)
#pragma unroll
        for (int b = 0; b < 2; ++b)
#pragma unroll
            for (int m = 0; m < 4; ++m)
#pragma unroll
                for (int n = 0; n < 2; ++n) acc[a][b][m][n] = (f32x4){0.f, 0.f, 0.f, 0.f};
    const int f8_unit_scale = 0x7f7f7f7f;
    const char* c8A = S.A0 + (size_t)cur.pm * S.tstep; const char* c8B = S.B0 + (size_t)cur.pn * S.tstep;
    PG8_STAGE(PG8_SB(0, 0), c8B, voffB); PG8_STAGE(PG8_SB(0, 1), c8B + hstep, voffB); PG8_STAGE(PG8_SA(0, 0), c8A, voffA); PG8_STAGE(PG8_SA(0, 1), c8A + hstep, voffA);
    if (wr == 1) PG8_BAR;
    PG8_WAIT_V(2); PG8_BAR;
    PG8_STAGE(PG8_SB(1, 0), c8B + kstep, voffB); PG8_STAGE(PG8_SA(1, 0), c8A + kstep, voffA); PG8_STAGE(PG8_SB(1, 1), c8B + hstep + kstep, voffB);
    PG8_WAIT_V(6); PG8_BAR;
    for (;;) {
        const bool has_next = S.o.tile(ui + 1, nxt);
        const char* c16A = S.A1 + (size_t)cur.pm * S.tstep; const char* c16B = S.B1 + (size_t)cur.pn * S.tstep;
        {   i32x8 At[4], B0[2], B1[2];
            const int t8 = opaque_tid(); int aoff8 = lds_byte(((t8 >> 8) & 1) * 64 + (t8 & 15), ((t8 & 63) >> 4) * 16), boff8 = lds_byte(((t8 >> 6) & 3) * 32 + (t8 & 15), ((t8 & 63) >> 4) * 16) + 65536;
            asm volatile("" : "+v"(aoff8), "+v"(boff8));
            for (int t = 0; t < nt8; t += 2) { const bool last = (t == nt8 - 2);
                const char* a1 = c8A + (size_t)(t + 1) * kstep;
                const char* a2 = last ? c16A : c8A + (size_t)(t + 2) * kstep; const char* b2 = last ? c16B : c8B + (size_t)(t + 2) * kstep;
                const char* a3 = a2 + kstep; const char* b3 = b2 + kstep;
                PG8_KPAIR(PG8_LDA8, PG8_LDB8, PG8_MMA8, At, B0, B1); } }
        if (wr == 0) PG8_BAR;
        { const int t2 = opaque_tid(), w2 = __builtin_amdgcn_readfirstlane(t2 >> 6); cur.sub = 0; E(acc, cur, w2 >> 2, w2 & 3, t2 & 15, (t2 & 63) >> 4); }
        if (wr == 1) PG8_BAR;
        const char* n8A = c8A; const char* n8B = c8B; if (has_next) { n8A = S.A0 + (size_t)nxt.pm * S.tstep; n8B = S.B0 + (size_t)nxt.pn * S.tstep; }
        {   bf16x8 At[4][2], B0[2][2], B1[2][2];
            const int t6 = opaque_tid(); int aoff16 = lds_byte(((t6 >> 8) & 1) * 64 + (t6 & 15), ((t6 & 63) >> 4) * 8), boff16 = lds_byte(((t6 >> 6) & 3) * 32 + (t6 & 15), ((t6 & 63) >> 4) * 8) + 65536;
            asm volatile("" : "+v"(aoff16), "+v"(boff16));
            for (int t = 0; t < nt16; t += 2) { const bool last = (t == nt16 - 2);
                const char* a1 = c16A + (size_t)(t + 1) * kstep;
                const char* a2 = last ? n8A : c16A + (size_t)(t + 2) * kstep; const char* b2 = last ? n8B : c16B + (size_t)(t + 2) * kstep;
                const char* a3 = a2 + kstep; const char* b3 = b2 + kstep;
                PG8_KPAIR(PG8_LDA16, PG8_LDB16, PG8_MMA16, At, B0, B1); } }
        if (wr == 0) PG8_BAR;
        { const int t2 = opaque_tid(), w2 = __builtin_amdgcn_readfirstlane(t2 >> 6); cur.sub = 1; E(acc, cur, w2 >> 2, w2 & 3, t2 & 15, (t2 & 63) >> 4); }
        if (!has_next) break;
#pragma unroll
        for (int a = 0; a < 2; ++a)
#pragma unroll
            for (int b = 0; b < 2; ++b)
#pragma unroll
                for (int m = 0; m < 4; ++m)
#pragma unroll
                    for (int n = 0; n < 2; ++n) acc[a][b][m][n] = (f32x4){0.f, 0.f, 0.f, 0.f};
        cur = nxt; c8A = n8A; c8B = n8B; ++ui;
        if (wr == 1) PG8_BAR;
    }
    PG8_WAIT_V(0);
    PG8_BAR;
#undef PG8_SA
#undef PG8_SB
#undef PG8_STAGE
#undef PG8_LD8
#undef PG8_LDA8
#undef PG8_LDB8
#undef PG8_MMA8
#undef PG8_LDA16
#undef PG8_LDB16
#undef PG8_MMA16
#undef PG8_KPAIR
#undef PG8_WAIT_V
#undef PG8_WAIT_L
#undef PG8_BAR
#undef PG8_SCHED
}
}

constexpr int NWAVES = 8;
constexpr int N_LAUNCHES = MK_N_LAUNCHES;
constexpr int PER_PHASE = 8;
constexpr int M = 16384, D = 4096, NIN = 18432, GMW = 2048, NAW = 2048, DFF = 11008, NGU = 2 * DFF;
constexpr float F8_ASCALE = 16.f, F8_WSCALE = 1024.f, F8_UNSCALE = 1.f / (16.f * 1024.f), F8_YSCALE = 64.f, F8_YUNSCALE = 1.f / (64.f * 1024.f);
constexpr int GRID_W = 64, GRID_H = M / GRID_W, NHEAD = 16, HD = 128, CHUNK = 128, NGROUP = 16;
constexpr float RMS_EPS = 1e-6f, LN_EPS = 1e-5f;
constexpr int F8P = 4096;

constexpr size_t MiB = 1u << 20;
constexpr size_t WS_CTL = 0, CTL_ZERO_BYTES = 1 * MiB;
constexpr size_t WS_WSB = 1 * MiB;
constexpr size_t WS_WIN = 4 * MiB;
constexpr size_t WS_WOA = 148 * MiB, WS_WOB = 164 * MiB;
constexpr size_t WS_WOUT = 180 * MiB;
constexpr size_t WS_RA = 212 * MiB;
constexpr size_t WS_YA = WS_RA, WS_YB = WS_RA + 64 * MiB;
constexpr size_t WS_RB = 340 * MiB;
constexpr size_t WS_U = WS_RB, WS_V = WS_RB + 64 * MiB, WS_Q = WS_RB + 128 * MiB, WS_K = WS_RB + 192 * MiB, WS_VV = WS_RB + 256 * MiB, WS_GA = WS_RB + 320 * MiB, WS_GB = WS_RB + 448 * MiB;
constexpr size_t WS_TB = WS_Q;
constexpr size_t WS_MRG = WS_RB;
constexpr size_t WS_ACT = WS_RB;
constexpr size_t WS_H16 = WS_WIN;
constexpr size_t WS_WQKV8 = WS_WIN + 32 * MiB;
constexpr size_t WS_XN8 = 916 * MiB;
constexpr size_t WS_WGU = 916 * MiB;
constexpr size_t WS_WD = 1088 * MiB;
constexpr size_t WS_PART = 1174 * MiB;
constexpr size_t WS_END = 1178 * MiB;
static_assert(WS_GB + (size_t)M * D * 2 == WS_WGU && WS_WGU + (size_t)NGU * D * 2 == WS_WD && WS_WD + (size_t)D * DFF * 2 == WS_PART && WS_PART + (size_t)M * 64 * 4 == WS_END && WS_ACT + (size_t)M * DFF * 2 <= WS_WGU, "d_ws map");
constexpr int CW_BAR = 4096;
constexpr int RING_BYTES = 131072;
constexpr int LDSCTL_OFF = RING_BYTES, MISC_OFF = LDSCTL_OFF + 320;
constexpr int LDS_BYTES = 147456;

#define GAS __attribute__((address_space(1)))
#define LAS __attribute__((address_space(3)))
typedef unsigned short bf16;
typedef unsigned v4u __attribute__((ext_vector_type(4)));
typedef unsigned v2u __attribute__((ext_vector_type(2)));
typedef float f32x4 __attribute__((ext_vector_type(4)));
typedef float f32x2 __attribute__((ext_vector_type(2)));
typedef short bf16x8 __attribute__((ext_vector_type(8)));
typedef GAS unsigned gu32;
#define RLX_AGENT __ATOMIC_RELAXED, __HIP_MEMORY_SCOPE_AGENT
#define LDS_WAIT() asm volatile("s_waitcnt lgkmcnt(0)" ::: "memory")
#define VM_WAIT() asm volatile("s_waitcnt vmcnt(0)" ::: "memory")
__device__ __forceinline__ unsigned f2bf(float f) { unsigned u = __builtin_bit_cast(unsigned, f); return (u + 0x7fffu + ((u >> 16) & 1u)) >> 16; }
__device__ __forceinline__ unsigned pk2(float lo, float hi) { return pg8::cvt_pk_bf16(lo, hi); }
__device__ __forceinline__ float bflo(unsigned w) { return __uint_as_float(w << 16); }
__device__ __forceinline__ float bfhi(unsigned w) { return __uint_as_float(w & 0xffff0000u); }

#define XB_TMO      128
#define XB_XCNT(j)  (256  + 64 * (j))
#define XB_XSUB(j)  (1280 + 64 * (j))
#define XB_XGEN(j)  (2304 + 64 * (j))
#define XB_TOP      3328
#define XB_TOPGEN   3392
#define XCD_BAR_WORDS 3456
#define XB_SPIN_CAP (1u << 20)

__device__ __forceinline__ unsigned xb_ld(unsigned* p)              { return __hip_atomic_load(p, __ATOMIC_RELAXED, __HIP_MEMORY_SCOPE_AGENT); }
__device__ __forceinline__ unsigned xb_add(unsigned* p, unsigned v) { return __hip_atomic_fetch_add(p, v, __ATOMIC_RELAXED, __HIP_MEMORY_SCOPE_AGENT); }
__device__ __forceinline__ unsigned xb_xcc_id() { return (unsigned)__builtin_amdgcn_s_getreg((3 << 11) | 20) & 0xFu; }
#define XB_SPIN(cond, bar) do { unsigned _sp = 0; while (cond) { __builtin_amdgcn_s_sleep(1); \
    if ((++_sp & 255u) == 0u) { if (xb_ld(&(bar)[XB_TMO])) break; if (_sp > XB_SPIN_CAP) { atomicAdd(&(bar)[XB_TMO], 1u); break; } } } } while (0)

struct XcdBarrier {
    unsigned* bar; unsigned x;
    volatile LAS unsigned* st;
};
__device__ __forceinline__ XcdBarrier xcd_barrier_post(unsigned* bar, volatile LAS unsigned* st) {
    XcdBarrier b; b.bar = bar; b.x = xb_xcc_id(); b.st = st;
    if (threadIdx.x == 0) (void)xb_add(&bar[XB_XCNT(b.x)], 1u);
    return b;
}
__device__ __forceinline__ void xcd_barrier_complete(unsigned* bar, unsigned x, unsigned& nloc, unsigned& nx) {
    const unsigned G = gridDim.x * gridDim.y * gridDim.z;
    unsigned sum, cnt, mine, sp = 0u;
    for (;;) {
        sum = 0u; cnt = 0u; mine = 0u;
#pragma unroll
        for (unsigned j = 0; j < 16; ++j) { const unsigned c = xb_ld(&bar[XB_XCNT(j)]); sum += c; cnt += (c > 0u) ? 1u : 0u; mine = (j == x) ? c : mine; }
        if (sum == G) break;
        __builtin_amdgcn_s_sleep(1);
        if ((++sp & 255u) == 0u) { if (xb_ld(&bar[XB_TMO])) break; if (sp > XB_SPIN_CAP) { atomicAdd(&bar[XB_TMO], 1u); break; } }
    }
    nloc = mine > 0u ? mine : 1u; nx = cnt > 0u ? cnt : 1u;
}
__device__ __forceinline__ void xcd_barrier(const XcdBarrier& b) {
    asm volatile("s_waitcnt vmcnt(0)" ::: "memory");
    __syncthreads();
    if (threadIdx.x == 0) {
        unsigned* bar = b.bar;
        __builtin_amdgcn_s_waitcnt(0);
        unsigned nloc = b.st[0], nx = b.st[1];
        if (nloc == 0u) { xcd_barrier_complete(bar, b.x, nloc, nx); b.st[0] = nloc; b.st[1] = nx; }
        const unsigned old = xb_add(&bar[XB_XSUB(b.x)], 1u);
        const unsigned gen = old / nloc;
        if (old + 1u == (gen + 1u) * nloc) {
            __builtin_amdgcn_fence(__ATOMIC_RELEASE, "agent");
            asm volatile("s_waitcnt vmcnt(0)" ::: "memory");
            const unsigned og = xb_add(&bar[XB_TOP], 1u);
            const unsigned tg = og / nx;
            if (og + 1u == (tg + 1u) * nx) xb_add(&bar[XB_TOPGEN], 1u);
            else XB_SPIN(xb_ld(&bar[XB_TOPGEN]) == tg, bar);
            __builtin_amdgcn_fence(__ATOMIC_ACQUIRE, "agent");
            xb_add(&bar[XB_XGEN(b.x)], 1u);
            asm volatile("s_waitcnt vmcnt(0)" ::: "memory");
        } else {
            XB_SPIN(xb_ld(&bar[XB_XGEN(b.x)]) == gen, bar);
            __builtin_amdgcn_fence(__ATOMIC_ACQUIRE, "agent");
            asm volatile("s_waitcnt vmcnt(0)" ::: "memory");
        }
    }
    __syncthreads();
}

struct Frame {
    LAS unsigned char* lds;
    volatile LAS unsigned* MISC;
    gu32* ctl;
    int tid, lane, wave;
    int vcu, G;
    unsigned char* ws;
    const float *x, *norm1_g, *w_in, *gm_ln_g, *gm_ln_b, *gm_w_s, *gm_b_s, *q_gain, *k_gain, *na_rpb, *w_o_gm, *w_o_na, *w_out, *norm2_g, *w_ff_gate, *w_ff_up, *w_ff_down;
    float* out;
};
template <int O> __device__ __forceinline__ float xor_lane(float v) {
    if constexpr (O < 32) return __builtin_bit_cast(float, __builtin_amdgcn_ds_swizzle(__builtin_bit_cast(int, v), (O << 10) | 0x1f));
    else return __shfl_xor(v, 32);
}
__device__ __forceinline__ float wave_sum(float v) {
    v += xor_lane<1>(v); v += xor_lane<2>(v); v += xor_lane<4>(v); v += xor_lane<8>(v); v += xor_lane<16>(v); v += xor_lane<32>(v);
    return v;
}
struct TrRegs { f32x4 v[8]; };
__device__ __forceinline__ void tr_load(TrRegs& R, const float* W, int ldw, int k0, int n0, int lane) {
    const GAS float* src = (const GAS float*)W + (size_t)(k0 + 8 * (lane >> 3)) * ldw + n0 + 4 * (lane & 7);
#pragma unroll
    for (int e = 0; e < 8; ++e) R.v[e] = *(const GAS f32x4*)(src + (size_t)e * ldw);
}
__device__ __forceinline__ void tr_store(const TrRegs& R, bf16* dst, int ldk, int lane) {
    GAS bf16* d = (GAS bf16*)dst + (size_t)(4 * (lane & 7)) * ldk + 8 * (lane >> 3);
#pragma unroll
    for (int i = 0; i < 4; ++i) { v4u o; o.x = pk2(R.v[0][i], R.v[1][i]); o.y = pk2(R.v[2][i], R.v[3][i]); o.z = pk2(R.v[4][i], R.v[5][i]); o.w = pk2(R.v[6][i], R.v[7][i]);
        *(GAS v4u*)(d + (size_t)i * ldk) = o; }
}
__device__ __forceinline__ unsigned pk4_fp8(float a, float b, float c, float d) {
    a = fminf(fmaxf(a, -448.f), 448.f); b = fminf(fmaxf(b, -448.f), 448.f); c = fminf(fmaxf(c, -448.f), 448.f); d = fminf(fmaxf(d, -448.f), 448.f);
    unsigned w = 0u; w = __builtin_amdgcn_cvt_pk_fp8_f32(a, b, w, false); w = __builtin_amdgcn_cvt_pk_fp8_f32(c, d, w, true); return w;
}
__device__ __forceinline__ void tr_store8(const TrRegs& R, unsigned char* dst8, int ldk, int lane, float sc) {
    GAS unsigned char* d = (GAS unsigned char*)dst8 + (size_t)(4 * (lane & 7)) * ldk + 8 * (lane >> 3);
#pragma unroll
    for (int i = 0; i < 4; ++i) { v2u o; o.x = pk4_fp8(R.v[0][i] * sc, R.v[1][i] * sc, R.v[2][i] * sc, R.v[3][i] * sc); o.y = pk4_fp8(R.v[4][i] * sc, R.v[5][i] * sc, R.v[6][i] * sc, R.v[7][i] * sc);
        *(GAS v2u*)(d + (size_t)i * ldk) = o; }
}
__device__ __forceinline__ void tr_matrix(Frame& F, int lane, const float* W, int K, int N, bf16* WT) {
    const int gw = F.vcu * NWAVES + F.wave, NGW = F.G * NWAVES, nblk = N / 32, nitems = (K / 64) * nblk;
    for (int it = gw; it < nitems; it += 2 * NGW) { const int it2 = it + NGW; const bool two = it2 < nitems; TrRegs A, B;
        const int kb = it / nblk, nb = it % nblk, kb2 = two ? it2 / nblk : kb, nb2 = two ? it2 % nblk : nb;
        tr_load(A, W, N, 64 * kb, 32 * nb, lane); tr_load(B, W, N, 64 * kb2, 32 * nb2, lane);
        tr_store(A, WT + (size_t)(32 * nb) * K + 64 * kb, K, lane); if (two) tr_store(B, WT + (size_t)(32 * nb2) * K + 64 * kb2, K, lane); }
}
constexpr int FF_ITEMS_GU = (D / 64) * (DFF / 32), FF_ITEMS_D = (DFF / 64) * (D / 32), FF_ITEMS = 2 * FF_ITEMS_GU + FF_ITEMS_D;
constexpr int FF_ITEMS_P2 = 2 * FF_ITEMS_GU;
struct FillItem { const float* src; bf16* dst; int ldw, ldk, k0, n0; };
__device__ __forceinline__ FillItem ff_item(Frame& F, int it) {
    it = it < FF_ITEMS ? it : FF_ITEMS - 1; FillItem I;
    if (it < 2 * FF_ITEMS_GU) { const int up = it >= FF_ITEMS_GU, r = up ? it - FF_ITEMS_GU : it, nblk = DFF / 32, kb = r / nblk, n0 = 32 * (r - kb * nblk);
        I.src = up ? F.w_ff_up : F.w_ff_gate; I.ldw = DFF; I.k0 = 64 * kb; I.n0 = n0; I.ldk = D;
        I.dst = (bf16*)(F.ws + WS_WGU) + (size_t)(256 * (n0 >> 7) + (n0 & 127) + (up ? 128 : 0)) * D + 64 * kb; }
    else { const int r = it - 2 * FF_ITEMS_GU, nblk = D / 32, kb = r / nblk, n0 = 32 * (r - kb * nblk);
        I.src = F.w_ff_down; I.ldw = D; I.k0 = 64 * kb; I.n0 = n0; I.ldk = DFF; I.dst = (bf16*)(F.ws + WS_WD) + (size_t)n0 * DFF + 64 * kb; }
    return I;
}
__device__ __forceinline__ void rms_row_to_bf16(int lane, const float* xrow, const float* gain, bf16* orow, unsigned char* orow8 = nullptr) {
    const GAS f32x4* xr = (const GAS f32x4*)xrow + lane;
    f32x4 v[16]; float s = 0.f;
#pragma unroll
    for (int j = 0; j < 16; ++j) { v[j] = xr[64 * j]; s += (v[j].x * v[j].x + v[j].y * v[j].y) + (v[j].z * v[j].z + v[j].w * v[j].w); }
    const float rstd = 1.f / sqrtf(wave_sum(s) * (1.f / D) + RMS_EPS);
    const GAS f32x4* gr = (const GAS f32x4*)gain + lane;
    GAS v2u* o8 = (GAS v2u*)orow + lane;
#pragma unroll
    for (int j = 0; j < 16; ++j) { const f32x4 g = gr[64 * j]; const float y0 = v[j].x * rstd * g.x, y1 = v[j].y * rstd * g.y, y2 = v[j].z * rstd * g.z, y3 = v[j].w * rstd * g.w;
        v2u o; o.x = pk2(y0, y1); o.y = pk2(y2, y3); o8[64 * j] = o;
        if (orow8) ((GAS unsigned*)orow8)[lane + 64 * j] = pk4_fp8(y0 * F8_ASCALE, y1 * F8_ASCALE, y2 * F8_ASCALE, y3 * F8_ASCALE); }
}

#ifndef MK_STAGGER_US
#define MK_STAGGER_US 0
#endif
__device__ __forceinline__ void stagger(int us_per_group) {
    const int grp = ((int)blockIdx.x >> 3) & 3;
    if (grp && us_per_group) { const unsigned long long t0 = __builtin_amdgcn_s_memrealtime(), dt = (unsigned long long)(grp * us_per_group) * 100ull;
        while (__builtin_amdgcn_s_memrealtime() - t0 < dt) __builtin_amdgcn_s_sleep(16); }
}
__device__ __forceinline__ void p0_prologue(Frame& F) {
    const int lane = opaque_tid() & 63;
    {
        const int gw0 = F.vcu * NWAVES + F.wave, NGW0 = F.G * NWAVES, nblk = NIN / 32, nitems = (D / 64) * nblk; bf16* WT = (bf16*)(F.ws + WS_WIN); unsigned char* W8 = F.ws + WS_WQKV8;
        for (int it = gw0; it < nitems; it += NGW0) { const int kb = it / nblk, n0 = 32 * (it - kb * nblk); TrRegs R; tr_load(R, F.w_in, NIN, 64 * kb, n0, lane);
            if (n0 >= 4096) tr_store8(R, W8 + (size_t)(n0 - 4096) * D + 64 * kb, D, lane, F8_WSCALE);
            else tr_store(R, WT + (size_t)n0 * D + 64 * kb, D, lane); } }
    tr_matrix(F, lane, F.w_o_gm, GMW, D, (bf16*)(F.ws + WS_WOA));
    {
        const int gw0 = F.vcu * NWAVES + F.wave, NGW0 = F.G * NWAVES, nblk = D / 32, nitems = (NAW / 64) * nblk; unsigned char* W8 = F.ws + WS_WOB;
        for (int it = gw0; it < nitems; it += NGW0) { const int kb = it / nblk, n0 = 32 * (it - kb * nblk); TrRegs R; tr_load(R, F.w_o_na, D, 64 * kb, n0, lane);
            tr_store8(R, W8 + (size_t)n0 * F8P + 64 * kb, F8P, lane, F8_WSCALE); } }
    tr_matrix(F, lane, F.w_out, D, D, (bf16*)(F.ws + WS_WOUT));
    const int gw = F.vcu * NWAVES + F.wave, NGW = F.G * NWAVES;
    { bf16* wsb = (bf16*)(F.ws + WS_WSB);
      for (int i = gw * 64 + lane; i < NGROUP * CHUNK * CHUNK / 4; i += NGW * 64) { const f32x4 v = ((const GAS f32x4*)F.gm_w_s)[i]; v2u o; o.x = pk2(v.x, v.y); o.y = pk2(v.z, v.w); ((GAS v2u*)wsb)[i] = o; } }
    bf16* XN = (bf16*)(F.ws + WS_RA);
    for (int m = gw; m < M; m += NGW) rms_row_to_bf16(lane, F.x + (size_t)m * D, F.norm1_g, XN + (size_t)m * D, F.ws + WS_XN8 + (size_t)m * D);
}
__device__ __forceinline__ void p5_norm_and_ffn_weights(Frame& F) {
    const int lane = opaque_tid() & 63;
    const int gw = F.vcu * NWAVES + F.wave, NGW = F.G * NWAVES;
    bf16* HN = (bf16*)(F.ws + WS_RA);
    for (int m = gw; m < M; m += NGW) rms_row_to_bf16(lane, F.out + (size_t)m * D, F.norm2_g, HN + (size_t)m * D);
}

typedef short s16x4 __attribute__((ext_vector_type(4)));
constexpr int GM_WP = 272, GM_VP = 288;
constexpr int GM_V_OFF = 128 * GM_WP, GM_ST_OFF = GM_V_OFF + 128 * GM_VP;
__device__ __forceinline__ void gmlp_unit(Frame& F, int chunk, int half) {
    LAS unsigned char* Wl = F.lds; LAS unsigned char* Vt = F.lds + GM_V_OFF; LAS f32x2* st = (LAS f32x2*)(F.lds + GM_ST_OFF);
    const bf16* U = (const bf16*)(F.ws + WS_U); const bf16* V = (const bf16*)(F.ws + WS_V); bf16* YA = (bf16*)(F.ws + WS_YA); const bf16* WSB = (const bf16*)(F.ws + WS_WSB);
    const int tid = opaque_tid();
    const int tok0 = chunk * CHUNK, lane = tid & 63, fr = lane & 15, fq = lane >> 4, q4 = fr >> 2, p4 = lane & 3;
    const int srow = tid >> 4, sch = tid & 15;
    const int g_first = half * (NGROUP / 2);
    v4u Wr[4], Vr[4]; f32x4 lg[2], lb[2];
#define GM_PREFETCH(g_) do { _Pragma("unroll") for (int q = 0; q < 4; ++q) { Wr[q] = *(const GAS v4u*)(WSB + (size_t)(g_) * CHUNK * CHUNK + (srow + 32 * q) * CHUNK + sch * 8); \
        Vr[q] = *(const GAS v4u*)(V + (size_t)(tok0 + srow + 32 * q) * GMW + (g_) * 128 + sch * 8); } \
        lg[0] = *(const GAS f32x4*)(F.gm_ln_g + (g_) * 128 + sch * 8); lg[1] = *(const GAS f32x4*)(F.gm_ln_g + (g_) * 128 + sch * 8 + 4); \
        lb[0] = *(const GAS f32x4*)(F.gm_ln_b + (g_) * 128 + sch * 8); lb[1] = *(const GAS f32x4*)(F.gm_ln_b + (g_) * 128 + sch * 8 + 4); } while (0)
    GM_PREFETCH(g_first);
    __syncthreads();
    { const GAS f32x4* p = (const GAS f32x4*)((const float*)(F.ws + WS_PART) + (size_t)(tok0 + (tid >> 2)) * 64 + (tid & 3) * 16); float sm = 0.f, sq = 0.f;
#pragma unroll
      for (int i = 0; i < 4; ++i) { const f32x4 v = p[i]; sm += v.x + v.z; sq += v.y + v.w; }
      sm += xor_lane<1>(sm); sm += xor_lane<2>(sm); sq += xor_lane<1>(sq); sq += xor_lane<2>(sq);
      const float mean = sm * (1.f / GMW), var = fmaxf(sq * (1.f / GMW) - mean * mean, 0.f);
      if ((tid & 3) == 0) st[tid >> 2] = (f32x2){mean, 1.f / sqrtf(var + LN_EPS)}; }
    const int wi = F.wave >> 1, wc2 = F.wave & 1;
#pragma unroll 1
    for (int gi = 0; gi < NGROUP / 2; ++gi) { const int g = g_first + gi;
        __syncthreads();
#pragma unroll
        for (int q = 0; q < 4; ++q) { const int row = srow + 32 * q;
            *(LAS v4u*)(Wl + row * GM_WP + sch * 16) = Wr[q];
            const v4u w = Vr[q]; const f32x2 ms = st[row]; v4u o;
            o.x = pk2((bflo(w.x) - ms.x) * ms.y * lg[0].x + lb[0].x, (bfhi(w.x) - ms.x) * ms.y * lg[0].y + lb[0].y); o.y = pk2((bflo(w.y) - ms.x) * ms.y * lg[0].z + lb[0].z, (bfhi(w.y) - ms.x) * ms.y * lg[0].w + lb[0].w);
            o.z = pk2((bflo(w.z) - ms.x) * ms.y * lg[1].x + lb[1].x, (bfhi(w.z) - ms.x) * ms.y * lg[1].y + lb[1].y); o.w = pk2((bflo(w.w) - ms.x) * ms.y * lg[1].z + lb[1].z, (bfhi(w.w) - ms.x) * ms.y * lg[1].w + lb[1].w);
            *(LAS v4u*)(Vt + row * GM_VP + sch * 16) = o; }
        if (gi + 1 < NGROUP / 2) GM_PREFETCH(g + 1);
        v4u uu[2][2]; float bs[2];
#pragma unroll
        for (int it = 0; it < 2; ++it) { const int i = 32 * wi + 16 * it + fr; bs[it] = F.gm_b_s[g * CHUNK + i];
#pragma unroll
            for (int t = 0; t < 2; ++t) uu[it][t] = *(const GAS v4u*)(U + (size_t)(tok0 + i) * GMW + g * 128 + 64 * wc2 + 32 * t + 8 * fq); }
        __syncthreads();
        f32x4 acc[4][2];
#pragma unroll
        for (int ct = 0; ct < 4; ++ct)
#pragma unroll
            for (int it = 0; it < 2; ++it) acc[ct][it] = (f32x4){0.f, 0.f, 0.f, 0.f};
#pragma unroll
        for (int kk = 0; kk < 8; ++kk) { s16x4 vf[4], wf[2];
#pragma unroll
            for (int ct = 0; ct < 4; ++ct) vf[ct] = __builtin_amdgcn_ds_read_tr16_b64_v4i16((LAS s16x4*)(Vt + (16 * kk + 4 * fq + q4) * GM_VP + (64 * wc2 + 32 * (ct >> 1) + 8 * p4 + 4 * (ct & 1)) * 2));
#pragma unroll
            for (int it = 0; it < 2; ++it) wf[it] = *(const LAS s16x4*)(Wl + (32 * wi + 16 * it + fr) * GM_WP + (16 * kk + 4 * fq) * 2);
#pragma unroll
            for (int ct = 0; ct < 4; ++ct)
#pragma unroll
                for (int it = 0; it < 2; ++it) acc[ct][it] = __builtin_amdgcn_mfma_f32_16x16x16bf16_1k(vf[ct], wf[it], acc[ct][it], 0, 0, 0); }
#pragma unroll
        for (int it = 0; it < 2; ++it) { const int i = 32 * wi + 16 * it + fr;
#pragma unroll
            for (int t = 0; t < 2; ++t) { const v4u u4 = uu[it][t]; const f32x4 a0 = acc[2 * t][it], a1 = acc[2 * t + 1][it]; const float b = bs[it]; v4u o;
                o.x = pk2((a0[0] + b) * bflo(u4.x), (a0[1] + b) * bfhi(u4.x)); o.y = pk2((a0[2] + b) * bflo(u4.y), (a0[3] + b) * bfhi(u4.y));
                o.z = pk2((a1[0] + b) * bflo(u4.z), (a1[1] + b) * bfhi(u4.z)); o.w = pk2((a1[2] + b) * bflo(u4.w), (a1[3] + b) * bfhi(u4.w));
                *(GAS v4u*)(YA + (size_t)(tok0 + i) * GMW + g * 128 + 64 * wc2 + 32 * t + 8 * fq) = o; } }
    }
#undef GM_PREFETCH
    __syncthreads();
}

constexpr int NA_KP = 272, NA_VP = 288;
constexpr int NA_KS = 64 * NA_KP, NA_SLOT = NA_KS + 64 * NA_VP, NA_RPB_OFF = 2 * NA_SLOT, NA_ROWS = 11;
constexpr float LOG2E = 1.4426950408889634f;
template <bool FILL> __device__ __forceinline__ void na_unit(Frame& F, int pq, int h, float cbound, int fill_it, int fill_stride) {
    LAS unsigned char* ring = F.lds; LAS float* rpbL = (LAS float*)(F.lds + NA_RPB_OFF);
    const bf16* Q = (const bf16*)(F.ws + WS_Q); const bf16* Kt = (const bf16*)(F.ws + WS_K); const bf16* Vv = (const bf16*)(F.ws + WS_VV);
    const int tid = opaque_tid();
    const int lane = tid & 63, wave = __builtin_amdgcn_readfirstlane(tid >> 6), fr = lane & 15, g = lane >> 4, q4 = fr >> 2, p4 = lane & 3;
    const int R0 = 4 * pq, r = R0 + (wave >> 1), half = wave & 1, kb0 = half;
    int b0 = R0 - 4; b0 = b0 < 0 ? 0 : (b0 > GRID_H - 8 ? GRID_H - 8 : b0);
    int rs = r - 4; rs = rs < 0 ? 0 : (rs > GRID_H - 8 ? GRID_H - 8 : rs);
    int c[2], cs[2];
#pragma unroll
    for (int tt = 0; tt < 2; ++tt) { c[tt] = 32 * half + 16 * tt + fr; int x = c[tt] - 8; cs[tt] = x < 0 ? 0 : (x > GRID_W - 16 ? GRID_W - 16 : x); }
    const int skey = tid >> 4, sdch = tid & 15;
    __syncthreads();
    for (int i = tid; i < 15 * 31; i += 512) rpbL[i] = __builtin_amdgcn_exp2f(F.na_rpb[h * 465 + i] * LOG2E);
    v4u RK[2][2], RV[2][2];
    TrRegs FR; FillItem FI;
#define NA_LOAD(s_) do { int kr_ = b0 + (s_); kr_ = kr_ > GRID_H - 1 ? GRID_H - 1 : kr_; _Pragma("unroll") for (int q2 = 0; q2 < 2; ++q2) { \
        const size_t o_ = (size_t)(kr_ * GRID_W + skey + 32 * q2) * NAW + h * HD + sdch * 8; RK[(s_) & 1][q2] = *(const GAS v4u*)(Kt + o_); RV[(s_) & 1][q2] = *(const GAS v4u*)(Vv + o_); } } while (0)
    NA_LOAD(0); NA_LOAD(1);
    bf16x8 Qf[2][4];
#pragma unroll
    for (int tt = 0; tt < 2; ++tt) { const size_t tq = (size_t)(r * GRID_W + c[tt]); v4u qw[4]; float ss = 0.f;
#pragma unroll
      for (int ks = 0; ks < 4; ++ks) { qw[ks] = *(const GAS v4u*)(Q + tq * NAW + h * HD + 32 * ks + 8 * g);
          const float a0 = bflo(qw[ks].x), a1 = bfhi(qw[ks].x), a2 = bflo(qw[ks].y), a3 = bfhi(qw[ks].y), a4 = bflo(qw[ks].z), a5 = bfhi(qw[ks].z), a6 = bflo(qw[ks].w), a7 = bfhi(qw[ks].w);
          ss += (a0 * a0 + a1 * a1) + (a2 * a2 + a3 * a3) + (a4 * a4 + a5 * a5) + (a6 * a6 + a7 * a7); }
      ss += xor_lane<16>(ss); ss += xor_lane<32>(ss);
      const float rq = (1.f / sqrtf(ss * (1.f / HD) + RMS_EPS)) * 0.08838834764831845f * LOG2E;
#pragma unroll
      for (int ks = 0; ks < 4; ++ks) { const f32x4 g0 = *(const GAS f32x4*)(F.q_gain + 32 * ks + 8 * g), g1 = *(const GAS f32x4*)(F.q_gain + 32 * ks + 8 * g + 4);
          v4u o; o.x = pk2(bflo(qw[ks].x) * rq * g0.x, bfhi(qw[ks].x) * rq * g0.y); o.y = pk2(bflo(qw[ks].y) * rq * g0.z, bfhi(qw[ks].y) * rq * g0.w);
          o.z = pk2(bflo(qw[ks].z) * rq * g1.x, bfhi(qw[ks].z) * rq * g1.y); o.w = pk2(bflo(qw[ks].w) * rq * g1.z, bfhi(qw[ks].w) * rq * g1.w);
          Qf[tt][ks] = __builtin_bit_cast(bf16x8, o); } }
    const f32x4 kg0 = *(const GAS f32x4*)(F.k_gain + sdch * 8), kg1 = *(const GAS f32x4*)(F.k_gain + sdch * 8 + 4);
    f32x4 O[2][8]; float lsum[2] = {0.f, 0.f};
#pragma unroll
    for (int tt = 0; tt < 2; ++tt)
#pragma unroll
        for (int db = 0; db < 8; ++db) O[tt][db] = (f32x4){0.f, 0.f, 0.f, 0.f};
#pragma unroll
    for (int s = 0; s < NA_ROWS; ++s) { LAS unsigned char* slot = ring + (s & 1) * NA_SLOT;
#pragma unroll
        for (int q2 = 0; q2 < 2; ++q2) { const v4u w = RK[s & 1][q2];
            const float a0 = bflo(w.x), a1 = bfhi(w.x), a2 = bflo(w.y), a3 = bfhi(w.y), a4 = bflo(w.z), a5 = bfhi(w.z), a6 = bflo(w.w), a7 = bfhi(w.w);
            float ss = (a0 * a0 + a1 * a1) + (a2 * a2 + a3 * a3) + (a4 * a4 + a5 * a5) + (a6 * a6 + a7 * a7);
            ss += xor_lane<1>(ss); ss += xor_lane<2>(ss); ss += xor_lane<4>(ss); ss += xor_lane<8>(ss);
            const float rk = 1.f / sqrtf(ss * (1.f / HD) + RMS_EPS);
            v4u o; o.x = pk2(a0 * rk * kg0.x, a1 * rk * kg0.y); o.y = pk2(a2 * rk * kg0.z, a3 * rk * kg0.w); o.z = pk2(a4 * rk * kg1.x, a5 * rk * kg1.y); o.w = pk2(a6 * rk * kg1.z, a7 * rk * kg1.w);
            *(LAS v4u*)(slot + (skey + 32 * q2) * NA_KP + sdch * 16) = o;
            *(LAS v4u*)(slot + NA_KS + (skey + 32 * q2) * NA_VP + sdch * 16) = RV[s & 1][q2]; }
        if (s + 2 < NA_ROWS) NA_LOAD(s + 2);
        if constexpr (FILL) { if (s > 0) tr_store(FR, FI.dst, FI.ldk, lane); FI = ff_item(F, fill_it + s * fill_stride); tr_load(FR, FI.src, FI.ldw, FI.k0, FI.n0, lane); }
        __syncthreads();
        const int kr = b0 + s;
        if (kr >= rs && kr <= rs + 7) {
            f32x4 S[2][3];
#pragma unroll
            for (int tt = 0; tt < 2; ++tt)
#pragma unroll
                for (int b = 0; b < 3; ++b) S[tt][b] = (f32x4){-cbound, -cbound, -cbound, -cbound};
#pragma unroll
            for (int b = 0; b < 3; ++b)
#pragma unroll
                for (int ks = 0; ks < 4; ++ks) { const bf16x8 a = *(const LAS bf16x8*)(slot + (16 * (kb0 + b) + fr) * NA_KP + (32 * ks + 8 * g) * 2);
#pragma unroll
                    for (int tt = 0; tt < 2; ++tt) S[tt][b] = __builtin_amdgcn_mfma_f32_16x16x32_bf16(a, Qf[tt][ks], S[tt][b], 0, 0, 0); }
            s16x4 pf[2][3];
#pragma unroll
            for (int tt = 0; tt < 2; ++tt) { const int rbase = (kr - r + 7) * 31 + 15 - c[tt];
#pragma unroll
                for (int b = 0; b < 3; ++b) { float pv[4];
#pragma unroll
                    for (int i = 0; i < 4; ++i) { const int kc = 16 * (kb0 + b) + 4 * g + i; const bool ok = (kc >= cs[tt]) && (kc <= cs[tt] + 15);
                        int idx = rbase + kc; idx = ok ? idx : 0; const float e = __builtin_amdgcn_exp2f(S[tt][b][i]) * rpbL[idx]; pv[i] = ok ? e : 0.f; lsum[tt] += pv[i]; }
                    v2u pw; pw.x = pk2(pv[0], pv[1]); pw.y = pk2(pv[2], pv[3]); pf[tt][b] = __builtin_bit_cast(s16x4, pw); } }
#pragma unroll
            for (int b = 0; b < 3; ++b)
#pragma unroll
                for (int db = 0; db < 8; ++db) { const s16x4 vf = __builtin_amdgcn_ds_read_tr16_b64_v4i16((LAS s16x4*)(slot + NA_KS + (16 * (kb0 + b) + 4 * g + q4) * NA_VP + (32 * (db >> 1) + 8 * p4 + 4 * (db & 1)) * 2));
#pragma unroll
                    for (int tt = 0; tt < 2; ++tt) O[tt][db] = __builtin_amdgcn_mfma_f32_16x16x16bf16_1k(vf, pf[tt][b], O[tt][db], 0, 0, 0); }
        }
    }
#undef NA_LOAD
    if constexpr (FILL) tr_store(FR, FI.dst, FI.ldk, lane);
#pragma unroll
    for (int tt = 0; tt < 2; ++tt) { float l = lsum[tt]; l += xor_lane<16>(l); l += xor_lane<32>(l); const float inv = 1.f / l;
        const float inv8 = inv * F8_YSCALE;
        GAS unsigned char* orow = (GAS unsigned char*)(F.ws + WS_YB) + (size_t)(r * GRID_W + c[tt]) * F8P + h * HD + 8 * g;
#pragma unroll
        for (int t = 0; t < 4; ++t) { const f32x4 a0 = O[tt][2 * t], a1 = O[tt][2 * t + 1]; v2u o;
            o.x = pk4_fp8(a0[0] * inv8, a0[1] * inv8, a0[2] * inv8, a0[3] * inv8); o.y = pk4_fp8(a1[0] * inv8, a1[1] * inv8, a1[2] * inv8, a1[3] * inv8);
            *(GAS v2u*)(orow + 32 * t) = o; } }
}

struct Args { const float* in[17]; float* out; unsigned char* ws; int ph_lo, ph_hi, li, pad; };
__global__ void __launch_bounds__(NWAVES * 64, 2) fwd_kernel(Args args) {
    extern __shared__ __attribute__((aligned(16))) unsigned char lds[];
    Frame F;
    F.lds = (LAS unsigned char*)lds;
    F.MISC = (volatile LAS unsigned*)(F.lds + MISC_OFF);
    F.tid = threadIdx.x; F.lane = F.tid & 63; F.wave = __builtin_amdgcn_readfirstlane(F.tid >> 6);
    F.G = gridDim.x; { const int bx = blockIdx.x; F.vcu = (F.G % 8 == 0) ? (bx % 8) * (F.G / 8) + bx / 8 : bx; }
    F.ws = args.ws; F.ctl = (gu32*)(args.ws + WS_CTL);
    F.x = args.in[0]; F.norm1_g = args.in[1]; F.w_in = args.in[2]; F.gm_ln_g = args.in[3]; F.gm_ln_b = args.in[4]; F.gm_w_s = args.in[5]; F.gm_b_s = args.in[6];
    F.q_gain = args.in[7]; F.k_gain = args.in[8]; F.na_rpb = args.in[9]; F.w_o_gm = args.in[10]; F.w_o_na = args.in[11]; F.w_out = args.in[12]; F.norm2_g = args.in[13];
    F.w_ff_gate = args.in[14]; F.w_ff_up = args.in[15]; F.w_ff_down = args.in[16]; F.out = args.out;
    for (int u = F.tid; u < (LDS_BYTES - LDSCTL_OFF) / 4; u += NWAVES * 64) ((LAS unsigned*)(F.lds + LDSCTL_OFF))[u] = 0u;
    __syncthreads();
    XcdBarrier bar; bar.bar = (unsigned*)(F.ctl + CW_BAR); bar.x = 0; bar.st = nullptr;
    if (N_LAUNCHES != PER_PHASE) bar = xcd_barrier_post((unsigned*)(F.ctl + CW_BAR), F.MISC + 8);
#define GRID_BAR() do { if (N_LAUNCHES != PER_PHASE) xcd_barrier(bar); } while (0)
    const int lo = args.ph_lo, hi = args.ph_hi < MK_STOP_AFTER + 1 ? args.ph_hi : MK_STOP_AFTER + 1;
#define IN(k) (lo <= (k) && (k) < hi)
#define BOTH(k) (IN(k) && IN((k) + 1))
    const int bx = (int)blockIdx.x;

    if (IN(0)) { _Pragma("unroll") for (int rep = 0; rep < NREP(0); ++rep) { p0_prologue(F); if (BOTH(0)) GRID_BAR(); } }

    if (IN(1)) _Pragma("unroll") for (int rep = 0; rep < NREP(1); ++rep) {
        { pg8::SchedP1a S; S.o.init(M, 16 * 256, F.G, bx); S.A = (const char*)(F.ws + WS_RA); S.B = (const char*)(F.ws + WS_WIN); S.tstep = (size_t)256 * D * 2;
          pg8::EpiProj E{(bf16*)(F.ws + WS_RB), M, 1.f, (float*)(F.ws + WS_PART)};
          stagger(MK_STAGGER_US); pg8::gemm_phase<pg8::EpiProj, pg8::SchedP1a, true, true>(F.lds, D, S, E); }
        { pg8::SchedP1b S; S.o.init(M, 56 * 256, F.G, bx); S.A8 = (const char*)(F.ws + WS_XN8); S.B8 = (const char*)(F.ws + WS_WQKV8); S.tstep8 = (size_t)256 * D;
          pg8::EpiQKV E{(bf16*)(F.ws + WS_RB), M, F8_UNSCALE, F.ws + WS_GA, F.ws + WS_GB};
          pg8::gemm_phase_f8<pg8::EpiQKV, pg8::SchedP1b>(F.lds, D, S, E); }
        if (BOTH(1)) GRID_BAR();
    }
    if (IN(2)) _Pragma("unroll") for (int rep = 0; rep < NREP(2); ++rep) {
        for (int u = bx; u < 2 * (M / CHUNK); u += F.G) gmlp_unit(F, u >> 1, u & 1);
#if defined(MK_PROBE_NA)
        for (int rep = 0; rep < args.pad + 2; ++rep)
#endif
        float cbound;
        { const int ln = opaque_tid() & 63; float mq = fmaxf(fabsf(F.q_gain[2 * ln]), fabsf(F.q_gain[2 * ln + 1])), mk = fmaxf(fabsf(F.k_gain[2 * ln]), fabsf(F.k_gain[2 * ln + 1]));
          mq = fmaxf(mq, xor_lane<1>(mq)); mq = fmaxf(mq, xor_lane<2>(mq)); mq = fmaxf(mq, xor_lane<4>(mq)); mq = fmaxf(mq, xor_lane<8>(mq)); mq = fmaxf(mq, xor_lane<16>(mq)); mq = fmaxf(mq, xor_lane<32>(mq));
          mk = fmaxf(mk, xor_lane<1>(mk)); mk = fmaxf(mk, xor_lane<2>(mk)); mk = fmaxf(mk, xor_lane<4>(mk)); mk = fmaxf(mk, xor_lane<8>(mk)); mk = fmaxf(mk, xor_lane<16>(mk)); mk = fmaxf(mk, xor_lane<32>(mk));
          cbound = 11.313708498984761f * 1.01f * LOG2E * mq * mk; }
        {
            const int gwv = F.vcu * NWAVES + F.wave, NGW = F.G * NWAVES, per_wave = (FF_ITEMS_P2 + NGW - 1) / NGW, nfill = (per_wave + NA_ROWS - 1) / NA_ROWS; int ui = 0, done = 0;
            for (int u = F.vcu; u < (GRID_H / 4) * NHEAD; u += F.G, ++ui) {
                if (ui < nfill) { na_unit<true>(F, u & (GRID_H / 4 - 1), u >> 6, cbound, gwv + done * NGW, NGW); done += NA_ROWS; }
                else na_unit<false>(F, u & (GRID_H / 4 - 1), u >> 6, cbound, 0, 0); }
            const int ln = opaque_tid() & 63;
            for (int it = gwv + done * NGW; it < FF_ITEMS_P2; it += NGW) { TrRegs R; const FillItem I = ff_item(F, it); tr_load(R, I.src, I.ldw, I.k0, I.n0, ln); tr_store(R, I.dst, I.ldk, ln); }
        }
        if (BOTH(2)) GRID_BAR();
    }
    if (IN(3)) _Pragma("unroll") for (int rep = 0; rep < NREP(3); ++rep) {
        { pg8::SchedMerge S; S.o.init(M, D, F.G, bx); S.A0 = (const char*)(F.ws + WS_YB); S.B0 = (const char*)(F.ws + WS_WOB); S.A1 = (const char*)(F.ws + WS_YA); S.B1 = (const char*)(F.ws + WS_WOA); S.tstep = (size_t)256 * F8P;
          pg8::EpiMix E{F.ws + WS_GA, F.ws + WS_GB, (bf16*)(F.ws + WS_MRG), F8_YUNSCALE};
          stagger(MK_STAGGER_US); pg8::gemm_phase_mix<pg8::EpiMix, pg8::SchedMerge>(F.lds, F8P, NAW / 128, GMW / 64, S, E); }
        if (BOTH(3)) GRID_BAR();
    }
    if (IN(4)) _Pragma("unroll") for (int rep = 0; rep < NREP(4); ++rep) {
        pg8::SchedPlain S; S.o.init(M, D, F.G, bx); S.A = (const char*)(F.ws + WS_MRG); S.B = (const char*)(F.ws + WS_WOUT); S.tstep = (size_t)256 * D * 2;
        pg8::EpiOutNorm E{F.x, (bf16*)(F.ws + WS_H16), (bf16*)(F.ws + WS_RA), F.norm2_g, (float*)(F.ws + WS_PART)};
        stagger(MK_STAGGER_US); pg8::gemm_phase<pg8::EpiOutNorm, pg8::SchedPlain, true, true>(F.lds, D, S, E);
        if (BOTH(4)) GRID_BAR();
    }
    if (IN(6)) _Pragma("unroll") for (int rep = 0; rep < NREP(6); ++rep) {
        pg8::SchedPlain S; S.o.init(M, NGU, F.G, bx); S.A = (const char*)(F.ws + WS_RA); S.B = (const char*)(F.ws + WS_WGU); S.tstep = (size_t)256 * D * 2;
        LAS float* rtab = (LAS float*)(F.lds + 135168); const int fm = 8 * (bx & 7);
        { const int t5 = opaque_tid(); const float* part = (const float*)(F.ws + WS_PART);
          for (int r = t5; r < 2048; r += NWAVES * 64) { const GAS f32x4* p = (const GAS f32x4*)(part + (size_t)(fm * 256 + r) * 64); float sacc = 0.f;
#pragma unroll
              for (int j = 0; j < 16; ++j) { const f32x4 v = p[j]; sacc += (v.x + v.y) + (v.z + v.w); }
              rtab[r] = 1.f / sqrtf(sacc * (1.f / D) + RMS_EPS); }
          __syncthreads(); }
        pg8::EpiSwiglu E{(bf16*)(F.ws + WS_ACT), DFF, rtab, fm};
        stagger(MK_STAGGER_US); pg8::gemm_phase<pg8::EpiSwiglu, pg8::SchedPlain, true, true>(F.lds, D, S, E);
        {
            const int rem = S.o.nwg % F.G, first = rem, nidle = rem ? F.G - rem : F.G;
            if (bx >= first || rem == 0) { const int ln = opaque_tid() & 63, w0 = ((rem ? bx - first : bx) * NWAVES + F.wave), NW = nidle * NWAVES;
                for (int it = FF_ITEMS_P2 + w0; it < FF_ITEMS; it += 2 * NW) { const int it2 = it + NW; TrRegs Ra, Rb; const FillItem Ia = ff_item(F, it), Ib = ff_item(F, it2);
                    tr_load(Ra, Ia.src, Ia.ldw, Ia.k0, Ia.n0, ln); tr_load(Rb, Ib.src, Ib.ldw, Ib.k0, Ib.n0, ln); tr_store(Ra, Ia.dst, Ia.ldk, ln); tr_store(Rb, Ib.dst, Ib.ldk, ln); } } }
        if (BOTH(6)) GRID_BAR();
    }
    if (IN(7)) {
        pg8::SchedPlain S; S.o.init(M, D, F.G, bx); S.A = (const char*)(F.ws + WS_ACT); S.B = (const char*)(F.ws + WS_WD); S.tstep = (size_t)256 * DFF * 2;
        pg8::EpiResH16 E{(const bf16*)(F.ws + WS_H16), F.out};
        stagger(MK_STAGGER_US); pg8::gemm_phase<pg8::EpiResH16, pg8::SchedPlain, true, true>(F.lds, DFF, S, E);
    }

#if MK_STOP_AFTER < 4
    {
        GRID_BAR();
        const bf16* pU = (const bf16*)(F.ws + WS_U); const bf16* pV = (const bf16*)(F.ws + WS_V); const bf16* pQ = (const bf16*)(F.ws + WS_Q); const bf16* pK = (const bf16*)(F.ws + WS_K); const bf16* pVV = (const bf16*)(F.ws + WS_VV);
        const bf16* pGA = (const bf16*)(F.ws + WS_GA); const bf16* pGB = (const bf16*)(F.ws + WS_GB); const bf16* pYA = (const bf16*)(F.ws + WS_YA); const bf16* pYB = (const bf16*)(F.ws + WS_YB); const bf16* pM = (const bf16*)(F.ws + WS_MRG);
        for (size_t i = (size_t)bx * 512 + F.tid; i < (size_t)M * D; i += (size_t)F.G * 512) { const size_t m = i >> 12; const int c = (int)(i & 4095), c2 = c & 2047; float v;
            if (MK_STOP_AFTER == 1) v = 0.f * bflo(pGA[i]) + 0.f * bflo(pGB[i]) + 8.f * bflo(((const bf16*)(F.ws + WS_WOA))[(m & 4095) * 2048 + c2]) + 9.f * bflo(((const bf16*)(F.ws + WS_WOB))[(m & 4095) * 2048 + c2]) + 10.f * bflo(((const bf16*)(F.ws + WS_WOUT))[(m & 4095) * 4096 + c]);
            else if (MK_STOP_AFTER == 2) v = c < 2048 ? bflo(pYA[m * 2048 + c2]) : bflo(pYB[m * 2048 + c2]);
            else if (MK_STOP_AFTER == 3) v = bflo(pM[i]);
            else v = F.x[i];
            F.out[i] = v; }
    }
#endif
#if defined(MK_PROBE_P7)
    {
        GRID_BAR();
        pg8::SchedPlain S; S.o.init(M, D, F.G, bx); S.A = (const char*)(F.ws + WS_ACT); S.B = (const char*)(F.ws + WS_WD); S.tstep = (size_t)256 * DFF * 2;
        pg8::EpiResF32 E{F.out, (float*)(F.ws + WS_END)};
        pg8::gemm_phase<pg8::EpiResF32, pg8::SchedPlain, true, true>(F.lds, DFF, S, E);
    }
#endif
#undef IN
#undef BOTH
#undef GRID_BAR
}

extern "C" void kernel_launch(void* const* d_in, const int* in_sizes, int n_in, void* d_out, int out_size, void* d_ws, size_t ws_size, hipStream_t stream) {
    static int grid = 0;
    if (grid == 0) {
        if (n_in != 17 || in_sizes[0] != M * D || out_size != M * D || ws_size < WS_END) { fprintf(stderr, "kernel_launch: unexpected shapes/workspace (n_in %d, in0 %d, out %d, ws %zu < %zu); nothing launched\n", n_in, n_in > 0 ? in_sizes[0] : -1, out_size, ws_size, (size_t)WS_END); grid = -1; return; }
        int dev = 0, cus = 0, per_cu = 0;
        if (hipGetDevice(&dev) != hipSuccess || hipDeviceGetAttribute(&cus, hipDeviceAttributeMultiprocessorCount, dev) != hipSuccess) { grid = -1; return; }
        if (hipFuncSetAttribute((const void*)fwd_kernel, hipFuncAttributeMaxDynamicSharedMemorySize, LDS_BYTES) != hipSuccess) { fprintf(stderr, "kernel_launch: hipFuncSetAttribute failed\n"); grid = -1; return; }
        if (hipOccupancyMaxActiveBlocksPerMultiprocessor(&per_cu, (const void*)fwd_kernel, NWAVES * 64, LDS_BYTES) != hipSuccess || per_cu < 1) fprintf(stderr, "kernel_launch: occupancy query reports %d\n", per_cu);
        (void)hipGetLastError();
        grid = cus - cus % 8;
    }
    if (grid < 0) return;
    if (hipMemsetAsync((char*)d_ws + WS_CTL, 0, CTL_ZERO_BYTES, stream) != hipSuccess) return;
    Args a{};
    for (int i = 0; i < 17; ++i) a.in[i] = (const float*)d_in[i];
    a.out = (float*)d_out; a.ws = (unsigned char*)d_ws;
    for (int li = 0; li < N_LAUNCHES; ++li) {
        if (N_LAUNCHES == PER_PHASE) { a.ph_lo = li; a.ph_hi = li + 1; } else { a.ph_lo = 0; a.ph_hi = PER_PHASE; }
        a.li = li; a.pad = 0;
        hipLaunchKernelGGL(fwd_kernel, dim3(grid), dim3(NWAVES * 64), LDS_BYTES, stream, a);
        const hipError_t le = hipPeekAtLastError();
        if (le != hipSuccess) { fprintf(stderr, "kernel_launch: launch %d failed: %s\n", li, hipGetErrorName(le)); break; }
    }
}
```

```cpp
#include <hip/hip_runtime.h>
#include <cstdio>
#include <cstdint>

#ifndef MK_N_LAUNCHES
#define MK_N_LAUNCHES 1
#endif
#ifndef MK_REPEAT
#define MK_REPEAT 0
#endif
#define NREP(k) (((MK_REPEAT >> (k)) & 1) + 1)
#ifndef MK_STOP_AFTER
#define MK_STOP_AFTER 7
#endif

__device__ __forceinline__ int opaque_tid() { int t = (int)threadIdx.x; asm volatile("" : "+v"(t)); return t; }
namespace pg8 {
#define PG8_LAS __attribute__((address_space(3)))
typedef unsigned short bf16_t;
typedef short bf16x8 __attribute__((ext_vector_type(8)));
typedef float f32x4 __attribute__((ext_vector_type(4)));
typedef float f32x2 __attribute__((ext_vector_type(2)));
typedef unsigned u32x4 __attribute__((ext_vector_type(4)));
typedef unsigned u32x2 __attribute__((ext_vector_type(2)));
constexpr int BM = 256, BK = 64, HALF = 128, HTB = HALF * BK * 2  , STAGE_BYTES = 8 * HTB, NXCD = 8, WGM = 8;

__host__ __device__ __forceinline__ int lds_byte(int r, int c) { const int st = (r >> 4) * 2 + (c >> 5), rr = r & 15, cc = c & 31, ob = rr * 64 + cc * 2; return st * 1024 + (ob ^ (((ob >> 9) & 1) << 5)); }
__host__ __device__ __forceinline__ void stage_rc(int b, int& R, int& C) { const int st = b / 1024, sb = b % 1024, swz = sb ^ (((sb >> 9) & 1) << 5); R = (st >> 1) * 16 + swz / 64; C = (st & 1) * 32 + (swz % 64) / 2; }
__host__ __device__ __forceinline__ int perm32(int rho) { const int n = rho >> 4, i = rho & 15; return 8 * (i >> 2) + 4 * n + (i & 3); }

__host__ __device__ __forceinline__ size_t blk_off(int row, int kb, int KB) { return (((size_t)(row >> 8) * (KB >> 7) + (kb >> 7)) * 256 + (row & 255)) * 128 + (kb & 127); }
struct Unit { int pm, pn, sub; };

struct StaticOrder {
    int nM, nN, nwg, G, c;
    __host__ __device__ void init(int M, int N, int G_, int c_) { nM = M / BM; nN = N / BM; nwg = nM * nN; G = G_; c = c_; }
    __host__ __device__ bool tile(int i, Unit& u) const {
        const long L = (long)i * G + c; if (L >= nwg) return false;
        int wgid = (int)L; { const int q = nwg / NXCD, r = nwg % NXCD, xcd = wgid % NXCD, off = wgid / NXCD; wgid = (xcd < r ? xcd * (q + 1) : r * (q + 1) + (xcd - r) * q) + off; }
        const int nig = WGM * nN, gid = wgid / nig, fm = gid * WGM, gsz = (nM - fm) < WGM ? (nM - fm) : WGM;
        u.pm = fm + ((wgid % nig) % gsz); u.pn = (wgid % nig) / gsz; u.sub = 0; return true;
    }
};
struct SchedPlain {
    StaticOrder o; const char* A; const char* B; size_t tstep;
    __device__ __forceinline__ bool next(int i, Unit& u) const { return o.tile(i, u); }
    __device__ __forceinline__ void ptrs(const Unit& u, const char*& a, const char*& b) const { a = A + (size_t)u.pm * tstep; b = B + (size_t)u.pn * tstep; }
};
struct SchedP1a {
    StaticOrder o; const char* A; const char* B; size_t tstep;
    __device__ __forceinline__ bool next(int i, Unit& u) const { const bool ok = o.tile(i, u); u.pn = u.pn < 16 ? u.pn : u.pn + 24; return ok; }
    __device__ __forceinline__ void ptrs(const Unit& u, const char*& a, const char*& b) const { a = A + (size_t)u.pm * tstep; b = B + (size_t)u.pn * tstep; }
};
struct SchedP1b {
    StaticOrder o; const char* A8; const char* B8; size_t tstep8;
    __device__ __forceinline__ bool next(int i, Unit& u) const { const bool ok = o.tile(i, u); u.sub = u.pn; u.pn = u.pn + 16; return ok; }
    __device__ __forceinline__ void ptrs(const Unit& u, const char*& a, const char*& b) const { a = A8 + (size_t)u.pm * tstep8; b = B8 + (size_t)u.sub * tstep8; }
};
struct SchedMerge {
    StaticOrder o; const char* A0; const char* B0; const char* A1; const char* B1; size_t tstep; size_t tstep8;
    __device__ __forceinline__ bool next(int i, Unit& u) const { const bool ok = o.tile(i >> 1, u); u.sub = i & 1; return ok; }
    __device__ __forceinline__ void ptrs(const Unit& u, const char*& a, const char*& b) const { a = (u.sub ? A1 : A0) + (size_t)u.pm * tstep; b = (u.sub ? B1 : B0) + (size_t)u.pn * tstep; }
};

typedef __bf16 bf16x2v __attribute__((ext_vector_type(2)));
__device__ __forceinline__ unsigned cvt_pk_bf16(float lo, float hi) { const bf16x2v v = __builtin_convertvector((f32x2){lo, hi}, bf16x2v); return __builtin_bit_cast(unsigned, v); }
__device__ __forceinline__ float bf_lo(unsigned w) { return __uint_as_float(w << 16); }
__device__ __forceinline__ float bf_hi(unsigned w) { return __uint_as_float(w & 0xffff0000u); }
__device__ __forceinline__ f32x2 gelu_pk(f32x2 v) {
    const f32x2 av = __builtin_elementwise_abs(v), d = av * 0.2316418882f + 1.0f;
    f32x2 t; t.x = __builtin_amdgcn_rcpf(d.x); t.y = __builtin_amdgcn_rcpf(d.y);
    f32x2 q = t * 0.5307027145f + (-0.7265760135f); q = q * t + 0.7107068705f; q = q * t + (-0.142248368f); q = q * t + 0.127414796f; q = q * t;
    const f32x2 s = (v * v) * (-0.72134752044f);
    f32x2 e; e.x = __builtin_amdgcn_exp2f(s.x); e.y = __builtin_amdgcn_exp2f(s.y);
    const f32x2 m = v * (q * e), r = v - m;
    f32x2 o; o.x = v.x < 0.f ? m.x : r.x; o.y = v.y < 0.f ? m.y : r.y; return o;
}
__device__ __forceinline__ float sigmoid_f(float x) { return __builtin_amdgcn_rcpf(1.0f + __builtin_amdgcn_exp2f(x * -1.44269504089f)); }
__device__ __forceinline__ f32x4 gelu4(f32x4 v) { const f32x2 a = gelu_pk((f32x2){v[0], v[1]}), b = gelu_pk((f32x2){v[2], v[3]}); return (f32x4){a.x, a.y, b.x, b.y}; }
__device__ __forceinline__ f32x4 sigm4(f32x4 v) { return (f32x4){sigmoid_f(v[0]), sigmoid_f(v[1]), sigmoid_f(v[2]), sigmoid_f(v[3])}; }
__device__ __forceinline__ u32x4 pack8(f32x4 v0, f32x4 v1) { u32x4 w; w.x = cvt_pk_bf16(v0[0], v0[1]); w.y = cvt_pk_bf16(v0[2], v0[3]); w.z = cvt_pk_bf16(v1[0], v1[1]); w.w = cvt_pk_bf16(v1[2], v1[3]); return w; }

__device__ __forceinline__ size_t lane_tile_idx(int T, int wr, int wc, int fr, int fq, int ai, int m, int bj) { return ((size_t)T * 128 + (((wr * 4 + wc) * 2 + ai) * 4 + m) * 2 + bj) * 64 + fr + 16 * fq; }
__device__ __forceinline__ unsigned pack_u8x4(f32x4 v) { const f32x4 q = v * 255.f + 0.5f; return (unsigned)q[0] | ((unsigned)q[1] << 8) | ((unsigned)q[2] << 16) | ((unsigned)q[3] << 24); }
__device__ __forceinline__ f32x4 unpack_u8x4(unsigned w) { return (f32x4){(float)(w & 0xffu), (float)((w >> 8) & 0xffu), (float)((w >> 16) & 0xffu), (float)(w >> 24)}; }
struct EpiProj {
    static constexpr bool PERM = true;
    bf16_t* base; int M; float qkv_scale;
    float* vstat;
    __device__ __forceinline__ void store_v(const f32x4 (&acc)[2][2][4][2], bf16_t* O, int row0, int col0, int slice, int fq) const {
#pragma unroll
        for (int ai = 0; ai < 2; ++ai)
#pragma unroll
            for (int m = 0; m < 4; ++m) { const int row = row0 + ai * HALF + m * 16; bf16_t* rowp = O + (size_t)row * 2048 + col0; float s = 0.f, s2 = 0.f;
#pragma unroll
                for (int bj = 0; bj < 2; ++bj) { const f32x4 v0 = gelu4(acc[ai][bj][m][0]), v1 = gelu4(acc[ai][bj][m][1]);
                    s += ((v0[0] + v0[1]) + (v0[2] + v0[3])) + ((v1[0] + v1[1]) + (v1[2] + v1[3]));
                    s2 += ((v0[0] * v0[0] + v0[1] * v0[1]) + (v0[2] * v0[2] + v0[3] * v0[3])) + ((v1[0] * v1[0] + v1[1] * v1[1]) + (v1[2] * v1[2] + v1[3] * v1[3]));
                    *(u32x4*)(rowp + bj * HALF) = pack8(v0, v1); }
                s += __shfl_xor(s, 16); s += __shfl_xor(s, 32); s2 += __shfl_xor(s2, 16); s2 += __shfl_xor(s2, 32);
                if (fq == 0) *(f32x2*)(vstat + (size_t)row * 64 + 2 * slice) = (f32x2){s, s2}; }
    }
    __device__ __forceinline__ bool keep(const Unit&) const { return false; }
    template <int ACT> __device__ __forceinline__ void store(const f32x4 (&acc)[2][2][4][2], bf16_t* O, int ldc, int row0, int col0) const {
#pragma unroll
        for (int ai = 0; ai < 2; ++ai)
#pragma unroll
            for (int m = 0; m < 4; ++m) { bf16_t* rowp = O + (size_t)(row0 + ai * HALF + m * 16) * ldc + col0;
#pragma unroll
                for (int bj = 0; bj < 2; ++bj) { f32x4 v0 = acc[ai][bj][m][0], v1 = acc[ai][bj][m][1];
                    if (ACT == 0) { v0 = v0 * qkv_scale; v1 = v1 * qkv_scale; }
                    if (ACT == 1) { v0 = gelu4(v0); v1 = gelu4(v1); }
                    if (ACT == 2) { v0 = sigm4(v0); v1 = sigm4(v1); }
                    *(u32x4*)(rowp + bj * HALF) = pack8(v0, v1); } }
    }
    __device__ __forceinline__ void operator()(f32x4 (&acc)[2][2][4][2], const Unit& u, int wr, int wc, int fr, int fq) const {
        const int row0 = u.pm * BM + wr * 64 + fr, pn = u.pn;
        if (pn < 40) { const int t = pn >> 3; bf16_t* O = base + (size_t)t * M * 2048; const int col0 = (pn & 7) * BM + wc * 32 + 8 * fq;
            if (t == 0) store<1>(acc, O, 2048, row0, col0); else if (t == 1) store_v(acc, O, row0, col0, (pn & 7) * 4 + wc, fq); else store<0>(acc, O, 2048, row0, col0); }
        else { const int t = (pn - 40) >> 4; bf16_t* O = base + (size_t)5 * M * 2048 + (size_t)t * M * 4096; const int col0 = ((pn - 40) & 15) * BM + wc * 32 + 8 * fq;
            store<2>(acc, O, 4096, row0, col0); }
    }
};
struct EpiQKV {
    static constexpr bool PERM = true;
    bf16_t* base; int M; float sc; unsigned char* ga8; unsigned char* gb8;
    __device__ __forceinline__ void store_gate(const f32x4 (&acc)[2][2][4][2], unsigned char* O8, int T, int wr, int wc, int fr, int fq) const {
#pragma unroll
        for (int ai = 0; ai < 2; ++ai)
#pragma unroll
            for (int m = 0; m < 4; ++m)
#pragma unroll
                for (int bj = 0; bj < 2; ++bj) { const f32x4 v0 = sigm4(acc[ai][bj][m][0] * sc), v1 = sigm4(acc[ai][bj][m][1] * sc);
                    *(u32x2*)(O8 + lane_tile_idx(T, wr, wc, fr, fq, ai, m, bj) * 8) = (u32x2){pack_u8x4(v0), pack_u8x4(v1)}; }
    }
    __device__ __forceinline__ bool keep(const Unit&) const { return false; }
    template <int ACT> __device__ __forceinline__ void store(const f32x4 (&acc)[2][2][4][2], bf16_t* O, int ldc, int row0, int col0) const {
#pragma unroll
        for (int ai = 0; ai < 2; ++ai)
#pragma unroll
            for (int m = 0; m < 4; ++m) { bf16_t* rowp = O + (size_t)(row0 + ai * HALF + m * 16) * ldc + col0;
#pragma unroll
                for (int bj = 0; bj < 2; ++bj) { f32x4 v0 = acc[ai][bj][m][0] * sc, v1 = acc[ai][bj][m][1] * sc;
                    if (ACT == 2) { v0 = sigm4(v0); v1 = sigm4(v1); }
                    *(u32x4*)(rowp + bj * HALF) = pack8(v0, v1); } }
    }
    __device__ __forceinline__ void operator()(f32x4 (&acc)[2][2][4][2], const Unit& u, int wr, int wc, int fr, int fq) const {
        const int row0 = u.pm * BM + wr * 64 + fr;
        if (u.pn < 40) store<0>(acc, base + (size_t)(u.pn >> 3) * M * 2048, 2048, row0, (u.pn & 7) * BM + wc * 32 + 8 * fq);
        else store_gate(acc, u.pn < 56 ? ga8 : gb8, u.pm * 16 + ((u.pn - 40) & 15), wr, wc, fr, fq);
    }
};
struct EpiTB {
    static constexpr bool PERM = true;
    const unsigned char* GB; bf16_t* T; float sc;
    __device__ __forceinline__ bool keep(const Unit&) const { return false; }
    __device__ __forceinline__ void operator()(f32x4 (&acc)[2][2][4][2], const Unit& u, int wr, int wc, int fr, int fq) const {
        const int row0 = u.pm * BM + wr * 64 + fr, col0 = u.pn * BM + wc * 32 + 8 * fq;
#pragma unroll
        for (int ai = 0; ai < 2; ++ai)
#pragma unroll
            for (int m = 0; m < 4; ++m) { const size_t off = (size_t)(row0 + ai * HALF + m * 16) * 4096 + col0;
#pragma unroll
                for (int bj = 0; bj < 2; ++bj) { const u32x2 b = *(const u32x2*)(GB + off + bj * HALF);
                    const f32x4 s0 = unpack_u8x4(b.x) * sc, s1 = unpack_u8x4(b.y) * sc;
                    *(u32x4*)(T + off + bj * HALF) = pack8(acc[ai][bj][m][0] * s0, acc[ai][bj][m][1] * s1); } }
    }
};
struct EpiMergeA {
    static constexpr bool PERM = true;
    const unsigned char* GA; const bf16_t* T; bf16_t* O;
    __device__ __forceinline__ bool keep(const Unit&) const { return false; }
    __device__ __forceinline__ void operator()(f32x4 (&acc)[2][2][4][2], const Unit& u, int wr, int wc, int fr, int fq) const {
        const int row0 = u.pm * BM + wr * 64 + fr, col0 = u.pn * BM + wc * 32 + 8 * fq;
#pragma unroll
        for (int ai = 0; ai < 2; ++ai)
#pragma unroll
            for (int m = 0; m < 4; ++m) { const size_t off = (size_t)(row0 + ai * HALF + m * 16) * 4096 + col0;
#pragma unroll
                for (int bj = 0; bj < 2; ++bj) { const u32x2 a = *(const u32x2*)(GA + off + bj * HALF); const u32x4 t = *(const u32x4*)(T + off + bj * HALF);
                    const f32x4 s0 = unpack_u8x4(a.x) * (1.f / 255.f), s1 = unpack_u8x4(a.y) * (1.f / 255.f);
                    const f32x4 t0 = (f32x4){bf_lo(t.x), bf_hi(t.x), bf_lo(t.y), bf_hi(t.y)}, t1 = (f32x4){bf_lo(t.z), bf_hi(t.z), bf_lo(t.w), bf_hi(t.w)};
                    *(u32x4*)(O + off + bj * HALF) = pack8(acc[ai][bj][m][0] * s0 + t0, acc[ai][bj][m][1] * s1 + t1); } }
    }
};
struct EpiMix {
    static constexpr bool PERM = true;
    const unsigned char* GA; const unsigned char* GB; bf16_t* O; float c;
    __device__ __forceinline__ bool keep(const Unit& u) const { return u.sub == 0; }
    __device__ __forceinline__ void operator()(f32x4 (&acc)[2][2][4][2], const Unit& u, int wr, int wc, int fr, int fq) const {
        const int row0 = u.pm * BM + wr * 64 + fr, col0 = u.pn * BM + wc * 32 + 8 * fq;
        if (u.sub == 0) {
#pragma unroll
            for (int ai = 0; ai < 2; ++ai)
#pragma unroll
                for (int m = 0; m < 4; ++m) { const size_t off = (size_t)(row0 + ai * HALF + m * 16) * 4096 + col0;
#pragma unroll
                    for (int bj = 0; bj < 2; ++bj) { const size_t gi = lane_tile_idx(u.pm * 16 + u.pn, wr, wc, fr, fq, ai, m, bj) * 8; (void)off; const u32x2 a = *(const u32x2*)(GA + gi), b = *(const u32x2*)(GB + gi);
                        f32x4 a0 = __builtin_elementwise_max(unpack_u8x4(a.x), (f32x4){9.5367431640625e-7f, 9.5367431640625e-7f, 9.5367431640625e-7f, 9.5367431640625e-7f});
                        f32x4 a1 = __builtin_elementwise_max(unpack_u8x4(a.y), (f32x4){9.5367431640625e-7f, 9.5367431640625e-7f, 9.5367431640625e-7f, 9.5367431640625e-7f});
                        const f32x4 r0 = (f32x4){__builtin_amdgcn_rcpf(a0[0]), __builtin_amdgcn_rcpf(a0[1]), __builtin_amdgcn_rcpf(a0[2]), __builtin_amdgcn_rcpf(a0[3])};
                        const f32x4 r1 = (f32x4){__builtin_amdgcn_rcpf(a1[0]), __builtin_amdgcn_rcpf(a1[1]), __builtin_amdgcn_rcpf(a1[2]), __builtin_amdgcn_rcpf(a1[3])};
                        acc[ai][bj][m][0] = acc[ai][bj][m][0] * (unpack_u8x4(b.x) * c) * r0; acc[ai][bj][m][1] = acc[ai][bj][m][1] * (unpack_u8x4(b.y) * c) * r1; } }
        } else {
#pragma unroll
            for (int ai = 0; ai < 2; ++ai)
#pragma unroll
                for (int m = 0; m < 4; ++m) { const size_t off = (size_t)(row0 + ai * HALF + m * 16) * 4096 + col0;
#pragma unroll
                    for (int bj = 0; bj < 2; ++bj) { const u32x2 a = *(const u32x2*)(GA + lane_tile_idx(u.pm * 16 + u.pn, wr, wc, fr, fq, ai, m, bj) * 8);
                        const f32x4 a0 = __builtin_elementwise_max(unpack_u8x4(a.x), (f32x4){9.5367431640625e-7f, 9.5367431640625e-7f, 9.5367431640625e-7f, 9.5367431640625e-7f}) * (1.f / 255.f);
                        const f32x4 a1 = __builtin_elementwise_max(unpack_u8x4(a.y), (f32x4){9.5367431640625e-7f, 9.5367431640625e-7f, 9.5367431640625e-7f, 9.5367431640625e-7f}) * (1.f / 255.f);
                        *(u32x4*)((char*)O + blk_off(row0 + ai * HALF + m * 16, (col0 + bj * HALF) * 2, 8192)) = pack8(acc[ai][bj][m][0] * a0, acc[ai][bj][m][1] * a1); (void)off; } }
        }
    }
};
__device__ __forceinline__ float sb_lo(unsigned w) { return fmaxf(bf_lo(w), 8.673617379884035e-19f); }
__device__ __forceinline__ float sb_hi(unsigned w) { return fmaxf(bf_hi(w), 8.673617379884035e-19f); }
struct EpiMerge {
    static constexpr bool PERM = true;
    const bf16_t* GA; const bf16_t* GB; bf16_t* O;
    __device__ __forceinline__ bool keep(const Unit& u) const { return u.sub == 0; }
    __device__ __forceinline__ void operator()(f32x4 (&acc)[2][2][4][2], const Unit& u, int wr, int wc, int fr, int fq) const {
        const int row0 = u.pm * BM + wr * 64 + fr, col0 = u.pn * BM + wc * 32 + 8 * fq;
        if (u.sub == 0) {
#pragma unroll
            for (int ai = 0; ai < 2; ++ai)
#pragma unroll
                for (int m = 0; m < 4; ++m) { const size_t off = (size_t)(row0 + ai * HALF + m * 16) * 4096 + col0;
#pragma unroll
                    for (int bj = 0; bj < 2; ++bj) { const u32x4 a = *(const u32x4*)(GA + off + bj * HALF), b = *(const u32x4*)(GB + off + bj * HALF);
                        f32x4 r0, r1;
                        r0[0] = bf_lo(a.x) * __builtin_amdgcn_rcpf(sb_lo(b.x)); r0[1] = bf_hi(a.x) * __builtin_amdgcn_rcpf(sb_hi(b.x));
                        r0[2] = bf_lo(a.y) * __builtin_amdgcn_rcpf(sb_lo(b.y)); r0[3] = bf_hi(a.y) * __builtin_amdgcn_rcpf(sb_hi(b.y));
                        r1[0] = bf_lo(a.z) * __builtin_amdgcn_rcpf(sb_lo(b.z)); r1[1] = bf_hi(a.z) * __builtin_amdgcn_rcpf(sb_hi(b.z));
                        r1[2] = bf_lo(a.w) * __builtin_amdgcn_rcpf(sb_lo(b.w)); r1[3] = bf_hi(a.w) * __builtin_amdgcn_rcpf(sb_hi(b.w));
                        acc[ai][bj][m][0] *= r0; acc[ai][bj][m][1] *= r1; } }
        } else {
#pragma unroll
            for (int ai = 0; ai < 2; ++ai)
#pragma unroll
                for (int m = 0; m < 4; ++m) { const size_t off = (size_t)(row0 + ai * HALF + m * 16) * 4096 + col0;
#pragma unroll
                    for (int bj = 0; bj < 2; ++bj) { const u32x4 b = *(const u32x4*)(GB + off + bj * HALF);
                        const f32x4 s0 = (f32x4){sb_lo(b.x), sb_hi(b.x), sb_lo(b.y), sb_hi(b.y)}, s1 = (f32x4){sb_lo(b.z), sb_hi(b.z), sb_lo(b.w), sb_hi(b.w)};
                        *(u32x4*)(O + off + bj * HALF) = pack8(acc[ai][bj][m][0] * s0, acc[ai][bj][m][1] * s1); } }
        }
    }
};
struct EpiResF32 {
    static constexpr bool PERM = false;
    const float* res; float* out;
    __device__ __forceinline__ bool keep(const Unit&) const { return false; }
    __device__ __forceinline__ void operator()(f32x4 (&acc)[2][2][4][2], const Unit& u, int wr, int wc, int fr, int fq) const {
        const int row0 = u.pm * BM + wr * 64 + fr, col0 = u.pn * BM + wc * 32 + 4 * fq;
#pragma unroll
        for (int ai = 0; ai < 2; ++ai)
#pragma unroll
            for (int m = 0; m < 4; ++m) { const size_t off = (size_t)(row0 + ai * HALF + m * 16) * 4096 + col0;
#pragma unroll
                for (int bj = 0; bj < 2; ++bj)
#pragma unroll
                    for (int n = 0; n < 2; ++n) { const f32x4 r = *(const f32x4*)(res + off + bj * HALF + n * 16); *(f32x4*)(out + off + bj * HALF + n * 16) = r + acc[ai][bj][m][n]; } }
    }
};
struct EpiResH16 {
    static constexpr bool PERM = true;
    const bf16_t* h16; float* out;
    __device__ __forceinline__ bool keep(const Unit&) const { return false; }
    __device__ __forceinline__ void operator()(f32x4 (&acc)[2][2][4][2], const Unit& u, int wr, int wc, int fr, int fq) const {
        const int row0 = u.pm * BM + wr * 64 + fr, col0 = u.pn * BM + wc * 32 + 8 * fq;
#pragma unroll
        for (int ai = 0; ai < 2; ++ai)
#pragma unroll
            for (int m = 0; m < 4; ++m) { const size_t off = (size_t)(row0 + ai * HALF + m * 16) * 4096 + col0;
#pragma unroll
                for (int bj = 0; bj < 2; ++bj) { const u32x4 hb = *(const u32x4*)(h16 + lane_tile_idx(u.pm * 16 + u.pn, wr, wc, fr, fq, ai, m, bj) * 8);
                    const f32x4 h0 = (f32x4){bf_lo(hb.x), bf_hi(hb.x), bf_lo(hb.y), bf_hi(hb.y)}, h1 = (f32x4){bf_lo(hb.z), bf_hi(hb.z), bf_lo(hb.w), bf_hi(hb.w)};
                    *(f32x4*)(out + off + bj * HALF) = h0 + acc[ai][bj][m][0]; *(f32x4*)(out + off + bj * HALF + 4) = h1 + acc[ai][bj][m][1]; } }
    }
};
struct EpiOutNorm {
    static constexpr bool PERM = true;
    const float* x; bf16_t* h16; bf16_t* HN; const float* g2; float* part;
    __device__ __forceinline__ bool keep(const Unit&) const { return false; }
    __device__ __forceinline__ void operator()(f32x4 (&acc)[2][2][4][2], const Unit& u, int wr, int wc, int fr, int fq) const {
        const int row0 = u.pm * BM + wr * 64 + fr, col0 = u.pn * BM + wc * 32 + 8 * fq;
        f32x4 gg[2][2];
#pragma unroll
        for (int bj = 0; bj < 2; ++bj)
#pragma unroll
            for (int n = 0; n < 2; ++n) gg[bj][n] = *(const f32x4*)(g2 + col0 + bj * HALF + 4 * n);
#pragma unroll
        for (int ai = 0; ai < 2; ++ai)
#pragma unroll
            for (int m = 0; m < 4; ++m) { const int row = row0 + ai * HALF + m * 16; const size_t off = (size_t)row * 4096 + col0; float ss = 0.f;
#pragma unroll
                for (int bj = 0; bj < 2; ++bj) { const f32x4 x0 = *(const f32x4*)(x + off + bj * HALF), x1 = *(const f32x4*)(x + off + bj * HALF + 4);
                    const f32x4 h0 = x0 + acc[ai][bj][m][0], h1 = x1 + acc[ai][bj][m][1];
                    *(u32x4*)(h16 + lane_tile_idx(u.pm * 16 + u.pn, wr, wc, fr, fq, ai, m, bj) * 8) = pack8(h0, h1);
                    ss += ((h0[0] * h0[0] + h0[1] * h0[1]) + (h0[2] * h0[2] + h0[3] * h0[3])) + ((h1[0] * h1[0] + h1[1] * h1[1]) + (h1[2] * h1[2] + h1[3] * h1[3]));
                    *(u32x4*)((char*)HN + blk_off(row, (col0 + bj * HALF) * 2, 8192)) = pack8(h0 * gg[bj][0], h1 * gg[bj][1]); }
                ss += __shfl_xor(ss, 16); ss += __shfl_xor(ss, 32);
                if (fq == 0) part[(size_t)row * 64 + u.pn * 4 + wc] = ss; }
    }
};
struct EpiSwiglu {
    static constexpr bool PERM = true; static constexpr int NST = 4;
    bf16_t* O; int ldc; const PG8_LAS float* rstd; int fm;
    __device__ __forceinline__ bool keep(const Unit&) const { return false; }
    template <int AI> __device__ __forceinline__ void half(const f32x4 (&acc)[2][2][4][2], const Unit& u, int wr, int wc, int fr, int fq) const {
        const int row0 = u.pm * BM + wr * 64 + fr, col0 = u.pn * HALF + wc * 32 + 8 * fq, rl0 = (u.pm - fm) * BM + wr * 64 + fr;
#pragma unroll
        for (int m = 0; m < 4; ++m) { bf16_t* rowp = (bf16_t*)((char*)O + blk_off(row0 + AI * HALF + m * 16, col0 * 2, ldc * 2)); const float r = rstd[rl0 + AI * HALF + m * 16];
            const f32x4 g0 = acc[AI][0][m][0] * r, g1 = acc[AI][0][m][1] * r;
            const f32x4 v0 = g0 * sigm4(g0) * (acc[AI][1][m][0] * r), v1 = g1 * sigm4(g1) * (acc[AI][1][m][1] * r);
            *(u32x4*)rowp = pack8(v0, v1); }
    }
    __device__ __forceinline__ void operator()(f32x4 (&acc)[2][2][4][2], const Unit& u, int wr, int wc, int fr, int fq) const { half<0>(acc, u, wr, wc, fr, fq); half<1>(acc, u, wr, wc, fr, fq); }
};

template <class Epi, class Sched, bool ALIGN_EPI, bool SP2>
__device__ __forceinline__ void gemm_phase(PG8_LAS unsigned char* lds, const int K, const Sched& S, const Epi& E) {
    const int tid = opaque_tid(), wid = __builtin_amdgcn_readfirstlane(tid >> 6), lane = tid & 63, wr = wid >> 2, wc = wid & 3, fr = lane & 15, fq = lane >> 4;
    const int nt = K / BK;
    unsigned voffA[2], voffB[2];
#pragma unroll
    for (int i = 0; i < 2; ++i) { int R, C; stage_rc(tid * 16 + i * 8192, R, C); const int Rb = Epi::PERM ? ((R & ~31) + perm32(R & 31)) : R;
        voffA[i] = (unsigned)(R * 128 + C * 2); voffB[i] = (unsigned)(Rb * 128 + C * 2); }
    const size_t kstep = 32768;
    const size_t hstep = (size_t)HALF * 128;
    const unsigned ldsw = (unsigned)wid * 1024u;
    const int aoff = lds_byte(wr * 64 + fr, fq * 8), boff = lds_byte(wc * 32 + fr, fq * 8);
#define PG8_SA(b, h) (((b) * 2 + (h)) * HTB)
#define PG8_SB(b, h) ((4 + (b) * 2 + (h)) * HTB)
#define PG8_STAGE(bufoff, gbase, voff) do { _Pragma("unroll") for (int _i = 0; _i < 2; ++_i) \
        __builtin_amdgcn_global_load_lds((const unsigned*)((const char*)(gbase) + (voff)[_i]), (PG8_LAS unsigned*)(lds + (bufoff) + ldsw + _i * 8192), 16, 0, 0); } while (0)
#define PG8_LDA(dst, b, h) do { _Pragma("unroll") for (int m = 0; m < 4; ++m) _Pragma("unroll") for (int k = 0; k < 2; ++k) dst[m][k] = *(const PG8_LAS bf16x8*)(lds + PG8_SA(b, h) + aoff + m * 2048 + k * 1024); } while (0)
#define PG8_LDB(dst, b, h) do { _Pragma("unroll") for (int n = 0; n < 2; ++n) _Pragma("unroll") for (int k = 0; k < 2; ++k) dst[n][k] = *(const PG8_LAS bf16x8*)(lds + PG8_SB(b, h) + boff + n * 2048 + k * 1024); } while (0)
#define PG8_MMA(ai, bj, At, Bt) do { __builtin_amdgcn_s_setprio(1); _Pragma("unroll") for (int m = 0; m < 4; ++m) _Pragma("unroll") for (int n = 0; n < 2; ++n) _Pragma("unroll") for (int k = 0; k < 2; ++k) \
        acc[ai][bj][m][n] = __builtin_amdgcn_mfma_f32_16x16x32_bf16(Bt[n][k], At[m][k], acc[ai][bj][m][n], 0, 0, 0); __builtin_amdgcn_s_setprio(0); } while (0)
#define PG8_WAIT_V(n) asm volatile("s_waitcnt vmcnt(" #n ")" ::: "memory")
#define PG8_WAIT_L(n) asm volatile("s_waitcnt lgkmcnt(" #n ")" ::: "memory")
#define PG8_BAR __builtin_amdgcn_s_barrier()
#define PG8_SCHED __builtin_amdgcn_sched_barrier(0)
    Unit cur, nxt; int ui = 0;
    if (!S.next(0, cur)) return;
    f32x4 acc[2][2][4][2];
#pragma unroll
    for (int a = 0; a < 2; ++a)
#pragma unroll
        for (int b = 0; b < 2; ++b)
#pragma unroll
            for (int m = 0; m < 4; ++m)
#pragma unroll
                for (int n = 0; n < 2; ++n) acc[a][b][m][n] = (f32x4){0.f, 0.f, 0.f, 0.f};
    bf16x8 At[4][2], B0[2][2], B1[2][2];
    const char* cA; const char* cB; S.ptrs(cur, cA, cB);
    if constexpr (SP2) {
        PG8_STAGE(PG8_SB(0, 0), cB, voffB); PG8_STAGE(PG8_SB(0, 1), cB + hstep, voffB); PG8_STAGE(PG8_SA(0, 0), cA, voffA); PG8_STAGE(PG8_SA(0, 1), cA + hstep, voffA);
        if (wr == 1) PG8_BAR;
        PG8_WAIT_V(2); PG8_BAR;
        PG8_STAGE(PG8_SB(1, 0), cB + kstep, voffB); PG8_STAGE(PG8_SA(1, 0), cA + kstep, voffA); PG8_STAGE(PG8_SB(1, 1), cB + hstep + kstep, voffB);
        PG8_WAIT_V(6); PG8_BAR;
    } else {
        PG8_STAGE(PG8_SB(0, 0), cB, voffB); PG8_STAGE(PG8_SA(0, 0), cA, voffA); PG8_STAGE(PG8_SB(0, 1), cB + hstep, voffB); PG8_STAGE(PG8_SA(0, 1), cA + hstep, voffA);
        if (wr == 1) PG8_BAR;
        PG8_WAIT_V(4); PG8_BAR;
        PG8_STAGE(PG8_SB(1, 0), cB + kstep, voffB); PG8_STAGE(PG8_SA(1, 0), cA + kstep, voffA); PG8_STAGE(PG8_SB(1, 1), cB + hstep + kstep, voffB);
        PG8_WAIT_V(6); PG8_BAR;
    }
    for (;;) {
        const bool has_next = S.next(ui + 1, nxt);
        const char* nA = cA; const char* nB = cB; if (has_next) S.ptrs(nxt, nA, nB);
        for (int t = 0; t < nt; t += 2) {
            const bool last = (t == nt - 2);
            const char* a1 = cA + (size_t)(t + 1) * kstep;
            const char* a2 = last ? nA : cA + (size_t)(t + 2) * kstep; const char* b2 = last ? nB : cB + (size_t)(t + 2) * kstep;
            const char* a3 = a2 + kstep; const char* b3 = b2 + kstep;
            if constexpr (SP2) {
            PG8_LDB(B0, 0, 0); PG8_LDB(B1, 0, 1); PG8_SCHED; PG8_LDA(At, 0, 0); PG8_STAGE(PG8_SA(1, 1), a1 + hstep, voffA);
            PG8_WAIT_V(8); PG8_WAIT_L(0); PG8_BAR; PG8_MMA(0, 0, At, B0); PG8_MMA(0, 1, At, B1); PG8_BAR; PG8_SCHED;
            PG8_LDA(At, 0, 1); PG8_STAGE(PG8_SB(0, 0), b2, voffB); PG8_STAGE(PG8_SB(0, 1), b2 + hstep, voffB); PG8_STAGE(PG8_SA(0, 0), a2, voffA);
            PG8_WAIT_V(8); PG8_WAIT_L(0); PG8_BAR; PG8_MMA(1, 0, At, B0); PG8_MMA(1, 1, At, B1); PG8_BAR; PG8_SCHED;
            PG8_LDB(B0, 1, 0); PG8_LDB(B1, 1, 1); PG8_SCHED; PG8_LDA(At, 1, 0); PG8_STAGE(PG8_SA(0, 1), a2 + hstep, voffA);
            PG8_WAIT_V(8); PG8_WAIT_L(0); PG8_BAR; PG8_MMA(0, 0, At, B0); PG8_MMA(0, 1, At, B1); PG8_BAR; PG8_SCHED;
            PG8_LDA(At, 1, 1); PG8_STAGE(PG8_SB(1, 0), b3, voffB); PG8_STAGE(PG8_SB(1, 1), b3 + hstep, voffB); PG8_STAGE(PG8_SA(1, 0), a3, voffA);
            PG8_WAIT_V(8); PG8_WAIT_L(0); PG8_BAR; PG8_MMA(1, 0, At, B0); PG8_MMA(1, 1, At, B1); PG8_BAR; PG8_SCHED;
            } else {
            PG8_LDB(B0, 0, 0); PG8_SCHED; PG8_LDA(At, 0, 0); PG8_STAGE(PG8_SA(1, 1), a1 + hstep, voffA);
            PG8_WAIT_L(8); PG8_BAR; PG8_WAIT_L(0); PG8_MMA(0, 0, At, B0); PG8_BAR; PG8_SCHED;
            PG8_LDB(B1, 0, 1); PG8_STAGE(PG8_SB(0, 0), b2, voffB);
            PG8_BAR; PG8_WAIT_L(0); PG8_MMA(0, 1, At, B1); PG8_BAR;
            PG8_LDA(At, 0, 1); PG8_STAGE(PG8_SA(0, 0), a2, voffA);
            PG8_BAR; PG8_WAIT_L(0); PG8_MMA(1, 0, At, B0); PG8_BAR; PG8_SCHED;
            PG8_STAGE(PG8_SB(0, 1), b2 + hstep, voffB);
            PG8_WAIT_V(6); PG8_BAR; PG8_MMA(1, 1, At, B1); PG8_BAR;
            PG8_LDB(B0, 1, 0); PG8_SCHED; PG8_LDA(At, 1, 0); PG8_STAGE(PG8_SA(0, 1), a2 + hstep, voffA);
            PG8_WAIT_L(8); PG8_BAR; PG8_WAIT_L(0); PG8_MMA(0, 0, At, B0); PG8_BAR; PG8_SCHED;
            PG8_LDB(B1, 1, 1); PG8_STAGE(PG8_SB(1, 0), b3, voffB);
            PG8_BAR; PG8_WAIT_L(0); PG8_MMA(0, 1, At, B1); PG8_BAR;
            PG8_LDA(At, 1, 1); PG8_STAGE(PG8_SA(1, 0), a3, voffA);
            PG8_BAR; PG8_WAIT_L(0); PG8_MMA(1, 0, At, B0); PG8_BAR; PG8_SCHED;
            PG8_STAGE(PG8_SB(1, 1), b3 + hstep, voffB);
            PG8_WAIT_V(6); PG8_BAR; PG8_MMA(1, 1, At, B1); PG8_BAR;
            }
        }
        if constexpr (ALIGN_EPI) { if (wr == 0) PG8_BAR; }
        E(acc, cur, wr, wc, fr, fq);
        if (!has_next) break;
        if (!E.keep(cur)) {
#pragma unroll
            for (int a = 0; a < 2; ++a)
#pragma unroll
                for (int b = 0; b < 2; ++b)
#pragma unroll
                    for (int m = 0; m < 4; ++m)
#pragma unroll
                        for (int n = 0; n < 2; ++n) acc[a][b][m][n] = (f32x4){0.f, 0.f, 0.f, 0.f};
        }
        cur = nxt; cA = nA; cB = nB; ++ui;
        if constexpr (ALIGN_EPI) { if (wr == 1) PG8_BAR; }
    }
    PG8_WAIT_V(0);
    if constexpr (!ALIGN_EPI) { if (wr == 0) PG8_BAR; }
    PG8_BAR;
#undef PG8_SA
#undef PG8_SB
#undef PG8_STAGE
#undef PG8_LDA
#undef PG8_LDB
#undef PG8_MMA
#undef PG8_WAIT_V
#undef PG8_WAIT_L
#undef PG8_BAR
#undef PG8_SCHED
}

typedef int i32x4 __attribute__((ext_vector_type(4)));
typedef int i32x8 __attribute__((ext_vector_type(8)));
template <class Epi, class Sched>
__device__ __forceinline__ void gemm_phase_f8(PG8_LAS unsigned char* lds, const int K, const Sched& S, const Epi& E) {
    const int tid = opaque_tid(), wid = __builtin_amdgcn_readfirstlane(tid >> 6), lane = tid & 63, wr = wid >> 2, wc = wid & 3, fr = lane & 15, fq = lane >> 4;
    const int nt = K / 128;
    unsigned voffA[2], voffB[2];
#pragma unroll
    for (int i = 0; i < 2; ++i) { int R, C; stage_rc(tid * 16 + i * 8192, R, C); const int Rb = Epi::PERM ? ((R & ~31) + perm32(R & 31)) : R;
        voffA[i] = (unsigned)(R * 128 + 2 * C); voffB[i] = (unsigned)(Rb * 128 + 2 * C); }
    const size_t kstep = 32768;
    const size_t hstep = (size_t)HALF * 128;
    const unsigned ldsw = (unsigned)wid * 1024u;
    const int aoff = lds_byte(wr * 64 + fr, fq * 16), boff = lds_byte(wc * 32 + fr, fq * 16);
#define PG8_SA(b, h) (((b) * 2 + (h)) * HTB)
#define PG8_SB(b, h) ((4 + (b) * 2 + (h)) * HTB)
#define PG8_STAGE(bufoff, gbase, voff) do { _Pragma("unroll") for (int _i = 0; _i < 2; ++_i) \
        __builtin_amdgcn_global_load_lds((const unsigned*)((const char*)(gbase) + (voff)[_i]), (PG8_LAS unsigned*)(lds + (bufoff) + ldsw + _i * 8192), 16, 0, 0); } while (0)
#define PG8_LD8(dst, off) do { const i32x4 _lo = *(const PG8_LAS i32x4*)(lds + (off)), _hi = *(const PG8_LAS i32x4*)(lds + (off) + 16); dst = __builtin_shufflevector(_lo, _hi, 0, 1, 2, 3, 4, 5, 6, 7); } while (0)
#define PG8_LDA(dst, b, h) do { _Pragma("unroll") for (int m = 0; m < 4; ++m) PG8_LD8(dst[m], PG8_SA(b, h) + aoff + m * 2048); } while (0)
#define PG8_LDB(dst, b, h) do { _Pragma("unroll") for (int n = 0; n < 2; ++n) PG8_LD8(dst[n], PG8_SB(b, h) + boff + n * 2048); } while (0)
#define PG8_MMA(ai, bj, At, Bt) do { __builtin_amdgcn_s_setprio(1); _Pragma("unroll") for (int m = 0; m < 4; ++m) _Pragma("unroll") for (int n = 0; n < 2; ++n) \
        asm volatile("v_mfma_scale_f32_16x16x128_f8f6f4 %0, %1, %2, %0, %3, %3 op_sel_hi:[0,0,0]" : "+v"(acc[ai][bj][m][n]) : "v"(Bt[n]), "v"(At[m]), "v"(f8_unit_scale)); __builtin_amdgcn_s_setprio(0); } while (0)
#define PG8_WAIT_V(n) asm volatile("s_waitcnt vmcnt(" #n ")" ::: "memory")
#define PG8_WAIT_L(n) asm volatile("s_waitcnt lgkmcnt(" #n ")" ::: "memory")
#define PG8_BAR __builtin_amdgcn_s_barrier()
#define PG8_SCHED __builtin_amdgcn_sched_barrier(0)
    Unit cur, nxt; int ui = 0;
    if (!S.next(0, cur)) return;
    f32x4 acc[2][2][4][2];
#pragma unroll
    for (int a = 0; a < 2; ++a)
#pragma unroll
        for (int b = 0; b < 2; ++b)
#pragma unroll
            for (int m = 0; m < 4; ++m)
#pragma unroll
                for (int n = 0; n < 2; ++n) acc[a][b][m][n] = (f32x4){0.f, 0.f, 0.f, 0.f};
    i32x8 At[4], B0[2], B1[2];
    const int f8_unit_scale = 0x7f7f7f7f;
    const char* cA; const char* cB; S.ptrs(cur, cA, cB);
    PG8_STAGE(PG8_SB(0, 0), cB, voffB); PG8_STAGE(PG8_SB(0, 1), cB + hstep, voffB); PG8_STAGE(PG8_SA(0, 0), cA, voffA); PG8_STAGE(PG8_SA(0, 1), cA + hstep, voffA);
    if (wr == 1) PG8_BAR;
    PG8_WAIT_V(2); PG8_BAR;
    PG8_STAGE(PG8_SB(1, 0), cB + kstep, voffB); PG8_STAGE(PG8_SA(1, 0), cA + kstep, voffA); PG8_STAGE(PG8_SB(1, 1), cB + hstep + kstep, voffB);
    PG8_WAIT_V(6); PG8_BAR;
    for (;;) {
        const bool has_next = S.next(ui + 1, nxt);
        const char* nA = cA; const char* nB = cB; if (has_next) S.ptrs(nxt, nA, nB);
        for (int t = 0; t < nt; t += 2) {
            const bool last = (t == nt - 2);
            const char* a1 = cA + (size_t)(t + 1) * kstep;
            const char* a2 = last ? nA : cA + (size_t)(t + 2) * kstep; const char* b2 = last ? nB : cB + (size_t)(t + 2) * kstep;
            const char* a3 = a2 + kstep; const char* b3 = b2 + kstep;
            PG8_LDB(B0, 0, 0); PG8_LDB(B1, 0, 1); PG8_SCHED; PG8_LDA(At, 0, 0); PG8_STAGE(PG8_SA(1, 1), a1 + hstep, voffA);
            PG8_WAIT_V(8); PG8_WAIT_L(0); PG8_BAR; PG8_MMA(0, 0, At, B0); PG8_MMA(0, 1, At, B1); PG8_BAR; PG8_SCHED;
            PG8_LDA(At, 0, 1); PG8_STAGE(PG8_SB(0, 0), b2, voffB); PG8_STAGE(PG8_SB(0, 1), b2 + hstep, voffB); PG8_STAGE(PG8_SA(0, 0), a2, voffA);
            PG8_WAIT_V(8); PG8_WAIT_L(0); PG8_BAR; PG8_MMA(1, 0, At, B0); PG8_MMA(1, 1, At, B1); PG8_BAR; PG8_SCHED;
            PG8_LDB(B0, 1, 0); PG8_LDB(B1, 1, 1); PG8_SCHED; PG8_LDA(At, 1, 0); PG8_STAGE(PG8_SA(0, 1), a2 + hstep, voffA);
            PG8_WAIT_V(8); PG8_WAIT_L(0); PG8_BAR; PG8_MMA(0, 0, At, B0); PG8_MMA(0, 1, At, B1); PG8_BAR; PG8_SCHED;
            PG8_LDA(At, 1, 1); PG8_STAGE(PG8_SB(1, 0), b3, voffB); PG8_STAGE(PG8_SB(1, 1), b3 + hstep, voffB); PG8_STAGE(PG8_SA(1, 0), a3, voffA);
            PG8_WAIT_V(8); PG8_WAIT_L(0); PG8_BAR; PG8_MMA(1, 0, At, B0); PG8_MMA(1, 1, At, B1); PG8_BAR; PG8_SCHED;
        }
        if (wr == 0) PG8_BAR;
        { const int t2 = opaque_tid(), w2 = __builtin_amdgcn_readfirstlane(t2 >> 6); E(acc, cur, w2 >> 2, w2 & 3, t2 & 15, (t2 & 63) >> 4); }
        if (!has_next) break;
#pragma unroll
        for (int a = 0; a < 2; ++a)
#pragma unroll
            for (int b = 0; b < 2; ++b)
#pragma unroll
                for (int m = 0; m < 4; ++m)
#pragma unroll
                    for (int n = 0; n < 2; ++n) acc[a][b][m][n] = (f32x4){0.f, 0.f, 0.f, 0.f};
        cur = nxt; cA = nA; cB = nB; ++ui;
        if (wr == 1) PG8_BAR;
    }
    PG8_WAIT_V(0);
    PG8_BAR;
#undef PG8_SA
#undef PG8_SB
#undef PG8_STAGE
#undef PG8_LD8
#undef PG8_LDA
#undef PG8_LDB
#undef PG8_MMA
#undef PG8_WAIT_V
#undef PG8_WAIT_L
#undef PG8_BAR
#undef PG8_SCHED
}

template <class Epi, class Sched>
__device__ __forceinline__ void gemm_phase_mix(PG8_LAS unsigned char* lds, const int P, const int nt8, const int nt16, const Sched& S, const Epi& E) {
    const int tid = opaque_tid(), wid = __builtin_amdgcn_readfirstlane(tid >> 6), lane = tid & 63, wr = wid >> 2, wc = wid & 3, fr = lane & 15, fq = lane >> 4;
    unsigned voffA[2], voffB[2];
#pragma unroll
    for (int i = 0; i < 2; ++i) { int R, C; stage_rc(tid * 16 + i * 8192, R, C); const int Rb = Epi::PERM ? ((R & ~31) + perm32(R & 31)) : R;
        voffA[i] = (unsigned)(R * 128 + 2 * C); voffB[i] = (unsigned)(Rb * 128 + 2 * C); }
    const size_t kstep = 32768;
    const size_t hstep = (size_t)HALF * 128;
    const unsigned ldsw = (unsigned)wid * 1024u;
#define PG8_SA(b, h) (((b) * 2 + (h)) * HTB)
#define PG8_SB(b, h) ((4 + (b) * 2 + (h)) * HTB)
#define PG8_STAGE(bufoff, gbase, voff) do { _Pragma("unroll") for (int _i = 0; _i < 2; ++_i) \
        __builtin_amdgcn_global_load_lds((const unsigned*)((const char*)(gbase) + (voff)[_i]), (PG8_LAS unsigned*)(lds + (bufoff) + ldsw + _i * 8192), 16, 0, 0); } while (0)
#define PG8_LD8(dst, off) do { const i32x4 _lo = *(const PG8_LAS i32x4*)(lds + (off)), _hi = *(const PG8_LAS i32x4*)(lds + (off) + 16); dst = __builtin_shufflevector(_lo, _hi, 0, 1, 2, 3, 4, 5, 6, 7); } while (0)
#define PG8_LDA8(dst, b, h) do { _Pragma("unroll") for (int m = 0; m < 4; ++m) PG8_LD8(dst[m], PG8_SA(b, h) + aoff8 + m * 2048); } while (0)
#define PG8_LDB8(dst, b, h) do { _Pragma("unroll") for (int n = 0; n < 2; ++n) PG8_LD8(dst[n], (PG8_SB(b, h) - 65536) + boff8 + n * 2048); } while (0)
#define PG8_MMA8(ai, bj, At, Bt) do { __builtin_amdgcn_s_setprio(1); _Pragma("unroll") for (int m = 0; m < 4; ++m) _Pragma("unroll") for (int n = 0; n < 2; ++n) \
        asm volatile("v_mfma_scale_f32_16x16x128_f8f6f4 %0, %1, %2, %0, %3, %3 op_sel_hi:[0,0,0]" : "+v"(acc[ai][bj][m][n]) : "v"(Bt[n]), "v"(At[m]), "v"(f8_unit_scale)); __builtin_amdgcn_s_setprio(0); } while (0)
#define PG8_LDA16(dst, b, h) do { _Pragma("unroll") for (int m = 0; m < 4; ++m) _Pragma("unroll") for (int k = 0; k < 2; ++k) dst[m][k] = *(const PG8_LAS bf16x8*)(lds + PG8_SA(b, h) + aoff16 + m * 2048 + k * 1024); } while (0)
#define PG8_LDB16(dst, b, h) do { _Pragma("unroll") for (int n = 0; n < 2; ++n) _Pragma("unroll") for (int k = 0; k < 2; ++k) dst[n][k] = *(const PG8_LAS bf16x8*)(lds + (PG8_SB(b, h) - 65536) + boff16 + n * 2048 + k * 1024); } while (0)
#define PG8_MMA16(ai, bj, At, Bt) do { __builtin_amdgcn_s_setprio(1); _Pragma("unroll") for (int k = 0; k < 2; ++k) _Pragma("unroll") for (int m = 0; m < 4; ++m) _Pragma("unroll") for (int n = 0; n < 2; ++n) \
        asm volatile("v_mfma_f32_16x16x32_bf16 %0, %1, %2, %0" : "+v"(acc[ai][bj][m][n]) : "v"(Bt[n][k]), "v"(At[m][k])); __builtin_amdgcn_s_setprio(0); } while (0)
#define PG8_WAIT_V(n) asm volatile("s_waitcnt vmcnt(" #n ")" ::: "memory")
#define PG8_WAIT_L(n) asm volatile("s_waitcnt lgkmcnt(" #n ")" ::: "memory")
#define PG8_BAR __builtin_amdgcn_s_barrier()
#define PG8_SCHED __builtin_amdgcn_sched_barrier(0)
#define PG8_KPAIR(LDA_, LDB_, MMA_, At_, B0_, B1_) do { \
            LDB_(B0_, 0, 0); LDB_(B1_, 0, 1); PG8_SCHED; LDA_(At_, 0, 0); PG8_STAGE(PG8_SA(1, 1), a1 + hstep, voffA); \
            PG8_WAIT_V(8); PG8_WAIT_L(0); PG8_BAR; MMA_(0, 0, At_, B0_); MMA_(0, 1, At_, B1_); PG8_BAR; PG8_SCHED; \
            LDA_(At_, 0, 1); PG8_STAGE(PG8_SB(0, 0), b2, voffB); PG8_STAGE(PG8_SB(0, 1), b2 + hstep, voffB); PG8_STAGE(PG8_SA(0, 0), a2, voffA); \
            PG8_WAIT_V(8); PG8_WAIT_L(0); PG8_BAR; MMA_(1, 0, At_, B0_); MMA_(1, 1, At_, B1_); PG8_BAR; PG8_SCHED; \
            LDB_(B0_, 1, 0); LDB_(B1_, 1, 1); PG8_SCHED; LDA_(At_, 1, 0); PG8_STAGE(PG8_SA(0, 1), a2 + hstep, voffA); \
            PG8_WAIT_V(8); PG8_WAIT_L(0); PG8_BAR; MMA_(0, 0, At_, B0_); MMA_(0, 1, At_, B1_); PG8_BAR; PG8_SCHED; \
            LDA_(At_, 1, 1); PG8_STAGE(PG8_SB(1, 0), b3, voffB); PG8_STAGE(PG8_SB(1, 1), b3 + hstep, voffB); PG8_STAGE(PG8_SA(1, 0), a3, voffA); \
            PG8_WAIT_V(8); PG8_WAIT_L(0); PG8_BAR; MMA_(1, 0, At_, B0_); MMA_(1, 1, At_, B1_); PG8_BAR; PG8_SCHED; } while (0)
    Unit cur, nxt; int ui = 0;
    if (!S.o.tile(0, cur)) return;
    f32x4 acc[2][2][4][2];
#pragma unroll
    for (int a = 0; a < 2; ++a)
#pragma unroll
        for (int b = 0; b < 2; ++b)
#pragma unroll
            for (int m = 0; m < 4; ++m)
#pragma unroll
                for (int n = 0; n < 2; ++n) acc[a][b][m][n] = (f32x4){0.f, 0.f, 0.f, 0.f};
    const int f8_unit_scale = 0x7f7f7f7f;
    const char* c8A = S.A0 + (size_t)cur.pm * S.tstep8; const char* c8B = S.B0 + (size_t)cur.pn * S.tstep8;
    PG8_STAGE(PG8_SB(0, 0), c8B, voffB); PG8_STAGE(PG8_SB(0, 1), c8B + hstep, voffB); PG8_STAGE(PG8_SA(0, 0), c8A, voffA); PG8_STAGE(PG8_SA(0, 1), c8A + hstep, voffA);
    if (wr == 1) PG8_BAR;
    PG8_WAIT_V(2); PG8_BAR;
    PG8_STAGE(PG8_SB(1, 0), c8B + kstep, voffB); PG8_STAGE(PG8_SA(1, 0), c8A + kstep, voffA); PG8_STAGE(PG8_SB(1, 1), c8B + hstep + kstep, voffB);
    PG8_WAIT_V(6); PG8_BAR;
    for (;;) {
        const bool has_next = S.o.tile(ui + 1, nxt);
        const char* c16A = S.A1 + (size_t)cur.pm * S.tstep; const char* c16B = S.B1 + (size_t)cur.pn * S.tstep;
        {   i32x8 At[4], B0[2], B1[2];
            const int t8 = opaque_tid(); int aoff8 = lds_byte(((t8 >> 8) & 1) * 64 + (t8 & 15), ((t8 & 63) >> 4) * 16), boff8 = lds_byte(((t8 >> 6) & 3) * 32 + (t8 & 15), ((t8 & 63) >> 4) * 16) + 65536;
            asm volatile("" : "+v"(aoff8), "+v"(boff8));
            for (int t = 0; t < nt8; t += 2) { const bool last = (t == nt8 - 2);
                const char* a1 = c8A + (size_t)(t + 1) * kstep;
                const char* a2 = last ? c16A : c8A + (size_t)(t + 2) * kstep; const char* b2 = last ? c16B : c8B + (size_t)(t + 2) * kstep;
                const char* a3 = a2 + kstep; const char* b3 = b2 + kstep;
                PG8_KPAIR(PG8_LDA8, PG8_LDB8, PG8_MMA8, At, B0, B1); } }
        if (wr == 0) PG8_BAR;
        { const int t2 = opaque_tid(), w2 = __builtin_amdgcn_readfirstlane(t2 >> 6); cur.sub = 0; E(acc, cur, w2 >> 2, w2 & 3, t2 & 15, (t2 & 63) >> 4); }
        if (wr == 1) PG8_BAR;
        const char* n8A = c8A; const char* n8B = c8B; if (has_next) { n8A = S.A0 + (size_t)nxt.pm * S.tstep8; n8B = S.B0 + (size_t)nxt.pn * S.tstep8; }
        {   bf16x8 At[4][2], B0[2][2], B1[2][2];
            const int t6 = opaque_tid(); int aoff16 = lds_byte(((t6 >> 8) & 1) * 64 + (t6 & 15), ((t6 & 63) >> 4) * 8), boff16 = lds_byte(((t6 >> 6) & 3) * 32 + (t6 & 15), ((t6 & 63) >> 4) * 8) + 65536;
            asm volatile("" : "+v"(aoff16), "+v"(boff16));
            for (int t = 0; t < nt16; t += 2) { const bool last = (t == nt16 - 2);
                const char* a1 = c16A + (size_t)(t + 1) * kstep;
                const char* a2 = last ? n8A : c16A + (size_t)(t + 2) * kstep; const char* b2 = last ? n8B : c16B + (size_t)(t + 2) * kstep;
                const char* a3 = a2 + kstep; const char* b3 = b2 + kstep;
                PG8_KPAIR(PG8_LDA16, PG8_LDB16, PG8_MMA16, At, B0, B1); } }
        if (wr == 0) PG8_BAR;
        { const int t2 = opaque_tid(), w2 = __builtin_amdgcn_readfirstlane(t2 >> 6); cur.sub = 1; E(acc, cur, w2 >> 2, w2 & 3, t2 & 15, (t2 & 63) >> 4); }
        if (!has_next) break;
#pragma unroll
        for (int a = 0; a < 2; ++a)
#pragma unroll
            for (int b = 0; b < 2; ++b)
#pragma unroll
                for (int m = 0; m < 4; ++m)
#pragma unroll
                    for (int n = 0; n < 2; ++n) acc[a][b][m][n] = (f32x4){0.f, 0.f, 0.f, 0.f};
        cur = nxt; c8A = n8A; c8B = n8B; ++ui;
        if (wr == 1) PG8_BAR;
    }
    PG8_WAIT_V(0);
    PG8_BAR;
#undef PG8_SA
#undef PG8_SB
#undef PG8_STAGE
#undef PG8_LD8
#undef PG8_LDA8
#undef PG8_LDB8
#undef PG8_MMA8
#undef PG8_LDA16
#undef PG8_LDB16
#undef PG8_MMA16
#undef PG8_KPAIR
#undef PG8_WAIT_V
#undef PG8_WAIT_L
#undef PG8_BAR
#undef PG8_SCHED
}
}

constexpr int NWAVES = 8;
constexpr int N_LAUNCHES = MK_N_LAUNCHES;
constexpr int PER_PHASE = 8;
constexpr int M = 16384, D = 4096, NIN = 18432, GMW = 2048, NAW = 2048, DFF = 11008, NGU = 2 * DFF;
constexpr float F8_ASCALE = 16.f, F8_WSCALE = 1024.f, F8_UNSCALE = 1.f / (16.f * 1024.f), F8_YSCALE = 64.f, F8_YUNSCALE = 1.f / (64.f * 1024.f);
constexpr int GRID_W = 64, GRID_H = M / GRID_W, NHEAD = 16, HD = 128, CHUNK = 128, NGROUP = 16;
constexpr float RMS_EPS = 1e-6f, LN_EPS = 1e-5f;

constexpr size_t MiB = 1u << 20;
constexpr size_t WS_CTL = 0, CTL_ZERO_BYTES = 1 * MiB;
constexpr size_t WS_WSB = 1 * MiB;
constexpr size_t WS_WIN = 4 * MiB;
constexpr size_t WS_WOA = 148 * MiB, WS_WOB = 164 * MiB;
constexpr size_t WS_WOUT = 180 * MiB;
constexpr size_t WS_RA = 212 * MiB;
constexpr size_t WS_YA = WS_RA, WS_YB = WS_RA + 64 * MiB;
constexpr size_t WS_RB = 340 * MiB;
constexpr size_t WS_U = WS_RB, WS_V = WS_RB + 64 * MiB, WS_Q = WS_RB + 128 * MiB, WS_K = WS_RB + 192 * MiB, WS_VV = WS_RB + 256 * MiB, WS_GA = WS_RB + 320 * MiB, WS_GB = WS_RB + 448 * MiB;
constexpr size_t WS_TB = WS_Q;
constexpr size_t WS_MRG = WS_RB;
constexpr size_t WS_ACT = WS_RB;
constexpr size_t WS_H16 = WS_WIN;
constexpr size_t WS_WQKV8 = WS_WIN + 32 * MiB;
constexpr size_t WS_XN8 = 916 * MiB;
constexpr size_t WS_WGU = 916 * MiB;
constexpr size_t WS_WD = 1088 * MiB;
constexpr size_t WS_PART = 1174 * MiB;
constexpr size_t WS_END = 1178 * MiB;
static_assert(WS_GB + (size_t)M * D * 2 == WS_WGU && WS_WGU + (size_t)NGU * D * 2 == WS_WD && WS_WD + (size_t)D * DFF * 2 == WS_PART && WS_PART + (size_t)M * 64 * 4 == WS_END && WS_ACT + (size_t)M * DFF * 2 <= WS_WGU, "d_ws map");
constexpr int CW_BAR = 4096;
constexpr int RING_BYTES = 131072;
constexpr int LDSCTL_OFF = RING_BYTES, MISC_OFF = LDSCTL_OFF + 320;
constexpr int LDS_BYTES = 147456;

#define GAS __attribute__((address_space(1)))
#define LAS __attribute__((address_space(3)))
typedef unsigned short bf16;
typedef unsigned v4u __attribute__((ext_vector_type(4)));
typedef unsigned v2u __attribute__((ext_vector_type(2)));
typedef float f32x4 __attribute__((ext_vector_type(4)));
typedef float f32x2 __attribute__((ext_vector_type(2)));
typedef short bf16x8 __attribute__((ext_vector_type(8)));
typedef GAS unsigned gu32;
#define RLX_AGENT __ATOMIC_RELAXED, __HIP_MEMORY_SCOPE_AGENT
#define LDS_WAIT() asm volatile("s_waitcnt lgkmcnt(0)" ::: "memory")
#define VM_WAIT() asm volatile("s_waitcnt vmcnt(0)" ::: "memory")
__device__ __forceinline__ unsigned f2bf(float f) { unsigned u = __builtin_bit_cast(unsigned, f); return (u + 0x7fffu + ((u >> 16) & 1u)) >> 16; }
__device__ __forceinline__ unsigned pk2(float lo, float hi) { return pg8::cvt_pk_bf16(lo, hi); }
__device__ __forceinline__ float bflo(unsigned w) { return __uint_as_float(w << 16); }
__device__ __forceinline__ float bfhi(unsigned w) { return __uint_as_float(w & 0xffff0000u); }

#define XB_TMO      128
#define XB_XCNT(j)  (256  + 64 * (j))
#define XB_XSUB(j)  (1280 + 64 * (j))
#define XB_XGEN(j)  (2304 + 64 * (j))
#define XB_TOP      3328
#define XB_TOPGEN   3392
#define XCD_BAR_WORDS 3456
#define XB_SPIN_CAP (1u << 20)

__device__ __forceinline__ unsigned xb_ld(unsigned* p)              { return __hip_atomic_load(p, __ATOMIC_RELAXED, __HIP_MEMORY_SCOPE_AGENT); }
__device__ __forceinline__ unsigned xb_add(unsigned* p, unsigned v) { return __hip_atomic_fetch_add(p, v, __ATOMIC_RELAXED, __HIP_MEMORY_SCOPE_AGENT); }
__device__ __forceinline__ unsigned xb_xcc_id() { return (unsigned)__builtin_amdgcn_s_getreg((3 << 11) | 20) & 0xFu; }
#define XB_SPIN(cond, bar) do { unsigned _sp = 0; while (cond) { __builtin_amdgcn_s_sleep(1); \
    if ((++_sp & 255u) == 0u) { if (xb_ld(&(bar)[XB_TMO])) break; if (_sp > XB_SPIN_CAP) { atomicAdd(&(bar)[XB_TMO], 1u); break; } } } } while (0)

struct XcdBarrier {
    unsigned* bar; unsigned x;
    volatile LAS unsigned* st;
};
__device__ __forceinline__ XcdBarrier xcd_barrier_post(unsigned* bar, volatile LAS unsigned* st) {
    XcdBarrier b; b.bar = bar; b.x = xb_xcc_id(); b.st = st;
    if (threadIdx.x == 0) (void)xb_add(&bar[XB_XCNT(b.x)], 1u);
    return b;
}
__device__ __forceinline__ void xcd_barrier_complete(unsigned* bar, unsigned x, unsigned& nloc, unsigned& nx) {
    const unsigned G = gridDim.x * gridDim.y * gridDim.z;
    unsigned sum, cnt, mine, sp = 0u;
    for (;;) {
        sum = 0u; cnt = 0u; mine = 0u;
#pragma unroll
        for (unsigned j = 0; j < 16; ++j) { const unsigned c = xb_ld(&bar[XB_XCNT(j)]); sum += c; cnt += (c > 0u) ? 1u : 0u; mine = (j == x) ? c : mine; }
        if (sum == G) break;
        __builtin_amdgcn_s_sleep(1);
        if ((++sp & 255u) == 0u) { if (xb_ld(&bar[XB_TMO])) break; if (sp > XB_SPIN_CAP) { atomicAdd(&bar[XB_TMO], 1u); break; } }
    }
    nloc = mine > 0u ? mine : 1u; nx = cnt > 0u ? cnt : 1u;
}
__device__ __forceinline__ void xcd_barrier(const XcdBarrier& b) {
    asm volatile("s_waitcnt vmcnt(0)" ::: "memory");
    __syncthreads();
    if (threadIdx.x == 0) {
        unsigned* bar = b.bar;
        __builtin_amdgcn_s_waitcnt(0);
        unsigned nloc = b.st[0], nx = b.st[1];
        if (nloc == 0u) { xcd_barrier_complete(bar, b.x, nloc, nx); b.st[0] = nloc; b.st[1] = nx; }
        const unsigned old = xb_add(&bar[XB_XSUB(b.x)], 1u);
        const unsigned gen = old / nloc;
        if (old + 1u == (gen + 1u) * nloc) {
            __builtin_amdgcn_fence(__ATOMIC_RELEASE, "agent");
            asm volatile("s_waitcnt vmcnt(0)" ::: "memory");
            const unsigned og = xb_add(&bar[XB_TOP], 1u);
            const unsigned tg = og / nx;
            if (og + 1u == (tg + 1u) * nx) xb_add(&bar[XB_TOPGEN], 1u);
            else XB_SPIN(xb_ld(&bar[XB_TOPGEN]) == tg, bar);
            __builtin_amdgcn_fence(__ATOMIC_ACQUIRE, "agent");
            xb_add(&bar[XB_XGEN(b.x)], 1u);
            asm volatile("s_waitcnt vmcnt(0)" ::: "memory");
        } else {
            XB_SPIN(xb_ld(&bar[XB_XGEN(b.x)]) == gen, bar);
            __builtin_amdgcn_fence(__ATOMIC_ACQUIRE, "agent");
            asm volatile("s_waitcnt vmcnt(0)" ::: "memory");
        }
    }
    __syncthreads();
}

struct Frame {
    LAS unsigned char* lds;
    volatile LAS unsigned* MISC;
    gu32* ctl;
    int tid, lane, wave;
    int vcu, G;
    unsigned char* ws;
    const float *x, *norm1_g, *w_in, *gm_ln_g, *gm_ln_b, *gm_w_s, *gm_b_s, *q_gain, *k_gain, *na_rpb, *w_o_gm, *w_o_na, *w_out, *norm2_g, *w_ff_gate, *w_ff_up, *w_ff_down;
    float* out;
};
template <int O> __device__ __forceinline__ float xor_lane(float v) {
    if constexpr (O < 32) return __builtin_bit_cast(float, __builtin_amdgcn_ds_swizzle(__builtin_bit_cast(int, v), (O << 10) | 0x1f));
    else return __shfl_xor(v, 32);
}
__device__ __forceinline__ float wave_sum(float v) {
    v += xor_lane<1>(v); v += xor_lane<2>(v); v += xor_lane<4>(v); v += xor_lane<8>(v); v += xor_lane<16>(v); v += xor_lane<32>(v);
    return v;
}
struct TrRegs { f32x4 v[8]; };
__device__ __forceinline__ void tr_load(TrRegs& R, const float* W, int ldw, int k0, int n0, int lane) {
    const GAS float* src = (const GAS float*)W + (size_t)(k0 + 8 * (lane >> 3)) * ldw + n0 + 4 * (lane & 7);
#pragma unroll
    for (int e = 0; e < 8; ++e) R.v[e] = *(const GAS f32x4*)(src + (size_t)e * ldw);
}
__device__ __forceinline__ void tr_store(const TrRegs& R, bf16* dst, int ldk, int lane) {
    GAS bf16* d = (GAS bf16*)dst + (size_t)(4 * (lane & 7)) * ldk + 8 * (lane >> 3);
#pragma unroll
    for (int i = 0; i < 4; ++i) { v4u o; o.x = pk2(R.v[0][i], R.v[1][i]); o.y = pk2(R.v[2][i], R.v[3][i]); o.z = pk2(R.v[4][i], R.v[5][i]); o.w = pk2(R.v[6][i], R.v[7][i]);
        *(GAS v4u*)(d + (size_t)i * ldk) = o; }
}
__device__ __forceinline__ unsigned pk4_fp8(float a, float b, float c, float d) {
    a = fminf(fmaxf(a, -448.f), 448.f); b = fminf(fmaxf(b, -448.f), 448.f); c = fminf(fmaxf(c, -448.f), 448.f); d = fminf(fmaxf(d, -448.f), 448.f);
    unsigned w = 0u; w = __builtin_amdgcn_cvt_pk_fp8_f32(a, b, w, false); w = __builtin_amdgcn_cvt_pk_fp8_f32(c, d, w, true); return w;
}
__device__ __forceinline__ void tr_store8(const TrRegs& R, unsigned char* dst8, int ldk, int lane, float sc) {
    GAS unsigned char* d = (GAS unsigned char*)dst8 + (size_t)(4 * (lane & 7)) * ldk + 8 * (lane >> 3);
#pragma unroll
    for (int i = 0; i < 4; ++i) { v2u o; o.x = pk4_fp8(R.v[0][i] * sc, R.v[1][i] * sc, R.v[2][i] * sc, R.v[3][i] * sc); o.y = pk4_fp8(R.v[4][i] * sc, R.v[5][i] * sc, R.v[6][i] * sc, R.v[7][i] * sc);
        *(GAS v2u*)(d + (size_t)i * ldk) = o; }
}
__device__ __forceinline__ size_t blkw(int n0, int kb, int K) { return (((size_t)(n0 >> 8) * (K >> 6) + kb) * 256 + (n0 & 255)) * 64; }
__device__ __forceinline__ size_t blkw8(int n0, int kb, int K) { return (((size_t)(n0 >> 8) * (K >> 7) + (kb >> 1)) * 256 + (n0 & 255)) * 128 + (kb & 1) * 64; }
__device__ __forceinline__ void tr_matrix(Frame& F, int lane, const float* W, int K, int N, bf16* WT) {
    const int gw = F.vcu * NWAVES + F.wave, NGW = F.G * NWAVES, nblk = N / 32, nitems = (K / 64) * nblk;
    for (int it = gw; it < nitems; it += 2 * NGW) { const int it2 = it + NGW; const bool two = it2 < nitems; TrRegs A, B;
        const int kb = it / nblk, nb = it % nblk, kb2 = two ? it2 / nblk : kb, nb2 = two ? it2 % nblk : nb;
        tr_load(A, W, N, 64 * kb, 32 * nb, lane); tr_load(B, W, N, 64 * kb2, 32 * nb2, lane);
        tr_store(A, WT + blkw(32 * nb, kb, K), 64, lane); if (two) tr_store(B, WT + blkw(32 * nb2, kb2, K), 64, lane); }
}
constexpr int FF_ITEMS_GU = (D / 64) * (DFF / 32), FF_ITEMS_D = (DFF / 64) * (D / 32), FF_ITEMS = 2 * FF_ITEMS_GU + FF_ITEMS_D;
constexpr int FF_ITEMS_P2 = 2 * FF_ITEMS_GU;
struct FillItem { const float* src; bf16* dst; int ldw, ldk, k0, n0; };
__device__ __forceinline__ FillItem ff_item(Frame& F, int it) {
    it = it < FF_ITEMS ? it : FF_ITEMS - 1; FillItem I;
    if (it < 2 * FF_ITEMS_GU) { const int up = it >= FF_ITEMS_GU, r = up ? it - FF_ITEMS_GU : it, nblk = DFF / 32, kb = r / nblk, n0 = 32 * (r - kb * nblk);
        I.src = up ? F.w_ff_up : F.w_ff_gate; I.ldw = DFF; I.k0 = 64 * kb; I.n0 = n0; I.ldk = D;
        I.dst = (bf16*)(F.ws + WS_WGU) + blkw(256 * (n0 >> 7) + (n0 & 127) + (up ? 128 : 0), kb, D); I.ldk = 64; }
    else { const int r = it - 2 * FF_ITEMS_GU, nblk = D / 32, kb = r / nblk, n0 = 32 * (r - kb * nblk);
        I.src = F.w_ff_down; I.ldw = D; I.k0 = 64 * kb; I.n0 = n0; I.ldk = 64; I.dst = (bf16*)(F.ws + WS_WD) + blkw(n0, kb, DFF); }
    return I;
}
__device__ __forceinline__ void rms_row_to_bf16(int lane, const float* xrow, const float* gain, bf16* obase, unsigned char* obase8, int m) {
    const GAS f32x4* xr = (const GAS f32x4*)xrow + lane;
    f32x4 v[16]; float s = 0.f;
#pragma unroll
    for (int j = 0; j < 16; ++j) { v[j] = xr[64 * j]; s += (v[j].x * v[j].x + v[j].y * v[j].y) + (v[j].z * v[j].z + v[j].w * v[j].w); }
    const float rstd = 1.f / sqrtf(wave_sum(s) * (1.f / D) + RMS_EPS);
    const GAS f32x4* gr = (const GAS f32x4*)gain + lane;
#pragma unroll
    for (int j = 0; j < 16; ++j) { const f32x4 g = gr[64 * j]; const float y0 = v[j].x * rstd * g.x, y1 = v[j].y * rstd * g.y, y2 = v[j].z * rstd * g.z, y3 = v[j].w * rstd * g.w;
        v2u o; o.x = pk2(y0, y1); o.y = pk2(y2, y3); *(GAS v2u*)((GAS char*)obase + pg8::blk_off(m, 8 * lane + 512 * j, 2 * D)) = o;
        *(GAS unsigned*)((GAS unsigned char*)obase8 + pg8::blk_off(m, 4 * lane + 256 * j, D)) = pk4_fp8(y0 * F8_ASCALE, y1 * F8_ASCALE, y2 * F8_ASCALE, y3 * F8_ASCALE); }
}

#ifndef MK_STAGGER_US
#define MK_STAGGER_US 0
#endif
__device__ __forceinline__ void stagger(int us_per_group) {
    const int grp = ((int)blockIdx.x >> 3) & 3;
    if (grp && us_per_group) { const unsigned long long t0 = __builtin_amdgcn_s_memrealtime(), dt = (unsigned long long)(grp * us_per_group) * 100ull;
        while (__builtin_amdgcn_s_memrealtime() - t0 < dt) __builtin_amdgcn_s_sleep(16); }
}
__device__ __forceinline__ void p0_prologue(Frame& F) {
    const int lane = opaque_tid() & 63;
    {
        const int gw0 = F.vcu * NWAVES + F.wave, NGW0 = F.G * NWAVES, nblk = NIN / 32, nitems = (D / 64) * nblk; bf16* WT = (bf16*)(F.ws + WS_WIN); unsigned char* W8 = F.ws + WS_WQKV8;
        for (int it = gw0; it < nitems; it += NGW0) { const int kb = it / nblk, n0 = 32 * (it - kb * nblk); TrRegs R; tr_load(R, F.w_in, NIN, 64 * kb, n0, lane);
            if (n0 >= 4096) tr_store8(R, W8 + blkw8(n0 - 4096, kb, D), 128, lane, F8_WSCALE);
            else tr_store(R, WT + blkw(n0, kb, D), 64, lane); } }
    tr_matrix(F, lane, F.w_o_gm, GMW, D, (bf16*)(F.ws + WS_WOA));
    {
        const int gw0 = F.vcu * NWAVES + F.wave, NGW0 = F.G * NWAVES, nblk = D / 32, nitems = (NAW / 64) * nblk; unsigned char* W8 = F.ws + WS_WOB;
        for (int it = gw0; it < nitems; it += NGW0) { const int kb = it / nblk, n0 = 32 * (it - kb * nblk); TrRegs R; tr_load(R, F.w_o_na, D, 64 * kb, n0, lane);
            tr_store8(R, W8 + blkw8(n0, kb, NAW), 128, lane, F8_WSCALE); } }
    tr_matrix(F, lane, F.w_out, D, D, (bf16*)(F.ws + WS_WOUT));
    const int gw = F.vcu * NWAVES + F.wave, NGW = F.G * NWAVES;
    { bf16* wsb = (bf16*)(F.ws + WS_WSB);
      for (int i = gw * 64 + lane; i < NGROUP * CHUNK * CHUNK / 4; i += NGW * 64) { const f32x4 v = ((const GAS f32x4*)F.gm_w_s)[i]; v2u o; o.x = pk2(v.x, v.y); o.y = pk2(v.z, v.w); ((GAS v2u*)wsb)[i] = o; } }
    bf16* XN = (bf16*)(F.ws + WS_RA);
    for (int m = gw; m < M; m += NGW) rms_row_to_bf16(lane, F.x + (size_t)m * D, F.norm1_g, XN, F.ws + WS_XN8, m);
}
typedef short s16x4 __attribute__((ext_vector_type(4)));
constexpr int GM_WP = 272, GM_VP = 288;
constexpr int GM_V_OFF = 128 * GM_WP, GM_ST_OFF = GM_V_OFF + 128 * GM_VP;
__device__ __forceinline__ void gmlp_unit(Frame& F, int chunk, int half) {
    LAS unsigned char* Wl = F.lds; LAS unsigned char* Vt = F.lds + GM_V_OFF; LAS f32x2* st = (LAS f32x2*)(F.lds + GM_ST_OFF);
    const bf16* U = (const bf16*)(F.ws + WS_U); const bf16* V = (const bf16*)(F.ws + WS_V); bf16* YA = (bf16*)(F.ws + WS_YA); const bf16* WSB = (const bf16*)(F.ws + WS_WSB);
    const int tid = opaque_tid();
    const int tok0 = chunk * CHUNK, lane = tid & 63, fr = lane & 15, fq = lane >> 4, q4 = fr >> 2, p4 = lane & 3;
    const int srow = tid >> 4, sch = tid & 15;
    const int g_first = half * (NGROUP / 2);
    v4u Wr[4], Vr[4]; f32x4 lg[2], lb[2];
#define GM_PREFETCH(g_) do { _Pragma("unroll") for (int q = 0; q < 4; ++q) { Wr[q] = *(const GAS v4u*)(WSB + (size_t)(g_) * CHUNK * CHUNK + (srow + 32 * q) * CHUNK + sch * 8); \
        Vr[q] = *(const GAS v4u*)(V + (size_t)(tok0 + srow + 32 * q) * GMW + (g_) * 128 + sch * 8); } \
        lg[0] = *(const GAS f32x4*)(F.gm_ln_g + (g_) * 128 + sch * 8); lg[1] = *(const GAS f32x4*)(F.gm_ln_g + (g_) * 128 + sch * 8 + 4); \
        lb[0] = *(const GAS f32x4*)(F.gm_ln_b + (g_) * 128 + sch * 8); lb[1] = *(const GAS f32x4*)(F.gm_ln_b + (g_) * 128 + sch * 8 + 4); } while (0)
    GM_PREFETCH(g_first);
    __syncthreads();
    { const GAS f32x4* p = (const GAS f32x4*)((const float*)(F.ws + WS_PART) + (size_t)(tok0 + (tid >> 2)) * 64 + (tid & 3) * 16); float sm = 0.f, sq = 0.f;
#pragma unroll
      for (int i = 0; i < 4; ++i) { const f32x4 v = p[i]; sm += v.x + v.z; sq += v.y + v.w; }
      sm += xor_lane<1>(sm); sm += xor_lane<2>(sm); sq += xor_lane<1>(sq); sq += xor_lane<2>(sq);
      const float mean = sm * (1.f / GMW), var = fmaxf(sq * (1.f / GMW) - mean * mean, 0.f);
      if ((tid & 3) == 0) st[tid >> 2] = (f32x2){mean, 1.f / sqrtf(var + LN_EPS)}; }
    const int wi = F.wave >> 1, wc2 = F.wave & 1;
#pragma unroll 1
    for (int gi = 0; gi < NGROUP / 2; ++gi) { const int g = g_first + gi;
        __syncthreads();
#pragma unroll
        for (int q = 0; q < 4; ++q) { const int row = srow + 32 * q;
            *(LAS v4u*)(Wl + row * GM_WP + sch * 16) = Wr[q];
            const v4u w = Vr[q]; const f32x2 ms = st[row]; v4u o;
            o.x = pk2((bflo(w.x) - ms.x) * ms.y * lg[0].x + lb[0].x, (bfhi(w.x) - ms.x) * ms.y * lg[0].y + lb[0].y); o.y = pk2((bflo(w.y) - ms.x) * ms.y * lg[0].z + lb[0].z, (bfhi(w.y) - ms.x) * ms.y * lg[0].w + lb[0].w);
            o.z = pk2((bflo(w.z) - ms.x) * ms.y * lg[1].x + lb[1].x, (bfhi(w.z) - ms.x) * ms.y * lg[1].y + lb[1].y); o.w = pk2((bflo(w.w) - ms.x) * ms.y * lg[1].z + lb[1].z, (bfhi(w.w) - ms.x) * ms.y * lg[1].w + lb[1].w);
            *(LAS v4u*)(Vt + row * GM_VP + sch * 16) = o; }
        if (gi + 1 < NGROUP / 2) GM_PREFETCH(g + 1);
        v4u uu[2][2]; float bs[2];
#pragma unroll
        for (int it = 0; it < 2; ++it) { const int i = 32 * wi + 16 * it + fr; bs[it] = F.gm_b_s[g * CHUNK + i];
#pragma unroll
            for (int t = 0; t < 2; ++t) uu[it][t] = *(const GAS v4u*)(U + (size_t)(tok0 + i) * GMW + g * 128 + 64 * wc2 + 32 * t + 8 * fq); }
        __syncthreads();
        f32x4 acc[4][2];
#pragma unroll
        for (int ct = 0; ct < 4; ++ct)
#pragma unroll
            for (int it = 0; it < 2; ++it) acc[ct][it] = (f32x4){0.f, 0.f, 0.f, 0.f};
#pragma unroll
        for (int kk = 0; kk < 8; ++kk) { s16x4 vf[4], wf[2];
#pragma unroll
            for (int ct = 0; ct < 4; ++ct) vf[ct] = __builtin_amdgcn_ds_read_tr16_b64_v4i16((LAS s16x4*)(Vt + (16 * kk + 4 * fq + q4) * GM_VP + (64 * wc2 + 32 * (ct >> 1) + 8 * p4 + 4 * (ct & 1)) * 2));
#pragma unroll
            for (int it = 0; it < 2; ++it) wf[it] = *(const LAS s16x4*)(Wl + (32 * wi + 16 * it + fr) * GM_WP + (16 * kk + 4 * fq) * 2);
#pragma unroll
            for (int ct = 0; ct < 4; ++ct)
#pragma unroll
                for (int it = 0; it < 2; ++it) acc[ct][it] = __builtin_amdgcn_mfma_f32_16x16x16bf16_1k(vf[ct], wf[it], acc[ct][it], 0, 0, 0); }
#pragma unroll
        for (int it = 0; it < 2; ++it) { const int i = 32 * wi + 16 * it + fr;
#pragma unroll
            for (int t = 0; t < 2; ++t) { const v4u u4 = uu[it][t]; const f32x4 a0 = acc[2 * t][it], a1 = acc[2 * t + 1][it]; const float b = bs[it]; v4u o;
                o.x = pk2((a0[0] + b) * bflo(u4.x), (a0[1] + b) * bfhi(u4.x)); o.y = pk2((a0[2] + b) * bflo(u4.y), (a0[3] + b) * bfhi(u4.y));
                o.z = pk2((a1[0] + b) * bflo(u4.z), (a1[1] + b) * bfhi(u4.z)); o.w = pk2((a1[2] + b) * bflo(u4.w), (a1[3] + b) * bfhi(u4.w));
                *(GAS v4u*)((GAS char*)YA + pg8::blk_off(tok0 + i, (g * 128 + 64 * wc2 + 32 * t + 8 * fq) * 2, 2 * GMW)) = o; } }
    }
#undef GM_PREFETCH
    __syncthreads();
}

constexpr int NA_KP = 272, NA_VP = 288;
constexpr int NA_KS = 64 * NA_KP, NA_SLOT = NA_KS + 64 * NA_VP, NA_RPB_OFF = 2 * NA_SLOT, NA_ROWS = 11;
constexpr float LOG2E = 1.4426950408889634f;
template <bool FILL> __device__ __forceinline__ void na_unit(Frame& F, int pq, int h, float cbound, int fill_it, int fill_stride) {
    LAS unsigned char* ring = F.lds; LAS float* rpbL = (LAS float*)(F.lds + NA_RPB_OFF);
    const bf16* Q = (const bf16*)(F.ws + WS_Q); const bf16* Kt = (const bf16*)(F.ws + WS_K); const bf16* Vv = (const bf16*)(F.ws + WS_VV);
    const int tid = opaque_tid();
    const int lane = tid & 63, wave = __builtin_amdgcn_readfirstlane(tid >> 6), fr = lane & 15, g = lane >> 4, q4 = fr >> 2, p4 = lane & 3;
    const int R0 = 4 * pq, r = R0 + (wave >> 1), half = wave & 1, kb0 = half;
    int b0 = R0 - 4; b0 = b0 < 0 ? 0 : (b0 > GRID_H - 8 ? GRID_H - 8 : b0);
    int rs = r - 4; rs = rs < 0 ? 0 : (rs > GRID_H - 8 ? GRID_H - 8 : rs);
    int c[2], cs[2];
#pragma unroll
    for (int tt = 0; tt < 2; ++tt) { c[tt] = 32 * half + 16 * tt + fr; int x = c[tt] - 8; cs[tt] = x < 0 ? 0 : (x > GRID_W - 16 ? GRID_W - 16 : x); }
    const int skey = tid >> 4, sdch = tid & 15;
    __syncthreads();
    for (int i = tid; i < 15 * 31; i += 512) rpbL[i] = __builtin_amdgcn_exp2f(F.na_rpb[h * 465 + i] * LOG2E);
    v4u RK[2][2], RV[2][2];
    TrRegs FR; FillItem FI;
#define NA_LOAD(s_) do { int kr_ = b0 + (s_); kr_ = kr_ > GRID_H - 1 ? GRID_H - 1 : kr_; _Pragma("unroll") for (int q2 = 0; q2 < 2; ++q2) { \
        const size_t o_ = (size_t)(kr_ * GRID_W + skey + 32 * q2) * NAW + h * HD + sdch * 8; RK[(s_) & 1][q2] = *(const GAS v4u*)(Kt + o_); RV[(s_) & 1][q2] = *(const GAS v4u*)(Vv + o_); } } while (0)
    NA_LOAD(0); NA_LOAD(1);
    bf16x8 Qf[2][4];
#pragma unroll
    for (int tt = 0; tt < 2; ++tt) { const size_t tq = (size_t)(r * GRID_W + c[tt]); v4u qw[4]; float ss = 0.f;
#pragma unroll
      for (int ks = 0; ks < 4; ++ks) { qw[ks] = *(const GAS v4u*)(Q + tq * NAW + h * HD + 32 * ks + 8 * g);
          const float a0 = bflo(qw[ks].x), a1 = bfhi(qw[ks].x), a2 = bflo(qw[ks].y), a3 = bfhi(qw[ks].y), a4 = bflo(qw[ks].z), a5 = bfhi(qw[ks].z), a6 = bflo(qw[ks].w), a7 = bfhi(qw[ks].w);
          ss += (a0 * a0 + a1 * a1) + (a2 * a2 + a3 * a3) + (a4 * a4 + a5 * a5) + (a6 * a6 + a7 * a7); }
      ss += xor_lane<16>(ss); ss += xor_lane<32>(ss);
      const float rq = (1.f / sqrtf(ss * (1.f / HD) + RMS_EPS)) * 0.08838834764831845f * LOG2E;
#pragma unroll
      for (int ks = 0; ks < 4; ++ks) { const f32x4 g0 = *(const GAS f32x4*)(F.q_gain + 32 * ks + 8 * g), g1 = *(const GAS f32x4*)(F.q_gain + 32 * ks + 8 * g + 4);
          v4u o; o.x = pk2(bflo(qw[ks].x) * rq * g0.x, bfhi(qw[ks].x) * rq * g0.y); o.y = pk2(bflo(qw[ks].y) * rq * g0.z, bfhi(qw[ks].y) * rq * g0.w);
          o.z = pk2(bflo(qw[ks].z) * rq * g1.x, bfhi(qw[ks].z) * rq * g1.y); o.w = pk2(bflo(qw[ks].w) * rq * g1.z, bfhi(qw[ks].w) * rq * g1.w);
          Qf[tt][ks] = __builtin_bit_cast(bf16x8, o); } }
    const f32x4 kg0 = *(const GAS f32x4*)(F.k_gain + sdch * 8), kg1 = *(const GAS f32x4*)(F.k_gain + sdch * 8 + 4);
    f32x4 O[2][8]; float lsum[2] = {0.f, 0.f};
#pragma unroll
    for (int tt = 0; tt < 2; ++tt)
#pragma unroll
        for (int db = 0; db < 8; ++db) O[tt][db] = (f32x4){0.f, 0.f, 0.f, 0.f};
#pragma unroll
    for (int s = 0; s < NA_ROWS; ++s) { LAS unsigned char* slot = ring + (s & 1) * NA_SLOT;
#pragma unroll
        for (int q2 = 0; q2 < 2; ++q2) { const v4u w = RK[s & 1][q2];
            const float a0 = bflo(w.x), a1 = bfhi(w.x), a2 = bflo(w.y), a3 = bfhi(w.y), a4 = bflo(w.z), a5 = bfhi(w.z), a6 = bflo(w.w), a7 = bfhi(w.w);
            float ss = (a0 * a0 + a1 * a1) + (a2 * a2 + a3 * a3) + (a4 * a4 + a5 * a5) + (a6 * a6 + a7 * a7);
            ss += xor_lane<1>(ss); ss += xor_lane<2>(ss); ss += xor_lane<4>(ss); ss += xor_lane<8>(ss);
            const float rk = 1.f / sqrtf(ss * (1.f / HD) + RMS_EPS);
            v4u o; o.x = pk2(a0 * rk * kg0.x, a1 * rk * kg0.y); o.y = pk2(a2 * rk * kg0.z, a3 * rk * kg0.w); o.z = pk2(a4 * rk * kg1.x, a5 * rk * kg1.y); o.w = pk2(a6 * rk * kg1.z, a7 * rk * kg1.w);
            *(LAS v4u*)(slot + (skey + 32 * q2) * NA_KP + sdch * 16) = o;
            *(LAS v4u*)(slot + NA_KS + (skey + 32 * q2) * NA_VP + sdch * 16) = RV[s & 1][q2]; }
        if (s + 2 < NA_ROWS) NA_LOAD(s + 2);
        if constexpr (FILL) { if (s > 0) tr_store(FR, FI.dst, FI.ldk, lane); FI = ff_item(F, fill_it + s * fill_stride); tr_load(FR, FI.src, FI.ldw, FI.k0, FI.n0, lane); }
        __syncthreads();
        const int kr = b0 + s;
        if (kr >= rs && kr <= rs + 7) {
            f32x4 S[2][3];
#pragma unroll
            for (int tt = 0; tt < 2; ++tt)
#pragma unroll
                for (int b = 0; b < 3; ++b) S[tt][b] = (f32x4){-cbound, -cbound, -cbound, -cbound};
#pragma unroll
            for (int b = 0; b < 3; ++b)
#pragma unroll
                for (int ks = 0; ks < 4; ++ks) { const bf16x8 a = *(const LAS bf16x8*)(slot + (16 * (kb0 + b) + fr) * NA_KP + (32 * ks + 8 * g) * 2);
#pragma unroll
                    for (int tt = 0; tt < 2; ++tt) S[tt][b] = __builtin_amdgcn_mfma_f32_16x16x32_bf16(a, Qf[tt][ks], S[tt][b], 0, 0, 0); }
            s16x4 pf[2][3];
#pragma unroll
            for (int tt = 0; tt < 2; ++tt) { const int rbase = (kr - r + 7) * 31 + 15 - c[tt];
#pragma unroll
                for (int b = 0; b < 3; ++b) { float pv[4];
#pragma unroll
                    for (int i = 0; i < 4; ++i) { const int kc = 16 * (kb0 + b) + 4 * g + i; const bool ok = (kc >= cs[tt]) && (kc <= cs[tt] + 15);
                        int idx = rbase + kc; idx = ok ? idx : 0; const float e = __builtin_amdgcn_exp2f(S[tt][b][i]) * rpbL[idx]; pv[i] = ok ? e : 0.f; lsum[tt] += pv[i]; }
                    v2u pw; pw.x = pk2(pv[0], pv[1]); pw.y = pk2(pv[2], pv[3]); pf[tt][b] = __builtin_bit_cast(s16x4, pw); } }
#pragma unroll
            for (int b = 0; b < 3; ++b)
#pragma unroll
                for (int db = 0; db < 8; ++db) { const s16x4 vf = __builtin_amdgcn_ds_read_tr16_b64_v4i16((LAS s16x4*)(slot + NA_KS + (16 * (kb0 + b) + 4 * g + q4) * NA_VP + (32 * (db >> 1) + 8 * p4 + 4 * (db & 1)) * 2));
#pragma unroll
                    for (int tt = 0; tt < 2; ++tt) O[tt][db] = __builtin_amdgcn_mfma_f32_16x16x16bf16_1k(vf, pf[tt][b], O[tt][db], 0, 0, 0); }
        }
    }
#undef NA_LOAD
    if constexpr (FILL) tr_store(FR, FI.dst, FI.ldk, lane);
#pragma unroll
    for (int tt = 0; tt < 2; ++tt) { float l = lsum[tt]; l += xor_lane<16>(l); l += xor_lane<32>(l); const float inv = 1.f / l;
        const float inv8 = inv * F8_YSCALE;
        GAS unsigned char* orow = (GAS unsigned char*)(F.ws + WS_YB) + pg8::blk_off(r * GRID_W + c[tt], h * HD + 8 * g, NAW);
#pragma unroll
        for (int t = 0; t < 4; ++t) { const f32x4 a0 = O[tt][2 * t], a1 = O[tt][2 * t + 1]; v2u o;
            o.x = pk4_fp8(a0[0] * inv8, a0[1] * inv8, a0[2] * inv8, a0[3] * inv8); o.y = pk4_fp8(a1[0] * inv8, a1[1] * inv8, a1[2] * inv8, a1[3] * inv8);
            *(GAS v2u*)(orow + 32 * t) = o; } }
}

struct Args { const float* in[17]; float* out; unsigned char* ws; int ph_lo, ph_hi, li, pad; };
__global__ void __launch_bounds__(NWAVES * 64, 2) fwd_kernel(Args args) {
    extern __shared__ __attribute__((aligned(16))) unsigned char lds[];
    Frame F;
    F.lds = (LAS unsigned char*)lds;
    F.MISC = (volatile LAS unsigned*)(F.lds + MISC_OFF);
    F.tid = threadIdx.x; F.lane = F.tid & 63; F.wave = __builtin_amdgcn_readfirstlane(F.tid >> 6);
    F.G = gridDim.x; { const int bx = blockIdx.x; F.vcu = (F.G % 8 == 0) ? (bx % 8) * (F.G / 8) + bx / 8 : bx; }
    F.ws = args.ws; F.ctl = (gu32*)(args.ws + WS_CTL);
    F.x = args.in[0]; F.norm1_g = args.in[1]; F.w_in = args.in[2]; F.gm_ln_g = args.in[3]; F.gm_ln_b = args.in[4]; F.gm_w_s = args.in[5]; F.gm_b_s = args.in[6];
    F.q_gain = args.in[7]; F.k_gain = args.in[8]; F.na_rpb = args.in[9]; F.w_o_gm = args.in[10]; F.w_o_na = args.in[11]; F.w_out = args.in[12]; F.norm2_g = args.in[13];
    F.w_ff_gate = args.in[14]; F.w_ff_up = args.in[15]; F.w_ff_down = args.in[16]; F.out = args.out;
    for (int u = F.tid; u < (LDS_BYTES - LDSCTL_OFF) / 4; u += NWAVES * 64) ((LAS unsigned*)(F.lds + LDSCTL_OFF))[u] = 0u;
    __syncthreads();
    XcdBarrier bar; bar.bar = (unsigned*)(F.ctl + CW_BAR); bar.x = 0; bar.st = nullptr;
    if (N_LAUNCHES != PER_PHASE) bar = xcd_barrier_post((unsigned*)(F.ctl + CW_BAR), F.MISC + 8);
#define GRID_BAR() do { if (N_LAUNCHES != PER_PHASE) xcd_barrier(bar); } while (0)
    const int lo = args.ph_lo, hi = args.ph_hi < MK_STOP_AFTER + 1 ? args.ph_hi : MK_STOP_AFTER + 1;
#define IN(k) (lo <= (k) && (k) < hi)
#define BOTH(k) (IN(k) && IN((k) + 1))
    const int bx = (int)blockIdx.x;

    if (IN(0)) { _Pragma("unroll") for (int rep = 0; rep < NREP(0); ++rep) { p0_prologue(F); if (BOTH(0)) GRID_BAR(); } }

    if (IN(1)) _Pragma("unroll") for (int rep = 0; rep < NREP(1); ++rep) {
        { pg8::SchedP1a S; S.o.init(M, 16 * 256, F.G, bx); S.A = (const char*)(F.ws + WS_RA); S.B = (const char*)(F.ws + WS_WIN); S.tstep = (size_t)256 * D * 2;
          pg8::EpiProj E{(bf16*)(F.ws + WS_RB), M, 1.f, (float*)(F.ws + WS_PART)};
          stagger(MK_STAGGER_US); pg8::gemm_phase<pg8::EpiProj, pg8::SchedP1a, true, true>(F.lds, D, S, E); }
        { pg8::SchedP1b S; S.o.init(M, 56 * 256, F.G, bx); S.A8 = (const char*)(F.ws + WS_XN8); S.B8 = (const char*)(F.ws + WS_WQKV8); S.tstep8 = (size_t)256 * D;
          pg8::EpiQKV E{(bf16*)(F.ws + WS_RB), M, F8_UNSCALE, F.ws + WS_GA, F.ws + WS_GB};
          pg8::gemm_phase_f8<pg8::EpiQKV, pg8::SchedP1b>(F.lds, D, S, E); }
        if (BOTH(1)) GRID_BAR();
    }
    if (IN(2)) _Pragma("unroll") for (int rep = 0; rep < NREP(2); ++rep) {
        for (int u = bx; u < 2 * (M / CHUNK); u += F.G) gmlp_unit(F, u >> 1, u & 1);
#if defined(MK_PROBE_NA)
        for (int rep = 0; rep < args.pad + 2; ++rep)
#endif
        float cbound;
        { const int ln = opaque_tid() & 63; float mq = fmaxf(fabsf(F.q_gain[2 * ln]), fabsf(F.q_gain[2 * ln + 1])), mk = fmaxf(fabsf(F.k_gain[2 * ln]), fabsf(F.k_gain[2 * ln + 1]));
          mq = fmaxf(mq, xor_lane<1>(mq)); mq = fmaxf(mq, xor_lane<2>(mq)); mq = fmaxf(mq, xor_lane<4>(mq)); mq = fmaxf(mq, xor_lane<8>(mq)); mq = fmaxf(mq, xor_lane<16>(mq)); mq = fmaxf(mq, xor_lane<32>(mq));
          mk = fmaxf(mk, xor_lane<1>(mk)); mk = fmaxf(mk, xor_lane<2>(mk)); mk = fmaxf(mk, xor_lane<4>(mk)); mk = fmaxf(mk, xor_lane<8>(mk)); mk = fmaxf(mk, xor_lane<16>(mk)); mk = fmaxf(mk, xor_lane<32>(mk));
          cbound = 11.313708498984761f * 1.01f * LOG2E * mq * mk; }
        {
            const int gwv = F.vcu * NWAVES + F.wave, NGW = F.G * NWAVES, per_wave = (FF_ITEMS_P2 + NGW - 1) / NGW, nfill = (per_wave + NA_ROWS - 1) / NA_ROWS; int ui = 0, done = 0;
            for (int u = F.vcu; u < (GRID_H / 4) * NHEAD; u += F.G, ++ui) {
                if (ui < nfill) { na_unit<true>(F, u & (GRID_H / 4 - 1), u >> 6, cbound, gwv + done * NGW, NGW); done += NA_ROWS; }
                else na_unit<false>(F, u & (GRID_H / 4 - 1), u >> 6, cbound, 0, 0); }
            const int ln = opaque_tid() & 63;
            for (int it = gwv + done * NGW; it < FF_ITEMS_P2; it += NGW) { TrRegs R; const FillItem I = ff_item(F, it); tr_load(R, I.src, I.ldw, I.k0, I.n0, ln); tr_store(R, I.dst, I.ldk, ln); }
        }
        if (BOTH(2)) GRID_BAR();
    }
    if (IN(3)) _Pragma("unroll") for (int rep = 0; rep < NREP(3); ++rep) {
        { pg8::SchedMerge S; S.o.init(M, D, F.G, bx); S.A0 = (const char*)(F.ws + WS_YB); S.B0 = (const char*)(F.ws + WS_WOB); S.A1 = (const char*)(F.ws + WS_YA); S.B1 = (const char*)(F.ws + WS_WOA); S.tstep = (size_t)256 * GMW * 2; S.tstep8 = (size_t)256 * NAW;
          pg8::EpiMix E{F.ws + WS_GA, F.ws + WS_GB, (bf16*)(F.ws + WS_MRG), F8_YUNSCALE};
          stagger(MK_STAGGER_US); pg8::gemm_phase_mix<pg8::EpiMix, pg8::SchedMerge>(F.lds, 0, NAW / 128, GMW / 64, S, E); }
        if (BOTH(3)) GRID_BAR();
    }
    if (IN(4)) _Pragma("unroll") for (int rep = 0; rep < NREP(4); ++rep) {
        pg8::SchedPlain S; S.o.init(M, D, F.G, bx); S.A = (const char*)(F.ws + WS_MRG); S.B = (const char*)(F.ws + WS_WOUT); S.tstep = (size_t)256 * D * 2;
        pg8::EpiOutNorm E{F.x, (bf16*)(F.ws + WS_H16), (bf16*)(F.ws + WS_RA), F.norm2_g, (float*)(F.ws + WS_PART)};
        stagger(MK_STAGGER_US); pg8::gemm_phase<pg8::EpiOutNorm, pg8::SchedPlain, true, true>(F.lds, D, S, E);
        if (BOTH(4)) GRID_BAR();
    }
    if (IN(6)) _Pragma("unroll") for (int rep = 0; rep < NREP(6); ++rep) {
        pg8::SchedPlain S; S.o.init(M, NGU, F.G, bx); S.A = (const char*)(F.ws + WS_RA); S.B = (const char*)(F.ws + WS_WGU); S.tstep = (size_t)256 * D * 2;
        LAS float* rtab = (LAS float*)(F.lds + 135168); const int fm = 8 * (bx & 7);
        { const int t5 = opaque_tid(); const float* part = (const float*)(F.ws + WS_PART);
          for (int r = t5; r < 2048; r += NWAVES * 64) { const GAS f32x4* p = (const GAS f32x4*)(part + (size_t)(fm * 256 + r) * 64); float sacc = 0.f;
#pragma unroll
              for (int j = 0; j < 16; ++j) { const f32x4 v = p[j]; sacc += (v.x + v.y) + (v.z + v.w); }
              rtab[r] = 1.f / sqrtf(sacc * (1.f / D) + RMS_EPS); }
          __syncthreads(); }
        pg8::EpiSwiglu E{(bf16*)(F.ws + WS_ACT), DFF, rtab, fm};
        stagger(MK_STAGGER_US); pg8::gemm_phase<pg8::EpiSwiglu, pg8::SchedPlain, true, true>(F.lds, D, S, E);
        {
            const int rem = S.o.nwg % F.G, first = rem, nidle = rem ? F.G - rem : F.G;
            if (bx >= first || rem == 0) { const int ln = opaque_tid() & 63, w0 = ((rem ? bx - first : bx) * NWAVES + F.wave), NW = nidle * NWAVES;
                for (int it = FF_ITEMS_P2 + w0; it < FF_ITEMS; it += 2 * NW) { const int it2 = it + NW; TrRegs Ra, Rb; const FillItem Ia = ff_item(F, it), Ib = ff_item(F, it2);
                    tr_load(Ra, Ia.src, Ia.ldw, Ia.k0, Ia.n0, ln); tr_load(Rb, Ib.src, Ib.ldw, Ib.k0, Ib.n0, ln); tr_store(Ra, Ia.dst, Ia.ldk, ln); tr_store(Rb, Ib.dst, Ib.ldk, ln); } } }
        if (BOTH(6)) GRID_BAR();
    }
    if (IN(7)) {
        pg8::SchedPlain S; S.o.init(M, D, F.G, bx); S.A = (const char*)(F.ws + WS_ACT); S.B = (const char*)(F.ws + WS_WD); S.tstep = (size_t)256 * DFF * 2;
        pg8::EpiResH16 E{(const bf16*)(F.ws + WS_H16), F.out};
        stagger(MK_STAGGER_US); pg8::gemm_phase<pg8::EpiResH16, pg8::SchedPlain, true, true>(F.lds, DFF, S, E);
    }

#if MK_STOP_AFTER < 4
    {
        GRID_BAR();
        const bf16* pU = (const bf16*)(F.ws + WS_U); const bf16* pV = (const bf16*)(F.ws + WS_V); const bf16* pQ = (const bf16*)(F.ws + WS_Q); const bf16* pK = (const bf16*)(F.ws + WS_K); const bf16* pVV = (const bf16*)(F.ws + WS_VV);
        const bf16* pGA = (const bf16*)(F.ws + WS_GA); const bf16* pGB = (const bf16*)(F.ws + WS_GB); const bf16* pYA = (const bf16*)(F.ws + WS_YA); const bf16* pYB = (const bf16*)(F.ws + WS_YB); const bf16* pM = (const bf16*)(F.ws + WS_MRG);
        for (size_t i = (size_t)bx * 512 + F.tid; i < (size_t)M * D; i += (size_t)F.G * 512) { const size_t m = i >> 12; const int c = (int)(i & 4095), c2 = c & 2047; float v;
            if (MK_STOP_AFTER == 1) v = 0.f * bflo(pGA[i]) + 0.f * bflo(pGB[i]) + 8.f * bflo(((const bf16*)(F.ws + WS_WOA))[(m & 4095) * 2048 + c2]) + 9.f * bflo(((const bf16*)(F.ws + WS_WOB))[(m & 4095) * 2048 + c2]) + 10.f * bflo(((const bf16*)(F.ws + WS_WOUT))[(m & 4095) * 4096 + c]);
            else if (MK_STOP_AFTER == 2) v = c < 2048 ? bflo(pYA[m * 2048 + c2]) : bflo(pYB[m * 2048 + c2]);
            else if (MK_STOP_AFTER == 3) v = bflo(pM[i]);
            else v = F.x[i];
            F.out[i] = v; }
    }
#endif
#if defined(MK_PROBE_P7)
    {
        GRID_BAR();
        pg8::SchedPlain S; S.o.init(M, D, F.G, bx); S.A = (const char*)(F.ws + WS_ACT); S.B = (const char*)(F.ws + WS_WD); S.tstep = (size_t)256 * DFF * 2;
        pg8::EpiResF32 E{F.out, (float*)(F.ws + WS_END)};
        pg8::gemm_phase<pg8::EpiResF32, pg8::SchedPlain, true, true>(F.lds, DFF, S, E);
    }
#endif
#undef IN
#undef BOTH
#undef GRID_BAR
}

extern "C" void kernel_launch(void* const* d_in, const int* in_sizes, int n_in, void* d_out, int out_size, void* d_ws, size_t ws_size, hipStream_t stream) {
    static int grid = 0;
    if (grid == 0) {
        if (n_in != 17 || in_sizes[0] != M * D || out_size != M * D || ws_size < WS_END) { fprintf(stderr, "kernel_launch: unexpected shapes/workspace (n_in %d, in0 %d, out %d, ws %zu < %zu); nothing launched\n", n_in, n_in > 0 ? in_sizes[0] : -1, out_size, ws_size, (size_t)WS_END); grid = -1; return; }
        int dev = 0, cus = 0, per_cu = 0;
        if (hipGetDevice(&dev) != hipSuccess || hipDeviceGetAttribute(&cus, hipDeviceAttributeMultiprocessorCount, dev) != hipSuccess) { grid = -1; return; }
        if (hipFuncSetAttribute((const void*)fwd_kernel, hipFuncAttributeMaxDynamicSharedMemorySize, LDS_BYTES) != hipSuccess) { fprintf(stderr, "kernel_launch: hipFuncSetAttribute failed\n"); grid = -1; return; }
        if (hipOccupancyMaxActiveBlocksPerMultiprocessor(&per_cu, (const void*)fwd_kernel, NWAVES * 64, LDS_BYTES) != hipSuccess || per_cu < 1) fprintf(stderr, "kernel_launch: occupancy query reports %d\n", per_cu);
        (void)hipGetLastError();
        grid = cus - cus % 8;
    }
    if (grid < 0) return;
    if (hipMemsetAsync((char*)d_ws + WS_CTL, 0, CTL_ZERO_BYTES, stream) != hipSuccess) return;
    Args a{};
    for (int i = 0; i < 17; ++i) a.in[i] = (const float*)d_in[i];
    a.out = (float*)d_out; a.ws = (unsigned char*)d_ws;
    for (int li = 0; li < N_LAUNCHES; ++li) {
        if (N_LAUNCHES == PER_PHASE) { a.ph_lo = li; a.ph_hi = li + 1; } else { a.ph_lo = 0; a.ph_hi = PER_PHASE; }
        a.li = li; a.pad = 0;
        hipLaunchKernelGGL(fwd_kernel, dim3(grid), dim3(NWAVES * 64), LDS_BYTES, stream, a);
        const hipError_t le = hipPeekAtLastError();
        if (le != hipSuccess) { fprintf(stderr, "kernel_launch: launch %d failed: %s\n", li, hipGetErrorName(le)); break; }
    }
}
```

```cpp
#include <hip/hip_runtime.h>
#include <cstdio>
#include <cstdint>

#ifndef MK_N_LAUNCHES
#define MK_N_LAUNCHES 1
#endif
#ifndef MK_REPEAT
#define MK_REPEAT 0
#endif
#define NREP(k) (((MK_REPEAT >> (k)) & 1) + 1)
#ifndef MK_STOP_AFTER
#define MK_STOP_AFTER 7
#endif

__device__ __forceinline__ int opaque_tid() { int t = (int)threadIdx.x; asm volatile("" : "+v"(t)); return t; }
namespace pg8 {
#define PG8_LAS __attribute__((address_space(3)))
typedef unsigned short bf16_t;
typedef short bf16x8 __attribute__((ext_vector_type(8)));
typedef float f32x4 __attribute__((ext_vector_type(4)));
typedef float f32x2 __attribute__((ext_vector_type(2)));
typedef unsigned u32x4 __attribute__((ext_vector_type(4)));
typedef unsigned u32x2 __attribute__((ext_vector_type(2)));
constexpr int BM = 256, BK = 64, HALF = 128, HTB = HALF * BK * 2  , STAGE_BYTES = 8 * HTB, NXCD = 8, WGM = 8;

__host__ __device__ __forceinline__ int lds_byte(int r, int c) { const int st = (r >> 4) * 2 + (c >> 5), rr = r & 15, cc = c & 31, ob = rr * 64 + cc * 2; return st * 1024 + (ob ^ (((ob >> 9) & 1) << 5)); }
__host__ __device__ __forceinline__ void stage_rc(int b, int& R, int& C) { const int st = b / 1024, sb = b % 1024, swz = sb ^ (((sb >> 9) & 1) << 5); R = (st >> 1) * 16 + swz / 64; C = (st & 1) * 32 + (swz % 64) / 2; }
__host__ __device__ __forceinline__ int perm32(int rho) { const int n = rho >> 4, i = rho & 15; return 8 * (i >> 2) + 4 * n + (i & 3); }

__host__ __device__ __forceinline__ size_t blk_off(int row, int kb, int KB) { return (((size_t)(row >> 8) * (KB >> 7) + (kb >> 7)) * 256 + (row & 255)) * 128 + (kb & 127); }
struct Unit { int pm, pn, sub; };

struct StaticOrder {
    int nM, nN, nwg, G, c;
    __host__ __device__ void init(int M, int N, int G_, int c_) { nM = M / BM; nN = N / BM; nwg = nM * nN; G = G_; c = c_; }
    __host__ __device__ bool tile(int i, Unit& u) const {
        const long L = (long)i * G + c; if (L >= nwg) return false;
        int wgid = (int)L; { const int q = nwg / NXCD, r = nwg % NXCD, xcd = wgid % NXCD, off = wgid / NXCD; wgid = (xcd < r ? xcd * (q + 1) : r * (q + 1) + (xcd - r) * q) + off; }
        const int nig = WGM * nN, gid = wgid / nig, fm = gid * WGM, gsz = (nM - fm) < WGM ? (nM - fm) : WGM;
        u.pm = fm + ((wgid % nig) % gsz); u.pn = (wgid % nig) / gsz; u.sub = 0; return true;
    }
};
struct SchedPlain {
    StaticOrder o; const char* A; const char* B; size_t tstep;
    __device__ __forceinline__ bool next(int i, Unit& u) const { return o.tile(i, u); }
    __device__ __forceinline__ void ptrs(const Unit& u, const char*& a, const char*& b) const { a = A + (size_t)u.pm * tstep; b = B + (size_t)u.pn * tstep; }
};
struct SchedP1a {
    StaticOrder o; const char* A; const char* B; size_t tstep;
    __device__ __forceinline__ bool next(int i, Unit& u) const { const bool ok = o.tile(i, u); u.pn = u.pn < 16 ? u.pn : u.pn + 24; return ok; }
    __device__ __forceinline__ void ptrs(const Unit& u, const char*& a, const char*& b) const { a = A + (size_t)u.pm * tstep; b = B + (size_t)u.pn * tstep; }
};
struct SchedP1b {
    StaticOrder o; const char* A8; const char* B8; size_t tstep8;
    __device__ __forceinline__ bool next(int i, Unit& u) const { const bool ok = o.tile(i, u); u.sub = u.pn; u.pn = u.pn + 16; return ok; }
    __device__ __forceinline__ void ptrs(const Unit& u, const char*& a, const char*& b) const { a = A8 + (size_t)u.pm * tstep8; b = B8 + (size_t)u.sub * tstep8; }
};
struct SchedMerge {
    StaticOrder o; const char* A0; const char* B0; const char* A1; const char* B1; size_t tstep; size_t tstep8;
    __device__ __forceinline__ bool next(int i, Unit& u) const { const bool ok = o.tile(i >> 1, u); u.sub = i & 1; return ok; }
    __device__ __forceinline__ void ptrs(const Unit& u, const char*& a, const char*& b) const { a = (u.sub ? A1 : A0) + (size_t)u.pm * tstep; b = (u.sub ? B1 : B0) + (size_t)u.pn * tstep; }
};

typedef __bf16 bf16x2v __attribute__((ext_vector_type(2)));
__device__ __forceinline__ unsigned cvt_pk_bf16(float lo, float hi) { const bf16x2v v = __builtin_convertvector((f32x2){lo, hi}, bf16x2v); return __builtin_bit_cast(unsigned, v); }
__device__ __forceinline__ float bf_lo(unsigned w) { return __uint_as_float(w << 16); }
__device__ __forceinline__ float bf_hi(unsigned w) { return __uint_as_float(w & 0xffff0000u); }
__device__ __forceinline__ f32x2 gelu_pk(f32x2 v) {
    const f32x2 av = __builtin_elementwise_abs(v), d = av * 0.2316418882f + 1.0f;
    f32x2 t; t.x = __builtin_amdgcn_rcpf(d.x); t.y = __builtin_amdgcn_rcpf(d.y);
    f32x2 q = t * 0.5307027145f + (-0.7265760135f); q = q * t + 0.7107068705f; q = q * t + (-0.142248368f); q = q * t + 0.127414796f; q = q * t;
    const f32x2 s = (v * v) * (-0.72134752044f);
    f32x2 e; e.x = __builtin_amdgcn_exp2f(s.x); e.y = __builtin_amdgcn_exp2f(s.y);
    const f32x2 m = v * (q * e), r = v - m;
    f32x2 o; o.x = v.x < 0.f ? m.x : r.x; o.y = v.y < 0.f ? m.y : r.y; return o;
}
__device__ __forceinline__ float sigmoid_f(float x) { return __builtin_amdgcn_rcpf(1.0f + __builtin_amdgcn_exp2f(x * -1.44269504089f)); }
__device__ __forceinline__ f32x4 gelu4(f32x4 v) { const f32x2 a = gelu_pk((f32x2){v[0], v[1]}), b = gelu_pk((f32x2){v[2], v[3]}); return (f32x4){a.x, a.y, b.x, b.y}; }
__device__ __forceinline__ f32x4 sigm4(f32x4 v) { return (f32x4){sigmoid_f(v[0]), sigmoid_f(v[1]), sigmoid_f(v[2]), sigmoid_f(v[3])}; }
__device__ __forceinline__ u32x4 pack8(f32x4 v0, f32x4 v1) { u32x4 w; w.x = cvt_pk_bf16(v0[0], v0[1]); w.y = cvt_pk_bf16(v0[2], v0[3]); w.z = cvt_pk_bf16(v1[0], v1[1]); w.w = cvt_pk_bf16(v1[2], v1[3]); return w; }

__device__ __forceinline__ size_t lane_tile_idx(int T, int wr, int wc, int fr, int fq, int ai, int m, int bj) { return ((size_t)T * 128 + (((wr * 4 + wc) * 2 + ai) * 4 + m) * 2 + bj) * 64 + fr + 16 * fq; }
__device__ __forceinline__ unsigned pack_u8x4(f32x4 v) { const f32x4 q = v * 255.f + 0.5f; return (unsigned)q[0] | ((unsigned)q[1] << 8) | ((unsigned)q[2] << 16) | ((unsigned)q[3] << 24); }
__device__ __forceinline__ f32x4 unpack_u8x4(unsigned w) { return (f32x4){(float)(w & 0xffu), (float)((w >> 8) & 0xffu), (float)((w >> 16) & 0xffu), (float)(w >> 24)}; }
struct EpiProj {
    static constexpr bool PERM = true;
    bf16_t* base; int M; float qkv_scale;
    float* vstat;
    __device__ __forceinline__ void store_v(const f32x4 (&acc)[2][2][4][2], bf16_t* O, int row0, int col0, int slice, int fq, size_t bjs) const {
#pragma unroll
        for (int ai = 0; ai < 2; ++ai)
#pragma unroll
            for (int m = 0; m < 4; ++m) { const int row = row0 + ai * HALF + m * 16; bf16_t* rowp = O + (size_t)row * 128 + col0; float s = 0.f, s2 = 0.f;
#pragma unroll
                for (int bj = 0; bj < 2; ++bj) { const f32x4 v0 = gelu4(acc[ai][bj][m][0]), v1 = gelu4(acc[ai][bj][m][1]);
                    s += ((v0[0] + v0[1]) + (v0[2] + v0[3])) + ((v1[0] + v1[1]) + (v1[2] + v1[3]));
                    s2 += ((v0[0] * v0[0] + v0[1] * v0[1]) + (v0[2] * v0[2] + v0[3] * v0[3])) + ((v1[0] * v1[0] + v1[1] * v1[1]) + (v1[2] * v1[2] + v1[3] * v1[3]));
                    *(u32x4*)(rowp + bj * bjs) = pack8(v0, v1); }
                s += __shfl_xor(s, 16); s += __shfl_xor(s, 32); s2 += __shfl_xor(s2, 16); s2 += __shfl_xor(s2, 32);
                if (fq == 0) *(f32x2*)(vstat + (size_t)row * 64 + 2 * slice) = (f32x2){s, s2}; }
    }
    __device__ __forceinline__ bool keep(const Unit&) const { return false; }
    template <int ACT> __device__ __forceinline__ void store(const f32x4 (&acc)[2][2][4][2], bf16_t* O, int ldc, int row0, int col0, size_t bjs) const {
#pragma unroll
        for (int ai = 0; ai < 2; ++ai)
#pragma unroll
            for (int m = 0; m < 4; ++m) { bf16_t* rowp = O + (size_t)(row0 + ai * HALF + m * 16) * ldc + col0;
#pragma unroll
                for (int bj = 0; bj < 2; ++bj) { f32x4 v0 = acc[ai][bj][m][0], v1 = acc[ai][bj][m][1];
                    if (ACT == 0) { v0 = v0 * qkv_scale; v1 = v1 * qkv_scale; }
                    if (ACT == 1) { v0 = gelu4(v0); v1 = gelu4(v1); }
                    if (ACT == 2) { v0 = sigm4(v0); v1 = sigm4(v1); }
                    *(u32x4*)(rowp + bj * bjs) = pack8(v0, v1); } }
    }
    __device__ __forceinline__ void operator()(f32x4 (&acc)[2][2][4][2], const Unit& u, int wr, int wc, int fr, int fq) const {
        const int row0 = u.pm * BM + wr * 64 + fr, pn = u.pn;
        if (pn < 40) { const int t = pn >> 3; const size_t hs = (size_t)M * 128; bf16_t* O = base + (size_t)t * M * 2048 + (size_t)(2 * (pn & 7)) * hs; const int col0 = wc * 32 + 8 * fq;
            if (t == 0) store<1>(acc, O, 128, row0, col0, hs); else if (t == 1) store_v(acc, O, row0, col0, (pn & 7) * 4 + wc, fq, hs); else store<0>(acc, O, 128, row0, col0, hs); }
        else { const int t = (pn - 40) >> 4; bf16_t* O = base + (size_t)5 * M * 2048 + (size_t)t * M * 4096; const int col0 = ((pn - 40) & 15) * BM + wc * 32 + 8 * fq;
            store<2>(acc, O, 4096, row0, col0, HALF); }
    }
};
struct EpiQKV {
    static constexpr bool PERM = true;
    bf16_t* base; int M; float sc; unsigned char* ga8; unsigned char* gb8;
    __device__ __forceinline__ void store_gate(const f32x4 (&acc)[2][2][4][2], unsigned char* O8, int T, int wr, int wc, int fr, int fq) const {
#pragma unroll
        for (int ai = 0; ai < 2; ++ai)
#pragma unroll
            for (int m = 0; m < 4; ++m)
#pragma unroll
                for (int bj = 0; bj < 2; ++bj) { const f32x4 v0 = sigm4(acc[ai][bj][m][0] * sc), v1 = sigm4(acc[ai][bj][m][1] * sc);
                    *(u32x2*)(O8 + lane_tile_idx(T, wr, wc, fr, fq, ai, m, bj) * 8) = (u32x2){pack_u8x4(v0), pack_u8x4(v1)}; }
    }
    __device__ __forceinline__ bool keep(const Unit&) const { return false; }
    template <int ACT> __device__ __forceinline__ void store(const f32x4 (&acc)[2][2][4][2], bf16_t* O, int ldc, int row0, int col0, size_t bjs) const {
#pragma unroll
        for (int ai = 0; ai < 2; ++ai)
#pragma unroll
            for (int m = 0; m < 4; ++m) { bf16_t* rowp = O + (size_t)(row0 + ai * HALF + m * 16) * ldc + col0;
#pragma unroll
                for (int bj = 0; bj < 2; ++bj) { f32x4 v0 = acc[ai][bj][m][0] * sc, v1 = acc[ai][bj][m][1] * sc;
                    if (ACT == 2) { v0 = sigm4(v0); v1 = sigm4(v1); }
                    *(u32x4*)(rowp + bj * bjs) = pack8(v0, v1); } }
    }
    __device__ __forceinline__ void operator()(f32x4 (&acc)[2][2][4][2], const Unit& u, int wr, int wc, int fr, int fq) const {
        const int row0 = u.pm * BM + wr * 64 + fr;
        if (u.pn < 40) store<0>(acc, base + (size_t)(u.pn >> 3) * M * 2048 + (size_t)(2 * (u.pn & 7)) * M * 128, 128, row0, wc * 32 + 8 * fq, (size_t)M * 128);
        else store_gate(acc, u.pn < 56 ? ga8 : gb8, u.pm * 16 + ((u.pn - 40) & 15), wr, wc, fr, fq);
    }
};
struct EpiTB {
    static constexpr bool PERM = true;
    const unsigned char* GB; bf16_t* T; float sc;
    __device__ __forceinline__ bool keep(const Unit&) const { return false; }
    __device__ __forceinline__ void operator()(f32x4 (&acc)[2][2][4][2], const Unit& u, int wr, int wc, int fr, int fq) const {
        const int row0 = u.pm * BM + wr * 64 + fr, col0 = u.pn * BM + wc * 32 + 8 * fq;
#pragma unroll
        for (int ai = 0; ai < 2; ++ai)
#pragma unroll
            for (int m = 0; m < 4; ++m) { const size_t off = (size_t)(row0 + ai * HALF + m * 16) * 4096 + col0;
#pragma unroll
                for (int bj = 0; bj < 2; ++bj) { const u32x2 b = *(const u32x2*)(GB + off + bj * HALF);
                    const f32x4 s0 = unpack_u8x4(b.x) * sc, s1 = unpack_u8x4(b.y) * sc;
                    *(u32x4*)(T + off + bj * HALF) = pack8(acc[ai][bj][m][0] * s0, acc[ai][bj][m][1] * s1); } }
    }
};
struct EpiMergeA {
    static constexpr bool PERM = true;
    const unsigned char* GA; const bf16_t* T; bf16_t* O;
    __device__ __forceinline__ bool keep(const Unit&) const { return false; }
    __device__ __forceinline__ void operator()(f32x4 (&acc)[2][2][4][2], const Unit& u, int wr, int wc, int fr, int fq) const {
        const int row0 = u.pm * BM + wr * 64 + fr, col0 = u.pn * BM + wc * 32 + 8 * fq;
#pragma unroll
        for (int ai = 0; ai < 2; ++ai)
#pragma unroll
            for (int m = 0; m < 4; ++m) { const size_t off = (size_t)(row0 + ai * HALF + m * 16) * 4096 + col0;
#pragma unroll
                for (int bj = 0; bj < 2; ++bj) { const u32x2 a = *(const u32x2*)(GA + off + bj * HALF); const u32x4 t = *(const u32x4*)(T + off + bj * HALF);
                    const f32x4 s0 = unpack_u8x4(a.x) * (1.f / 255.f), s1 = unpack_u8x4(a.y) * (1.f / 255.f);
                    const f32x4 t0 = (f32x4){bf_lo(t.x), bf_hi(t.x), bf_lo(t.y), bf_hi(t.y)}, t1 = (f32x4){bf_lo(t.z), bf_hi(t.z), bf_lo(t.w), bf_hi(t.w)};
                    *(u32x4*)(O + off + bj * HALF) = pack8(acc[ai][bj][m][0] * s0 + t0, acc[ai][bj][m][1] * s1 + t1); } }
    }
};
struct EpiMix {
    static constexpr bool PERM = true;
    const unsigned char* GA; const unsigned char* GB; bf16_t* O; float c;
    __device__ __forceinline__ bool keep(const Unit& u) const { return u.sub == 0; }
    __device__ __forceinline__ void operator()(f32x4 (&acc)[2][2][4][2], const Unit& u, int wr, int wc, int fr, int fq) const {
        const int row0 = u.pm * BM + wr * 64 + fr, col0 = u.pn * BM + wc * 32 + 8 * fq;
        if (u.sub == 0) {
#pragma unroll
            for (int ai = 0; ai < 2; ++ai)
#pragma unroll
                for (int m = 0; m < 4; ++m) { const size_t off = (size_t)(row0 + ai * HALF + m * 16) * 4096 + col0;
#pragma unroll
                    for (int bj = 0; bj < 2; ++bj) { const size_t gi = lane_tile_idx(u.pm * 16 + u.pn, wr, wc, fr, fq, ai, m, bj) * 8; (void)off; const u32x2 a = *(const u32x2*)(GA + gi), b = *(const u32x2*)(GB + gi);
                        f32x4 a0 = __builtin_elementwise_max(unpack_u8x4(a.x), (f32x4){9.5367431640625e-7f, 9.5367431640625e-7f, 9.5367431640625e-7f, 9.5367431640625e-7f});
                        f32x4 a1 = __builtin_elementwise_max(unpack_u8x4(a.y), (f32x4){9.5367431640625e-7f, 9.5367431640625e-7f, 9.5367431640625e-7f, 9.5367431640625e-7f});
                        const f32x4 r0 = (f32x4){__builtin_amdgcn_rcpf(a0[0]), __builtin_amdgcn_rcpf(a0[1]), __builtin_amdgcn_rcpf(a0[2]), __builtin_amdgcn_rcpf(a0[3])};
                        const f32x4 r1 = (f32x4){__builtin_amdgcn_rcpf(a1[0]), __builtin_amdgcn_rcpf(a1[1]), __builtin_amdgcn_rcpf(a1[2]), __builtin_amdgcn_rcpf(a1[3])};
                        acc[ai][bj][m][0] = acc[ai][bj][m][0] * (unpack_u8x4(b.x) * c) * r0; acc[ai][bj][m][1] = acc[ai][bj][m][1] * (unpack_u8x4(b.y) * c) * r1; } }
        } else {
#pragma unroll
            for (int ai = 0; ai < 2; ++ai)
#pragma unroll
                for (int m = 0; m < 4; ++m) { const size_t off = (size_t)(row0 + ai * HALF + m * 16) * 4096 + col0;
#pragma unroll
                    for (int bj = 0; bj < 2; ++bj) { const u32x2 a = *(const u32x2*)(GA + lane_tile_idx(u.pm * 16 + u.pn, wr, wc, fr, fq, ai, m, bj) * 8);
                        const f32x4 a0 = __builtin_elementwise_max(unpack_u8x4(a.x), (f32x4){9.5367431640625e-7f, 9.5367431640625e-7f, 9.5367431640625e-7f, 9.5367431640625e-7f}) * (1.f / 255.f);
                        const f32x4 a1 = __builtin_elementwise_max(unpack_u8x4(a.y), (f32x4){9.5367431640625e-7f, 9.5367431640625e-7f, 9.5367431640625e-7f, 9.5367431640625e-7f}) * (1.f / 255.f);
                        *(u32x4*)((char*)O + blk_off(row0 + ai * HALF + m * 16, (col0 + bj * HALF) * 2, 8192)) = pack8(acc[ai][bj][m][0] * a0, acc[ai][bj][m][1] * a1); (void)off; } }
        }
    }
};
__device__ __forceinline__ float sb_lo(unsigned w) { return fmaxf(bf_lo(w), 8.673617379884035e-19f); }
__device__ __forceinline__ float sb_hi(unsigned w) { return fmaxf(bf_hi(w), 8.673617379884035e-19f); }
struct EpiMerge {
    static constexpr bool PERM = true;
    const bf16_t* GA; const bf16_t* GB; bf16_t* O;
    __device__ __forceinline__ bool keep(const Unit& u) const { return u.sub == 0; }
    __device__ __forceinline__ void operator()(f32x4 (&acc)[2][2][4][2], const Unit& u, int wr, int wc, int fr, int fq) const {
        const int row0 = u.pm * BM + wr * 64 + fr, col0 = u.pn * BM + wc * 32 + 8 * fq;
        if (u.sub == 0) {
#pragma unroll
            for (int ai = 0; ai < 2; ++ai)
#pragma unroll
                for (int m = 0; m < 4; ++m) { const size_t off = (size_t)(row0 + ai * HALF + m * 16) * 4096 + col0;
#pragma unroll
                    for (int bj = 0; bj < 2; ++bj) { const u32x4 a = *(const u32x4*)(GA + off + bj * HALF), b = *(const u32x4*)(GB + off + bj * HALF);
                        f32x4 r0, r1;
                        r0[0] = bf_lo(a.x) * __builtin_amdgcn_rcpf(sb_lo(b.x)); r0[1] = bf_hi(a.x) * __builtin_amdgcn_rcpf(sb_hi(b.x));
                        r0[2] = bf_lo(a.y) * __builtin_amdgcn_rcpf(sb_lo(b.y)); r0[3] = bf_hi(a.y) * __builtin_amdgcn_rcpf(sb_hi(b.y));
                        r1[0] = bf_lo(a.z) * __builtin_amdgcn_rcpf(sb_lo(b.z)); r1[1] = bf_hi(a.z) * __builtin_amdgcn_rcpf(sb_hi(b.z));
                        r1[2] = bf_lo(a.w) * __builtin_amdgcn_rcpf(sb_lo(b.w)); r1[3] = bf_hi(a.w) * __builtin_amdgcn_rcpf(sb_hi(b.w));
                        acc[ai][bj][m][0] *= r0; acc[ai][bj][m][1] *= r1; } }
        } else {
#pragma unroll
            for (int ai = 0; ai < 2; ++ai)
#pragma unroll
                for (int m = 0; m < 4; ++m) { const size_t off = (size_t)(row0 + ai * HALF + m * 16) * 4096 + col0;
#pragma unroll
                    for (int bj = 0; bj < 2; ++bj) { const u32x4 b = *(const u32x4*)(GB + off + bj * HALF);
                        const f32x4 s0 = (f32x4){sb_lo(b.x), sb_hi(b.x), sb_lo(b.y), sb_hi(b.y)}, s1 = (f32x4){sb_lo(b.z), sb_hi(b.z), sb_lo(b.w), sb_hi(b.w)};
                        *(u32x4*)(O + off + bj * HALF) = pack8(acc[ai][bj][m][0] * s0, acc[ai][bj][m][1] * s1); } }
        }
    }
};
struct EpiResF32 {
    static constexpr bool PERM = false;
    const float* res; float* out;
    __device__ __forceinline__ bool keep(const Unit&) const { return false; }
    __device__ __forceinline__ void operator()(f32x4 (&acc)[2][2][4][2], const Unit& u, int wr, int wc, int fr, int fq) const {
        const int row0 = u.pm * BM + wr * 64 + fr, col0 = u.pn * BM + wc * 32 + 4 * fq;
#pragma unroll
        for (int ai = 0; ai < 2; ++ai)
#pragma unroll
            for (int m = 0; m < 4; ++m) { const size_t off = (size_t)(row0 + ai * HALF + m * 16) * 4096 + col0;
#pragma unroll
                for (int bj = 0; bj < 2; ++bj)
#pragma unroll
                    for (int n = 0; n < 2; ++n) { const f32x4 r = *(const f32x4*)(res + off + bj * HALF + n * 16); *(f32x4*)(out + off + bj * HALF + n * 16) = r + acc[ai][bj][m][n]; } }
    }
};
struct EpiResH16 {
    static constexpr bool PERM = true;
    const bf16_t* h16; float* out;
    __device__ __forceinline__ bool keep(const Unit&) const { return false; }
    __device__ __forceinline__ void operator()(f32x4 (&acc)[2][2][4][2], const Unit& u, int wr, int wc, int fr, int fq) const {
        const int row0 = u.pm * BM + wr * 64 + fr, col0 = u.pn * BM + wc * 32 + 8 * fq;
#pragma unroll
        for (int ai = 0; ai < 2; ++ai)
#pragma unroll
            for (int m = 0; m < 4; ++m) { const size_t off = (size_t)(row0 + ai * HALF + m * 16) * 4096 + col0;
#pragma unroll
                for (int bj = 0; bj < 2; ++bj) { const u32x4 hb = *(const u32x4*)(h16 + lane_tile_idx(u.pm * 16 + u.pn, wr, wc, fr, fq, ai, m, bj) * 8);
                    const f32x4 h0 = (f32x4){bf_lo(hb.x), bf_hi(hb.x), bf_lo(hb.y), bf_hi(hb.y)}, h1 = (f32x4){bf_lo(hb.z), bf_hi(hb.z), bf_lo(hb.w), bf_hi(hb.w)};
                    *(f32x4*)(out + off + bj * HALF) = h0 + acc[ai][bj][m][0]; *(f32x4*)(out + off + bj * HALF + 4) = h1 + acc[ai][bj][m][1]; } }
    }
};
struct EpiOutNorm {
    static constexpr bool PERM = true;
    const float* x; bf16_t* h16; bf16_t* HN; const float* g2; float* part;
    __device__ __forceinline__ bool keep(const Unit&) const { return false; }
    __device__ __forceinline__ void operator()(f32x4 (&acc)[2][2][4][2], const Unit& u, int wr, int wc, int fr, int fq) const {
        const int row0 = u.pm * BM + wr * 64 + fr, col0 = u.pn * BM + wc * 32 + 8 * fq;
        f32x4 gg[2][2];
#pragma unroll
        for (int bj = 0; bj < 2; ++bj)
#pragma unroll
            for (int n = 0; n < 2; ++n) gg[bj][n] = *(const f32x4*)(g2 + col0 + bj * HALF + 4 * n);
#pragma unroll
        for (int ai = 0; ai < 2; ++ai)
#pragma unroll
            for (int m = 0; m < 4; ++m) { const int row = row0 + ai * HALF + m * 16; const size_t off = (size_t)row * 4096 + col0; float ss = 0.f;
#pragma unroll
                for (int bj = 0; bj < 2; ++bj) { const f32x4 x0 = *(const f32x4*)(x + off + bj * HALF), x1 = *(const f32x4*)(x + off + bj * HALF + 4);
                    const f32x4 h0 = x0 + acc[ai][bj][m][0], h1 = x1 + acc[ai][bj][m][1];
                    *(u32x4*)(h16 + lane_tile_idx(u.pm * 16 + u.pn, wr, wc, fr, fq, ai, m, bj) * 8) = pack8(h0, h1);
                    ss += ((h0[0] * h0[0] + h0[1] * h0[1]) + (h0[2] * h0[2] + h0[3] * h0[3])) + ((h1[0] * h1[0] + h1[1] * h1[1]) + (h1[2] * h1[2] + h1[3] * h1[3]));
                    *(u32x4*)((char*)HN + blk_off(row, (col0 + bj * HALF) * 2, 8192)) = pack8(h0 * gg[bj][0], h1 * gg[bj][1]); }
                ss += __shfl_xor(ss, 16); ss += __shfl_xor(ss, 32);
                if (fq == 0) part[(size_t)row * 64 + u.pn * 4 + wc] = ss; }
    }
};
struct EpiSwiglu {
    static constexpr bool PERM = true; static constexpr int NST = 4;
    bf16_t* O; int ldc; const PG8_LAS float* rstd; int fm;
    __device__ __forceinline__ bool keep(const Unit&) const { return false; }
    template <int AI> __device__ __forceinline__ void half(const f32x4 (&acc)[2][2][4][2], const Unit& u, int wr, int wc, int fr, int fq) const {
        const int row0 = u.pm * BM + wr * 64 + fr, col0 = u.pn * HALF + wc * 32 + 8 * fq, rl0 = (u.pm - fm) * BM + wr * 64 + fr;
#pragma unroll
        for (int m = 0; m < 4; ++m) { bf16_t* rowp = (bf16_t*)((char*)O + blk_off(row0 + AI * HALF + m * 16, col0 * 2, ldc * 2)); const float r = rstd[rl0 + AI * HALF + m * 16];
            const f32x4 g0 = acc[AI][0][m][0] * r, g1 = acc[AI][0][m][1] * r;
            const f32x4 v0 = g0 * sigm4(g0) * (acc[AI][1][m][0] * r), v1 = g1 * sigm4(g1) * (acc[AI][1][m][1] * r);
            *(u32x4*)rowp = pack8(v0, v1); }
    }
    __device__ __forceinline__ void operator()(f32x4 (&acc)[2][2][4][2], const Unit& u, int wr, int wc, int fr, int fq) const { half<0>(acc, u, wr, wc, fr, fq); half<1>(acc, u, wr, wc, fr, fq); }
};

template <class Epi, class Sched, bool ALIGN_EPI, bool SP2>
__device__ __forceinline__ void gemm_phase(PG8_LAS unsigned char* lds, const int K, const Sched& S, const Epi& E) {
    const int tid = opaque_tid(), wid = __builtin_amdgcn_readfirstlane(tid >> 6), lane = tid & 63, wr = wid >> 2, wc = wid & 3, fr = lane & 15, fq = lane >> 4;
    const int nt = K / BK;
    unsigned voffA[2], voffB[2];
#pragma unroll
    for (int i = 0; i < 2; ++i) { int R, C; stage_rc(tid * 16 + i * 8192, R, C); const int Rb = Epi::PERM ? ((R & ~31) + perm32(R & 31)) : R;
        voffA[i] = (unsigned)(R * 128 + C * 2); voffB[i] = (unsigned)(Rb * 128 + C * 2); }
    const size_t kstep = 32768;
    const size_t hstep = (size_t)HALF * 128;
    const unsigned ldsw = (unsigned)wid * 1024u;
    const int aoff = lds_byte(wr * 64 + fr, fq * 8), boff = lds_byte(wc * 32 + fr, fq * 8);
#define PG8_SA(b, h) (((b) * 2 + (h)) * HTB)
#define PG8_SB(b, h) ((4 + (b) * 2 + (h)) * HTB)
#define PG8_STAGE(bufoff, gbase, voff) do { _Pragma("unroll") for (int _i = 0; _i < 2; ++_i) \
        __builtin_amdgcn_global_load_lds((const unsigned*)((const char*)(gbase) + (voff)[_i]), (PG8_LAS unsigned*)(lds + (bufoff) + ldsw + _i * 8192), 16, 0, 0); } while (0)
#define PG8_LDA(dst, b, h) do { _Pragma("unroll") for (int m = 0; m < 4; ++m) _Pragma("unroll") for (int k = 0; k < 2; ++k) dst[m][k] = *(const PG8_LAS bf16x8*)(lds + PG8_SA(b, h) + aoff + m * 2048 + k * 1024); } while (0)
#define PG8_LDB(dst, b, h) do { _Pragma("unroll") for (int n = 0; n < 2; ++n) _Pragma("unroll") for (int k = 0; k < 2; ++k) dst[n][k] = *(const PG8_LAS bf16x8*)(lds + PG8_SB(b, h) + boff + n * 2048 + k * 1024); } while (0)
#define PG8_MMA(ai, bj, At, Bt) do { __builtin_amdgcn_s_setprio(1); _Pragma("unroll") for (int m = 0; m < 4; ++m) _Pragma("unroll") for (int n = 0; n < 2; ++n) _Pragma("unroll") for (int k = 0; k < 2; ++k) \
        acc[ai][bj][m][n] = __builtin_amdgcn_mfma_f32_16x16x32_bf16(Bt[n][k], At[m][k], acc[ai][bj][m][n], 0, 0, 0); __builtin_amdgcn_s_setprio(0); } while (0)
#define PG8_WAIT_V(n) asm volatile("s_waitcnt vmcnt(" #n ")" ::: "memory")
#define PG8_WAIT_L(n) asm volatile("s_waitcnt lgkmcnt(" #n ")" ::: "memory")
#define PG8_BAR __builtin_amdgcn_s_barrier()
#define PG8_SCHED __builtin_amdgcn_sched_barrier(0)
    Unit cur, nxt; int ui = 0;
    if (!S.next(0, cur)) return;
    f32x4 acc[2][2][4][2];
#pragma unroll
    for (int a = 0; a < 2; ++a)
#pragma unroll
        for (int b = 0; b < 2; ++b)
#pragma unroll
            for (int m = 0; m < 4; ++m)
#pragma unroll
                for (int n = 0; n < 2; ++n) acc[a][b][m][n] = (f32x4){0.f, 0.f, 0.f, 0.f};
    bf16x8 At[4][2], B0[2][2], B1[2][2];
    const char* cA; const char* cB; S.ptrs(cur, cA, cB);
    if constexpr (SP2) {
        PG8_STAGE(PG8_SB(0, 0), cB, voffB); PG8_STAGE(PG8_SB(0, 1), cB + hstep, voffB); PG8_STAGE(PG8_SA(0, 0), cA, voffA); PG8_STAGE(PG8_SA(0, 1), cA + hstep, voffA);
        if (wr == 1) PG8_BAR;
        PG8_WAIT_V(2); PG8_BAR;
        PG8_STAGE(PG8_SB(1, 0), cB + kstep, voffB); PG8_STAGE(PG8_SA(1, 0), cA + kstep, voffA); PG8_STAGE(PG8_SB(1, 1), cB + hstep + kstep, voffB);
        PG8_WAIT_V(6); PG8_BAR;
    } else {
        PG8_STAGE(PG8_SB(0, 0), cB, voffB); PG8_STAGE(PG8_SA(0, 0), cA, voffA); PG8_STAGE(PG8_SB(0, 1), cB + hstep, voffB); PG8_STAGE(PG8_SA(0, 1), cA + hstep, voffA);
        if (wr == 1) PG8_BAR;
        PG8_WAIT_V(4); PG8_BAR;
        PG8_STAGE(PG8_SB(1, 0), cB + kstep, voffB); PG8_STAGE(PG8_SA(1, 0), cA + kstep, voffA); PG8_STAGE(PG8_SB(1, 1), cB + hstep + kstep, voffB);
        PG8_WAIT_V(6); PG8_BAR;
    }
    for (;;) {
        const bool has_next = S.next(ui + 1, nxt);
        const char* nA = cA; const char* nB = cB; if (has_next) S.ptrs(nxt, nA, nB);
        for (int t = 0; t < nt; t += 2) {
            const bool last = (t == nt - 2);
            const char* a1 = cA + (size_t)(t + 1) * kstep;
            const char* a2 = last ? nA : cA + (size_t)(t + 2) * kstep; const char* b2 = last ? nB : cB + (size_t)(t + 2) * kstep;
            const char* a3 = a2 + kstep; const char* b3 = b2 + kstep;
            if constexpr (SP2) {
            PG8_LDB(B0, 0, 0); PG8_LDB(B1, 0, 1); PG8_SCHED; PG8_LDA(At, 0, 0); PG8_STAGE(PG8_SA(1, 1), a1 + hstep, voffA);
            PG8_WAIT_V(8); PG8_WAIT_L(0); PG8_BAR; PG8_MMA(0, 0, At, B0); PG8_MMA(0, 1, At, B1); PG8_BAR; PG8_SCHED;
            PG8_LDA(At, 0, 1); PG8_STAGE(PG8_SB(0, 0), b2, voffB); PG8_STAGE(PG8_SB(0, 1), b2 + hstep, voffB); PG8_STAGE(PG8_SA(0, 0), a2, voffA);
            PG8_WAIT_V(8); PG8_WAIT_L(0); PG8_BAR; PG8_MMA(1, 0, At, B0); PG8_MMA(1, 1, At, B1); PG8_BAR; PG8_SCHED;
            PG8_LDB(B0, 1, 0); PG8_LDB(B1, 1, 1); PG8_SCHED; PG8_LDA(At, 1, 0); PG8_STAGE(PG8_SA(0, 1), a2 + hstep, voffA);
            PG8_WAIT_V(8); PG8_WAIT_L(0); PG8_BAR; PG8_MMA(0, 0, At, B0); PG8_MMA(0, 1, At, B1); PG8_BAR; PG8_SCHED;
            PG8_LDA(At, 1, 1); PG8_STAGE(PG8_SB(1, 0), b3, voffB); PG8_STAGE(PG8_SB(1, 1), b3 + hstep, voffB); PG8_STAGE(PG8_SA(1, 0), a3, voffA);
            PG8_WAIT_V(8); PG8_WAIT_L(0); PG8_BAR; PG8_MMA(1, 0, At, B0); PG8_MMA(1, 1, At, B1); PG8_BAR; PG8_SCHED;
            } else {
            PG8_LDB(B0, 0, 0); PG8_SCHED; PG8_LDA(At, 0, 0); PG8_STAGE(PG8_SA(1, 1), a1 + hstep, voffA);
            PG8_WAIT_L(8); PG8_BAR; PG8_WAIT_L(0); PG8_MMA(0, 0, At, B0); PG8_BAR; PG8_SCHED;
            PG8_LDB(B1, 0, 1); PG8_STAGE(PG8_SB(0, 0), b2, voffB);
            PG8_BAR; PG8_WAIT_L(0); PG8_MMA(0, 1, At, B1); PG8_BAR;
            PG8_LDA(At, 0, 1); PG8_STAGE(PG8_SA(0, 0), a2, voffA);
            PG8_BAR; PG8_WAIT_L(0); PG8_MMA(1, 0, At, B0); PG8_BAR; PG8_SCHED;
            PG8_STAGE(PG8_SB(0, 1), b2 + hstep, voffB);
            PG8_WAIT_V(6); PG8_BAR; PG8_MMA(1, 1, At, B1); PG8_BAR;
            PG8_LDB(B0, 1, 0); PG8_SCHED; PG8_LDA(At, 1, 0); PG8_STAGE(PG8_SA(0, 1), a2 + hstep, voffA);
            PG8_WAIT_L(8); PG8_BAR; PG8_WAIT_L(0); PG8_MMA(0, 0, At, B0); PG8_BAR; PG8_SCHED;
            PG8_LDB(B1, 1, 1); PG8_STAGE(PG8_SB(1, 0), b3, voffB);
            PG8_BAR; PG8_WAIT_L(0); PG8_MMA(0, 1, At, B1); PG8_BAR;
            PG8_LDA(At, 1, 1); PG8_STAGE(PG8_SA(1, 0), a3, voffA);
            PG8_BAR; PG8_WAIT_L(0); PG8_MMA(1, 0, At, B0); PG8_BAR; PG8_SCHED;
            PG8_STAGE(PG8_SB(1, 1), b3 + hstep, voffB);
            PG8_WAIT_V(6); PG8_BAR; PG8_MMA(1, 1, At, B1); PG8_BAR;
            }
        }
        if constexpr (ALIGN_EPI) { if (wr == 0) PG8_BAR; }
        E(acc, cur, wr, wc, fr, fq);
        if (!has_next) break;
        if (!E.keep(cur)) {
#pragma unroll
            for (int a = 0; a < 2; ++a)
#pragma unroll
                for (int b = 0; b < 2; ++b)
#pragma unroll
                    for (int m = 0; m < 4; ++m)
#pragma unroll
                        for (int n = 0; n < 2; ++n) acc[a][b][m][n] = (f32x4){0.f, 0.f, 0.f, 0.f};
        }
        cur = nxt; cA = nA; cB = nB; ++ui;
        if constexpr (ALIGN_EPI) { if (wr == 1) PG8_BAR; }
    }
    PG8_WAIT_V(0);
    if constexpr (!ALIGN_EPI) { if (wr == 0) PG8_BAR; }
    PG8_BAR;
#undef PG8_SA
#undef PG8_SB
#undef PG8_STAGE
#undef PG8_LDA
#undef PG8_LDB
#undef PG8_MMA
#undef PG8_WAIT_V
#undef PG8_WAIT_L
#undef PG8_BAR
#undef PG8_SCHED
}

typedef int i32x4 __attribute__((ext_vector_type(4)));
typedef int i32x8 __attribute__((ext_vector_type(8)));
template <class Epi, class Sched>
__device__ __forceinline__ void gemm_phase_f8(PG8_LAS unsigned char* lds, const int K, const Sched& S, const Epi& E) {
    const int tid = opaque_tid(), wid = __builtin_amdgcn_readfirstlane(tid >> 6), lane = tid & 63, wr = wid >> 2, wc = wid & 3, fr = lane & 15, fq = lane >> 4;
    const int nt = K / 128;
    unsigned voffA[2], voffB[2];
#pragma unroll
    for (int i = 0; i < 2; ++i) { int R, C; stage_rc(tid * 16 + i * 8192, R, C); const int Rb = Epi::PERM ? ((R & ~31) + perm32(R & 31)) : R;
        voffA[i] = (unsigned)(R * 128 + 2 * C); voffB[i] = (unsigned)(Rb * 128 + 2 * C); }
    const size_t kstep = 32768;
    const size_t hstep = (size_t)HALF * 128;
    const unsigned ldsw = (unsigned)wid * 1024u;
    const int aoff = lds_byte(wr * 64 + fr, fq * 16), boff = lds_byte(wc * 32 + fr, fq * 16);
#define PG8_SA(b, h) (((b) * 2 + (h)) * HTB)
#define PG8_SB(b, h) ((4 + (b) * 2 + (h)) * HTB)
#define PG8_STAGE(bufoff, gbase, voff) do { _Pragma("unroll") for (int _i = 0; _i < 2; ++_i) \
        __builtin_amdgcn_global_load_lds((const unsigned*)((const char*)(gbase) + (voff)[_i]), (PG8_LAS unsigned*)(lds + (bufoff) + ldsw + _i * 8192), 16, 0, 0); } while (0)
#define PG8_LD8(dst, off) do { const i32x4 _lo = *(const PG8_LAS i32x4*)(lds + (off)), _hi = *(const PG8_LAS i32x4*)(lds + (off) + 16); dst = __builtin_shufflevector(_lo, _hi, 0, 1, 2, 3, 4, 5, 6, 7); } while (0)
#define PG8_LDA(dst, b, h) do { _Pragma("unroll") for (int m = 0; m < 4; ++m) PG8_LD8(dst[m], PG8_SA(b, h) + aoff + m * 2048); } while (0)
#define PG8_LDB(dst, b, h) do { _Pragma("unroll") for (int n = 0; n < 2; ++n) PG8_LD8(dst[n], PG8_SB(b, h) + boff + n * 2048); } while (0)
#define PG8_MMA(ai, bj, At, Bt) do { __builtin_amdgcn_s_setprio(1); _Pragma("unroll") for (int m = 0; m < 4; ++m) _Pragma("unroll") for (int n = 0; n < 2; ++n) \
        asm volatile("v_mfma_scale_f32_16x16x128_f8f6f4 %0, %1, %2, %0, %3, %3 op_sel_hi:[0,0,0]" : "+v"(acc[ai][bj][m][n]) : "v"(Bt[n]), "v"(At[m]), "v"(f8_unit_scale)); __builtin_amdgcn_s_setprio(0); } while (0)
#define PG8_WAIT_V(n) asm volatile("s_waitcnt vmcnt(" #n ")" ::: "memory")
#define PG8_WAIT_L(n) asm volatile("s_waitcnt lgkmcnt(" #n ")" ::: "memory")
#define PG8_BAR __builtin_amdgcn_s_barrier()
#define PG8_SCHED __builtin_amdgcn_sched_barrier(0)
    Unit cur, nxt; int ui = 0;
    if (!S.next(0, cur)) return;
    f32x4 acc[2][2][4][2];
#pragma unroll
    for (int a = 0; a < 2; ++a)
#pragma unroll
        for (int b = 0; b < 2; ++b)
#pragma unroll
            for (int m = 0; m < 4; ++m)
#pragma unroll
                for (int n = 0; n < 2; ++n) acc[a][b][m][n] = (f32x4){0.f, 0.f, 0.f, 0.f};
    i32x8 At[4], B0[2], B1[2];
    const int f8_unit_scale = 0x7f7f7f7f;
    const char* cA; const char* cB; S.ptrs(cur, cA, cB);
    PG8_STAGE(PG8_SB(0, 0), cB, voffB); PG8_STAGE(PG8_SB(0, 1), cB + hstep, voffB); PG8_STAGE(PG8_SA(0, 0), cA, voffA); PG8_STAGE(PG8_SA(0, 1), cA + hstep, voffA);
    if (wr == 1) PG8_BAR;
    PG8_WAIT_V(2); PG8_BAR;
    PG8_STAGE(PG8_SB(1, 0), cB + kstep, voffB); PG8_STAGE(PG8_SA(1, 0), cA + kstep, voffA); PG8_STAGE(PG8_SB(1, 1), cB + hstep + kstep, voffB);
    PG8_WAIT_V(6); PG8_BAR;
    for (;;) {
        const bool has_next = S.next(ui + 1, nxt);
        const char* nA = cA; const char* nB = cB; if (has_next) S.ptrs(nxt, nA, nB);
        for (int t = 0; t < nt; t += 2) {
            const bool last = (t == nt - 2);
            const char* a1 = cA + (size_t)(t + 1) * kstep;
            const char* a2 = last ? nA : cA + (size_t)(t + 2) * kstep; const char* b2 = last ? nB : cB + (size_t)(t + 2) * kstep;
            const char* a3 = a2 + kstep; const char* b3 = b2 + kstep;
            PG8_LDB(B0, 0, 0); PG8_LDB(B1, 0, 1); PG8_SCHED; PG8_LDA(At, 0, 0); PG8_STAGE(PG8_SA(1, 1), a1 + hstep, voffA);
            PG8_WAIT_V(8); PG8_WAIT_L(0); PG8_BAR; PG8_MMA(0, 0, At, B0); PG8_MMA(0, 1, At, B1); PG8_BAR; PG8_SCHED;
            PG8_LDA(At, 0, 1); PG8_STAGE(PG8_SB(0, 0), b2, voffB); PG8_STAGE(PG8_SB(0, 1), b2 + hstep, voffB); PG8_STAGE(PG8_SA(0, 0), a2, voffA);
            PG8_WAIT_V(8); PG8_WAIT_L(0); PG8_BAR; PG8_MMA(1, 0, At, B0); PG8_MMA(1, 1, At, B1); PG8_BAR; PG8_SCHED;
            PG8_LDB(B0, 1, 0); PG8_LDB(B1, 1, 1); PG8_SCHED; PG8_LDA(At, 1, 0); PG8_STAGE(PG8_SA(0, 1), a2 + hstep, voffA);
            PG8_WAIT_V(8); PG8_WAIT_L(0); PG8_BAR; PG8_MMA(0, 0, At, B0); PG8_MMA(0, 1, At, B1); PG8_BAR; PG8_SCHED;
            PG8_LDA(At, 1, 1); PG8_STAGE(PG8_SB(1, 0), b3, voffB); PG8_STAGE(PG8_SB(1, 1), b3 + hstep, voffB); PG8_STAGE(PG8_SA(1, 0), a3, voffA);
            PG8_WAIT_V(8); PG8_WAIT_L(0); PG8_BAR; PG8_MMA(1, 0, At, B0); PG8_MMA(1, 1, At, B1); PG8_BAR; PG8_SCHED;
        }
        if (wr == 0) PG8_BAR;
        { const int t2 = opaque_tid(), w2 = __builtin_amdgcn_readfirstlane(t2 >> 6); E(acc, cur, w2 >> 2, w2 & 3, t2 & 15, (t2 & 63) >> 4); }
        if (!has_next) break;
#pragma unroll
        for (int a = 0; a < 2; ++a)
#pragma unroll
            for (int b = 0; b < 2; ++b)
#pragma unroll
                for (int m = 0; m < 4; ++m)
#pragma unroll
                    for (int n = 0; n < 2; ++n) acc[a][b][m][n] = (f32x4){0.f, 0.f, 0.f, 0.f};
        cur = nxt; cA = nA; cB = nB; ++ui;
        if (wr == 1) PG8_BAR;
    }
    PG8_WAIT_V(0);
    PG8_BAR;
#undef PG8_SA
#undef PG8_SB
#undef PG8_STAGE
#undef PG8_LD8
#undef PG8_LDA
#undef PG8_LDB
#undef PG8_MMA
#undef PG8_WAIT_V
#undef PG8_WAIT_L
#undef PG8_BAR
#undef PG8_SCHED
}

template <class Epi, class Sched>
__device__ __forceinline__ void gemm_phase_mix(PG8_LAS unsigned char* lds, const int P, const int nt8, const int nt16, const Sched& S, const Epi& E) {
    const int tid = opaque_tid(), wid = __builtin_amdgcn_readfirstlane(tid >> 6), lane = tid & 63, wr = wid >> 2, wc = wid & 3, fr = lane & 15, fq = lane >> 4;
    unsigned voffA[2], voffB[2];
#pragma unroll
    for (int i = 0; i < 2; ++i) { int R, C; stage_rc(tid * 16 + i * 8192, R, C); const int Rb = Epi::PERM ? ((R & ~31) + perm32(R & 31)) : R;
        voffA[i] = (unsigned)(R * 128 + 2 * C); voffB[i] = (unsigned)(Rb * 128 + 2 * C); }
    const size_t kstep = 32768;
    const size_t hstep = (size_t)HALF * 128;
    const unsigned ldsw = (unsigned)wid * 1024u;
#define PG8_SA(b, h) (((b) * 2 + (h)) * HTB)
#define PG8_SB(b, h) ((4 + (b) * 2 + (h)) * HTB)
#define PG8_STAGE(bufoff, gbase, voff) do { _Pragma("unroll") for (int _i = 0; _i < 2; ++_i) \
        __builtin_amdgcn_global_load_lds((const unsigned*)((const char*)(gbase) + (voff)[_i]), (PG8_LAS unsigned*)(lds + (bufoff) + ldsw + _i * 8192), 16, 0, 0); } while (0)
#define PG8_LD8(dst, off) do { const i32x4 _lo = *(const PG8_LAS i32x4*)(lds + (off)), _hi = *(const PG8_LAS i32x4*)(lds + (off) + 16); dst = __builtin_shufflevector(_lo, _hi, 0, 1, 2, 3, 4, 5, 6, 7); } while (0)
#define PG8_LDA8(dst, b, h) do { _Pragma("unroll") for (int m = 0; m < 4; ++m) PG8_LD8(dst[m], PG8_SA(b, h) + aoff8 + m * 2048); } while (0)
#define PG8_LDB8(dst, b, h) do { _Pragma("unroll") for (int n = 0; n < 2; ++n) PG8_LD8(dst[n], (PG8_SB(b, h) - 65536) + boff8 + n * 2048); } while (0)
#define PG8_MMA8(ai, bj, At, Bt) do { __builtin_amdgcn_s_setprio(1); _Pragma("unroll") for (int m = 0; m < 4; ++m) _Pragma("unroll") for (int n = 0; n < 2; ++n) \
        asm volatile("v_mfma_scale_f32_16x16x128_f8f6f4 %0, %1, %2, %0, %3, %3 op_sel_hi:[0,0,0]" : "+v"(acc[ai][bj][m][n]) : "v"(Bt[n]), "v"(At[m]), "v"(f8_unit_scale)); __builtin_amdgcn_s_setprio(0); } while (0)
#define PG8_LDA16(dst, b, h) do { _Pragma("unroll") for (int m = 0; m < 4; ++m) _Pragma("unroll") for (int k = 0; k < 2; ++k) dst[m][k] = *(const PG8_LAS bf16x8*)(lds + PG8_SA(b, h) + aoff16 + m * 2048 + k * 1024); } while (0)
#define PG8_LDB16(dst, b, h) do { _Pragma("unroll") for (int n = 0; n < 2; ++n) _Pragma("unroll") for (int k = 0; k < 2; ++k) dst[n][k] = *(const PG8_LAS bf16x8*)(lds + (PG8_SB(b, h) - 65536) + boff16 + n * 2048 + k * 1024); } while (0)
#define PG8_MMA16(ai, bj, At, Bt) do { __builtin_amdgcn_s_setprio(1); _Pragma("unroll") for (int k = 0; k < 2; ++k) _Pragma("unroll") for (int m = 0; m < 4; ++m) _Pragma("unroll") for (int n = 0; n < 2; ++n) \
        asm volatile("v_mfma_f32_16x16x32_bf16 %0, %1, %2, %0" : "+v"(acc[ai][bj][m][n]) : "v"(Bt[n][k]), "v"(At[m][k])); __builtin_amdgcn_s_setprio(0); } while (0)
#define PG8_WAIT_V(n) asm volatile("s_waitcnt vmcnt(" #n ")" ::: "memory")
#define PG8_WAIT_L(n) asm volatile("s_waitcnt lgkmcnt(" #n ")" ::: "memory")
#define PG8_BAR __builtin_amdgcn_s_barrier()
#define PG8_SCHED __builtin_amdgcn_sched_barrier(0)
#define PG8_KPAIR(LDA_, LDB_, MMA_, At_, B0_, B1_) do { \
            LDB_(B0_, 0, 0); LDB_(B1_, 0, 1); PG8_SCHED; LDA_(At_, 0, 0); PG8_STAGE(PG8_SA(1, 1), a1 + hstep, voffA); \
            PG8_WAIT_V(8); PG8_WAIT_L(0); PG8_BAR; MMA_(0, 0, At_, B0_); MMA_(0, 1, At_, B1_); PG8_BAR; PG8_SCHED; \
            LDA_(At_, 0, 1); PG8_STAGE(PG8_SB(0, 0), b2, voffB); PG8_STAGE(PG8_SB(0, 1), b2 + hstep, voffB); PG8_STAGE(PG8_SA(0, 0), a2, voffA); \
            PG8_WAIT_V(8); PG8_WAIT_L(0); PG8_BAR; MMA_(1, 0, At_, B0_); MMA_(1, 1, At_, B1_); PG8_BAR; PG8_SCHED; \
            LDB_(B0_, 1, 0); LDB_(B1_, 1, 1); PG8_SCHED; LDA_(At_, 1, 0); PG8_STAGE(PG8_SA(0, 1), a2 + hstep, voffA); \
            PG8_WAIT_V(8); PG8_WAIT_L(0); PG8_BAR; MMA_(0, 0, At_, B0_); MMA_(0, 1, At_, B1_); PG8_BAR; PG8_SCHED; \
            LDA_(At_, 1, 1); PG8_STAGE(PG8_SB(1, 0), b3, voffB); PG8_STAGE(PG8_SB(1, 1), b3 + hstep, voffB); PG8_STAGE(PG8_SA(1, 0), a3, voffA); \
            PG8_WAIT_V(8); PG8_WAIT_L(0); PG8_BAR; MMA_(1, 0, At_, B0_); MMA_(1, 1, At_, B1_); PG8_BAR; PG8_SCHED; } while (0)
    Unit cur, nxt; int ui = 0;
    if (!S.o.tile(0, cur)) return;
    f32x4 acc[2][2][4][2];
#pragma unroll
    for (int a = 0; a < 2; ++a)
#pragma unroll
        for (int b = 0; b < 2; ++b)
#pragma unroll
            for (int m = 0; m < 4; ++m)
#pragma unroll
                for (int n = 0; n < 2; ++n) acc[a][b][m][n] = (f32x4){0.f, 0.f, 0.f, 0.f};
    const int f8_unit_scale = 0x7f7f7f7f;
    const char* c8A = S.A0 + (size_t)cur.pm * S.tstep8; const char* c8B = S.B0 + (size_t)cur.pn * S.tstep8;
    PG8_STAGE(PG8_SB(0, 0), c8B, voffB); PG8_STAGE(PG8_SB(0, 1), c8B + hstep, voffB); PG8_STAGE(PG8_SA(0, 0), c8A, voffA); PG8_STAGE(PG8_SA(0, 1), c8A + hstep, voffA);
    if (wr == 1) PG8_BAR;
    PG8_WAIT_V(2); PG8_BAR;
    PG8_STAGE(PG8_SB(1, 0), c8B + kstep, voffB); PG8_STAGE(PG8_SA(1, 0), c8A + kstep, voffA); PG8_STAGE(PG8_SB(1, 1), c8B + hstep + kstep, voffB);
    PG8_WAIT_V(6); PG8_BAR;
    for (;;) {
        const bool has_next = S.o.tile(ui + 1, nxt);
        const char* c16A = S.A1 + (size_t)cur.pm * S.tstep; const char* c16B = S.B1 + (size_t)cur.pn * S.tstep;
        {   i32x8 At[4], B0[2], B1[2];
            const int t8 = opaque_tid(); int aoff8 = lds_byte(((t8 >> 8) & 1) * 64 + (t8 & 15), ((t8 & 63) >> 4) * 16), boff8 = lds_byte(((t8 >> 6) & 3) * 32 + (t8 & 15), ((t8 & 63) >> 4) * 16) + 65536;
            asm volatile("" : "+v"(aoff8), "+v"(boff8));
            for (int t = 0; t < nt8; t += 2) { const bool last = (t == nt8 - 2);
                const char* a1 = c8A + (size_t)(t + 1) * kstep;
                const char* a2 = last ? c16A : c8A + (size_t)(t + 2) * kstep; const char* b2 = last ? c16B : c8B + (size_t)(t + 2) * kstep;
                const char* a3 = a2 + kstep; const char* b3 = b2 + kstep;
                PG8_KPAIR(PG8_LDA8, PG8_LDB8, PG8_MMA8, At, B0, B1); } }
        if (wr == 0) PG8_BAR;
        { const int t2 = opaque_tid(), w2 = __builtin_amdgcn_readfirstlane(t2 >> 6); cur.sub = 0; E(acc, cur, w2 >> 2, w2 & 3, t2 & 15, (t2 & 63) >> 4); }
        if (wr == 1) PG8_BAR;
        const char* n8A = c8A; const char* n8B = c8B; if (has_next) { n8A = S.A0 + (size_t)nxt.pm * S.tstep8; n8B = S.B0 + (size_t)nxt.pn * S.tstep8; }
        {   bf16x8 At[4][2], B0[2][2], B1[2][2];
            const int t6 = opaque_tid(); int aoff16 = lds_byte(((t6 >> 8) & 1) * 64 + (t6 & 15), ((t6 & 63) >> 4) * 8), boff16 = lds_byte(((t6 >> 6) & 3) * 32 + (t6 & 15), ((t6 & 63) >> 4) * 8) + 65536;
            asm volatile("" : "+v"(aoff16), "+v"(boff16));
            for (int t = 0; t < nt16; t += 2) { const bool last = (t == nt16 - 2);
                const char* a1 = c16A + (size_t)(t + 1) * kstep;
                const char* a2 = last ? n8A : c16A + (size_t)(t + 2) * kstep; const char* b2 = last ? n8B : c16B + (size_t)(t + 2) * kstep;
                const char* a3 = a2 + kstep; const char* b3 = b2 + kstep;
                PG8_KPAIR(PG8_LDA16, PG8_LDB16, PG8_MMA16, At, B0, B1); } }
        if (wr == 0) PG8_BAR;
        { const int t2 = opaque_tid(), w2 = __builtin_amdgcn_readfirstlane(t2 >> 6); cur.sub = 1; E(acc, cur, w2 >> 2, w2 & 3, t2 & 15, (t2 & 63) >> 4); }
        if (!has_next) break;
#pragma unroll
        for (int a = 0; a < 2; ++a)
#pragma unroll
            for (int b = 0; b < 2; ++b)
#pragma unroll
                for (int m = 0; m < 4; ++m)
#pragma unroll
                    for (int n = 0; n < 2; ++n) acc[a][b][m][n] = (f32x4){0.f, 0.f, 0.f, 0.f};
        cur = nxt; c8A = n8A; c8B = n8B; ++ui;
        if (wr == 1) PG8_BAR;
    }
    PG8_WAIT_V(0);
    PG8_BAR;
#undef PG8_SA
#undef PG8_SB
#undef PG8_STAGE
#undef PG8_LD8
#undef PG8_LDA8
#undef PG8_LDB8
#undef PG8_MMA8
#undef PG8_LDA16
#undef PG8_LDB16
#undef PG8_MMA16
#undef PG8_KPAIR
#undef PG8_WAIT_V
#undef PG8_WAIT_L
#undef PG8_BAR
#undef PG8_SCHED
}
}

constexpr int NWAVES = 8;
constexpr int N_LAUNCHES = MK_N_LAUNCHES;
constexpr int PER_PHASE = 8;
constexpr int M = 16384, D = 4096, NIN = 18432, GMW = 2048, NAW = 2048, DFF = 11008, NGU = 2 * DFF;
constexpr float F8_ASCALE = 16.f, F8_WSCALE = 1024.f, F8_UNSCALE = 1.f / (16.f * 1024.f), F8_YSCALE = 64.f, F8_YUNSCALE = 1.f / (64.f * 1024.f);
constexpr int GRID_W = 64, GRID_H = M / GRID_W, NHEAD = 16, HD = 128, CHUNK = 128, NGROUP = 16;
constexpr float RMS_EPS = 1e-6f, LN_EPS = 1e-5f;

constexpr size_t MiB = 1u << 20;
constexpr size_t WS_CTL = 0, CTL_ZERO_BYTES = 1 * MiB;
constexpr size_t WS_WSB = 1 * MiB;
constexpr size_t WS_WIN = 4 * MiB;
constexpr size_t WS_WOA = 148 * MiB, WS_WOB = 164 * MiB;
constexpr size_t WS_WOUT = 180 * MiB;
constexpr size_t WS_RA = 212 * MiB;
constexpr size_t WS_YA = WS_RA, WS_YB = WS_RA + 64 * MiB;
constexpr size_t WS_RB = 340 * MiB;
constexpr size_t WS_U = WS_RB, WS_V = WS_RB + 64 * MiB, WS_Q = WS_RB + 128 * MiB, WS_K = WS_RB + 192 * MiB, WS_VV = WS_RB + 256 * MiB, WS_GA = WS_RB + 320 * MiB, WS_GB = WS_RB + 448 * MiB;
constexpr size_t WS_TB = WS_Q;
constexpr size_t WS_MRG = WS_RB;
constexpr size_t WS_ACT = WS_RB;
constexpr size_t WS_H16 = WS_WIN;
constexpr size_t WS_WQKV8 = WS_WIN + 32 * MiB;
constexpr size_t WS_XN8 = 916 * MiB;
constexpr size_t WS_WGU = 916 * MiB;
constexpr size_t WS_WD = 1088 * MiB;
constexpr size_t WS_PART = 1174 * MiB;
constexpr size_t WS_END = 1178 * MiB;
static_assert(WS_GB + (size_t)M * D * 2 == WS_WGU && WS_WGU + (size_t)NGU * D * 2 == WS_WD && WS_WD + (size_t)D * DFF * 2 == WS_PART && WS_PART + (size_t)M * 64 * 4 == WS_END && WS_ACT + (size_t)M * DFF * 2 <= WS_WGU, "d_ws map");
constexpr int CW_BAR = 4096;
constexpr int RING_BYTES = 131072;
constexpr int LDSCTL_OFF = RING_BYTES, MISC_OFF = LDSCTL_OFF + 320;
constexpr int LDS_BYTES = 147456;

#define GAS __attribute__((address_space(1)))
#define LAS __attribute__((address_space(3)))
typedef unsigned short bf16;
typedef unsigned v4u __attribute__((ext_vector_type(4)));
typedef unsigned v2u __attribute__((ext_vector_type(2)));
typedef float f32x4 __attribute__((ext_vector_type(4)));
typedef float f32x2 __attribute__((ext_vector_type(2)));
typedef short bf16x8 __attribute__((ext_vector_type(8)));
typedef GAS unsigned gu32;
#define RLX_AGENT __ATOMIC_RELAXED, __HIP_MEMORY_SCOPE_AGENT
#define LDS_WAIT() asm volatile("s_waitcnt lgkmcnt(0)" ::: "memory")
#define VM_WAIT() asm volatile("s_waitcnt vmcnt(0)" ::: "memory")
__device__ __forceinline__ unsigned f2bf(float f) { unsigned u = __builtin_bit_cast(unsigned, f); return (u + 0x7fffu + ((u >> 16) & 1u)) >> 16; }
__device__ __forceinline__ unsigned pk2(float lo, float hi) { return pg8::cvt_pk_bf16(lo, hi); }
__device__ __forceinline__ float bflo(unsigned w) { return __uint_as_float(w << 16); }
__device__ __forceinline__ float bfhi(unsigned w) { return __uint_as_float(w & 0xffff0000u); }

#define XB_TMO      128
#define XB_XCNT(j)  (256  + 64 * (j))
#define XB_XSUB(j)  (1280 + 64 * (j))
#define XB_XGEN(j)  (2304 + 64 * (j))
#define XB_TOP      3328
#define XB_TOPGEN   3392
#define XCD_BAR_WORDS 3456
#define XB_SPIN_CAP (1u << 20)

__device__ __forceinline__ unsigned xb_ld(unsigned* p)              { return __hip_atomic_load(p, __ATOMIC_RELAXED, __HIP_MEMORY_SCOPE_AGENT); }
__device__ __forceinline__ unsigned xb_add(unsigned* p, unsigned v) { return __hip_atomic_fetch_add(p, v, __ATOMIC_RELAXED, __HIP_MEMORY_SCOPE_AGENT); }
__device__ __forceinline__ unsigned xb_xcc_id() { return (unsigned)__builtin_amdgcn_s_getreg((3 << 11) | 20) & 0xFu; }
#define XB_SPIN(cond, bar) do { unsigned _sp = 0; while (cond) { __builtin_amdgcn_s_sleep(1); \
    if ((++_sp & 255u) == 0u) { if (xb_ld(&(bar)[XB_TMO])) break; if (_sp > XB_SPIN_CAP) { atomicAdd(&(bar)[XB_TMO], 1u); break; } } } } while (0)

struct XcdBarrier {
    unsigned* bar; unsigned x;
    volatile LAS unsigned* st;
};
__device__ __forceinline__ XcdBarrier xcd_barrier_post(unsigned* bar, volatile LAS unsigned* st) {
    XcdBarrier b; b.bar = bar; b.x = xb_xcc_id(); b.st = st;
    if (threadIdx.x == 0) (void)xb_add(&bar[XB_XCNT(b.x)], 1u);
    return b;
}
__device__ __forceinline__ void xcd_barrier_complete(unsigned* bar, unsigned x, unsigned& nloc, unsigned& nx) {
    const unsigned G = gridDim.x * gridDim.y * gridDim.z;
    unsigned sum, cnt, mine, sp = 0u;
    for (;;) {
        sum = 0u; cnt = 0u; mine = 0u;
#pragma unroll
        for (unsigned j = 0; j < 16; ++j) { const unsigned c = xb_ld(&bar[XB_XCNT(j)]); sum += c; cnt += (c > 0u) ? 1u : 0u; mine = (j == x) ? c : mine; }
        if (sum == G) break;
        __builtin_amdgcn_s_sleep(1);
        if ((++sp & 255u) == 0u) { if (xb_ld(&bar[XB_TMO])) break; if (sp > XB_SPIN_CAP) { atomicAdd(&bar[XB_TMO], 1u); break; } }
    }
    nloc = mine > 0u ? mine : 1u; nx = cnt > 0u ? cnt : 1u;
}
__device__ __forceinline__ void xcd_barrier(const XcdBarrier& b) {
    asm volatile("s_waitcnt vmcnt(0)" ::: "memory");
    __syncthreads();
    if (threadIdx.x == 0) {
        unsigned* bar = b.bar;
        __builtin_amdgcn_s_waitcnt(0);
        unsigned nloc = b.st[0], nx = b.st[1];
        if (nloc == 0u) { xcd_barrier_complete(bar, b.x, nloc, nx); b.st[0] = nloc; b.st[1] = nx; }
        const unsigned old = xb_add(&bar[XB_XSUB(b.x)], 1u);
        const unsigned gen = old / nloc;
        if (old + 1u == (gen + 1u) * nloc) {
            __builtin_amdgcn_fence(__ATOMIC_RELEASE, "agent");
            asm volatile("s_waitcnt vmcnt(0)" ::: "memory");
            const unsigned og = xb_add(&bar[XB_TOP], 1u);
            const unsigned tg = og / nx;
            if (og + 1u == (tg + 1u) * nx) xb_add(&bar[XB_TOPGEN], 1u);
            else XB_SPIN(xb_ld(&bar[XB_TOPGEN]) == tg, bar);
            __builtin_amdgcn_fence(__ATOMIC_ACQUIRE, "agent");
            xb_add(&bar[XB_XGEN(b.x)], 1u);
            asm volatile("s_waitcnt vmcnt(0)" ::: "memory");
        } else {
            XB_SPIN(xb_ld(&bar[XB_XGEN(b.x)]) == gen, bar);
            __builtin_amdgcn_fence(__ATOMIC_ACQUIRE, "agent");
            asm volatile("s_waitcnt vmcnt(0)" ::: "memory");
        }
    }
    __syncthreads();
}

struct Frame {
    LAS unsigned char* lds;
    volatile LAS unsigned* MISC;
    gu32* ctl;
    int tid, lane, wave;
    int vcu, G;
    unsigned char* ws;
    const float *x, *norm1_g, *w_in, *gm_ln_g, *gm_ln_b, *gm_w_s, *gm_b_s, *q_gain, *k_gain, *na_rpb, *w_o_gm, *w_o_na, *w_out, *norm2_g, *w_ff_gate, *w_ff_up, *w_ff_down;
    float* out;
};
template <int O> __device__ __forceinline__ float xor_lane(float v) {
    if constexpr (O < 32) return __builtin_bit_cast(float, __builtin_amdgcn_ds_swizzle(__builtin_bit_cast(int, v), (O << 10) | 0x1f));
    else return __shfl_xor(v, 32);
}
__device__ __forceinline__ float wave_sum(float v) {
    v += xor_lane<1>(v); v += xor_lane<2>(v); v += xor_lane<4>(v); v += xor_lane<8>(v); v += xor_lane<16>(v); v += xor_lane<32>(v);
    return v;
}
struct TrRegs { f32x4 v[8]; };
__device__ __forceinline__ void tr_load(TrRegs& R, const float* W, int ldw, int k0, int n0, int lane) {
    const GAS float* src = (const GAS float*)W + (size_t)(k0 + 8 * (lane >> 3)) * ldw + n0 + 4 * (lane & 7);
#pragma unroll
    for (int e = 0; e < 8; ++e) R.v[e] = *(const GAS f32x4*)(src + (size_t)e * ldw);
}
__device__ __forceinline__ void tr_store(const TrRegs& R, bf16* dst, int ldk, int lane) {
    GAS bf16* d = (GAS bf16*)dst + (size_t)(4 * (lane & 7)) * ldk + 8 * (lane >> 3);
#pragma unroll
    for (int i = 0; i < 4; ++i) { v4u o; o.x = pk2(R.v[0][i], R.v[1][i]); o.y = pk2(R.v[2][i], R.v[3][i]); o.z = pk2(R.v[4][i], R.v[5][i]); o.w = pk2(R.v[6][i], R.v[7][i]);
        *(GAS v4u*)(d + (size_t)i * ldk) = o; }
}
__device__ __forceinline__ unsigned pk4_fp8(float a, float b, float c, float d) {
    a = fminf(fmaxf(a, -448.f), 448.f); b = fminf(fmaxf(b, -448.f), 448.f); c = fminf(fmaxf(c, -448.f), 448.f); d = fminf(fmaxf(d, -448.f), 448.f);
    unsigned w = 0u; w = __builtin_amdgcn_cvt_pk_fp8_f32(a, b, w, false); w = __builtin_amdgcn_cvt_pk_fp8_f32(c, d, w, true); return w;
}
__device__ __forceinline__ void tr_store8(const TrRegs& R, unsigned char* dst8, int ldk, int lane, float sc) {
    GAS unsigned char* d = (GAS unsigned char*)dst8 + (size_t)(4 * (lane & 7)) * ldk + 8 * (lane >> 3);
#pragma unroll
    for (int i = 0; i < 4; ++i) { v2u o; o.x = pk4_fp8(R.v[0][i] * sc, R.v[1][i] * sc, R.v[2][i] * sc, R.v[3][i] * sc); o.y = pk4_fp8(R.v[4][i] * sc, R.v[5][i] * sc, R.v[6][i] * sc, R.v[7][i] * sc);
        *(GAS v2u*)(d + (size_t)i * ldk) = o; }
}
__device__ __forceinline__ size_t blkw(int n0, int kb, int K) { return (((size_t)(n0 >> 8) * (K >> 6) + kb) * 256 + (n0 & 255)) * 64; }
__device__ __forceinline__ size_t blkw8(int n0, int kb, int K) { return (((size_t)(n0 >> 8) * (K >> 7) + (kb >> 1)) * 256 + (n0 & 255)) * 128 + (kb & 1) * 64; }
__device__ __forceinline__ void tr_matrix(Frame& F, int lane, const float* W, int K, int N, bf16* WT) {
    const int gw = F.vcu * NWAVES + F.wave, NGW = F.G * NWAVES, nblk = N / 32, nitems = (K / 64) * nblk;
    for (int it = gw; it < nitems; it += 2 * NGW) { const int it2 = it + NGW; const bool two = it2 < nitems; TrRegs A, B;
        const int kb = it / nblk, nb = it % nblk, kb2 = two ? it2 / nblk : kb, nb2 = two ? it2 % nblk : nb;
        tr_load(A, W, N, 64 * kb, 32 * nb, lane); tr_load(B, W, N, 64 * kb2, 32 * nb2, lane);
        tr_store(A, WT + blkw(32 * nb, kb, K), 64, lane); if (two) tr_store(B, WT + blkw(32 * nb2, kb2, K), 64, lane); }
}
constexpr int FF_ITEMS_GU = (D / 64) * (DFF / 32), FF_ITEMS_D = (DFF / 64) * (D / 32), FF_ITEMS = 2 * FF_ITEMS_GU + FF_ITEMS_D;
constexpr int FF_ITEMS_P2 = 2 * FF_ITEMS_GU;
struct FillItem { const float* src; bf16* dst; int ldw, ldk, k0, n0; };
__device__ __forceinline__ FillItem ff_item(Frame& F, int it) {
    it = it < FF_ITEMS ? it : FF_ITEMS - 1; FillItem I;
    if (it < 2 * FF_ITEMS_GU) { const int up = it >= FF_ITEMS_GU, r = up ? it - FF_ITEMS_GU : it, nblk = DFF / 32, kb = r / nblk, n0 = 32 * (r - kb * nblk);
        I.src = up ? F.w_ff_up : F.w_ff_gate; I.ldw = DFF; I.k0 = 64 * kb; I.n0 = n0; I.ldk = D;
        I.dst = (bf16*)(F.ws + WS_WGU) + blkw(256 * (n0 >> 7) + (n0 & 127) + (up ? 128 : 0), kb, D); I.ldk = 64; }
    else { const int r = it - 2 * FF_ITEMS_GU, nblk = D / 32, kb = r / nblk, n0 = 32 * (r - kb * nblk);
        I.src = F.w_ff_down; I.ldw = D; I.k0 = 64 * kb; I.n0 = n0; I.ldk = 64; I.dst = (bf16*)(F.ws + WS_WD) + blkw(n0, kb, DFF); }
    return I;
}
__device__ __forceinline__ void rms_row_to_bf16(int lane, const float* xrow, const float* gain, bf16* obase, unsigned char* obase8, int m) {
    const GAS f32x4* xr = (const GAS f32x4*)xrow + lane;
    f32x4 v[16]; float s = 0.f;
#pragma unroll
    for (int j = 0; j < 16; ++j) { v[j] = xr[64 * j]; s += (v[j].x * v[j].x + v[j].y * v[j].y) + (v[j].z * v[j].z + v[j].w * v[j].w); }
    const float rstd = 1.f / sqrtf(wave_sum(s) * (1.f / D) + RMS_EPS);
    const GAS f32x4* gr = (const GAS f32x4*)gain + lane;
#pragma unroll
    for (int j = 0; j < 16; ++j) { const f32x4 g = gr[64 * j]; const float y0 = v[j].x * rstd * g.x, y1 = v[j].y * rstd * g.y, y2 = v[j].z * rstd * g.z, y3 = v[j].w * rstd * g.w;
        v2u o; o.x = pk2(y0, y1); o.y = pk2(y2, y3); *(GAS v2u*)((GAS char*)obase + pg8::blk_off(m, 8 * lane + 512 * j, 2 * D)) = o;
        *(GAS unsigned*)((GAS unsigned char*)obase8 + pg8::blk_off(m, 4 * lane + 256 * j, D)) = pk4_fp8(y0 * F8_ASCALE, y1 * F8_ASCALE, y2 * F8_ASCALE, y3 * F8_ASCALE); }
}

#ifndef MK_STAGGER_US
#define MK_STAGGER_US 0
#endif
__device__ __forceinline__ void stagger(int us_per_group) {
    const int grp = ((int)blockIdx.x >> 3) & 3;
    if (grp && us_per_group) { const unsigned long long t0 = __builtin_amdgcn_s_memrealtime(), dt = (unsigned long long)(grp * us_per_group) * 100ull;
        while (__builtin_amdgcn_s_memrealtime() - t0 < dt) __builtin_amdgcn_s_sleep(16); }
}
__device__ __forceinline__ void p0_prologue(Frame& F) {
    const int lane = opaque_tid() & 63;
    {
        const int gw0 = F.vcu * NWAVES + F.wave, NGW0 = F.G * NWAVES, nblk = NIN / 32, nitems = (D / 64) * nblk; bf16* WT = (bf16*)(F.ws + WS_WIN); unsigned char* W8 = F.ws + WS_WQKV8;
        for (int it = gw0; it < nitems; it += NGW0) { const int kb = it / nblk, n0 = 32 * (it - kb * nblk); TrRegs R; tr_load(R, F.w_in, NIN, 64 * kb, n0, lane);
            if (n0 >= 4096) tr_store8(R, W8 + blkw8(n0 - 4096, kb, D), 128, lane, F8_WSCALE);
            else tr_store(R, WT + blkw(n0, kb, D), 64, lane); } }
    tr_matrix(F, lane, F.w_o_gm, GMW, D, (bf16*)(F.ws + WS_WOA));
    {
        const int gw0 = F.vcu * NWAVES + F.wave, NGW0 = F.G * NWAVES, nblk = D / 32, nitems = (NAW / 64) * nblk; unsigned char* W8 = F.ws + WS_WOB;
        for (int it = gw0; it < nitems; it += NGW0) { const int kb = it / nblk, n0 = 32 * (it - kb * nblk); TrRegs R; tr_load(R, F.w_o_na, D, 64 * kb, n0, lane);
            tr_store8(R, W8 + blkw8(n0, kb, NAW), 128, lane, F8_WSCALE); } }
    tr_matrix(F, lane, F.w_out, D, D, (bf16*)(F.ws + WS_WOUT));
    const int gw = F.vcu * NWAVES + F.wave, NGW = F.G * NWAVES;
    { bf16* wsb = (bf16*)(F.ws + WS_WSB);
      for (int i = gw * 64 + lane; i < NGROUP * CHUNK * CHUNK / 4; i += NGW * 64) { const f32x4 v = ((const GAS f32x4*)F.gm_w_s)[i]; v2u o; o.x = pk2(v.x, v.y); o.y = pk2(v.z, v.w); ((GAS v2u*)wsb)[i] = o; } }
    bf16* XN = (bf16*)(F.ws + WS_RA);
    for (int m = gw; m < M; m += NGW) rms_row_to_bf16(lane, F.x + (size_t)m * D, F.norm1_g, XN, F.ws + WS_XN8, m);
}
typedef short s16x4 __attribute__((ext_vector_type(4)));
constexpr int GM_WP = 272, GM_VP = 288;
constexpr int GM_V_OFF = 128 * GM_WP, GM_ST_OFF = GM_V_OFF + 128 * GM_VP;
__device__ __forceinline__ void gmlp_unit(Frame& F, int chunk, int half) {
    LAS unsigned char* Wl = F.lds; LAS unsigned char* Vt = F.lds + GM_V_OFF; LAS f32x2* st = (LAS f32x2*)(F.lds + GM_ST_OFF);
    const bf16* U = (const bf16*)(F.ws + WS_U); const bf16* V = (const bf16*)(F.ws + WS_V); bf16* YA = (bf16*)(F.ws + WS_YA); const bf16* WSB = (const bf16*)(F.ws + WS_WSB);
    const int tid = opaque_tid();
    const int tok0 = chunk * CHUNK, lane = tid & 63, fr = lane & 15, fq = lane >> 4, q4 = fr >> 2, p4 = lane & 3;
    const int srow = tid >> 4, sch = tid & 15;
    const int g_first = half * (NGROUP / 2);
    v4u Wr[4], Vr[4]; f32x4 lg[2], lb[2];
#define GM_PREFETCH(g_) do { _Pragma("unroll") for (int q = 0; q < 4; ++q) { Wr[q] = *(const GAS v4u*)(WSB + (size_t)(g_) * CHUNK * CHUNK + (srow + 32 * q) * CHUNK + sch * 8); \
        Vr[q] = *(const GAS v4u*)(V + ((size_t)(g_) * M + tok0 + srow + 32 * q) * 128 + sch * 8); } \
        lg[0] = *(const GAS f32x4*)(F.gm_ln_g + (g_) * 128 + sch * 8); lg[1] = *(const GAS f32x4*)(F.gm_ln_g + (g_) * 128 + sch * 8 + 4); \
        lb[0] = *(const GAS f32x4*)(F.gm_ln_b + (g_) * 128 + sch * 8); lb[1] = *(const GAS f32x4*)(F.gm_ln_b + (g_) * 128 + sch * 8 + 4); } while (0)
    GM_PREFETCH(g_first);
    __syncthreads();
    { const GAS f32x4* p = (const GAS f32x4*)((const float*)(F.ws + WS_PART) + (size_t)(tok0 + (tid >> 2)) * 64 + (tid & 3) * 16); float sm = 0.f, sq = 0.f;
#pragma unroll
      for (int i = 0; i < 4; ++i) { const f32x4 v = p[i]; sm += v.x + v.z; sq += v.y + v.w; }
      sm += xor_lane<1>(sm); sm += xor_lane<2>(sm); sq += xor_lane<1>(sq); sq += xor_lane<2>(sq);
      const float mean = sm * (1.f / GMW), var = fmaxf(sq * (1.f / GMW) - mean * mean, 0.f);
      if ((tid & 3) == 0) st[tid >> 2] = (f32x2){mean, 1.f / sqrtf(var + LN_EPS)}; }
    const int wi = F.wave >> 1, wc2 = F.wave & 1;
#pragma unroll 1
    for (int gi = 0; gi < NGROUP / 2; ++gi) { const int g = g_first + gi;
        __syncthreads();
#pragma unroll
        for (int q = 0; q < 4; ++q) { const int row = srow + 32 * q;
            *(LAS v4u*)(Wl + row * GM_WP + sch * 16) = Wr[q];
            const v4u w = Vr[q]; const f32x2 ms = st[row]; v4u o;
            o.x = pk2((bflo(w.x) - ms.x) * ms.y * lg[0].x + lb[0].x, (bfhi(w.x) - ms.x) * ms.y * lg[0].y + lb[0].y); o.y = pk2((bflo(w.y) - ms.x) * ms.y * lg[0].z + lb[0].z, (bfhi(w.y) - ms.x) * ms.y * lg[0].w + lb[0].w);
            o.z = pk2((bflo(w.z) - ms.x) * ms.y * lg[1].x + lb[1].x, (bfhi(w.z) - ms.x) * ms.y * lg[1].y + lb[1].y); o.w = pk2((bflo(w.w) - ms.x) * ms.y * lg[1].z + lb[1].z, (bfhi(w.w) - ms.x) * ms.y * lg[1].w + lb[1].w);
            *(LAS v4u*)(Vt + row * GM_VP + sch * 16) = o; }
        if (gi + 1 < NGROUP / 2) GM_PREFETCH(g + 1);
        v4u uu[2][2]; float bs[2];
#pragma unroll
        for (int it = 0; it < 2; ++it) { const int i = 32 * wi + 16 * it + fr; bs[it] = F.gm_b_s[g * CHUNK + i];
#pragma unroll
            for (int t = 0; t < 2; ++t) uu[it][t] = *(const GAS v4u*)(U + ((size_t)g * M + tok0 + i) * 128 + 64 * wc2 + 32 * t + 8 * fq); }
        __syncthreads();
        f32x4 acc[4][2];
#pragma unroll
        for (int ct = 0; ct < 4; ++ct)
#pragma unroll
            for (int it = 0; it < 2; ++it) acc[ct][it] = (f32x4){0.f, 0.f, 0.f, 0.f};
#pragma unroll
        for (int kk = 0; kk < 8; ++kk) { s16x4 vf[4], wf[2];
#pragma unroll
            for (int ct = 0; ct < 4; ++ct) vf[ct] = __builtin_amdgcn_ds_read_tr16_b64_v4i16((LAS s16x4*)(Vt + (16 * kk + 4 * fq + q4) * GM_VP + (64 * wc2 + 32 * (ct >> 1) + 8 * p4 + 4 * (ct & 1)) * 2));
#pragma unroll
            for (int it = 0; it < 2; ++it) wf[it] = *(const LAS s16x4*)(Wl + (32 * wi + 16 * it + fr) * GM_WP + (16 * kk + 4 * fq) * 2);
#pragma unroll
            for (int ct = 0; ct < 4; ++ct)
#pragma unroll
                for (int it = 0; it < 2; ++it) acc[ct][it] = __builtin_amdgcn_mfma_f32_16x16x16bf16_1k(vf[ct], wf[it], acc[ct][it], 0, 0, 0); }
#pragma unroll
        for (int it = 0; it < 2; ++it) { const int i = 32 * wi + 16 * it + fr;
#pragma unroll
            for (int t = 0; t < 2; ++t) { const v4u u4 = uu[it][t]; const f32x4 a0 = acc[2 * t][it], a1 = acc[2 * t + 1][it]; const float b = bs[it]; v4u o;
                o.x = pk2((a0[0] + b) * bflo(u4.x), (a0[1] + b) * bfhi(u4.x)); o.y = pk2((a0[2] + b) * bflo(u4.y), (a0[3] + b) * bfhi(u4.y));
                o.z = pk2((a1[0] + b) * bflo(u4.z), (a1[1] + b) * bfhi(u4.z)); o.w = pk2((a1[2] + b) * bflo(u4.w), (a1[3] + b) * bfhi(u4.w));
                *(GAS v4u*)((GAS char*)YA + pg8::blk_off(tok0 + i, (g * 128 + 64 * wc2 + 32 * t + 8 * fq) * 2, 2 * GMW)) = o; } }
    }
#undef GM_PREFETCH
    __syncthreads();
}

constexpr int NA_KP = 272, NA_VP = 288;
constexpr int NA_KS = 64 * NA_KP, NA_SLOT = NA_KS + 64 * NA_VP, NA_RPB_OFF = 2 * NA_SLOT, NA_ROWS = 11;
constexpr float LOG2E = 1.4426950408889634f;
template <bool FILL> __device__ __forceinline__ void na_unit(Frame& F, int pq, int h, float cbound, int fill_it, int fill_stride) {
    LAS unsigned char* ring = F.lds; LAS float* rpbL = (LAS float*)(F.lds + NA_RPB_OFF);
    const bf16* Q = (const bf16*)(F.ws + WS_Q); const bf16* Kt = (const bf16*)(F.ws + WS_K); const bf16* Vv = (const bf16*)(F.ws + WS_VV);
    const int tid = opaque_tid();
    const int lane = tid & 63, wave = __builtin_amdgcn_readfirstlane(tid >> 6), fr = lane & 15, g = lane >> 4, q4 = fr >> 2, p4 = lane & 3;
    const int R0 = 4 * pq, r = R0 + (wave >> 1), half = wave & 1, kb0 = half;
    int b0 = R0 - 4; b0 = b0 < 0 ? 0 : (b0 > GRID_H - 8 ? GRID_H - 8 : b0);
    int rs = r - 4; rs = rs < 0 ? 0 : (rs > GRID_H - 8 ? GRID_H - 8 : rs);
    int c[2], cs[2];
#pragma unroll
    for (int tt = 0; tt < 2; ++tt) { c[tt] = 32 * half + 16 * tt + fr; int x = c[tt] - 8; cs[tt] = x < 0 ? 0 : (x > GRID_W - 16 ? GRID_W - 16 : x); }
    const int skey = tid >> 4, sdch = tid & 15;
    __syncthreads();
    for (int i = tid; i < 15 * 31; i += 512) rpbL[i] = __builtin_amdgcn_exp2f(F.na_rpb[h * 465 + i] * LOG2E);
    v4u RK[2][2], RV[2][2];
    TrRegs FR; FillItem FI;
#define NA_LOAD(s_) do { int kr_ = b0 + (s_); kr_ = kr_ > GRID_H - 1 ? GRID_H - 1 : kr_; _Pragma("unroll") for (int q2 = 0; q2 < 2; ++q2) { \
        const size_t o_ = ((size_t)h * M + kr_ * GRID_W + skey + 32 * q2) * HD + sdch * 8; RK[(s_) & 1][q2] = *(const GAS v4u*)(Kt + o_); RV[(s_) & 1][q2] = *(const GAS v4u*)(Vv + o_); } } while (0)
    NA_LOAD(0); NA_LOAD(1);
    bf16x8 Qf[2][4];
#pragma unroll
    for (int tt = 0; tt < 2; ++tt) { const size_t tq = (size_t)(r * GRID_W + c[tt]); v4u qw[4]; float ss = 0.f;
#pragma unroll
      for (int ks = 0; ks < 4; ++ks) { qw[ks] = *(const GAS v4u*)(Q + ((size_t)h * M + tq) * HD + 32 * ks + 8 * g);
          const float a0 = bflo(qw[ks].x), a1 = bfhi(qw[ks].x), a2 = bflo(qw[ks].y), a3 = bfhi(qw[ks].y), a4 = bflo(qw[ks].z), a5 = bfhi(qw[ks].z), a6 = bflo(qw[ks].w), a7 = bfhi(qw[ks].w);
          ss += (a0 * a0 + a1 * a1) + (a2 * a2 + a3 * a3) + (a4 * a4 + a5 * a5) + (a6 * a6 + a7 * a7); }
      ss += xor_lane<16>(ss); ss += xor_lane<32>(ss);
      const float rq = (1.f / sqrtf(ss * (1.f / HD) + RMS_EPS)) * 0.08838834764831845f * LOG2E;
#pragma unroll
      for (int ks = 0; ks < 4; ++ks) { const f32x4 g0 = *(const GAS f32x4*)(F.q_gain + 32 * ks + 8 * g), g1 = *(const GAS f32x4*)(F.q_gain + 32 * ks + 8 * g + 4);
          v4u o; o.x = pk2(bflo(qw[ks].x) * rq * g0.x, bfhi(qw[ks].x) * rq * g0.y); o.y = pk2(bflo(qw[ks].y) * rq * g0.z, bfhi(qw[ks].y) * rq * g0.w);
          o.z = pk2(bflo(qw[ks].z) * rq * g1.x, bfhi(qw[ks].z) * rq * g1.y); o.w = pk2(bflo(qw[ks].w) * rq * g1.z, bfhi(qw[ks].w) * rq * g1.w);
          Qf[tt][ks] = __builtin_bit_cast(bf16x8, o); } }
    const f32x4 kg0 = *(const GAS f32x4*)(F.k_gain + sdch * 8), kg1 = *(const GAS f32x4*)(F.k_gain + sdch * 8 + 4);
    f32x4 O[2][8]; float lsum[2] = {0.f, 0.f};
#pragma unroll
    for (int tt = 0; tt < 2; ++tt)
#pragma unroll
        for (int db = 0; db < 8; ++db) O[tt][db] = (f32x4){0.f, 0.f, 0.f, 0.f};
#pragma unroll
    for (int s = 0; s < NA_ROWS; ++s) { LAS unsigned char* slot = ring + (s & 1) * NA_SLOT;
#pragma unroll
        for (int q2 = 0; q2 < 2; ++q2) { const v4u w = RK[s & 1][q2];
            const float a0 = bflo(w.x), a1 = bfhi(w.x), a2 = bflo(w.y), a3 = bfhi(w.y), a4 = bflo(w.z), a5 = bfhi(w.z), a6 = bflo(w.w), a7 = bfhi(w.w);
            float ss = (a0 * a0 + a1 * a1) + (a2 * a2 + a3 * a3) + (a4 * a4 + a5 * a5) + (a6 * a6 + a7 * a7);
            ss += xor_lane<1>(ss); ss += xor_lane<2>(ss); ss += xor_lane<4>(ss); ss += xor_lane<8>(ss);
            const float rk = 1.f / sqrtf(ss * (1.f / HD) + RMS_EPS);
            v4u o; o.x = pk2(a0 * rk * kg0.x, a1 * rk * kg0.y); o.y = pk2(a2 * rk * kg0.z, a3 * rk * kg0.w); o.z = pk2(a4 * rk * kg1.x, a5 * rk * kg1.y); o.w = pk2(a6 * rk * kg1.z, a7 * rk * kg1.w);
            *(LAS v4u*)(slot + (skey + 32 * q2) * NA_KP + sdch * 16) = o;
            *(LAS v4u*)(slot + NA_KS + (skey + 32 * q2) * NA_VP + sdch * 16) = RV[s & 1][q2]; }
        if (s + 2 < NA_ROWS) NA_LOAD(s + 2);
        if constexpr (FILL) { if (s > 0) tr_store(FR, FI.dst, FI.ldk, lane); FI = ff_item(F, fill_it + s * fill_stride); tr_load(FR, FI.src, FI.ldw, FI.k0, FI.n0, lane); }
        __syncthreads();
        const int kr = b0 + s;
        if (kr >= rs && kr <= rs + 7) {
            f32x4 S[2][3];
#pragma unroll
            for (int tt = 0; tt < 2; ++tt)
#pragma unroll
                for (int b = 0; b < 3; ++b) S[tt][b] = (f32x4){-cbound, -cbound, -cbound, -cbound};
#pragma unroll
            for (int b = 0; b < 3; ++b)
#pragma unroll
                for (int ks = 0; ks < 4; ++ks) { const bf16x8 a = *(const LAS bf16x8*)(slot + (16 * (kb0 + b) + fr) * NA_KP + (32 * ks + 8 * g) * 2);
#pragma unroll
                    for (int tt = 0; tt < 2; ++tt) S[tt][b] = __builtin_amdgcn_mfma_f32_16x16x32_bf16(a, Qf[tt][ks], S[tt][b], 0, 0, 0); }
            s16x4 pf[2][3];
#pragma unroll
            for (int tt = 0; tt < 2; ++tt) { const int rbase = (kr - r + 7) * 31 + 15 - c[tt];
#pragma unroll
                for (int b = 0; b < 3; ++b) { float pv[4];
#pragma unroll
                    for (int i = 0; i < 4; ++i) { const int kc = 16 * (kb0 + b) + 4 * g + i; const bool ok = (kc >= cs[tt]) && (kc <= cs[tt] + 15);
                        int idx = rbase + kc; idx = ok ? idx : 0; const float e = __builtin_amdgcn_exp2f(S[tt][b][i]) * rpbL[idx]; pv[i] = ok ? e : 0.f; lsum[tt] += pv[i]; }
                    v2u pw; pw.x = pk2(pv[0], pv[1]); pw.y = pk2(pv[2], pv[3]); pf[tt][b] = __builtin_bit_cast(s16x4, pw); } }
#pragma unroll
            for (int b = 0; b < 3; ++b)
#pragma unroll
                for (int db = 0; db < 8; ++db) { const s16x4 vf = __builtin_amdgcn_ds_read_tr16_b64_v4i16((LAS s16x4*)(slot + NA_KS + (16 * (kb0 + b) + 4 * g + q4) * NA_VP + (32 * (db >> 1) + 8 * p4 + 4 * (db & 1)) * 2));
#pragma unroll
                    for (int tt = 0; tt < 2; ++tt) O[tt][db] = __builtin_amdgcn_mfma_f32_16x16x16bf16_1k(vf, pf[tt][b], O[tt][db], 0, 0, 0); }
        }
    }
#undef NA_LOAD
    if constexpr (FILL) tr_store(FR, FI.dst, FI.ldk, lane);
#pragma unroll
    for (int tt = 0; tt < 2; ++tt) { float l = lsum[tt]; l += xor_lane<16>(l); l += xor_lane<32>(l); const float inv = 1.f / l;
        const float inv8 = inv * F8_YSCALE;
        GAS unsigned char* orow = (GAS unsigned char*)(F.ws + WS_YB) + pg8::blk_off(r * GRID_W + c[tt], h * HD + 8 * g, NAW);
#pragma unroll
        for (int t = 0; t < 4; ++t) { const f32x4 a0 = O[tt][2 * t], a1 = O[tt][2 * t + 1]; v2u o;
            o.x = pk4_fp8(a0[0] * inv8, a0[1] * inv8, a0[2] * inv8, a0[3] * inv8); o.y = pk4_fp8(a1[0] * inv8, a1[1] * inv8, a1[2] * inv8, a1[3] * inv8);
            *(GAS v2u*)(orow + 32 * t) = o; } }
}

struct Args { const float* in[17]; float* out; unsigned char* ws; int ph_lo, ph_hi, li, pad; };
__global__ void __launch_bounds__(NWAVES * 64, 2) fwd_kernel(Args args) {
    extern __shared__ __attribute__((aligned(16))) unsigned char lds[];
    Frame F;
    F.lds = (LAS unsigned char*)lds;
    F.MISC = (volatile LAS unsigned*)(F.lds + MISC_OFF);
    F.tid = threadIdx.x; F.lane = F.tid & 63; F.wave = __builtin_amdgcn_readfirstlane(F.tid >> 6);
    F.G = gridDim.x; { const int bx = blockIdx.x; F.vcu = (F.G % 8 == 0) ? (bx % 8) * (F.G / 8) + bx / 8 : bx; }
    F.ws = args.ws; F.ctl = (gu32*)(args.ws + WS_CTL);
    F.x = args.in[0]; F.norm1_g = args.in[1]; F.w_in = args.in[2]; F.gm_ln_g = args.in[3]; F.gm_ln_b = args.in[4]; F.gm_w_s = args.in[5]; F.gm_b_s = args.in[6];
    F.q_gain = args.in[7]; F.k_gain = args.in[8]; F.na_rpb = args.in[9]; F.w_o_gm = args.in[10]; F.w_o_na = args.in[11]; F.w_out = args.in[12]; F.norm2_g = args.in[13];
    F.w_ff_gate = args.in[14]; F.w_ff_up = args.in[15]; F.w_ff_down = args.in[16]; F.out = args.out;
    for (int u = F.tid; u < (LDS_BYTES - LDSCTL_OFF) / 4; u += NWAVES * 64) ((LAS unsigned*)(F.lds + LDSCTL_OFF))[u] = 0u;
    __syncthreads();
    XcdBarrier bar; bar.bar = (unsigned*)(F.ctl + CW_BAR); bar.x = 0; bar.st = nullptr;
    if (N_LAUNCHES != PER_PHASE) bar = xcd_barrier_post((unsigned*)(F.ctl + CW_BAR), F.MISC + 8);
#define GRID_BAR() do { if (N_LAUNCHES != PER_PHASE) xcd_barrier(bar); } while (0)
    const int lo = args.ph_lo, hi = args.ph_hi < MK_STOP_AFTER + 1 ? args.ph_hi : MK_STOP_AFTER + 1;
#define IN(k) (lo <= (k) && (k) < hi)
#define BOTH(k) (IN(k) && IN((k) + 1))
    const int bx = (int)blockIdx.x;

    if (IN(0)) { _Pragma("unroll") for (int rep = 0; rep < NREP(0); ++rep) { p0_prologue(F); if (BOTH(0)) GRID_BAR(); } }

    if (IN(1)) _Pragma("unroll") for (int rep = 0; rep < NREP(1); ++rep) {
        { pg8::SchedP1a S; S.o.init(M, 16 * 256, F.G, bx); S.A = (const char*)(F.ws + WS_RA); S.B = (const char*)(F.ws + WS_WIN); S.tstep = (size_t)256 * D * 2;
          pg8::EpiProj E{(bf16*)(F.ws + WS_RB), M, 1.f, (float*)(F.ws + WS_PART)};
          stagger(MK_STAGGER_US); pg8::gemm_phase<pg8::EpiProj, pg8::SchedP1a, true, true>(F.lds, D, S, E); }
        { pg8::SchedP1b S; S.o.init(M, 56 * 256, F.G, bx); S.A8 = (const char*)(F.ws + WS_XN8); S.B8 = (const char*)(F.ws + WS_WQKV8); S.tstep8 = (size_t)256 * D;
          pg8::EpiQKV E{(bf16*)(F.ws + WS_RB), M, F8_UNSCALE, F.ws + WS_GA, F.ws + WS_GB};
          pg8::gemm_phase_f8<pg8::EpiQKV, pg8::SchedP1b>(F.lds, D, S, E); }
        if (BOTH(1)) GRID_BAR();
    }
    if (IN(2)) _Pragma("unroll") for (int rep = 0; rep < NREP(2); ++rep) {
        for (int u = bx; u < 2 * (M / CHUNK); u += F.G) gmlp_unit(F, u >> 1, u & 1);
#if defined(MK_PROBE_NA)
        for (int rep = 0; rep < args.pad + 2; ++rep)
#endif
        float cbound;
        { const int ln = opaque_tid() & 63; float mq = fmaxf(fabsf(F.q_gain[2 * ln]), fabsf(F.q_gain[2 * ln + 1])), mk = fmaxf(fabsf(F.k_gain[2 * ln]), fabsf(F.k_gain[2 * ln + 1]));
          mq = fmaxf(mq, xor_lane<1>(mq)); mq = fmaxf(mq, xor_lane<2>(mq)); mq = fmaxf(mq, xor_lane<4>(mq)); mq = fmaxf(mq, xor_lane<8>(mq)); mq = fmaxf(mq, xor_lane<16>(mq)); mq = fmaxf(mq, xor_lane<32>(mq));
          mk = fmaxf(mk, xor_lane<1>(mk)); mk = fmaxf(mk, xor_lane<2>(mk)); mk = fmaxf(mk, xor_lane<4>(mk)); mk = fmaxf(mk, xor_lane<8>(mk)); mk = fmaxf(mk, xor_lane<16>(mk)); mk = fmaxf(mk, xor_lane<32>(mk));
          cbound = 11.313708498984761f * 1.01f * LOG2E * mq * mk; }
        {
            const int gwv = F.vcu * NWAVES + F.wave, NGW = F.G * NWAVES, per_wave = (FF_ITEMS_P2 + NGW - 1) / NGW, nfill = (per_wave + NA_ROWS - 1) / NA_ROWS; int ui = 0, done = 0;
            for (int u = F.vcu; u < (GRID_H / 4) * NHEAD; u += F.G, ++ui) {
                if (ui < nfill) { na_unit<true>(F, u & (GRID_H / 4 - 1), u >> 6, cbound, gwv + done * NGW, NGW); done += NA_ROWS; }
                else na_unit<false>(F, u & (GRID_H / 4 - 1), u >> 6, cbound, 0, 0); }
            const int ln = opaque_tid() & 63;
            for (int it = gwv + done * NGW; it < FF_ITEMS_P2; it += NGW) { TrRegs R; const FillItem I = ff_item(F, it); tr_load(R, I.src, I.ldw, I.k0, I.n0, ln); tr_store(R, I.dst, I.ldk, ln); }
        }
        if (BOTH(2)) GRID_BAR();
    }
    if (IN(3)) _Pragma("unroll") for (int rep = 0; rep < NREP(3); ++rep) {
        { pg8::SchedMerge S; S.o.init(M, D, F.G, bx); S.A0 = (const char*)(F.ws + WS_YB); S.B0 = (const char*)(F.ws + WS_WOB); S.A1 = (const char*)(F.ws + WS_YA); S.B1 = (const char*)(F.ws + WS_WOA); S.tstep = (size_t)256 * GMW * 2; S.tstep8 = (size_t)256 * NAW;
          pg8::EpiMix E{F.ws + WS_GA, F.ws + WS_GB, (bf16*)(F.ws + WS_MRG), F8_YUNSCALE};
          stagger(MK_STAGGER_US); pg8::gemm_phase_mix<pg8::EpiMix, pg8::SchedMerge>(F.lds, 0, NAW / 128, GMW / 64, S, E); }
        if (BOTH(3)) GRID_BAR();
    }
    if (IN(4)) _Pragma("unroll") for (int rep = 0; rep < NREP(4); ++rep) {
        pg8::SchedPlain S; S.o.init(M, D, F.G, bx); S.A = (const char*)(F.ws + WS_MRG); S.B = (const char*)(F.ws + WS_WOUT); S.tstep = (size_t)256 * D * 2;
        pg8::EpiOutNorm E{F.x, (bf16*)(F.ws + WS_H16), (bf16*)(F.ws + WS_RA), F.norm2_g, (float*)(F.ws + WS_PART)};
        stagger(MK_STAGGER_US); pg8::gemm_phase<pg8::EpiOutNorm, pg8::SchedPlain, true, true>(F.lds, D, S, E);
        if (BOTH(4)) GRID_BAR();
    }
    if (IN(6)) _Pragma("unroll") for (int rep = 0; rep < NREP(6); ++rep) {
        pg8::SchedPlain S; S.o.init(M, NGU, F.G, bx); S.A = (const char*)(F.ws + WS_RA); S.B = (const char*)(F.ws + WS_WGU); S.tstep = (size_t)256 * D * 2;
        LAS float* rtab = (LAS float*)(F.lds + 135168); const int fm = 8 * (bx & 7);
        { const int t5 = opaque_tid(); const float* part = (const float*)(F.ws + WS_PART);
          for (int r = t5; r < 2048; r += NWAVES * 64) { const GAS f32x4* p = (const GAS f32x4*)(part + (size_t)(fm * 256 + r) * 64); float sacc = 0.f;
#pragma unroll
              for (int j = 0; j < 16; ++j) { const f32x4 v = p[j]; sacc += (v.x + v.y) + (v.z + v.w); }
              rtab[r] = 1.f / sqrtf(sacc * (1.f / D) + RMS_EPS); }
          __syncthreads(); }
        pg8::EpiSwiglu E{(bf16*)(F.ws + WS_ACT), DFF, rtab, fm};
        stagger(MK_STAGGER_US); pg8::gemm_phase<pg8::EpiSwiglu, pg8::SchedPlain, true, true>(F.lds, D, S, E);
        {
            const int rem = S.o.nwg % F.G, first = rem, nidle = rem ? F.G - rem : F.G;
            if (bx >= first || rem == 0) { const int ln = opaque_tid() & 63, w0 = ((rem ? bx - first : bx) * NWAVES + F.wave), NW = nidle * NWAVES;
                for (int it = FF_ITEMS_P2 + w0; it < FF_ITEMS; it += 2 * NW) { const int it2 = it + NW; TrRegs Ra, Rb; const FillItem Ia = ff_item(F, it), Ib = ff_item(F, it2);
                    tr_load(Ra, Ia.src, Ia.ldw, Ia.k0, Ia.n0, ln); tr_load(Rb, Ib.src, Ib.ldw, Ib.k0, Ib.n0, ln); tr_store(Ra, Ia.dst, Ia.ldk, ln); tr_store(Rb, Ib.dst, Ib.ldk, ln); } } }
        if (BOTH(6)) GRID_BAR();
    }
    if (IN(7)) {
        pg8::SchedPlain S; S.o.init(M, D, F.G, bx); S.A = (const char*)(F.ws + WS_ACT); S.B = (const char*)(F.ws + WS_WD); S.tstep = (size_t)256 * DFF * 2;
        pg8::EpiResH16 E{(const bf16*)(F.ws + WS_H16), F.out};
        stagger(MK_STAGGER_US); pg8::gemm_phase<pg8::EpiResH16, pg8::SchedPlain, true, true>(F.lds, DFF, S, E);
    }

#if MK_STOP_AFTER < 4
    {
        GRID_BAR();
        const bf16* pU = (const bf16*)(F.ws + WS_U); const bf16* pV = (const bf16*)(F.ws + WS_V); const bf16* pQ = (const bf16*)(F.ws + WS_Q); const bf16* pK = (const bf16*)(F.ws + WS_K); const bf16* pVV = (const bf16*)(F.ws + WS_VV);
        const bf16* pGA = (const bf16*)(F.ws + WS_GA); const bf16* pGB = (const bf16*)(F.ws + WS_GB); const bf16* pYA = (const bf16*)(F.ws + WS_YA); const bf16* pYB = (const bf16*)(F.ws + WS_YB); const bf16* pM = (const bf16*)(F.ws + WS_MRG);
        for (size_t i = (size_t)bx * 512 + F.tid; i < (size_t)M * D; i += (size_t)F.G * 512) { const size_t m = i >> 12; const int c = (int)(i & 4095), c2 = c & 2047; float v;
            if (MK_STOP_AFTER == 1) v = 0.f * bflo(pGA[i]) + 0.f * bflo(pGB[i]) + 8.f * bflo(((const bf16*)(F.ws + WS_WOA))[(m & 4095) * 2048 + c2]) + 9.f * bflo(((const bf16*)(F.ws + WS_WOB))[(m & 4095) * 2048 + c2]) + 10.f * bflo(((const bf16*)(F.ws + WS_WOUT))[(m & 4095) * 4096 + c]);
            else if (MK_STOP_AFTER == 2) v = c < 2048 ? bflo(pYA[m * 2048 + c2]) : bflo(pYB[m * 2048 + c2]);
            else if (MK_STOP_AFTER == 3) v = bflo(pM[i]);
            else v = F.x[i];
            F.out[i] = v; }
    }
#endif
#if defined(MK_PROBE_P7)
    {
        GRID_BAR();
        pg8::SchedPlain S; S.o.init(M, D, F.G, bx); S.A = (const char*)(F.ws + WS_ACT); S.B = (const char*)(F.ws + WS_WD); S.tstep = (size_t)256 * DFF * 2;
        pg8::EpiResF32 E{F.out, (float*)(F.ws + WS_END)};
        pg8::gemm_phase<pg8::EpiResF32, pg8::SchedPlain, true, true>(F.lds, DFF, S, E);
    }
#endif
#undef IN
#undef BOTH
#undef GRID_BAR
}

extern "C" void kernel_launch(void* const* d_in, const int* in_sizes, int n_in, void* d_out, int out_size, void* d_ws, size_t ws_size, hipStream_t stream) {
    static int grid = 0;
    if (grid == 0) {
        if (n_in != 17 || in_sizes[0] != M * D || out_size != M * D || ws_size < WS_END) { fprintf(stderr, "kernel_launch: unexpected shapes/workspace (n_in %d, in0 %d, out %d, ws %zu < %zu); nothing launched\n", n_in, n_in > 0 ? in_sizes[0] : -1, out_size, ws_size, (size_t)WS_END); grid = -1; return; }
        int dev = 0, cus = 0, per_cu = 0;
        if (hipGetDevice(&dev) != hipSuccess || hipDeviceGetAttribute(&cus, hipDeviceAttributeMultiprocessorCount, dev) != hipSuccess) { grid = -1; return; }
        if (hipFuncSetAttribute((const void*)fwd_kernel, hipFuncAttributeMaxDynamicSharedMemorySize, LDS_BYTES) != hipSuccess) { fprintf(stderr, "kernel_launch: hipFuncSetAttribute failed\n"); grid = -1; return; }
        if (hipOccupancyMaxActiveBlocksPerMultiprocessor(&per_cu, (const void*)fwd_kernel, NWAVES * 64, LDS_BYTES) != hipSuccess || per_cu < 1) fprintf(stderr, "kernel_launch: occupancy query reports %d\n", per_cu);
        (void)hipGetLastError();
        grid = cus - cus % 8;
    }
    if (grid < 0) return;
    if (hipMemsetAsync((char*)d_ws + WS_CTL, 0, CTL_ZERO_BYTES, stream) != hipSuccess) return;
    Args a{};
    for (int i = 0; i < 17; ++i) a.in[i] = (const float*)d_in[i];
    a.out = (float*)d_out; a.ws = (unsigned char*)d_ws;
    for (int li = 0; li < N_LAUNCHES; ++li) {
        if (N_LAUNCHES == PER_PHASE) { a.ph_lo = li; a.ph_hi = li + 1; } else { a.ph_lo = 0; a.ph_hi = PER_PHASE; }
        a.li = li; a.pad = 0;
        hipLaunchKernelGGL(fwd_kernel, dim3(grid), dim3(NWAVES * 64), LDS_BYTES, stream, a);
        const hipError_t le = hipPeekAtLastError();
        if (le != hipSuccess) { fprintf(stderr, "kernel_launch: launch %d failed: %s\n", li, hipGetErrorName(le)); break; }
    }
}
```

```cpp
#include <hip/hip_runtime.h>
#include <cstdio>
#include <cstdint>

#ifndef MK_N_LAUNCHES
#define MK_N_LAUNCHES 1
#endif
#ifndef MK_REPEAT
#define MK_REPEAT 0
#endif
#define NREP(k) (((MK_REPEAT >> (k)) & 1) + 1)
#ifndef MK_STOP_AFTER
#define MK_STOP_AFTER 7
#endif

__device__ __forceinline__ int opaque_tid() { int t = (int)threadIdx.x; asm volatile("" : "+v"(t)); return t; }
namespace pg8 {
#define PG8_LAS __attribute__((address_space(3)))
typedef unsigned short bf16_t;
typedef short bf16x8 __attribute__((ext_vector_type(8)));
typedef float f32x4 __attribute__((ext_vector_type(4)));
typedef float f32x2 __attribute__((ext_vector_type(2)));
typedef unsigned u32x4 __attribute__((ext_vector_type(4)));
typedef unsigned u32x2 __attribute__((ext_vector_type(2)));
constexpr int BM = 256, BK = 64, HALF = 128, HTB = HALF * BK * 2  , STAGE_BYTES = 8 * HTB, NXCD = 8, WGM = 8;

__host__ __device__ __forceinline__ int lds_byte(int r, int c) { const int st = (r >> 4) * 2 + (c >> 5), rr = r & 15, cc = c & 31, ob = rr * 64 + cc * 2; return st * 1024 + (ob ^ (((ob >> 9) & 1) << 5)); }
__host__ __device__ __forceinline__ void stage_rc(int b, int& R, int& C) { const int st = b / 1024, sb = b % 1024, swz = sb ^ (((sb >> 9) & 1) << 5); R = (st >> 1) * 16 + swz / 64; C = (st & 1) * 32 + (swz % 64) / 2; }
__host__ __device__ __forceinline__ int perm32(int rho) { const int n = rho >> 4, i = rho & 15; return 8 * (i >> 2) + 4 * n + (i & 3); }

__host__ __device__ __forceinline__ int invperm32(int w) { return 16 * ((w >> 2) & 1) + 4 * (w >> 3) + (w & 3); }
__host__ __device__ __forceinline__ size_t blk_off(int row, int kb, int KB) { return ((size_t)(row >> 8) * (KB >> 7) + (kb >> 7)) * 32768 + ((row >> 7) & 1) * 16384 + lds_byte(row & 127, (kb & 127) >> 1) + (kb & 1); }
__host__ __device__ __forceinline__ int img_off_w(int nloc, int c) { const int w = nloc & 127; return (nloc >> 7) * 16384 + lds_byte((w & ~31) + invperm32(w & 31), c); }
struct Unit { int pm, pn, sub; };

struct StaticOrder {
    int nM, nN, nwg, G, c;
    __host__ __device__ void init(int M, int N, int G_, int c_) { nM = M / BM; nN = N / BM; nwg = nM * nN; G = G_; c = c_; }
    __host__ __device__ bool tile(int i, Unit& u) const {
        const long L = (long)i * G + c; if (L >= nwg) return false;
        int wgid = (int)L; { const int q = nwg / NXCD, r = nwg % NXCD, xcd = wgid % NXCD, off = wgid / NXCD; wgid = (xcd < r ? xcd * (q + 1) : r * (q + 1) + (xcd - r) * q) + off; }
        const int nig = WGM * nN, gid = wgid / nig, fm = gid * WGM, gsz = (nM - fm) < WGM ? (nM - fm) : WGM;
        u.pm = fm + ((wgid % nig) % gsz); u.pn = (wgid % nig) / gsz; u.sub = 0; return true;
    }
};
struct SchedPlain {
    StaticOrder o; const char* A; const char* B; size_t tstep;
    __device__ __forceinline__ bool next(int i, Unit& u) const { return o.tile(i, u); }
    __device__ __forceinline__ void ptrs(const Unit& u, const char*& a, const char*& b) const { a = A + (size_t)u.pm * tstep; b = B + (size_t)u.pn * tstep; }
};
struct SchedP1a {
    StaticOrder o; const char* A; const char* B; size_t tstep;
    __device__ __forceinline__ bool next(int i, Unit& u) const { const bool ok = o.tile(i, u); u.pn = u.pn < 16 ? u.pn : u.pn + 24; return ok; }
    __device__ __forceinline__ void ptrs(const Unit& u, const char*& a, const char*& b) const { a = A + (size_t)u.pm * tstep; b = B + (size_t)u.pn * tstep; }
};
struct SchedP1b {
    StaticOrder o; const char* A8; const char* B8; size_t tstep8;
    __device__ __forceinline__ bool next(int i, Unit& u) const { const bool ok = o.tile(i, u); u.sub = u.pn; u.pn = u.pn + 16; return ok; }
    __device__ __forceinline__ void ptrs(const Unit& u, const char*& a, const char*& b) const { a = A8 + (size_t)u.pm * tstep8; b = B8 + (size_t)u.sub * tstep8; }
};
struct SchedMerge {
    StaticOrder o; const char* A0; const char* B0; const char* A1; const char* B1; size_t tstep; size_t tstep8;
    __device__ __forceinline__ bool next(int i, Unit& u) const { const bool ok = o.tile(i >> 1, u); u.sub = i & 1; return ok; }
    __device__ __forceinline__ void ptrs(const Unit& u, const char*& a, const char*& b) const { a = (u.sub ? A1 : A0) + (size_t)u.pm * tstep; b = (u.sub ? B1 : B0) + (size_t)u.pn * tstep; }
};

typedef __bf16 bf16x2v __attribute__((ext_vector_type(2)));
__device__ __forceinline__ unsigned cvt_pk_bf16(float lo, float hi) { const bf16x2v v = __builtin_convertvector((f32x2){lo, hi}, bf16x2v); return __builtin_bit_cast(unsigned, v); }
__device__ __forceinline__ float bf_lo(unsigned w) { return __uint_as_float(w << 16); }
__device__ __forceinline__ float bf_hi(unsigned w) { return __uint_as_float(w & 0xffff0000u); }
__device__ __forceinline__ f32x2 gelu_pk(f32x2 v) {
    const f32x2 av = __builtin_elementwise_abs(v), d = av * 0.2316418882f + 1.0f;
    f32x2 t; t.x = __builtin_amdgcn_rcpf(d.x); t.y = __builtin_amdgcn_rcpf(d.y);
    f32x2 q = t * 0.5307027145f + (-0.7265760135f); q = q * t + 0.7107068705f; q = q * t + (-0.142248368f); q = q * t + 0.127414796f; q = q * t;
    const f32x2 s = (v * v) * (-0.72134752044f);
    f32x2 e; e.x = __builtin_amdgcn_exp2f(s.x); e.y = __builtin_amdgcn_exp2f(s.y);
    const f32x2 m = v * (q * e), r = v - m;
    f32x2 o; o.x = v.x < 0.f ? m.x : r.x; o.y = v.y < 0.f ? m.y : r.y; return o;
}
__device__ __forceinline__ float sigmoid_f(float x) { return __builtin_amdgcn_rcpf(1.0f + __builtin_amdgcn_exp2f(x * -1.44269504089f)); }
__device__ __forceinline__ f32x4 gelu4(f32x4 v) { const f32x2 a = gelu_pk((f32x2){v[0], v[1]}), b = gelu_pk((f32x2){v[2], v[3]}); return (f32x4){a.x, a.y, b.x, b.y}; }
__device__ __forceinline__ f32x4 sigm4(f32x4 v) { return (f32x4){sigmoid_f(v[0]), sigmoid_f(v[1]), sigmoid_f(v[2]), sigmoid_f(v[3])}; }
__device__ __forceinline__ u32x4 pack8(f32x4 v0, f32x4 v1) { u32x4 w; w.x = cvt_pk_bf16(v0[0], v0[1]); w.y = cvt_pk_bf16(v0[2], v0[3]); w.z = cvt_pk_bf16(v1[0], v1[1]); w.w = cvt_pk_bf16(v1[2], v1[3]); return w; }

__device__ __forceinline__ size_t lane_tile_idx(int T, int wr, int wc, int fr, int fq, int ai, int m, int bj) { return ((size_t)T * 128 + (((wr * 4 + wc) * 2 + ai) * 4 + m) * 2 + bj) * 64 + fr + 16 * fq; }
__device__ __forceinline__ unsigned pack_u8x4(f32x4 v) { const f32x4 q = v * 255.f + 0.5f; return (unsigned)q[0] | ((unsigned)q[1] << 8) | ((unsigned)q[2] << 16) | ((unsigned)q[3] << 24); }
__device__ __forceinline__ f32x4 unpack_u8x4(unsigned w) { return (f32x4){(float)(w & 0xffu), (float)((w >> 8) & 0xffu), (float)((w >> 16) & 0xffu), (float)(w >> 24)}; }
struct EpiProj {
    static constexpr bool PERM = true;
    bf16_t* base; int M; float qkv_scale;
    float* vstat;
    __device__ __forceinline__ void store_v(const f32x4 (&acc)[2][2][4][2], bf16_t* O, int row0, int col0, int slice, int fq, size_t bjs) const {
#pragma unroll
        for (int ai = 0; ai < 2; ++ai)
#pragma unroll
            for (int m = 0; m < 4; ++m) { const int row = row0 + ai * HALF + m * 16; bf16_t* rowp = O + (size_t)row * 128 + col0; float s = 0.f, s2 = 0.f;
#pragma unroll
                for (int bj = 0; bj < 2; ++bj) { const f32x4 v0 = gelu4(acc[ai][bj][m][0]), v1 = gelu4(acc[ai][bj][m][1]);
                    s += ((v0[0] + v0[1]) + (v0[2] + v0[3])) + ((v1[0] + v1[1]) + (v1[2] + v1[3]));
                    s2 += ((v0[0] * v0[0] + v0[1] * v0[1]) + (v0[2] * v0[2] + v0[3] * v0[3])) + ((v1[0] * v1[0] + v1[1] * v1[1]) + (v1[2] * v1[2] + v1[3] * v1[3]));
                    *(u32x4*)(rowp + bj * bjs) = pack8(v0, v1); }
                s += __shfl_xor(s, 16); s += __shfl_xor(s, 32); s2 += __shfl_xor(s2, 16); s2 += __shfl_xor(s2, 32);
                if (fq == 0) *(f32x2*)(vstat + (size_t)row * 64 + 2 * slice) = (f32x2){s, s2}; }
    }
    __device__ __forceinline__ bool keep(const Unit&) const { return false; }
    template <int ACT> __device__ __forceinline__ void store(const f32x4 (&acc)[2][2][4][2], bf16_t* O, int ldc, int row0, int col0, size_t bjs) const {
#pragma unroll
        for (int ai = 0; ai < 2; ++ai)
#pragma unroll
            for (int m = 0; m < 4; ++m) { bf16_t* rowp = O + (size_t)(row0 + ai * HALF + m * 16) * ldc + col0;
#pragma unroll
                for (int bj = 0; bj < 2; ++bj) { f32x4 v0 = acc[ai][bj][m][0], v1 = acc[ai][bj][m][1];
                    if (ACT == 0) { v0 = v0 * qkv_scale; v1 = v1 * qkv_scale; }
                    if (ACT == 1) { v0 = gelu4(v0); v1 = gelu4(v1); }
                    if (ACT == 2) { v0 = sigm4(v0); v1 = sigm4(v1); }
                    *(u32x4*)(rowp + bj * bjs) = pack8(v0, v1); } }
    }
    __device__ __forceinline__ void operator()(f32x4 (&acc)[2][2][4][2], const Unit& u, int wr, int wc, int fr, int fq) const {
        const int row0 = u.pm * BM + wr * 64 + fr, pn = u.pn;
        if (pn < 40) { const int t = pn >> 3; const size_t hs = (size_t)M * 128; bf16_t* O = base + (size_t)t * M * 2048 + (size_t)(2 * (pn & 7)) * hs; const int col0 = wc * 32 + 8 * fq;
            if (t == 0) store<1>(acc, O, 128, row0, col0, hs); else if (t == 1) store_v(acc, O, row0, col0, (pn & 7) * 4 + wc, fq, hs); else store<0>(acc, O, 128, row0, col0, hs); }
        else { const int t = (pn - 40) >> 4; bf16_t* O = base + (size_t)5 * M * 2048 + (size_t)t * M * 4096; const int col0 = ((pn - 40) & 15) * BM + wc * 32 + 8 * fq;
            store<2>(acc, O, 4096, row0, col0, HALF); }
    }
};
struct EpiQKV {
    static constexpr bool PERM = true;
    bf16_t* base; int M; float sc; unsigned char* ga8; unsigned char* gb8;
    __device__ __forceinline__ void store_gate(const f32x4 (&acc)[2][2][4][2], unsigned char* O8, int T, int wr, int wc, int fr, int fq) const {
#pragma unroll
        for (int ai = 0; ai < 2; ++ai)
#pragma unroll
            for (int m = 0; m < 4; ++m)
#pragma unroll
                for (int bj = 0; bj < 2; ++bj) { const f32x4 v0 = sigm4(acc[ai][bj][m][0] * sc), v1 = sigm4(acc[ai][bj][m][1] * sc);
                    *(u32x2*)(O8 + lane_tile_idx(T, wr, wc, fr, fq, ai, m, bj) * 8) = (u32x2){pack_u8x4(v0), pack_u8x4(v1)}; }
    }
    __device__ __forceinline__ bool keep(const Unit&) const { return false; }
    template <int ACT> __device__ __forceinline__ void store(const f32x4 (&acc)[2][2][4][2], bf16_t* O, int ldc, int row0, int col0, size_t bjs) const {
#pragma unroll
        for (int ai = 0; ai < 2; ++ai)
#pragma unroll
            for (int m = 0; m < 4; ++m) { bf16_t* rowp = O + (size_t)(row0 + ai * HALF + m * 16) * ldc + col0;
#pragma unroll
                for (int bj = 0; bj < 2; ++bj) { f32x4 v0 = acc[ai][bj][m][0] * sc, v1 = acc[ai][bj][m][1] * sc;
                    if (ACT == 2) { v0 = sigm4(v0); v1 = sigm4(v1); }
                    *(u32x4*)(rowp + bj * bjs) = pack8(v0, v1); } }
    }
    __device__ __forceinline__ void operator()(f32x4 (&acc)[2][2][4][2], const Unit& u, int wr, int wc, int fr, int fq) const {
        const int row0 = u.pm * BM + wr * 64 + fr;
        if (u.pn < 40) store<0>(acc, base + (size_t)(u.pn >> 3) * M * 2048 + (size_t)(2 * (u.pn & 7)) * M * 128, 128, row0, wc * 32 + 8 * fq, (size_t)M * 128);
        else store_gate(acc, u.pn < 56 ? ga8 : gb8, u.pm * 16 + ((u.pn - 40) & 15), wr, wc, fr, fq);
    }
};
struct EpiTB {
    static constexpr bool PERM = true;
    const unsigned char* GB; bf16_t* T; float sc;
    __device__ __forceinline__ bool keep(const Unit&) const { return false; }
    __device__ __forceinline__ void operator()(f32x4 (&acc)[2][2][4][2], const Unit& u, int wr, int wc, int fr, int fq) const {
        const int row0 = u.pm * BM + wr * 64 + fr, col0 = u.pn * BM + wc * 32 + 8 * fq;
#pragma unroll
        for (int ai = 0; ai < 2; ++ai)
#pragma unroll
            for (int m = 0; m < 4; ++m) { const size_t off = (size_t)(row0 + ai * HALF + m * 16) * 4096 + col0;
#pragma unroll
                for (int bj = 0; bj < 2; ++bj) { const u32x2 b = *(const u32x2*)(GB + off + bj * HALF);
                    const f32x4 s0 = unpack_u8x4(b.x) * sc, s1 = unpack_u8x4(b.y) * sc;
                    *(u32x4*)(T + off + bj * HALF) = pack8(acc[ai][bj][m][0] * s0, acc[ai][bj][m][1] * s1); } }
    }
};
struct EpiMergeA {
    static constexpr bool PERM = true;
    const unsigned char* GA; const bf16_t* T; bf16_t* O;
    __device__ __forceinline__ bool keep(const Unit&) const { return false; }
    __device__ __forceinline__ void operator()(f32x4 (&acc)[2][2][4][2], const Unit& u, int wr, int wc, int fr, int fq) const {
        const int row0 = u.pm * BM + wr * 64 + fr, col0 = u.pn * BM + wc * 32 + 8 * fq;
#pragma unroll
        for (int ai = 0; ai < 2; ++ai)
#pragma unroll
            for (int m = 0; m < 4; ++m) { const size_t off = (size_t)(row0 + ai * HALF + m * 16) * 4096 + col0;
#pragma unroll
                for (int bj = 0; bj < 2; ++bj) { const u32x2 a = *(const u32x2*)(GA + off + bj * HALF); const u32x4 t = *(const u32x4*)(T + off + bj * HALF);
                    const f32x4 s0 = unpack_u8x4(a.x) * (1.f / 255.f), s1 = unpack_u8x4(a.y) * (1.f / 255.f);
                    const f32x4 t0 = (f32x4){bf_lo(t.x), bf_hi(t.x), bf_lo(t.y), bf_hi(t.y)}, t1 = (f32x4){bf_lo(t.z), bf_hi(t.z), bf_lo(t.w), bf_hi(t.w)};
                    *(u32x4*)(O + off + bj * HALF) = pack8(acc[ai][bj][m][0] * s0 + t0, acc[ai][bj][m][1] * s1 + t1); } }
    }
};
struct EpiMix {
    static constexpr bool PERM = true;
    const unsigned char* GA; const unsigned char* GB; bf16_t* O; float c;
    __device__ __forceinline__ bool keep(const Unit& u) const { return u.sub == 0; }
    __device__ __forceinline__ void operator()(f32x4 (&acc)[2][2][4][2], const Unit& u, int wr, int wc, int fr, int fq) const {
        const int row0 = u.pm * BM + wr * 64 + fr, col0 = u.pn * BM + wc * 32 + 8 * fq;
        if (u.sub == 0) {
#pragma unroll
            for (int ai = 0; ai < 2; ++ai)
#pragma unroll
                for (int m = 0; m < 4; ++m) { const size_t off = (size_t)(row0 + ai * HALF + m * 16) * 4096 + col0;
#pragma unroll
                    for (int bj = 0; bj < 2; ++bj) { const size_t gi = lane_tile_idx(u.pm * 16 + u.pn, wr, wc, fr, fq, ai, m, bj) * 8; (void)off; const u32x2 a = *(const u32x2*)(GA + gi), b = *(const u32x2*)(GB + gi);
                        f32x4 a0 = __builtin_elementwise_max(unpack_u8x4(a.x), (f32x4){9.5367431640625e-7f, 9.5367431640625e-7f, 9.5367431640625e-7f, 9.5367431640625e-7f});
                        f32x4 a1 = __builtin_elementwise_max(unpack_u8x4(a.y), (f32x4){9.5367431640625e-7f, 9.5367431640625e-7f, 9.5367431640625e-7f, 9.5367431640625e-7f});
                        const f32x4 r0 = (f32x4){__builtin_amdgcn_rcpf(a0[0]), __builtin_amdgcn_rcpf(a0[1]), __builtin_amdgcn_rcpf(a0[2]), __builtin_amdgcn_rcpf(a0[3])};
                        const f32x4 r1 = (f32x4){__builtin_amdgcn_rcpf(a1[0]), __builtin_amdgcn_rcpf(a1[1]), __builtin_amdgcn_rcpf(a1[2]), __builtin_amdgcn_rcpf(a1[3])};
                        acc[ai][bj][m][0] = acc[ai][bj][m][0] * (unpack_u8x4(b.x) * c) * r0; acc[ai][bj][m][1] = acc[ai][bj][m][1] * (unpack_u8x4(b.y) * c) * r1; } }
        } else {
#pragma unroll
            for (int ai = 0; ai < 2; ++ai)
#pragma unroll
                for (int m = 0; m < 4; ++m) { const size_t off = (size_t)(row0 + ai * HALF + m * 16) * 4096 + col0;
#pragma unroll
                    for (int bj = 0; bj < 2; ++bj) { const u32x2 a = *(const u32x2*)(GA + lane_tile_idx(u.pm * 16 + u.pn, wr, wc, fr, fq, ai, m, bj) * 8);
                        const f32x4 a0 = __builtin_elementwise_max(unpack_u8x4(a.x), (f32x4){9.5367431640625e-7f, 9.5367431640625e-7f, 9.5367431640625e-7f, 9.5367431640625e-7f}) * (1.f / 255.f);
                        const f32x4 a1 = __builtin_elementwise_max(unpack_u8x4(a.y), (f32x4){9.5367431640625e-7f, 9.5367431640625e-7f, 9.5367431640625e-7f, 9.5367431640625e-7f}) * (1.f / 255.f);
                        *(u32x4*)((char*)O + blk_off(row0 + ai * HALF + m * 16, (col0 + bj * HALF) * 2, 8192)) = pack8(acc[ai][bj][m][0] * a0, acc[ai][bj][m][1] * a1); (void)off; } }
        }
    }
};
__device__ __forceinline__ float sb_lo(unsigned w) { return fmaxf(bf_lo(w), 8.673617379884035e-19f); }
__device__ __forceinline__ float sb_hi(unsigned w) { return fmaxf(bf_hi(w), 8.673617379884035e-19f); }
struct EpiMerge {
    static constexpr bool PERM = true;
    const bf16_t* GA; const bf16_t* GB; bf16_t* O;
    __device__ __forceinline__ bool keep(const Unit& u) const { return u.sub == 0; }
    __device__ __forceinline__ void operator()(f32x4 (&acc)[2][2][4][2], const Unit& u, int wr, int wc, int fr, int fq) const {
        const int row0 = u.pm * BM + wr * 64 + fr, col0 = u.pn * BM + wc * 32 + 8 * fq;
        if (u.sub == 0) {
#pragma unroll
            for (int ai = 0; ai < 2; ++ai)
#pragma unroll
                for (int m = 0; m < 4; ++m) { const size_t off = (size_t)(row0 + ai * HALF + m * 16) * 4096 + col0;
#pragma unroll
                    for (int bj = 0; bj < 2; ++bj) { const u32x4 a = *(const u32x4*)(GA + off + bj * HALF), b = *(const u32x4*)(GB + off + bj * HALF);
                        f32x4 r0, r1;
                        r0[0] = bf_lo(a.x) * __builtin_amdgcn_rcpf(sb_lo(b.x)); r0[1] = bf_hi(a.x) * __builtin_amdgcn_rcpf(sb_hi(b.x));
                        r0[2] = bf_lo(a.y) * __builtin_amdgcn_rcpf(sb_lo(b.y)); r0[3] = bf_hi(a.y) * __builtin_amdgcn_rcpf(sb_hi(b.y));
                        r1[0] = bf_lo(a.z) * __builtin_amdgcn_rcpf(sb_lo(b.z)); r1[1] = bf_hi(a.z) * __builtin_amdgcn_rcpf(sb_hi(b.z));
                        r1[2] = bf_lo(a.w) * __builtin_amdgcn_rcpf(sb_lo(b.w)); r1[3] = bf_hi(a.w) * __builtin_amdgcn_rcpf(sb_hi(b.w));
                        acc[ai][bj][m][0] *= r0; acc[ai][bj][m][1] *= r1; } }
        } else {
#pragma unroll
            for (int ai = 0; ai < 2; ++ai)
#pragma unroll
                for (int m = 0; m < 4; ++m) { const size_t off = (size_t)(row0 + ai * HALF + m * 16) * 4096 + col0;
#pragma unroll
                    for (int bj = 0; bj < 2; ++bj) { const u32x4 b = *(const u32x4*)(GB + off + bj * HALF);
                        const f32x4 s0 = (f32x4){sb_lo(b.x), sb_hi(b.x), sb_lo(b.y), sb_hi(b.y)}, s1 = (f32x4){sb_lo(b.z), sb_hi(b.z), sb_lo(b.w), sb_hi(b.w)};
                        *(u32x4*)(O + off + bj * HALF) = pack8(acc[ai][bj][m][0] * s0, acc[ai][bj][m][1] * s1); } }
        }
    }
};
struct EpiResF32 {
    static constexpr bool PERM = false;
    const float* res; float* out;
    __device__ __forceinline__ bool keep(const Unit&) const { return false; }
    __device__ __forceinline__ void operator()(f32x4 (&acc)[2][2][4][2], const Unit& u, int wr, int wc, int fr, int fq) const {
        const int row0 = u.pm * BM + wr * 64 + fr, col0 = u.pn * BM + wc * 32 + 4 * fq;
#pragma unroll
        for (int ai = 0; ai < 2; ++ai)
#pragma unroll
            for (int m = 0; m < 4; ++m) { const size_t off = (size_t)(row0 + ai * HALF + m * 16) * 4096 + col0;
#pragma unroll
                for (int bj = 0; bj < 2; ++bj)
#pragma unroll
                    for (int n = 0; n < 2; ++n) { const f32x4 r = *(const f32x4*)(res + off + bj * HALF + n * 16); *(f32x4*)(out + off + bj * HALF + n * 16) = r + acc[ai][bj][m][n]; } }
    }
};
struct EpiResH16 {
    static constexpr bool PERM = true;
    const bf16_t* h16; float* out;
    __device__ __forceinline__ bool keep(const Unit&) const { return false; }
    __device__ __forceinline__ void operator()(f32x4 (&acc)[2][2][4][2], const Unit& u, int wr, int wc, int fr, int fq) const {
        const int row0 = u.pm * BM + wr * 64 + fr, col0 = u.pn * BM + wc * 32 + 8 * fq;
#pragma unroll
        for (int ai = 0; ai < 2; ++ai)
#pragma unroll
            for (int m = 0; m < 4; ++m) { const size_t off = (size_t)(row0 + ai * HALF + m * 16) * 4096 + col0;
#pragma unroll
                for (int bj = 0; bj < 2; ++bj) { const u32x4 hb = *(const u32x4*)(h16 + lane_tile_idx(u.pm * 16 + u.pn, wr, wc, fr, fq, ai, m, bj) * 8);
                    const f32x4 h0 = (f32x4){bf_lo(hb.x), bf_hi(hb.x), bf_lo(hb.y), bf_hi(hb.y)}, h1 = (f32x4){bf_lo(hb.z), bf_hi(hb.z), bf_lo(hb.w), bf_hi(hb.w)};
                    *(f32x4*)(out + off + bj * HALF) = h0 + acc[ai][bj][m][0]; *(f32x4*)(out + off + bj * HALF + 4) = h1 + acc[ai][bj][m][1]; } }
    }
};
struct EpiOutNorm {
    static constexpr bool PERM = true;
    const float* x; bf16_t* h16; bf16_t* HN; const float* g2; float* part;
    __device__ __forceinline__ bool keep(const Unit&) const { return false; }
    __device__ __forceinline__ void operator()(f32x4 (&acc)[2][2][4][2], const Unit& u, int wr, int wc, int fr, int fq) const {
        const int row0 = u.pm * BM + wr * 64 + fr, col0 = u.pn * BM + wc * 32 + 8 * fq;
        f32x4 gg[2][2];
#pragma unroll
        for (int bj = 0; bj < 2; ++bj)
#pragma unroll
            for (int n = 0; n < 2; ++n) gg[bj][n] = *(const f32x4*)(g2 + col0 + bj * HALF + 4 * n);
#pragma unroll
        for (int ai = 0; ai < 2; ++ai)
#pragma unroll
            for (int m = 0; m < 4; ++m) { const int row = row0 + ai * HALF + m * 16; const size_t off = (size_t)row * 4096 + col0; float ss = 0.f;
#pragma unroll
                for (int bj = 0; bj < 2; ++bj) { const f32x4 x0 = *(const f32x4*)(x + off + bj * HALF), x1 = *(const f32x4*)(x + off + bj * HALF + 4);
                    const f32x4 h0 = x0 + acc[ai][bj][m][0], h1 = x1 + acc[ai][bj][m][1];
                    *(u32x4*)(h16 + lane_tile_idx(u.pm * 16 + u.pn, wr, wc, fr, fq, ai, m, bj) * 8) = pack8(h0, h1);
                    ss += ((h0[0] * h0[0] + h0[1] * h0[1]) + (h0[2] * h0[2] + h0[3] * h0[3])) + ((h1[0] * h1[0] + h1[1] * h1[1]) + (h1[2] * h1[2] + h1[3] * h1[3]));
                    *(u32x4*)((char*)HN + blk_off(row, (col0 + bj * HALF) * 2, 8192)) = pack8(h0 * gg[bj][0], h1 * gg[bj][1]); }
                ss += __shfl_xor(ss, 16); ss += __shfl_xor(ss, 32);
                if (fq == 0) part[(size_t)row * 64 + u.pn * 4 + wc] = ss; }
    }
};
struct EpiSwiglu {
    static constexpr bool PERM = true; static constexpr int NST = 4;
    bf16_t* O; int ldc; const PG8_LAS float* rstd; int fm;
    __device__ __forceinline__ bool keep(const Unit&) const { return false; }
    template <int AI> __device__ __forceinline__ void half(const f32x4 (&acc)[2][2][4][2], const Unit& u, int wr, int wc, int fr, int fq) const {
        const int row0 = u.pm * BM + wr * 64 + fr, col0 = u.pn * HALF + wc * 32 + 8 * fq, rl0 = (u.pm - fm) * BM + wr * 64 + fr;
#pragma unroll
        for (int m = 0; m < 4; ++m) { bf16_t* rowp = (bf16_t*)((char*)O + blk_off(row0 + AI * HALF + m * 16, col0 * 2, ldc * 2)); const float r = rstd[rl0 + AI * HALF + m * 16];
            const f32x4 g0 = acc[AI][0][m][0] * r, g1 = acc[AI][0][m][1] * r;
            const f32x4 v0 = g0 * sigm4(g0) * (acc[AI][1][m][0] * r), v1 = g1 * sigm4(g1) * (acc[AI][1][m][1] * r);
            *(u32x4*)rowp = pack8(v0, v1); }
    }
    __device__ __forceinline__ void operator()(f32x4 (&acc)[2][2][4][2], const Unit& u, int wr, int wc, int fr, int fq) const { half<0>(acc, u, wr, wc, fr, fq); half<1>(acc, u, wr, wc, fr, fq); }
};

template <class Epi, class Sched, bool ALIGN_EPI, bool SP2>
__device__ __forceinline__ void gemm_phase(PG8_LAS unsigned char* lds, const int K, const Sched& S, const Epi& E) {
    const int tid = opaque_tid(), wid = __builtin_amdgcn_readfirstlane(tid >> 6), lane = tid & 63, wr = wid >> 2, wc = wid & 3, fr = lane & 15, fq = lane >> 4;
    const int nt = K / BK;
    unsigned voffA[2], voffB[2];
#pragma unroll
    for (int i = 0; i < 2; ++i) { int R, C; stage_rc(tid * 16 + i * 8192, R, C); const int Rb = Epi::PERM ? ((R & ~31) + perm32(R & 31)) : R;
        voffA[i] = voffB[i] = (unsigned)(tid * 16 + i * 8192); (void)R; (void)C; (void)Rb; }
    const size_t kstep = 32768;
    const size_t hstep = (size_t)HALF * 128;
    const unsigned ldsw = (unsigned)wid * 1024u;
    const int aoff = lds_byte(wr * 64 + fr, fq * 8), boff = lds_byte(wc * 32 + fr, fq * 8);
#define PG8_SA(b, h) (((b) * 2 + (h)) * HTB)
#define PG8_SB(b, h) ((4 + (b) * 2 + (h)) * HTB)
#define PG8_STAGE(bufoff, gbase, voff) do { _Pragma("unroll") for (int _i = 0; _i < 2; ++_i) \
        __builtin_amdgcn_global_load_lds((const unsigned*)((const char*)(gbase) + (voff)[_i]), (PG8_LAS unsigned*)(lds + (bufoff) + ldsw + _i * 8192), 16, 0, 0); } while (0)
#define PG8_LDA(dst, b, h) do { _Pragma("unroll") for (int m = 0; m < 4; ++m) _Pragma("unroll") for (int k = 0; k < 2; ++k) dst[m][k] = *(const PG8_LAS bf16x8*)(lds + PG8_SA(b, h) + aoff + m * 2048 + k * 1024); } while (0)
#define PG8_LDB(dst, b, h) do { _Pragma("unroll") for (int n = 0; n < 2; ++n) _Pragma("unroll") for (int k = 0; k < 2; ++k) dst[n][k] = *(const PG8_LAS bf16x8*)(lds + PG8_SB(b, h) + boff + n * 2048 + k * 1024); } while (0)
#define PG8_MMA(ai, bj, At, Bt) do { __builtin_amdgcn_s_setprio(1); _Pragma("unroll") for (int m = 0; m < 4; ++m) _Pragma("unroll") for (int n = 0; n < 2; ++n) _Pragma("unroll") for (int k = 0; k < 2; ++k) \
        acc[ai][bj][m][n] = __builtin_amdgcn_mfma_f32_16x16x32_bf16(Bt[n][k], At[m][k], acc[ai][bj][m][n], 0, 0, 0); __builtin_amdgcn_s_setprio(0); } while (0)
#define PG8_WAIT_V(n) asm volatile("s_waitcnt vmcnt(" #n ")" ::: "memory")
#define PG8_WAIT_L(n) asm volatile("s_waitcnt lgkmcnt(" #n ")" ::: "memory")
#define PG8_BAR __builtin_amdgcn_s_barrier()
#define PG8_SCHED __builtin_amdgcn_sched_barrier(0)
    Unit cur, nxt; int ui = 0;
    if (!S.next(0, cur)) return;
    f32x4 acc[2][2][4][2];
#pragma unroll
    for (int a = 0; a < 2; ++a)
#pragma unroll
        for (int b = 0; b < 2; ++b)
#pragma unroll
            for (int m = 0; m < 4; ++m)
#pragma unroll
                for (int n = 0; n < 2; ++n) acc[a][b][m][n] = (f32x4){0.f, 0.f, 0.f, 0.f};
    bf16x8 At[4][2], B0[2][2], B1[2][2];
    const char* cA; const char* cB; S.ptrs(cur, cA, cB);
    if constexpr (SP2) {
        PG8_STAGE(PG8_SB(0, 0), cB, voffB); PG8_STAGE(PG8_SB(0, 1), cB + hstep, voffB); PG8_STAGE(PG8_SA(0, 0), cA, voffA); PG8_STAGE(PG8_SA(0, 1), cA + hstep, voffA);
        if (wr == 1) PG8_BAR;
        PG8_WAIT_V(2); PG8_BAR;
        PG8_STAGE(PG8_SB(1, 0), cB + kstep, voffB); PG8_STAGE(PG8_SA(1, 0), cA + kstep, voffA); PG8_STAGE(PG8_SB(1, 1), cB + hstep + kstep, voffB);
        PG8_WAIT_V(6); PG8_BAR;
    } else {
        PG8_STAGE(PG8_SB(0, 0), cB, voffB); PG8_STAGE(PG8_SA(0, 0), cA, voffA); PG8_STAGE(PG8_SB(0, 1), cB + hstep, voffB); PG8_STAGE(PG8_SA(0, 1), cA + hstep, voffA);
        if (wr == 1) PG8_BAR;
        PG8_WAIT_V(4); PG8_BAR;
        PG8_STAGE(PG8_SB(1, 0), cB + kstep, voffB); PG8_STAGE(PG8_SA(1, 0), cA + kstep, voffA); PG8_STAGE(PG8_SB(1, 1), cB + hstep + kstep, voffB);
        PG8_WAIT_V(6); PG8_BAR;
    }
    for (;;) {
        const bool has_next = S.next(ui + 1, nxt);
        const char* nA = cA; const char* nB = cB; if (has_next) S.ptrs(nxt, nA, nB);
        for (int t = 0; t < nt; t += 2) {
            const bool last = (t == nt - 2);
            const char* a1 = cA + (size_t)(t + 1) * kstep;
            const char* a2 = last ? nA : cA + (size_t)(t + 2) * kstep; const char* b2 = last ? nB : cB + (size_t)(t + 2) * kstep;
            const char* a3 = a2 + kstep; const char* b3 = b2 + kstep;
            if constexpr (SP2) {
            PG8_LDB(B0, 0, 0); PG8_LDB(B1, 0, 1); PG8_SCHED; PG8_LDA(At, 0, 0); PG8_STAGE(PG8_SA(1, 1), a1 + hstep, voffA);
            PG8_WAIT_V(8); PG8_WAIT_L(0); PG8_BAR; PG8_MMA(0, 0, At, B0); PG8_MMA(0, 1, At, B1); PG8_BAR; PG8_SCHED;
            PG8_LDA(At, 0, 1); PG8_STAGE(PG8_SB(0, 0), b2, voffB); PG8_STAGE(PG8_SB(0, 1), b2 + hstep, voffB); PG8_STAGE(PG8_SA(0, 0), a2, voffA);
            PG8_WAIT_V(8); PG8_WAIT_L(0); PG8_BAR; PG8_MMA(1, 0, At, B0); PG8_MMA(1, 1, At, B1); PG8_BAR; PG8_SCHED;
            PG8_LDB(B0, 1, 0); PG8_LDB(B1, 1, 1); PG8_SCHED; PG8_LDA(At, 1, 0); PG8_STAGE(PG8_SA(0, 1), a2 + hstep, voffA);
            PG8_WAIT_V(8); PG8_WAIT_L(0); PG8_BAR; PG8_MMA(0, 0, At, B0); PG8_MMA(0, 1, At, B1); PG8_BAR; PG8_SCHED;
            PG8_LDA(At, 1, 1); PG8_STAGE(PG8_SB(1, 0), b3, voffB); PG8_STAGE(PG8_SB(1, 1), b3 + hstep, voffB); PG8_STAGE(PG8_SA(1, 0), a3, voffA);
            PG8_WAIT_V(8); PG8_WAIT_L(0); PG8_BAR; PG8_MMA(1, 0, At, B0); PG8_MMA(1, 1, At, B1); PG8_BAR; PG8_SCHED;
            } else {
            PG8_LDB(B0, 0, 0); PG8_SCHED; PG8_LDA(At, 0, 0); PG8_STAGE(PG8_SA(1, 1), a1 + hstep, voffA);
            PG8_WAIT_L(8); PG8_BAR; PG8_WAIT_L(0); PG8_MMA(0, 0, At, B0); PG8_BAR; PG8_SCHED;
            PG8_LDB(B1, 0, 1); PG8_STAGE(PG8_SB(0, 0), b2, voffB);
            PG8_BAR; PG8_WAIT_L(0); PG8_MMA(0, 1, At, B1); PG8_BAR;
            PG8_LDA(At, 0, 1); PG8_STAGE(PG8_SA(0, 0), a2, voffA);
            PG8_BAR; PG8_WAIT_L(0); PG8_MMA(1, 0, At, B0); PG8_BAR; PG8_SCHED;
            PG8_STAGE(PG8_SB(0, 1), b2 + hstep, voffB);
            PG8_WAIT_V(6); PG8_BAR; PG8_MMA(1, 1, At, B1); PG8_BAR;
            PG8_LDB(B0, 1, 0); PG8_SCHED; PG8_LDA(At, 1, 0); PG8_STAGE(PG8_SA(0, 1), a2 + hstep, voffA);
            PG8_WAIT_L(8); PG8_BAR; PG8_WAIT_L(0); PG8_MMA(0, 0, At, B0); PG8_BAR; PG8_SCHED;
            PG8_LDB(B1, 1, 1); PG8_STAGE(PG8_SB(1, 0), b3, voffB);
            PG8_BAR; PG8_WAIT_L(0); PG8_MMA(0, 1, At, B1); PG8_BAR;
            PG8_LDA(At, 1, 1); PG8_STAGE(PG8_SA(1, 0), a3, voffA);
            PG8_BAR; PG8_WAIT_L(0); PG8_MMA(1, 0, At, B0); PG8_BAR; PG8_SCHED;
            PG8_STAGE(PG8_SB(1, 1), b3 + hstep, voffB);
            PG8_WAIT_V(6); PG8_BAR; PG8_MMA(1, 1, At, B1); PG8_BAR;
            }
        }
        if constexpr (ALIGN_EPI) { if (wr == 0) PG8_BAR; }
        E(acc, cur, wr, wc, fr, fq);
        if (!has_next) break;
        if (!E.keep(cur)) {
#pragma unroll
            for (int a = 0; a < 2; ++a)
#pragma unroll
                for (int b = 0; b < 2; ++b)
#pragma unroll
                    for (int m = 0; m < 4; ++m)
#pragma unroll
                        for (int n = 0; n < 2; ++n) acc[a][b][m][n] = (f32x4){0.f, 0.f, 0.f, 0.f};
        }
        cur = nxt; cA = nA; cB = nB; ++ui;
        if constexpr (ALIGN_EPI) { if (wr == 1) PG8_BAR; }
    }
    PG8_WAIT_V(0);
    if constexpr (!ALIGN_EPI) { if (wr == 0) PG8_BAR; }
    PG8_BAR;
#undef PG8_SA
#undef PG8_SB
#undef PG8_STAGE
#undef PG8_LDA
#undef PG8_LDB
#undef PG8_MMA
#undef PG8_WAIT_V
#undef PG8_WAIT_L
#undef PG8_BAR
#undef PG8_SCHED
}

typedef int i32x4 __attribute__((ext_vector_type(4)));
typedef int i32x8 __attribute__((ext_vector_type(8)));
template <class Epi, class Sched>
__device__ __forceinline__ void gemm_phase_f8(PG8_LAS unsigned char* lds, const int K, const Sched& S, const Epi& E) {
    const int tid = opaque_tid(), wid = __builtin_amdgcn_readfirstlane(tid >> 6), lane = tid & 63, wr = wid >> 2, wc = wid & 3, fr = lane & 15, fq = lane >> 4;
    const int nt = K / 128;
    unsigned voffA[2], voffB[2];
#pragma unroll
    for (int i = 0; i < 2; ++i) { int R, C; stage_rc(tid * 16 + i * 8192, R, C); const int Rb = Epi::PERM ? ((R & ~31) + perm32(R & 31)) : R;
        voffA[i] = voffB[i] = (unsigned)(tid * 16 + i * 8192); (void)R; (void)C; (void)Rb; }
    const size_t kstep = 32768;
    const size_t hstep = (size_t)HALF * 128;
    const unsigned ldsw = (unsigned)wid * 1024u;
    const int aoff = lds_byte(wr * 64 + fr, fq * 16), boff = lds_byte(wc * 32 + fr, fq * 16);
#define PG8_SA(b, h) (((b) * 2 + (h)) * HTB)
#define PG8_SB(b, h) ((4 + (b) * 2 + (h)) * HTB)
#define PG8_STAGE(bufoff, gbase, voff) do { _Pragma("unroll") for (int _i = 0; _i < 2; ++_i) \
        __builtin_amdgcn_global_load_lds((const unsigned*)((const char*)(gbase) + (voff)[_i]), (PG8_LAS unsigned*)(lds + (bufoff) + ldsw + _i * 8192), 16, 0, 0); } while (0)
#define PG8_LD8(dst, off) do { const i32x4 _lo = *(const PG8_LAS i32x4*)(lds + (off)), _hi = *(const PG8_LAS i32x4*)(lds + (off) + 16); dst = __builtin_shufflevector(_lo, _hi, 0, 1, 2, 3, 4, 5, 6, 7); } while (0)
#define PG8_LDA(dst, b, h) do { _Pragma("unroll") for (int m = 0; m < 4; ++m) PG8_LD8(dst[m], PG8_SA(b, h) + aoff + m * 2048); } while (0)
#define PG8_LDB(dst, b, h) do { _Pragma("unroll") for (int n = 0; n < 2; ++n) PG8_LD8(dst[n], PG8_SB(b, h) + boff + n * 2048); } while (0)
#define PG8_MMA(ai, bj, At, Bt) do { __builtin_amdgcn_s_setprio(1); _Pragma("unroll") for (int m = 0; m < 4; ++m) _Pragma("unroll") for (int n = 0; n < 2; ++n) \
        asm volatile("v_mfma_scale_f32_16x16x128_f8f6f4 %0, %1, %2, %0, %3, %3 op_sel_hi:[0,0,0]" : "+v"(acc[ai][bj][m][n]) : "v"(Bt[n]), "v"(At[m]), "v"(f8_unit_scale)); __builtin_amdgcn_s_setprio(0); } while (0)
#define PG8_WAIT_V(n) asm volatile("s_waitcnt vmcnt(" #n ")" ::: "memory")
#define PG8_WAIT_L(n) asm volatile("s_waitcnt lgkmcnt(" #n ")" ::: "memory")
#define PG8_BAR __builtin_amdgcn_s_barrier()
#define PG8_SCHED __builtin_amdgcn_sched_barrier(0)
    Unit cur, nxt; int ui = 0;
    if (!S.next(0, cur)) return;
    f32x4 acc[2][2][4][2];
#pragma unroll
    for (int a = 0; a < 2; ++a)
#pragma unroll
        for (int b = 0; b < 2; ++b)
#pragma unroll
            for (int m = 0; m < 4; ++m)
#pragma unroll
                for (int n = 0; n < 2; ++n) acc[a][b][m][n] = (f32x4){0.f, 0.f, 0.f, 0.f};
    i32x8 At[4], B0[2], B1[2];
    const int f8_unit_scale = 0x7f7f7f7f;
    const char* cA; const char* cB; S.ptrs(cur, cA, cB);
    PG8_STAGE(PG8_SB(0, 0), cB, voffB); PG8_STAGE(PG8_SB(0, 1), cB + hstep, voffB); PG8_STAGE(PG8_SA(0, 0), cA, voffA); PG8_STAGE(PG8_SA(0, 1), cA + hstep, voffA);
    if (wr == 1) PG8_BAR;
    PG8_WAIT_V(2); PG8_BAR;
    PG8_STAGE(PG8_SB(1, 0), cB + kstep, voffB); PG8_STAGE(PG8_SA(1, 0), cA + kstep, voffA); PG8_STAGE(PG8_SB(1, 1), cB + hstep + kstep, voffB);
    PG8_WAIT_V(6); PG8_BAR;
    for (;;) {
        const bool has_next = S.next(ui + 1, nxt);
        const char* nA = cA; const char* nB = cB; if (has_next) S.ptrs(nxt, nA, nB);
        for (int t = 0; t < nt; t += 2) {
            const bool last = (t == nt - 2);
            const char* a1 = cA + (size_t)(t + 1) * kstep;
            const char* a2 = last ? nA : cA + (size_t)(t + 2) * kstep; const char* b2 = last ? nB : cB + (size_t)(t + 2) * kstep;
            const char* a3 = a2 + kstep; const char* b3 = b2 + kstep;
            PG8_LDB(B0, 0, 0); PG8_LDB(B1, 0, 1); PG8_SCHED; PG8_LDA(At, 0, 0); PG8_STAGE(PG8_SA(1, 1), a1 + hstep, voffA);
            PG8_WAIT_V(8); PG8_WAIT_L(0); PG8_BAR; PG8_MMA(0, 0, At, B0); PG8_MMA(0, 1, At, B1); PG8_BAR; PG8_SCHED;
            PG8_LDA(At, 0, 1); PG8_STAGE(PG8_SB(0, 0), b2, voffB); PG8_STAGE(PG8_SB(0, 1), b2 + hstep, voffB); PG8_STAGE(PG8_SA(0, 0), a2, voffA);
            PG8_WAIT_V(8); PG8_WAIT_L(0); PG8_BAR; PG8_MMA(1, 0, At, B0); PG8_MMA(1, 1, At, B1); PG8_BAR; PG8_SCHED;
            PG8_LDB(B0, 1, 0); PG8_LDB(B1, 1, 1); PG8_SCHED; PG8_LDA(At, 1, 0); PG8_STAGE(PG8_SA(0, 1), a2 + hstep, voffA);
            PG8_WAIT_V(8); PG8_WAIT_L(0); PG8_BAR; PG8_MMA(0, 0, At, B0); PG8_MMA(0, 1, At, B1); PG8_BAR; PG8_SCHED;
            PG8_LDA(At, 1, 1); PG8_STAGE(PG8_SB(1, 0), b3, voffB); PG8_STAGE(PG8_SB(1, 1), b3 + hstep, voffB); PG8_STAGE(PG8_SA(1, 0), a3, voffA);
            PG8_WAIT_V(8); PG8_WAIT_L(0); PG8_BAR; PG8_MMA(1, 0, At, B0); PG8_MMA(1, 1, At, B1); PG8_BAR; PG8_SCHED;
        }
        if (wr == 0) PG8_BAR;
        { const int t2 = opaque_tid(), w2 = __builtin_amdgcn_readfirstlane(t2 >> 6); E(acc, cur, w2 >> 2, w2 & 3, t2 & 15, (t2 & 63) >> 4); }
        if (!has_next) break;
#pragma unroll
        for (int a = 0; a < 2; ++a)
#pragma unroll
            for (int b = 0; b < 2; ++b)
#pragma unroll
                for (int m = 0; m < 4; ++m)
#pragma unroll
                    for (int n = 0; n < 2; ++n) acc[a][b][m][n] = (f32x4){0.f, 0.f, 0.f, 0.f};
        cur = nxt; cA = nA; cB = nB; ++ui;
        if (wr == 1) PG8_BAR;
    }
    PG8_WAIT_V(0);
    PG8_BAR;
#undef PG8_SA
#undef PG8_SB
#undef PG8_STAGE
#undef PG8_LD8
#undef PG8_LDA
#undef PG8_LDB
#undef PG8_MMA
#undef PG8_WAIT_V
#undef PG8_WAIT_L
#undef PG8_BAR
#undef PG8_SCHED
}

template <class Epi, class Sched>
__device__ __forceinline__ void gemm_phase_mix(PG8_LAS unsigned char* lds, const int P, const int nt8, const int nt16, const Sched& S, const Epi& E) {
    const int tid = opaque_tid(), wid = __builtin_amdgcn_readfirstlane(tid >> 6), lane = tid & 63, wr = wid >> 2, wc = wid & 3, fr = lane & 15, fq = lane >> 4;
    unsigned voffA[2], voffB[2];
#pragma unroll
    for (int i = 0; i < 2; ++i) { int R, C; stage_rc(tid * 16 + i * 8192, R, C); const int Rb = Epi::PERM ? ((R & ~31) + perm32(R & 31)) : R;
        voffA[i] = voffB[i] = (unsigned)(tid * 16 + i * 8192); (void)R; (void)C; (void)Rb; }
    const size_t kstep = 32768;
    const size_t hstep = (size_t)HALF * 128;
    const unsigned ldsw = (unsigned)wid * 1024u;
#define PG8_SA(b, h) (((b) * 2 + (h)) * HTB)
#define PG8_SB(b, h) ((4 + (b) * 2 + (h)) * HTB)
#define PG8_STAGE(bufoff, gbase, voff) do { _Pragma("unroll") for (int _i = 0; _i < 2; ++_i) \
        __builtin_amdgcn_global_load_lds((const unsigned*)((const char*)(gbase) + (voff)[_i]), (PG8_LAS unsigned*)(lds + (bufoff) + ldsw + _i * 8192), 16, 0, 0); } while (0)
#define PG8_LD8(dst, off) do { const i32x4 _lo = *(const PG8_LAS i32x4*)(lds + (off)), _hi = *(const PG8_LAS i32x4*)(lds + (off) + 16); dst = __builtin_shufflevector(_lo, _hi, 0, 1, 2, 3, 4, 5, 6, 7); } while (0)
#define PG8_LDA8(dst, b, h) do { _Pragma("unroll") for (int m = 0; m < 4; ++m) PG8_LD8(dst[m], PG8_SA(b, h) + aoff8 + m * 2048); } while (0)
#define PG8_LDB8(dst, b, h) do { _Pragma("unroll") for (int n = 0; n < 2; ++n) PG8_LD8(dst[n], (PG8_SB(b, h) - 65536) + boff8 + n * 2048); } while (0)
#define PG8_MMA8(ai, bj, At, Bt) do { __builtin_amdgcn_s_setprio(1); _Pragma("unroll") for (int m = 0; m < 4; ++m) _Pragma("unroll") for (int n = 0; n < 2; ++n) \
        asm volatile("v_mfma_scale_f32_16x16x128_f8f6f4 %0, %1, %2, %0, %3, %3 op_sel_hi:[0,0,0]" : "+v"(acc[ai][bj][m][n]) : "v"(Bt[n]), "v"(At[m]), "v"(f8_unit_scale)); __builtin_amdgcn_s_setprio(0); } while (0)
#define PG8_LDA16(dst, b, h) do { _Pragma("unroll") for (int m = 0; m < 4; ++m) _Pragma("unroll") for (int k = 0; k < 2; ++k) dst[m][k] = *(const PG8_LAS bf16x8*)(lds + PG8_SA(b, h) + aoff16 + m * 2048 + k * 1024); } while (0)
#define PG8_LDB16(dst, b, h) do { _Pragma("unroll") for (int n = 0; n < 2; ++n) _Pragma("unroll") for (int k = 0; k < 2; ++k) dst[n][k] = *(const PG8_LAS bf16x8*)(lds + (PG8_SB(b, h) - 65536) + boff16 + n * 2048 + k * 1024); } while (0)
#define PG8_MMA16(ai, bj, At, Bt) do { __builtin_amdgcn_s_setprio(1); _Pragma("unroll") for (int k = 0; k < 2; ++k) _Pragma("unroll") for (int m = 0; m < 4; ++m) _Pragma("unroll") for (int n = 0; n < 2; ++n) \
        asm volatile("v_mfma_f32_16x16x32_bf16 %0, %1, %2, %0" : "+v"(acc[ai][bj][m][n]) : "v"(Bt[n][k]), "v"(At[m][k])); __builtin_amdgcn_s_setprio(0); } while (0)
#define PG8_WAIT_V(n) asm volatile("s_waitcnt vmcnt(" #n ")" ::: "memory")
#define PG8_WAIT_L(n) asm volatile("s_waitcnt lgkmcnt(" #n ")" ::: "memory")
#define PG8_BAR __builtin_amdgcn_s_barrier()
#define PG8_SCHED __builtin_amdgcn_sched_barrier(0)
#define PG8_KPAIR(LDA_, LDB_, MMA_, At_, B0_, B1_) do { \
            LDB_(B0_, 0, 0); LDB_(B1_, 0, 1); PG8_SCHED; LDA_(At_, 0, 0); PG8_STAGE(PG8_SA(1, 1), a1 + hstep, voffA); \
            PG8_WAIT_V(8); PG8_WAIT_L(0); PG8_BAR; MMA_(0, 0, At_, B0_); MMA_(0, 1, At_, B1_); PG8_BAR; PG8_SCHED; \
            LDA_(At_, 0, 1); PG8_STAGE(PG8_SB(0, 0), b2, voffB); PG8_STAGE(PG8_SB(0, 1), b2 + hstep, voffB); PG8_STAGE(PG8_SA(0, 0), a2, voffA); \
            PG8_WAIT_V(8); PG8_WAIT_L(0); PG8_BAR; MMA_(1, 0, At_, B0_); MMA_(1, 1, At_, B1_); PG8_BAR; PG8_SCHED; \
            LDB_(B0_, 1, 0); LDB_(B1_, 1, 1); PG8_SCHED; LDA_(At_, 1, 0); PG8_STAGE(PG8_SA(0, 1), a2 + hstep, voffA); \
            PG8_WAIT_V(8); PG8_WAIT_L(0); PG8_BAR; MMA_(0, 0, At_, B0_); MMA_(0, 1, At_, B1_); PG8_BAR; PG8_SCHED; \
            LDA_(At_, 1, 1); PG8_STAGE(PG8_SB(1, 0), b3, voffB); PG8_STAGE(PG8_SB(1, 1), b3 + hstep, voffB); PG8_STAGE(PG8_SA(1, 0), a3, voffA); \
            PG8_WAIT_V(8); PG8_WAIT_L(0); PG8_BAR; MMA_(1, 0, At_, B0_); MMA_(1, 1, At_, B1_); PG8_BAR; PG8_SCHED; } while (0)
    Unit cur, nxt; int ui = 0;
    if (!S.o.tile(0, cur)) return;
    f32x4 acc[2][2][4][2];
#pragma unroll
    for (int a = 0; a < 2; ++a)
#pragma unroll
        for (int b = 0; b < 2; ++b)
#pragma unroll
            for (int m = 0; m < 4; ++m)
#pragma unroll
                for (int n = 0; n < 2; ++n) acc[a][b][m][n] = (f32x4){0.f, 0.f, 0.f, 0.f};
    const int f8_unit_scale = 0x7f7f7f7f;
    const char* c8A = S.A0 + (size_t)cur.pm * S.tstep8; const char* c8B = S.B0 + (size_t)cur.pn * S.tstep8;
    PG8_STAGE(PG8_SB(0, 0), c8B, voffB); PG8_STAGE(PG8_SB(0, 1), c8B + hstep, voffB); PG8_STAGE(PG8_SA(0, 0), c8A, voffA); PG8_STAGE(PG8_SA(0, 1), c8A + hstep, voffA);
    if (wr == 1) PG8_BAR;
    PG8_WAIT_V(2); PG8_BAR;
    PG8_STAGE(PG8_SB(1, 0), c8B + kstep, voffB); PG8_STAGE(PG8_SA(1, 0), c8A + kstep, voffA); PG8_STAGE(PG8_SB(1, 1), c8B + hstep + kstep, voffB);
    PG8_WAIT_V(6); PG8_BAR;
    for (;;) {
        const bool has_next = S.o.tile(ui + 1, nxt);
        const char* c16A = S.A1 + (size_t)cur.pm * S.tstep; const char* c16B = S.B1 + (size_t)cur.pn * S.tstep;
        {   i32x8 At[4], B0[2], B1[2];
            const int t8 = opaque_tid(); int aoff8 = lds_byte(((t8 >> 8) & 1) * 64 + (t8 & 15), ((t8 & 63) >> 4) * 16), boff8 = lds_byte(((t8 >> 6) & 3) * 32 + (t8 & 15), ((t8 & 63) >> 4) * 16) + 65536;
            asm volatile("" : "+v"(aoff8), "+v"(boff8));
            for (int t = 0; t < nt8; t += 2) { const bool last = (t == nt8 - 2);
                const char* a1 = c8A + (size_t)(t + 1) * kstep;
                const char* a2 = last ? c16A : c8A + (size_t)(t + 2) * kstep; const char* b2 = last ? c16B : c8B + (size_t)(t + 2) * kstep;
                const char* a3 = a2 + kstep; const char* b3 = b2 + kstep;
                PG8_KPAIR(PG8_LDA8, PG8_LDB8, PG8_MMA8, At, B0, B1); } }
        if (wr == 0) PG8_BAR;
        { const int t2 = opaque_tid(), w2 = __builtin_amdgcn_readfirstlane(t2 >> 6); cur.sub = 0; E(acc, cur, w2 >> 2, w2 & 3, t2 & 15, (t2 & 63) >> 4); }
        if (wr == 1) PG8_BAR;
        const char* n8A = c8A; const char* n8B = c8B; if (has_next) { n8A = S.A0 + (size_t)nxt.pm * S.tstep8; n8B = S.B0 + (size_t)nxt.pn * S.tstep8; }
        {   bf16x8 At[4][2], B0[2][2], B1[2][2];
            const int t6 = opaque_tid(); int aoff16 = lds_byte(((t6 >> 8) & 1) * 64 + (t6 & 15), ((t6 & 63) >> 4) * 8), boff16 = lds_byte(((t6 >> 6) & 3) * 32 + (t6 & 15), ((t6 & 63) >> 4) * 8) + 65536;
            asm volatile("" : "+v"(aoff16), "+v"(boff16));
            for (int t = 0; t < nt16; t += 2) { const bool last = (t == nt16 - 2);
                const char* a1 = c16A + (size_t)(t + 1) * kstep;
                const char* a2 = last ? n8A : c16A + (size_t)(t + 2) * kstep; const char* b2 = last ? n8B : c16B + (size_t)(t + 2) * kstep;
                const char* a3 = a2 + kstep; const char* b3 = b2 + kstep;
                PG8_KPAIR(PG8_LDA16, PG8_LDB16, PG8_MMA16, At, B0, B1); } }
        if (wr == 0) PG8_BAR;
        { const int t2 = opaque_tid(), w2 = __builtin_amdgcn_readfirstlane(t2 >> 6); cur.sub = 1; E(acc, cur, w2 >> 2, w2 & 3, t2 & 15, (t2 & 63) >> 4); }
        if (!has_next) break;
#pragma unroll
        for (int a = 0; a < 2; ++a)
#pragma unroll
            for (int b = 0; b < 2; ++b)
#pragma unroll
                for (int m = 0; m < 4; ++m)
#pragma unroll
                    for (int n = 0; n < 2; ++n) acc[a][b][m][n] = (f32x4){0.f, 0.f, 0.f, 0.f};
        cur = nxt; c8A = n8A; c8B = n8B; ++ui;
        if (wr == 1) PG8_BAR;
    }
    PG8_WAIT_V(0);
    PG8_BAR;
#undef PG8_SA
#undef PG8_SB
#undef PG8_STAGE
#undef PG8_LD8
#undef PG8_LDA8
#undef PG8_LDB8
#undef PG8_MMA8
#undef PG8_LDA16
#undef PG8_LDB16
#undef PG8_MMA16
#undef PG8_KPAIR
#undef PG8_WAIT_V
#undef PG8_WAIT_L
#undef PG8_BAR
#undef PG8_SCHED
}
}

constexpr int NWAVES = 8;
constexpr int N_LAUNCHES = MK_N_LAUNCHES;
constexpr int PER_PHASE = 8;
constexpr int M = 16384, D = 4096, NIN = 18432, GMW = 2048, NAW = 2048, DFF = 11008, NGU = 2 * DFF;
constexpr float F8_ASCALE = 16.f, F8_WSCALE = 1024.f, F8_UNSCALE = 1.f / (16.f * 1024.f), F8_YSCALE = 64.f, F8_YUNSCALE = 1.f / (64.f * 1024.f);
constexpr int GRID_W = 64, GRID_H = M / GRID_W, NHEAD = 16, HD = 128, CHUNK = 128, NGROUP = 16;
constexpr float RMS_EPS = 1e-6f, LN_EPS = 1e-5f;

constexpr size_t MiB = 1u << 20;
constexpr size_t WS_CTL = 0, CTL_ZERO_BYTES = 1 * MiB;
constexpr size_t WS_WSB = 1 * MiB;
constexpr size_t WS_WIN = 4 * MiB;
constexpr size_t WS_WOA = 148 * MiB, WS_WOB = 164 * MiB;
constexpr size_t WS_WOUT = 180 * MiB;
constexpr size_t WS_RA = 212 * MiB;
constexpr size_t WS_YA = WS_RA, WS_YB = WS_RA + 64 * MiB;
constexpr size_t WS_RB = 340 * MiB;
constexpr size_t WS_U = WS_RB, WS_V = WS_RB + 64 * MiB, WS_Q = WS_RB + 128 * MiB, WS_K = WS_RB + 192 * MiB, WS_VV = WS_RB + 256 * MiB, WS_GA = WS_RB + 320 * MiB, WS_GB = WS_RB + 448 * MiB;
constexpr size_t WS_TB = WS_Q;
constexpr size_t WS_MRG = WS_RB;
constexpr size_t WS_ACT = WS_RB;
constexpr size_t WS_H16 = WS_WIN;
constexpr size_t WS_WQKV8 = WS_WIN + 32 * MiB;
constexpr size_t WS_XN8 = 916 * MiB;
constexpr size_t WS_WGU = 916 * MiB;
constexpr size_t WS_WD = 1088 * MiB;
constexpr size_t WS_PART = 1174 * MiB;
constexpr size_t WS_END = 1178 * MiB;
static_assert(WS_GB + (size_t)M * D * 2 == WS_WGU && WS_WGU + (size_t)NGU * D * 2 == WS_WD && WS_WD + (size_t)D * DFF * 2 == WS_PART && WS_PART + (size_t)M * 64 * 4 == WS_END && WS_ACT + (size_t)M * DFF * 2 <= WS_WGU, "d_ws map");
constexpr int CW_BAR = 4096;
constexpr int RING_BYTES = 131072;
constexpr int LDSCTL_OFF = RING_BYTES, MISC_OFF = LDSCTL_OFF + 320;
constexpr int LDS_BYTES = 147456;

#define GAS __attribute__((address_space(1)))
#define LAS __attribute__((address_space(3)))
typedef unsigned short bf16;
typedef unsigned v4u __attribute__((ext_vector_type(4)));
typedef unsigned v2u __attribute__((ext_vector_type(2)));
typedef float f32x4 __attribute__((ext_vector_type(4)));
typedef float f32x2 __attribute__((ext_vector_type(2)));
typedef short bf16x8 __attribute__((ext_vector_type(8)));
typedef GAS unsigned gu32;
#define RLX_AGENT __ATOMIC_RELAXED, __HIP_MEMORY_SCOPE_AGENT
#define LDS_WAIT() asm volatile("s_waitcnt lgkmcnt(0)" ::: "memory")
#define VM_WAIT() asm volatile("s_waitcnt vmcnt(0)" ::: "memory")
__device__ __forceinline__ unsigned f2bf(float f) { unsigned u = __builtin_bit_cast(unsigned, f); return (u + 0x7fffu + ((u >> 16) & 1u)) >> 16; }
__device__ __forceinline__ unsigned pk2(float lo, float hi) { return pg8::cvt_pk_bf16(lo, hi); }
__device__ __forceinline__ float bflo(unsigned w) { return __uint_as_float(w << 16); }
__device__ __forceinline__ float bfhi(unsigned w) { return __uint_as_float(w & 0xffff0000u); }

#define XB_TMO      128
#define XB_XCNT(j)  (256  + 64 * (j))
#define XB_XSUB(j)  (1280 + 64 * (j))
#define XB_XGEN(j)  (2304 + 64 * (j))
#define XB_TOP      3328
#define XB_TOPGEN   3392
#define XCD_BAR_WORDS 3456
#define XB_SPIN_CAP (1u << 20)

__device__ __forceinline__ unsigned xb_ld(unsigned* p)              { return __hip_atomic_load(p, __ATOMIC_RELAXED, __HIP_MEMORY_SCOPE_AGENT); }
__device__ __forceinline__ unsigned xb_add(unsigned* p, unsigned v) { return __hip_atomic_fetch_add(p, v, __ATOMIC_RELAXED, __HIP_MEMORY_SCOPE_AGENT); }
__device__ __forceinline__ unsigned xb_xcc_id() { return (unsigned)__builtin_amdgcn_s_getreg((3 << 11) | 20) & 0xFu; }
#define XB_SPIN(cond, bar) do { unsigned _sp = 0; while (cond) { __builtin_amdgcn_s_sleep(1); \
    if ((++_sp & 255u) == 0u) { if (xb_ld(&(bar)[XB_TMO])) break; if (_sp > XB_SPIN_CAP) { atomicAdd(&(bar)[XB_TMO], 1u); break; } } } } while (0)

struct XcdBarrier {
    unsigned* bar; unsigned x;
    volatile LAS unsigned* st;
};
__device__ __forceinline__ XcdBarrier xcd_barrier_post(unsigned* bar, volatile LAS unsigned* st) {
    XcdBarrier b; b.bar = bar; b.x = xb_xcc_id(); b.st = st;
    if (threadIdx.x == 0) (void)xb_add(&bar[XB_XCNT(b.x)], 1u);
    return b;
}
__device__ __forceinline__ void xcd_barrier_complete(unsigned* bar, unsigned x, unsigned& nloc, unsigned& nx) {
    const unsigned G = gridDim.x * gridDim.y * gridDim.z;
    unsigned sum, cnt, mine, sp = 0u;
    for (;;) {
        sum = 0u; cnt = 0u; mine = 0u;
#pragma unroll
        for (unsigned j = 0; j < 16; ++j) { const unsigned c = xb_ld(&bar[XB_XCNT(j)]); sum += c; cnt += (c > 0u) ? 1u : 0u; mine = (j == x) ? c : mine; }
        if (sum == G) break;
        __builtin_amdgcn_s_sleep(1);
        if ((++sp & 255u) == 0u) { if (xb_ld(&bar[XB_TMO])) break; if (sp > XB_SPIN_CAP) { atomicAdd(&bar[XB_TMO], 1u); break; } }
    }
    nloc = mine > 0u ? mine : 1u; nx = cnt > 0u ? cnt : 1u;
}
__device__ __forceinline__ void xcd_barrier(const XcdBarrier& b) {
    asm volatile("s_waitcnt vmcnt(0)" ::: "memory");
    __syncthreads();
    if (threadIdx.x == 0) {
        unsigned* bar = b.bar;
        __builtin_amdgcn_s_waitcnt(0);
        unsigned nloc = b.st[0], nx = b.st[1];
        if (nloc == 0u) { xcd_barrier_complete(bar, b.x, nloc, nx); b.st[0] = nloc; b.st[1] = nx; }
        const unsigned old = xb_add(&bar[XB_XSUB(b.x)], 1u);
        const unsigned gen = old / nloc;
        if (old + 1u == (gen + 1u) * nloc) {
            __builtin_amdgcn_fence(__ATOMIC_RELEASE, "agent");
            asm volatile("s_waitcnt vmcnt(0)" ::: "memory");
            const unsigned og = xb_add(&bar[XB_TOP], 1u);
            const unsigned tg = og / nx;
            if (og + 1u == (tg + 1u) * nx) xb_add(&bar[XB_TOPGEN], 1u);
            else XB_SPIN(xb_ld(&bar[XB_TOPGEN]) == tg, bar);
            __builtin_amdgcn_fence(__ATOMIC_ACQUIRE, "agent");
            xb_add(&bar[XB_XGEN(b.x)], 1u);
            asm volatile("s_waitcnt vmcnt(0)" ::: "memory");
        } else {
            XB_SPIN(xb_ld(&bar[XB_XGEN(b.x)]) == gen, bar);
            __builtin_amdgcn_fence(__ATOMIC_ACQUIRE, "agent");
            asm volatile("s_waitcnt vmcnt(0)" ::: "memory");
        }
    }
    __syncthreads();
}

struct Frame {
    LAS unsigned char* lds;
    volatile LAS unsigned* MISC;
    gu32* ctl;
    int tid, lane, wave;
    int vcu, G;
    unsigned char* ws;
    const float *x, *norm1_g, *w_in, *gm_ln_g, *gm_ln_b, *gm_w_s, *gm_b_s, *q_gain, *k_gain, *na_rpb, *w_o_gm, *w_o_na, *w_out, *norm2_g, *w_ff_gate, *w_ff_up, *w_ff_down;
    float* out;
};
template <int O> __device__ __forceinline__ float xor_lane(float v) {
    if constexpr (O < 32) return __builtin_bit_cast(float, __builtin_amdgcn_ds_swizzle(__builtin_bit_cast(int, v), (O << 10) | 0x1f));
    else return __shfl_xor(v, 32);
}
__device__ __forceinline__ float wave_sum(float v) {
    v += xor_lane<1>(v); v += xor_lane<2>(v); v += xor_lane<4>(v); v += xor_lane<8>(v); v += xor_lane<16>(v); v += xor_lane<32>(v);
    return v;
}
struct TrRegs { f32x4 v[8]; };
__device__ __forceinline__ void tr_load(TrRegs& R, const float* W, int ldw, int k0, int n0, int lane) {
    const GAS float* src = (const GAS float*)W + (size_t)(k0 + 8 * (lane >> 3)) * ldw + n0 + 4 * (lane & 7);
#pragma unroll
    for (int e = 0; e < 8; ++e) R.v[e] = *(const GAS f32x4*)(src + (size_t)e * ldw);
}
__device__ __forceinline__ void tr_store(const TrRegs& R, bf16* blk, int nloc, int lane) {
#pragma unroll
    for (int i = 0; i < 4; ++i) { v4u o; o.x = pk2(R.v[0][i], R.v[1][i]); o.y = pk2(R.v[2][i], R.v[3][i]); o.z = pk2(R.v[4][i], R.v[5][i]); o.w = pk2(R.v[6][i], R.v[7][i]);
        *(GAS v4u*)((GAS char*)blk + pg8::img_off_w(nloc + 4 * (lane & 7) + i, 8 * (lane >> 3))) = o; }
}
__device__ __forceinline__ unsigned pk4_fp8(float a, float b, float c, float d) {
    a = fminf(fmaxf(a, -448.f), 448.f); b = fminf(fmaxf(b, -448.f), 448.f); c = fminf(fmaxf(c, -448.f), 448.f); d = fminf(fmaxf(d, -448.f), 448.f);
    unsigned w = 0u; w = __builtin_amdgcn_cvt_pk_fp8_f32(a, b, w, false); w = __builtin_amdgcn_cvt_pk_fp8_f32(c, d, w, true); return w;
}
__device__ __forceinline__ void tr_store8(const TrRegs& R, unsigned char* blk8, int nloc, int khalf, int lane, float sc) {
#pragma unroll
    for (int i = 0; i < 4; ++i) { v2u o; o.x = pk4_fp8(R.v[0][i] * sc, R.v[1][i] * sc, R.v[2][i] * sc, R.v[3][i] * sc); o.y = pk4_fp8(R.v[4][i] * sc, R.v[5][i] * sc, R.v[6][i] * sc, R.v[7][i] * sc);
        *(GAS v2u*)((GAS unsigned char*)blk8 + pg8::img_off_w(nloc + 4 * (lane & 7) + i, khalf * 32 + 4 * (lane >> 3))) = o; }
}
__device__ __forceinline__ size_t blkw(int n0, int kb, int K) { return ((size_t)(n0 >> 8) * (K >> 6) + kb) * 16384; }
__device__ __forceinline__ size_t blkw8(int n0, int kb, int K) { return ((size_t)(n0 >> 8) * (K >> 7) + (kb >> 1)) * 32768; }
__device__ __forceinline__ void tr_matrix(Frame& F, int lane, const float* W, int K, int N, bf16* WT) {
    const int gw = F.vcu * NWAVES + F.wave, NGW = F.G * NWAVES, nblk = N / 32, nitems = (K / 64) * nblk;
    for (int it = gw; it < nitems; it += 2 * NGW) { const int it2 = it + NGW; const bool two = it2 < nitems; TrRegs A, B;
        const int kb = it / nblk, nb = it % nblk, kb2 = two ? it2 / nblk : kb, nb2 = two ? it2 % nblk : nb;
        tr_load(A, W, N, 64 * kb, 32 * nb, lane); tr_load(B, W, N, 64 * kb2, 32 * nb2, lane);
        tr_store(A, WT + blkw(32 * nb, kb, K), (32 * nb) & 255, lane); if (two) tr_store(B, WT + blkw(32 * nb2, kb2, K), (32 * nb2) & 255, lane); }
}
constexpr int FF_ITEMS_GU = (D / 64) * (DFF / 32), FF_ITEMS_D = (DFF / 64) * (D / 32), FF_ITEMS = 2 * FF_ITEMS_GU + FF_ITEMS_D;
constexpr int FF_ITEMS_P2 = 2 * FF_ITEMS_GU;
struct FillItem { const float* src; bf16* dst; int ldw, ldk, k0, n0; };
__device__ __forceinline__ FillItem ff_item(Frame& F, int it) {
    it = it < FF_ITEMS ? it : FF_ITEMS - 1; FillItem I;
    if (it < 2 * FF_ITEMS_GU) { const int up = it >= FF_ITEMS_GU, r = up ? it - FF_ITEMS_GU : it, nblk = DFF / 32, kb = r / nblk, n0 = 32 * (r - kb * nblk);
        I.src = up ? F.w_ff_up : F.w_ff_gate; I.ldw = DFF; I.k0 = 64 * kb; I.n0 = n0; I.ldk = D;
        const int drow = 256 * (n0 >> 7) + (n0 & 127) + (up ? 128 : 0); I.dst = (bf16*)(F.ws + WS_WGU) + blkw(drow, kb, D); I.ldk = drow & 255; }
    else { const int r = it - 2 * FF_ITEMS_GU, nblk = D / 32, kb = r / nblk, n0 = 32 * (r - kb * nblk);
        I.src = F.w_ff_down; I.ldw = D; I.k0 = 64 * kb; I.n0 = n0; I.ldk = n0 & 255; I.dst = (bf16*)(F.ws + WS_WD) + blkw(n0, kb, DFF); }
    return I;
}
__device__ __forceinline__ void rms_row_to_bf16(int lane, const float* xrow, const float* gain, bf16* obase, unsigned char* obase8, int m) {
    const GAS f32x4* xr = (const GAS f32x4*)xrow + lane;
    f32x4 v[16]; float s = 0.f;
#pragma unroll
    for (int j = 0; j < 16; ++j) { v[j] = xr[64 * j]; s += (v[j].x * v[j].x + v[j].y * v[j].y) + (v[j].z * v[j].z + v[j].w * v[j].w); }
    const float rstd = 1.f / sqrtf(wave_sum(s) * (1.f / D) + RMS_EPS);
    const GAS f32x4* gr = (const GAS f32x4*)gain + lane;
#pragma unroll
    for (int j = 0; j < 16; ++j) { const f32x4 g = gr[64 * j]; const float y0 = v[j].x * rstd * g.x, y1 = v[j].y * rstd * g.y, y2 = v[j].z * rstd * g.z, y3 = v[j].w * rstd * g.w;
        v2u o; o.x = pk2(y0, y1); o.y = pk2(y2, y3); *(GAS v2u*)((GAS char*)obase + pg8::blk_off(m, 8 * lane + 512 * j, 2 * D)) = o;
        *(GAS unsigned*)((GAS unsigned char*)obase8 + pg8::blk_off(m, 4 * lane + 256 * j, D)) = pk4_fp8(y0 * F8_ASCALE, y1 * F8_ASCALE, y2 * F8_ASCALE, y3 * F8_ASCALE); }
}

#ifndef MK_STAGGER_US
#define MK_STAGGER_US 0
#endif
__device__ __forceinline__ void stagger(int us_per_group) {
    const int grp = ((int)blockIdx.x >> 3) & 3;
    if (grp && us_per_group) { const unsigned long long t0 = __builtin_amdgcn_s_memrealtime(), dt = (unsigned long long)(grp * us_per_group) * 100ull;
        while (__builtin_amdgcn_s_memrealtime() - t0 < dt) __builtin_amdgcn_s_sleep(16); }
}
__device__ __forceinline__ void p0_prologue(Frame& F) {
    const int lane = opaque_tid() & 63;
    {
        const int gw0 = F.vcu * NWAVES + F.wave, NGW0 = F.G * NWAVES, nblk = NIN / 32, nitems = (D / 64) * nblk; bf16* WT = (bf16*)(F.ws + WS_WIN); unsigned char* W8 = F.ws + WS_WQKV8;
        for (int it = gw0; it < nitems; it += NGW0) { const int kb = it / nblk, n0 = 32 * (it - kb * nblk); TrRegs R; tr_load(R, F.w_in, NIN, 64 * kb, n0, lane);
            if (n0 >= 4096) tr_store8(R, W8 + blkw8(n0 - 4096, kb, D), (n0 - 4096) & 255, kb & 1, lane, F8_WSCALE);
            else tr_store(R, WT + blkw(n0, kb, D), n0 & 255, lane); } }
    tr_matrix(F, lane, F.w_o_gm, GMW, D, (bf16*)(F.ws + WS_WOA));
    {
        const int gw0 = F.vcu * NWAVES + F.wave, NGW0 = F.G * NWAVES, nblk = D / 32, nitems = (NAW / 64) * nblk; unsigned char* W8 = F.ws + WS_WOB;
        for (int it = gw0; it < nitems; it += NGW0) { const int kb = it / nblk, n0 = 32 * (it - kb * nblk); TrRegs R; tr_load(R, F.w_o_na, D, 64 * kb, n0, lane);
            tr_store8(R, W8 + blkw8(n0, kb, NAW), n0 & 255, kb & 1, lane, F8_WSCALE); } }
    tr_matrix(F, lane, F.w_out, D, D, (bf16*)(F.ws + WS_WOUT));
    const int gw = F.vcu * NWAVES + F.wave, NGW = F.G * NWAVES;
    { bf16* wsb = (bf16*)(F.ws + WS_WSB);
      for (int i = gw * 64 + lane; i < NGROUP * CHUNK * CHUNK / 4; i += NGW * 64) { const f32x4 v = ((const GAS f32x4*)F.gm_w_s)[i]; v2u o; o.x = pk2(v.x, v.y); o.y = pk2(v.z, v.w); ((GAS v2u*)wsb)[i] = o; } }
    bf16* XN = (bf16*)(F.ws + WS_RA);
    for (int m = gw; m < M; m += NGW) rms_row_to_bf16(lane, F.x + (size_t)m * D, F.norm1_g, XN, F.ws + WS_XN8, m);
}
typedef short s16x4 __attribute__((ext_vector_type(4)));
constexpr int GM_WP = 272, GM_VP = 288;
constexpr int GM_V_OFF = 128 * GM_WP, GM_ST_OFF = GM_V_OFF + 128 * GM_VP;
__device__ __forceinline__ void gmlp_unit(Frame& F, int chunk, int half) {
    LAS unsigned char* Wl = F.lds; LAS unsigned char* Vt = F.lds + GM_V_OFF; LAS f32x2* st = (LAS f32x2*)(F.lds + GM_ST_OFF);
    const bf16* U = (const bf16*)(F.ws + WS_U); const bf16* V = (const bf16*)(F.ws + WS_V); bf16* YA = (bf16*)(F.ws + WS_YA); const bf16* WSB = (const bf16*)(F.ws + WS_WSB);
    const int tid = opaque_tid();
    const int tok0 = chunk * CHUNK, lane = tid & 63, fr = lane & 15, fq = lane >> 4, q4 = fr >> 2, p4 = lane & 3;
    const int srow = tid >> 4, sch = tid & 15;
    const int g_first = half * (NGROUP / 2);
    v4u Wr[4], Vr[4]; f32x4 lg[2], lb[2];
#define GM_PREFETCH(g_) do { _Pragma("unroll") for (int q = 0; q < 4; ++q) { Wr[q] = *(const GAS v4u*)(WSB + (size_t)(g_) * CHUNK * CHUNK + (srow + 32 * q) * CHUNK + sch * 8); \
        Vr[q] = *(const GAS v4u*)(V + ((size_t)(g_) * M + tok0 + srow + 32 * q) * 128 + sch * 8); } \
        lg[0] = *(const GAS f32x4*)(F.gm_ln_g + (g_) * 128 + sch * 8); lg[1] = *(const GAS f32x4*)(F.gm_ln_g + (g_) * 128 + sch * 8 + 4); \
        lb[0] = *(const GAS f32x4*)(F.gm_ln_b + (g_) * 128 + sch * 8); lb[1] = *(const GAS f32x4*)(F.gm_ln_b + (g_) * 128 + sch * 8 + 4); } while (0)
    GM_PREFETCH(g_first);
    __syncthreads();
    { const GAS f32x4* p = (const GAS f32x4*)((const float*)(F.ws + WS_PART) + (size_t)(tok0 + (tid >> 2)) * 64 + (tid & 3) * 16); float sm = 0.f, sq = 0.f;
#pragma unroll
      for (int i = 0; i < 4; ++i) { const f32x4 v = p[i]; sm += v.x + v.z; sq += v.y + v.w; }
      sm += xor_lane<1>(sm); sm += xor_lane<2>(sm); sq += xor_lane<1>(sq); sq += xor_lane<2>(sq);
      const float mean = sm * (1.f / GMW), var = fmaxf(sq * (1.f / GMW) - mean * mean, 0.f);
      if ((tid & 3) == 0) st[tid >> 2] = (f32x2){mean, 1.f / sqrtf(var + LN_EPS)}; }
    const int wi = F.wave >> 1, wc2 = F.wave & 1;
#pragma unroll 1
    for (int gi = 0; gi < NGROUP / 2; ++gi) { const int g = g_first + gi;
        __syncthreads();
#pragma unroll
        for (int q = 0; q < 4; ++q) { const int row = srow + 32 * q;
            *(LAS v4u*)(Wl + row * GM_WP + sch * 16) = Wr[q];
            const v4u w = Vr[q]; const f32x2 ms = st[row]; v4u o;
            o.x = pk2((bflo(w.x) - ms.x) * ms.y * lg[0].x + lb[0].x, (bfhi(w.x) - ms.x) * ms.y * lg[0].y + lb[0].y); o.y = pk2((bflo(w.y) - ms.x) * ms.y * lg[0].z + lb[0].z, (bfhi(w.y) - ms.x) * ms.y * lg[0].w + lb[0].w);
            o.z = pk2((bflo(w.z) - ms.x) * ms.y * lg[1].x + lb[1].x, (bfhi(w.z) - ms.x) * ms.y * lg[1].y + lb[1].y); o.w = pk2((bflo(w.w) - ms.x) * ms.y * lg[1].z + lb[1].z, (bfhi(w.w) - ms.x) * ms.y * lg[1].w + lb[1].w);
            *(LAS v4u*)(Vt + row * GM_VP + sch * 16) = o; }
        if (gi + 1 < NGROUP / 2) GM_PREFETCH(g + 1);
        v4u uu[2][2]; float bs[2];
#pragma unroll
        for (int it = 0; it < 2; ++it) { const int i = 32 * wi + 16 * it + fr; bs[it] = F.gm_b_s[g * CHUNK + i];
#pragma unroll
            for (int t = 0; t < 2; ++t) uu[it][t] = *(const GAS v4u*)(U + ((size_t)g * M + tok0 + i) * 128 + 64 * wc2 + 32 * t + 8 * fq); }
        __syncthreads();
        f32x4 acc[4][2];
#pragma unroll
        for (int ct = 0; ct < 4; ++ct)
#pragma unroll
            for (int it = 0; it < 2; ++it) acc[ct][it] = (f32x4){0.f, 0.f, 0.f, 0.f};
#pragma unroll
        for (int kk = 0; kk < 8; ++kk) { s16x4 vf[4], wf[2];
#pragma unroll
            for (int ct = 0; ct < 4; ++ct) vf[ct] = __builtin_amdgcn_ds_read_tr16_b64_v4i16((LAS s16x4*)(Vt + (16 * kk + 4 * fq + q4) * GM_VP + (64 * wc2 + 32 * (ct >> 1) + 8 * p4 + 4 * (ct & 1)) * 2));
#pragma unroll
            for (int it = 0; it < 2; ++it) wf[it] = *(const LAS s16x4*)(Wl + (32 * wi + 16 * it + fr) * GM_WP + (16 * kk + 4 * fq) * 2);
#pragma unroll
            for (int ct = 0; ct < 4; ++ct)
#pragma unroll
                for (int it = 0; it < 2; ++it) acc[ct][it] = __builtin_amdgcn_mfma_f32_16x16x16bf16_1k(vf[ct], wf[it], acc[ct][it], 0, 0, 0); }
#pragma unroll
        for (int it = 0; it < 2; ++it) { const int i = 32 * wi + 16 * it + fr;
#pragma unroll
            for (int t = 0; t < 2; ++t) { const v4u u4 = uu[it][t]; const f32x4 a0 = acc[2 * t][it], a1 = acc[2 * t + 1][it]; const float b = bs[it]; v4u o;
                o.x = pk2((a0[0] + b) * bflo(u4.x), (a0[1] + b) * bfhi(u4.x)); o.y = pk2((a0[2] + b) * bflo(u4.y), (a0[3] + b) * bfhi(u4.y));
                o.z = pk2((a1[0] + b) * bflo(u4.z), (a1[1] + b) * bfhi(u4.z)); o.w = pk2((a1[2] + b) * bflo(u4.w), (a1[3] + b) * bfhi(u4.w));
                *(GAS v4u*)((GAS char*)YA + pg8::blk_off(tok0 + i, (g * 128 + 64 * wc2 + 32 * t + 8 * fq) * 2, 2 * GMW)) = o; } }
    }
#undef GM_PREFETCH
    __syncthreads();
}

constexpr int NA_KP = 272, NA_VP = 288;
constexpr int NA_KS = 64 * NA_KP, NA_SLOT = NA_KS + 64 * NA_VP, NA_RPB_OFF = 2 * NA_SLOT, NA_ROWS = 11;
constexpr float LOG2E = 1.4426950408889634f;
template <bool FILL> __device__ __forceinline__ void na_unit(Frame& F, int pq, int h, float cbound, int fill_it, int fill_stride) {
    LAS unsigned char* ring = F.lds; LAS float* rpbL = (LAS float*)(F.lds + NA_RPB_OFF);
    const bf16* Q = (const bf16*)(F.ws + WS_Q); const bf16* Kt = (const bf16*)(F.ws + WS_K); const bf16* Vv = (const bf16*)(F.ws + WS_VV);
    const int tid = opaque_tid();
    const int lane = tid & 63, wave = __builtin_amdgcn_readfirstlane(tid >> 6), fr = lane & 15, g = lane >> 4, q4 = fr >> 2, p4 = lane & 3;
    const int R0 = 4 * pq, r = R0 + (wave >> 1), half = wave & 1, kb0 = half;
    int b0 = R0 - 4; b0 = b0 < 0 ? 0 : (b0 > GRID_H - 8 ? GRID_H - 8 : b0);
    int rs = r - 4; rs = rs < 0 ? 0 : (rs > GRID_H - 8 ? GRID_H - 8 : rs);
    int c[2], cs[2];
#pragma unroll
    for (int tt = 0; tt < 2; ++tt) { c[tt] = 32 * half + 16 * tt + fr; int x = c[tt] - 8; cs[tt] = x < 0 ? 0 : (x > GRID_W - 16 ? GRID_W - 16 : x); }
    const int skey = tid >> 4, sdch = tid & 15;
    __syncthreads();
    for (int i = tid; i < 15 * 31; i += 512) rpbL[i] = __builtin_amdgcn_exp2f(F.na_rpb[h * 465 + i] * LOG2E);
    v4u RK[2][2], RV[2][2];
    TrRegs FR; FillItem FI;
#define NA_LOAD(s_) do { int kr_ = b0 + (s_); kr_ = kr_ > GRID_H - 1 ? GRID_H - 1 : kr_; _Pragma("unroll") for (int q2 = 0; q2 < 2; ++q2) { \
        const size_t o_ = ((size_t)h * M + kr_ * GRID_W + skey + 32 * q2) * HD + sdch * 8; RK[(s_) & 1][q2] = *(const GAS v4u*)(Kt + o_); RV[(s_) & 1][q2] = *(const GAS v4u*)(Vv + o_); } } while (0)
    NA_LOAD(0); NA_LOAD(1);
    bf16x8 Qf[2][4];
#pragma unroll
    for (int tt = 0; tt < 2; ++tt) { const size_t tq = (size_t)(r * GRID_W + c[tt]); v4u qw[4]; float ss = 0.f;
#pragma unroll
      for (int ks = 0; ks < 4; ++ks) { qw[ks] = *(const GAS v4u*)(Q + ((size_t)h * M + tq) * HD + 32 * ks + 8 * g);
          const float a0 = bflo(qw[ks].x), a1 = bfhi(qw[ks].x), a2 = bflo(qw[ks].y), a3 = bfhi(qw[ks].y), a4 = bflo(qw[ks].z), a5 = bfhi(qw[ks].z), a6 = bflo(qw[ks].w), a7 = bfhi(qw[ks].w);
          ss += (a0 * a0 + a1 * a1) + (a2 * a2 + a3 * a3) + (a4 * a4 + a5 * a5) + (a6 * a6 + a7 * a7); }
      ss += xor_lane<16>(ss); ss += xor_lane<32>(ss);
      const float rq = (1.f / sqrtf(ss * (1.f / HD) + RMS_EPS)) * 0.08838834764831845f * LOG2E;
#pragma unroll
      for (int ks = 0; ks < 4; ++ks) { const f32x4 g0 = *(const GAS f32x4*)(F.q_gain + 32 * ks + 8 * g), g1 = *(const GAS f32x4*)(F.q_gain + 32 * ks + 8 * g + 4);
          v4u o; o.x = pk2(bflo(qw[ks].x) * rq * g0.x, bfhi(qw[ks].x) * rq * g0.y); o.y = pk2(bflo(qw[ks].y) * rq * g0.z, bfhi(qw[ks].y) * rq * g0.w);
          o.z = pk2(bflo(qw[ks].z) * rq * g1.x, bfhi(qw[ks].z) * rq * g1.y); o.w = pk2(bflo(qw[ks].w) * rq * g1.z, bfhi(qw[ks].w) * rq * g1.w);
          Qf[tt][ks] = __builtin_bit_cast(bf16x8, o); } }
    const f32x4 kg0 = *(const GAS f32x4*)(F.k_gain + sdch * 8), kg1 = *(const GAS f32x4*)(F.k_gain + sdch * 8 + 4);
    f32x4 O[2][8]; float lsum[2] = {0.f, 0.f};
#pragma unroll
    for (int tt = 0; tt < 2; ++tt)
#pragma unroll
        for (int db = 0; db < 8; ++db) O[tt][db] = (f32x4){0.f, 0.f, 0.f, 0.f};
#pragma unroll
    for (int s = 0; s < NA_ROWS; ++s) { LAS unsigned char* slot = ring + (s & 1) * NA_SLOT;
#pragma unroll
        for (int q2 = 0; q2 < 2; ++q2) { const v4u w = RK[s & 1][q2];
            const float a0 = bflo(w.x), a1 = bfhi(w.x), a2 = bflo(w.y), a3 = bfhi(w.y), a4 = bflo(w.z), a5 = bfhi(w.z), a6 = bflo(w.w), a7 = bfhi(w.w);
            float ss = (a0 * a0 + a1 * a1) + (a2 * a2 + a3 * a3) + (a4 * a4 + a5 * a5) + (a6 * a6 + a7 * a7);
            ss += xor_lane<1>(ss); ss += xor_lane<2>(ss); ss += xor_lane<4>(ss); ss += xor_lane<8>(ss);
            const float rk = 1.f / sqrtf(ss * (1.f / HD) + RMS_EPS);
            v4u o; o.x = pk2(a0 * rk * kg0.x, a1 * rk * kg0.y); o.y = pk2(a2 * rk * kg0.z, a3 * rk * kg0.w); o.z = pk2(a4 * rk * kg1.x, a5 * rk * kg1.y); o.w = pk2(a6 * rk * kg1.z, a7 * rk * kg1.w);
            *(LAS v4u*)(slot + (skey + 32 * q2) * NA_KP + sdch * 16) = o;
            *(LAS v4u*)(slot + NA_KS + (skey + 32 * q2) * NA_VP + sdch * 16) = RV[s & 1][q2]; }
        if (s + 2 < NA_ROWS) NA_LOAD(s + 2);
        if constexpr (FILL) { if (s > 0) tr_store(FR, FI.dst, FI.ldk, lane); FI = ff_item(F, fill_it + s * fill_stride); tr_load(FR, FI.src, FI.ldw, FI.k0, FI.n0, lane); }
        __syncthreads();
        const int kr = b0 + s;
        if (kr >= rs && kr <= rs + 7) {
            f32x4 S[2][3];
#pragma unroll
            for (int tt = 0; tt < 2; ++tt)
#pragma unroll
                for (int b = 0; b < 3; ++b) S[tt][b] = (f32x4){-cbound, -cbound, -cbound, -cbound};
#pragma unroll
            for (int b = 0; b < 3; ++b)
#pragma unroll
                for (int ks = 0; ks < 4; ++ks) { const bf16x8 a = *(const LAS bf16x8*)(slot + (16 * (kb0 + b) + fr) * NA_KP + (32 * ks + 8 * g) * 2);
#pragma unroll
                    for (int tt = 0; tt < 2; ++tt) S[tt][b] = __builtin_amdgcn_mfma_f32_16x16x32_bf16(a, Qf[tt][ks], S[tt][b], 0, 0, 0); }
            s16x4 pf[2][3];
#pragma unroll
            for (int tt = 0; tt < 2; ++tt) { const int rbase = (kr - r + 7) * 31 + 15 - c[tt];
#pragma unroll
                for (int b = 0; b < 3; ++b) { float pv[4];
#pragma unroll
                    for (int i = 0; i < 4; ++i) { const int kc = 16 * (kb0 + b) + 4 * g + i; const bool ok = (kc >= cs[tt]) && (kc <= cs[tt] + 15);
                        int idx = rbase + kc; idx = ok ? idx : 0; const float e = __builtin_amdgcn_exp2f(S[tt][b][i]) * rpbL[idx]; pv[i] = ok ? e : 0.f; lsum[tt] += pv[i]; }
                    v2u pw; pw.x = pk2(pv[0], pv[1]); pw.y = pk2(pv[2], pv[3]); pf[tt][b] = __builtin_bit_cast(s16x4, pw); } }
#pragma unroll
            for (int b = 0; b < 3; ++b)
#pragma unroll
                for (int db = 0; db < 8; ++db) { const s16x4 vf = __builtin_amdgcn_ds_read_tr16_b64_v4i16((LAS s16x4*)(slot + NA_KS + (16 * (kb0 + b) + 4 * g + q4) * NA_VP + (32 * (db >> 1) + 8 * p4 + 4 * (db & 1)) * 2));
#pragma unroll
                    for (int tt = 0; tt < 2; ++tt) O[tt][db] = __builtin_amdgcn_mfma_f32_16x16x16bf16_1k(vf, pf[tt][b], O[tt][db], 0, 0, 0); }
        }
    }
#undef NA_LOAD
    if constexpr (FILL) tr_store(FR, FI.dst, FI.ldk, lane);
#pragma unroll
    for (int tt = 0; tt < 2; ++tt) { float l = lsum[tt]; l += xor_lane<16>(l); l += xor_lane<32>(l); const float inv = 1.f / l;
        const float inv8 = inv * F8_YSCALE;
        GAS unsigned char* ybase = (GAS unsigned char*)(F.ws + WS_YB); const int tokr = r * GRID_W + c[tt];
#pragma unroll
        for (int t = 0; t < 4; ++t) { const f32x4 a0 = O[tt][2 * t], a1 = O[tt][2 * t + 1]; v2u o;
            o.x = pk4_fp8(a0[0] * inv8, a0[1] * inv8, a0[2] * inv8, a0[3] * inv8); o.y = pk4_fp8(a1[0] * inv8, a1[1] * inv8, a1[2] * inv8, a1[3] * inv8);
            *(GAS v2u*)(ybase + pg8::blk_off(tokr, h * HD + 8 * g + 32 * t, NAW)) = o; } }
}

struct Args { const float* in[17]; float* out; unsigned char* ws; int ph_lo, ph_hi, li, pad; };
__global__ void __launch_bounds__(NWAVES * 64, 2) fwd_kernel(Args args) {
    extern __shared__ __attribute__((aligned(16))) unsigned char lds[];
    Frame F;
    F.lds = (LAS unsigned char*)lds;
    F.MISC = (volatile LAS unsigned*)(F.lds + MISC_OFF);
    F.tid = threadIdx.x; F.lane = F.tid & 63; F.wave = __builtin_amdgcn_readfirstlane(F.tid >> 6);
    F.G = gridDim.x; { const int bx = blockIdx.x; F.vcu = (F.G % 8 == 0) ? (bx % 8) * (F.G / 8) + bx / 8 : bx; }
    F.ws = args.ws; F.ctl = (gu32*)(args.ws + WS_CTL);
    F.x = args.in[0]; F.norm1_g = args.in[1]; F.w_in = args.in[2]; F.gm_ln_g = args.in[3]; F.gm_ln_b = args.in[4]; F.gm_w_s = args.in[5]; F.gm_b_s = args.in[6];
    F.q_gain = args.in[7]; F.k_gain = args.in[8]; F.na_rpb = args.in[9]; F.w_o_gm = args.in[10]; F.w_o_na = args.in[11]; F.w_out = args.in[12]; F.norm2_g = args.in[13];
    F.w_ff_gate = args.in[14]; F.w_ff_up = args.in[15]; F.w_ff_down = args.in[16]; F.out = args.out;
    for (int u = F.tid; u < (LDS_BYTES - LDSCTL_OFF) / 4; u += NWAVES * 64) ((LAS unsigned*)(F.lds + LDSCTL_OFF))[u] = 0u;
    __syncthreads();
    XcdBarrier bar; bar.bar = (unsigned*)(F.ctl + CW_BAR); bar.x = 0; bar.st = nullptr;
    if (N_LAUNCHES != PER_PHASE) bar = xcd_barrier_post((unsigned*)(F.ctl + CW_BAR), F.MISC + 8);
#define GRID_BAR() do { if (N_LAUNCHES != PER_PHASE) xcd_barrier(bar); } while (0)
    const int lo = args.ph_lo, hi = args.ph_hi < MK_STOP_AFTER + 1 ? args.ph_hi : MK_STOP_AFTER + 1;
#define IN(k) (lo <= (k) && (k) < hi)
#define BOTH(k) (IN(k) && IN((k) + 1))
    const int bx = (int)blockIdx.x;

    if (IN(0)) { _Pragma("unroll") for (int rep = 0; rep < NREP(0); ++rep) { p0_prologue(F); if (BOTH(0)) GRID_BAR(); } }

    if (IN(1)) _Pragma("unroll") for (int rep = 0; rep < NREP(1); ++rep) {
        { pg8::SchedP1a S; S.o.init(M, 16 * 256, F.G, bx); S.A = (const char*)(F.ws + WS_RA); S.B = (const char*)(F.ws + WS_WIN); S.tstep = (size_t)256 * D * 2;
          pg8::EpiProj E{(bf16*)(F.ws + WS_RB), M, 1.f, (float*)(F.ws + WS_PART)};
          stagger(MK_STAGGER_US); pg8::gemm_phase<pg8::EpiProj, pg8::SchedP1a, true, true>(F.lds, D, S, E); }
        { pg8::SchedP1b S; S.o.init(M, 56 * 256, F.G, bx); S.A8 = (const char*)(F.ws + WS_XN8); S.B8 = (const char*)(F.ws + WS_WQKV8); S.tstep8 = (size_t)256 * D;
          pg8::EpiQKV E{(bf16*)(F.ws + WS_RB), M, F8_UNSCALE, F.ws + WS_GA, F.ws + WS_GB};
          pg8::gemm_phase_f8<pg8::EpiQKV, pg8::SchedP1b>(F.lds, D, S, E); }
        if (BOTH(1)) GRID_BAR();
    }
    if (IN(2)) _Pragma("unroll") for (int rep = 0; rep < NREP(2); ++rep) {
        for (int u = bx; u < 2 * (M / CHUNK); u += F.G) gmlp_unit(F, u >> 1, u & 1);
#if defined(MK_PROBE_NA)
        for (int rep = 0; rep < args.pad + 2; ++rep)
#endif
        float cbound;
        { const int ln = opaque_tid() & 63; float mq = fmaxf(fabsf(F.q_gain[2 * ln]), fabsf(F.q_gain[2 * ln + 1])), mk = fmaxf(fabsf(F.k_gain[2 * ln]), fabsf(F.k_gain[2 * ln + 1]));
          mq = fmaxf(mq, xor_lane<1>(mq)); mq = fmaxf(mq, xor_lane<2>(mq)); mq = fmaxf(mq, xor_lane<4>(mq)); mq = fmaxf(mq, xor_lane<8>(mq)); mq = fmaxf(mq, xor_lane<16>(mq)); mq = fmaxf(mq, xor_lane<32>(mq));
          mk = fmaxf(mk, xor_lane<1>(mk)); mk = fmaxf(mk, xor_lane<2>(mk)); mk = fmaxf(mk, xor_lane<4>(mk)); mk = fmaxf(mk, xor_lane<8>(mk)); mk = fmaxf(mk, xor_lane<16>(mk)); mk = fmaxf(mk, xor_lane<32>(mk));
          cbound = 11.313708498984761f * 1.01f * LOG2E * mq * mk; }
        {
            const int gwv = F.vcu * NWAVES + F.wave, NGW = F.G * NWAVES, per_wave = (FF_ITEMS_P2 + NGW - 1) / NGW, nfill = (per_wave + NA_ROWS - 1) / NA_ROWS; int ui = 0, done = 0;
            for (int u = F.vcu; u < (GRID_H / 4) * NHEAD; u += F.G, ++ui) {
                if (ui < nfill) { na_unit<true>(F, u & (GRID_H / 4 - 1), u >> 6, cbound, gwv + done * NGW, NGW); done += NA_ROWS; }
                else na_unit<false>(F, u & (GRID_H / 4 - 1), u >> 6, cbound, 0, 0); }
            const int ln = opaque_tid() & 63;
            for (int it = gwv + done * NGW; it < FF_ITEMS_P2; it += NGW) { TrRegs R; const FillItem I = ff_item(F, it); tr_load(R, I.src, I.ldw, I.k0, I.n0, ln); tr_store(R, I.dst, I.ldk, ln); }
        }
        if (BOTH(2)) GRID_BAR();
    }
    if (IN(3)) _Pragma("unroll") for (int rep = 0; rep < NREP(3); ++rep) {
        { pg8::SchedMerge S; S.o.init(M, D, F.G, bx); S.A0 = (const char*)(F.ws + WS_YB); S.B0 = (const char*)(F.ws + WS_WOB); S.A1 = (const char*)(F.ws + WS_YA); S.B1 = (const char*)(F.ws + WS_WOA); S.tstep = (size_t)256 * GMW * 2; S.tstep8 = (size_t)256 * NAW;
          pg8::EpiMix E{F.ws + WS_GA, F.ws + WS_GB, (bf16*)(F.ws + WS_MRG), F8_YUNSCALE};
          stagger(MK_STAGGER_US); pg8::gemm_phase_mix<pg8::EpiMix, pg8::SchedMerge>(F.lds, 0, NAW / 128, GMW / 64, S, E); }
        if (BOTH(3)) GRID_BAR();
    }
    if (IN(4)) _Pragma("unroll") for (int rep = 0; rep < NREP(4); ++rep) {
        pg8::SchedPlain S; S.o.init(M, D, F.G, bx); S.A = (const char*)(F.ws + WS_MRG); S.B = (const char*)(F.ws + WS_WOUT); S.tstep = (size_t)256 * D * 2;
        pg8::EpiOutNorm E{F.x, (bf16*)(F.ws + WS_H16), (bf16*)(F.ws + WS_RA), F.norm2_g, (float*)(F.ws + WS_PART)};
        stagger(MK_STAGGER_US); pg8::gemm_phase<pg8::EpiOutNorm, pg8::SchedPlain, true, true>(F.lds, D, S, E);
        if (BOTH(4)) GRID_BAR();
    }
    if (IN(6)) _Pragma("unroll") for (int rep = 0; rep < NREP(6); ++rep) {
        pg8::SchedPlain S; S.o.init(M, NGU, F.G, bx); S.A = (const char*)(F.ws + WS_RA); S.B = (const char*)(F.ws + WS_WGU); S.tstep = (size_t)256 * D * 2;
        LAS float* rtab = (LAS float*)(F.lds + 135168); const int fm = 8 * (bx & 7);
        { const int t5 = opaque_tid(); const float* part = (const float*)(F.ws + WS_PART);
          for (int r = t5; r < 2048; r += NWAVES * 64) { const GAS f32x4* p = (const GAS f32x4*)(part + (size_t)(fm * 256 + r) * 64); float sacc = 0.f;
#pragma unroll
              for (int j = 0; j < 16; ++j) { const f32x4 v = p[j]; sacc += (v.x + v.y) + (v.z + v.w); }
              rtab[r] = 1.f / sqrtf(sacc * (1.f / D) + RMS_EPS); }
          __syncthreads(); }
        pg8::EpiSwiglu E{(bf16*)(F.ws + WS_ACT), DFF, rtab, fm};
        stagger(MK_STAGGER_US); pg8::gemm_phase<pg8::EpiSwiglu, pg8::SchedPlain, true, true>(F.lds, D, S, E);
        {
            const int rem = S.o.nwg % F.G, first = rem, nidle = rem ? F.G - rem : F.G;
            if (bx >= first || rem == 0) { const int ln = opaque_tid() & 63, w0 = ((rem ? bx - first : bx) * NWAVES + F.wave), NW = nidle * NWAVES;
                for (int it = FF_ITEMS_P2 + w0; it < FF_ITEMS; it += 2 * NW) { const int it2 = it + NW; TrRegs Ra, Rb; const FillItem Ia = ff_item(F, it), Ib = ff_item(F, it2);
                    tr_load(Ra, Ia.src, Ia.ldw, Ia.k0, Ia.n0, ln); tr_load(Rb, Ib.src, Ib.ldw, Ib.k0, Ib.n0, ln); tr_store(Ra, Ia.dst, Ia.ldk, ln); tr_store(Rb, Ib.dst, Ib.ldk, ln); } } }
        if (BOTH(6)) GRID_BAR();
    }
    if (IN(7)) {
        pg8::SchedPlain S; S.o.init(M, D, F.G, bx); S.A = (const char*)(F.ws + WS_ACT); S.B = (const char*)(F.ws + WS_WD); S.tstep = (size_t)256 * DFF * 2;
        pg8::EpiResH16 E{(const bf16*)(F.ws + WS_H16), F.out};
        stagger(MK_STAGGER_US); pg8::gemm_phase<pg8::EpiResH16, pg8::SchedPlain, true, true>(F.lds, DFF, S, E);
    }

#if MK_STOP_AFTER < 4
    {
        GRID_BAR();
        const bf16* pU = (const bf16*)(F.ws + WS_U); const bf16* pV = (const bf16*)(F.ws + WS_V); const bf16* pQ = (const bf16*)(F.ws + WS_Q); const bf16* pK = (const bf16*)(F.ws + WS_K); const bf16* pVV = (const bf16*)(F.ws + WS_VV);
        const bf16* pGA = (const bf16*)(F.ws + WS_GA); const bf16* pGB = (const bf16*)(F.ws + WS_GB); const bf16* pYA = (const bf16*)(F.ws + WS_YA); const bf16* pYB = (const bf16*)(F.ws + WS_YB); const bf16* pM = (const bf16*)(F.ws + WS_MRG);
        for (size_t i = (size_t)bx * 512 + F.tid; i < (size_t)M * D; i += (size_t)F.G * 512) { const size_t m = i >> 12; const int c = (int)(i & 4095), c2 = c & 2047; float v;
            if (MK_STOP_AFTER == 1) v = 0.f * bflo(pGA[i]) + 0.f * bflo(pGB[i]) + 8.f * bflo(((const bf16*)(F.ws + WS_WOA))[(m & 4095) * 2048 + c2]) + 9.f * bflo(((const bf16*)(F.ws + WS_WOB))[(m & 4095) * 2048 + c2]) + 10.f * bflo(((const bf16*)(F.ws + WS_WOUT))[(m & 4095) * 4096 + c]);
            else if (MK_STOP_AFTER == 2) v = c < 2048 ? bflo(pYA[m * 2048 + c2]) : bflo(pYB[m * 2048 + c2]);
            else if (MK_STOP_AFTER == 3) v = bflo(pM[i]);
            else v = F.x[i];
            F.out[i] = v; }
    }
#endif
#if defined(MK_PROBE_P7)
    {
        GRID_BAR();
        pg8::SchedPlain S; S.o.init(M, D, F.G, bx); S.A = (const char*)(F.ws + WS_ACT); S.B = (const char*)(F.ws + WS_WD); S.tstep = (size_t)256 * DFF * 2;
        pg8::EpiResF32 E{F.out, (float*)(F.ws + WS_END)};
        pg8::gemm_phase<pg8::EpiResF32, pg8::SchedPlain, true, true>(F.lds, DFF, S, E);
    }
#endif
#undef IN
#undef BOTH
#undef GRID_BAR
}

extern "C" void kernel_launch(void* const* d_in, const int* in_sizes, int n_in, void* d_out, int out_size, void* d_ws, size_t ws_size, hipStream_t stream) {
    static int grid = 0;
    if (grid == 0) {
        if (n_in != 17 || in_sizes[0] != M * D || out_size != M * D || ws_size < WS_END) { fprintf(stderr, "kernel_launch: unexpected shapes/workspace (n_in %d, in0 %d, out %d, ws %zu < %zu); nothing launched\n", n_in, n_in > 0 ? in_sizes[0] : -1, out_size, ws_size, (size_t)WS_END); grid = -1; return; }
        int dev = 0, cus = 0, per_cu = 0;
        if (hipGetDevice(&dev) != hipSuccess || hipDeviceGetAttribute(&cus, hipDeviceAttributeMultiprocessorCount, dev) != hipSuccess) { grid = -1; return; }
        if (hipFuncSetAttribute((const void*)fwd_kernel, hipFuncAttributeMaxDynamicSharedMemorySize, LDS_BYTES) != hipSuccess) { fprintf(stderr, "kernel_launch: hipFuncSetAttribute failed\n"); grid = -1; return; }
        if (hipOccupancyMaxActiveBlocksPerMultiprocessor(&per_cu, (const void*)fwd_kernel, NWAVES * 64, LDS_BYTES) != hipSuccess || per_cu < 1) fprintf(stderr, "kernel_launch: occupancy query reports %d\n", per_cu);
        (void)hipGetLastError();
        grid = cus - cus % 8;
    }
    if (grid < 0) return;
    if (hipMemsetAsync((char*)d_ws + WS_CTL, 0, CTL_ZERO_BYTES, stream) != hipSuccess) return;
    Args a{};
    for (int i = 0; i < 17; ++i) a.in[i] = (const float*)d_in[i];
    a.out = (float*)d_out; a.ws = (unsigned char*)d_ws;
    for (int li = 0; li < N_LAUNCHES; ++li) {
        if (N_LAUNCHES == PER_PHASE) { a.ph_lo = li; a.ph_hi = li + 1; } else { a.ph_lo = 0; a.ph_hi = PER_PHASE; }
        a.li = li; a.pad = 0;
        hipLaunchKernelGGL(fwd_kernel, dim3(grid), dim3(NWAVES * 64), LDS_BYTES, stream, a);
        const hipError_t le = hipPeekAtLastError();
        if (le != hipSuccess) { fprintf(stderr, "kernel_launch: launch %d failed: %s\n", li, hipGetErrorName(le)); break; }
    }
}
```

```cpp
#include <hip/hip_runtime.h>
#include <cstdio>
#include <cstdint>

#ifndef MK_N_LAUNCHES
#define MK_N_LAUNCHES 1
#endif
#ifndef MK_REPEAT
#define MK_REPEAT 0
#endif
#define NREP(k) (((MK_REPEAT >> (k)) & 1) + 1)
#ifndef MK_STOP_AFTER
#define MK_STOP_AFTER 7
#endif

__device__ __forceinline__ int opaque_tid() { int t = (int)threadIdx.x; asm volatile("" : "+v"(t)); return t; }
namespace pg8 {
#define PG8_LAS __attribute__((address_space(3)))
typedef unsigned short bf16_t;
typedef short bf16x8 __attribute__((ext_vector_type(8)));
typedef float f32x4 __attribute__((ext_vector_type(4)));
typedef float f32x2 __attribute__((ext_vector_type(2)));
typedef unsigned u32x4 __attribute__((ext_vector_type(4)));
typedef unsigned u32x2 __attribute__((ext_vector_type(2)));
constexpr int BM = 256, BK = 64, HALF = 128, HTB = HALF * BK * 2  , STAGE_BYTES = 8 * HTB, NXCD = 8, WGM = 8;

__host__ __device__ __forceinline__ int lds_byte(int r, int c) { const int st = (r >> 4) * 2 + (c >> 5), rr = r & 15, cc = c & 31, ob = rr * 64 + cc * 2; return st * 1024 + (ob ^ (((ob >> 9) & 1) << 5)); }
__host__ __device__ __forceinline__ void stage_rc(int b, int& R, int& C) { const int st = b / 1024, sb = b % 1024, swz = sb ^ (((sb >> 9) & 1) << 5); R = (st >> 1) * 16 + swz / 64; C = (st & 1) * 32 + (swz % 64) / 2; }
__host__ __device__ __forceinline__ int perm32(int rho) { const int n = rho >> 4, i = rho & 15; return 8 * (i >> 2) + 4 * n + (i & 3); }

__host__ __device__ __forceinline__ int invperm32(int w) { return 16 * ((w >> 2) & 1) + 4 * (w >> 3) + (w & 3); }
__host__ __device__ __forceinline__ size_t blk_off(int row, int kb, int KB) { return ((size_t)(row >> 8) * (KB >> 7) + (kb >> 7)) * 32768 + ((row >> 7) & 1) * 16384 + lds_byte(row & 127, (kb & 127) >> 1) + (kb & 1); }
__host__ __device__ __forceinline__ int img_off_w(int nloc, int c) { const int w = nloc & 127; return (nloc >> 7) * 16384 + lds_byte((w & ~31) + invperm32(w & 31), c); }
struct Unit { int pm, pn, sub; };

struct StaticOrder {
    int nM, nN, nwg, G, c;
    __host__ __device__ void init(int M, int N, int G_, int c_) { nM = M / BM; nN = N / BM; nwg = nM * nN; G = G_; c = c_; }
    __host__ __device__ bool tile(int i, Unit& u) const {
        const long L = (long)i * G + c; if (L >= nwg) return false;
        int wgid = (int)L; { const int q = nwg / NXCD, r = nwg % NXCD, xcd = wgid % NXCD, off = wgid / NXCD; wgid = (xcd < r ? xcd * (q + 1) : r * (q + 1) + (xcd - r) * q) + off; }
        const int nig = WGM * nN, gid = wgid / nig, fm = gid * WGM, gsz = (nM - fm) < WGM ? (nM - fm) : WGM;
        u.pm = fm + ((wgid % nig) % gsz); u.pn = (wgid % nig) / gsz; u.sub = 0; return true;
    }
};
struct SchedPlain {
    StaticOrder o; const char* A; const char* B; size_t tstep;
    __device__ __forceinline__ bool next(int i, Unit& u) const { return o.tile(i, u); }
    __device__ __forceinline__ void ptrs(const Unit& u, const char*& a, const char*& b) const { a = A + (size_t)u.pm * tstep; b = B + (size_t)u.pn * tstep; }
};
struct SchedP1a {
    StaticOrder o; const char* A; const char* B; size_t tstep;
    __device__ __forceinline__ bool next(int i, Unit& u) const { const bool ok = o.tile(i, u); u.pn = u.pn < 16 ? u.pn : u.pn + 24; return ok; }
    __device__ __forceinline__ void ptrs(const Unit& u, const char*& a, const char*& b) const { a = A + (size_t)u.pm * tstep; b = B + (size_t)u.pn * tstep; }
};
struct SchedP1b {
    StaticOrder o; const char* A8; const char* B8; size_t tstep8;
    __device__ __forceinline__ bool next(int i, Unit& u) const { const bool ok = o.tile(i, u); u.sub = u.pn; u.pn = u.pn + 16; return ok; }
    __device__ __forceinline__ void ptrs(const Unit& u, const char*& a, const char*& b) const { a = A8 + (size_t)u.pm * tstep8; b = B8 + (size_t)u.sub * tstep8; }
};
struct SchedMerge {
    StaticOrder o; const char* A0; const char* B0; const char* A1; const char* B1; size_t tstep; size_t tstep8;
    __device__ __forceinline__ bool next(int i, Unit& u) const { const bool ok = o.tile(i >> 1, u); u.sub = i & 1; return ok; }
    __device__ __forceinline__ void ptrs(const Unit& u, const char*& a, const char*& b) const { a = (u.sub ? A1 : A0) + (size_t)u.pm * tstep; b = (u.sub ? B1 : B0) + (size_t)u.pn * tstep; }
};

typedef __bf16 bf16x2v __attribute__((ext_vector_type(2)));
__device__ __forceinline__ unsigned cvt_pk_bf16(float lo, float hi) { const bf16x2v v = __builtin_convertvector((f32x2){lo, hi}, bf16x2v); return __builtin_bit_cast(unsigned, v); }
__device__ __forceinline__ float bf_lo(unsigned w) { return __uint_as_float(w << 16); }
__device__ __forceinline__ float bf_hi(unsigned w) { return __uint_as_float(w & 0xffff0000u); }
__device__ __forceinline__ f32x2 gelu_pk(f32x2 v) {
    const f32x2 av = __builtin_elementwise_abs(v), d = av * 0.2316418882f + 1.0f;
    f32x2 t; t.x = __builtin_amdgcn_rcpf(d.x); t.y = __builtin_amdgcn_rcpf(d.y);
    f32x2 q = t * 0.5307027145f + (-0.7265760135f); q = q * t + 0.7107068705f; q = q * t + (-0.142248368f); q = q * t + 0.127414796f; q = q * t;
    const f32x2 s = (v * v) * (-0.72134752044f);
    f32x2 e; e.x = __builtin_amdgcn_exp2f(s.x); e.y = __builtin_amdgcn_exp2f(s.y);
    const f32x2 m = v * (q * e), r = v - m;
    f32x2 o; o.x = v.x < 0.f ? m.x : r.x; o.y = v.y < 0.f ? m.y : r.y; return o;
}
__device__ __forceinline__ float sigmoid_f(float x) { return __builtin_amdgcn_rcpf(1.0f + __builtin_amdgcn_exp2f(x * -1.44269504089f)); }
__device__ __forceinline__ f32x4 gelu4(f32x4 v) { const f32x2 a = gelu_pk((f32x2){v[0], v[1]}), b = gelu_pk((f32x2){v[2], v[3]}); return (f32x4){a.x, a.y, b.x, b.y}; }
__device__ __forceinline__ f32x4 sigm4(f32x4 v) { return (f32x4){sigmoid_f(v[0]), sigmoid_f(v[1]), sigmoid_f(v[2]), sigmoid_f(v[3])}; }
__device__ __forceinline__ u32x4 pack8(f32x4 v0, f32x4 v1) { u32x4 w; w.x = cvt_pk_bf16(v0[0], v0[1]); w.y = cvt_pk_bf16(v0[2], v0[3]); w.z = cvt_pk_bf16(v1[0], v1[1]); w.w = cvt_pk_bf16(v1[2], v1[3]); return w; }

__device__ __forceinline__ size_t lane_tile_idx(int T, int wr, int wc, int fr, int fq, int ai, int m, int bj) { return ((size_t)T * 128 + (((wr * 4 + wc) * 2 + ai) * 4 + m) * 2 + bj) * 64 + fr + 16 * fq; }
__device__ __forceinline__ unsigned pack_u8x4(f32x4 v) { const f32x4 q = v * 255.f + 0.5f; return (unsigned)q[0] | ((unsigned)q[1] << 8) | ((unsigned)q[2] << 16) | ((unsigned)q[3] << 24); }
__device__ __forceinline__ f32x4 unpack_u8x4(unsigned w) { return (f32x4){(float)(w & 0xffu), (float)((w >> 8) & 0xffu), (float)((w >> 16) & 0xffu), (float)(w >> 24)}; }
struct EpiProj {
    static constexpr bool PERM = true;
    bf16_t* base; int M; float qkv_scale;
    float* vstat;
    __device__ __forceinline__ void store_v(const f32x4 (&acc)[2][2][4][2], bf16_t* O, int row0, int col0, int slice, int fq, size_t bjs) const {
#pragma unroll
        for (int ai = 0; ai < 2; ++ai)
#pragma unroll
            for (int m = 0; m < 4; ++m) { const int row = row0 + ai * HALF + m * 16; bf16_t* rowp = O + (size_t)row * 128 + col0; float s = 0.f, s2 = 0.f;
#pragma unroll
                for (int bj = 0; bj < 2; ++bj) { const f32x4 v0 = gelu4(acc[ai][bj][m][0]), v1 = gelu4(acc[ai][bj][m][1]);
                    s += ((v0[0] + v0[1]) + (v0[2] + v0[3])) + ((v1[0] + v1[1]) + (v1[2] + v1[3]));
                    s2 += ((v0[0] * v0[0] + v0[1] * v0[1]) + (v0[2] * v0[2] + v0[3] * v0[3])) + ((v1[0] * v1[0] + v1[1] * v1[1]) + (v1[2] * v1[2] + v1[3] * v1[3]));
                    *(u32x4*)(rowp + bj * bjs) = pack8(v0, v1); }
                s += __shfl_xor(s, 16); s += __shfl_xor(s, 32); s2 += __shfl_xor(s2, 16); s2 += __shfl_xor(s2, 32);
                if (fq == 0) *(f32x2*)(vstat + (size_t)row * 64 + 2 * slice) = (f32x2){s, s2}; }
    }
    __device__ __forceinline__ bool keep(const Unit&) const { return false; }
    template <int ACT> __device__ __forceinline__ void store(const f32x4 (&acc)[2][2][4][2], bf16_t* O, int ldc, int row0, int col0, size_t bjs) const {
#pragma unroll
        for (int ai = 0; ai < 2; ++ai)
#pragma unroll
            for (int m = 0; m < 4; ++m) { bf16_t* rowp = O + (size_t)(row0 + ai * HALF + m * 16) * ldc + col0;
#pragma unroll
                for (int bj = 0; bj < 2; ++bj) { f32x4 v0 = acc[ai][bj][m][0], v1 = acc[ai][bj][m][1];
                    if (ACT == 0) { v0 = v0 * qkv_scale; v1 = v1 * qkv_scale; }
                    if (ACT == 1) { v0 = gelu4(v0); v1 = gelu4(v1); }
                    if (ACT == 2) { v0 = sigm4(v0); v1 = sigm4(v1); }
                    *(u32x4*)(rowp + bj * bjs) = pack8(v0, v1); } }
    }
    __device__ __forceinline__ void operator()(f32x4 (&acc)[2][2][4][2], const Unit& u, int wr, int wc, int fr, int fq) const {
        const int row0 = u.pm * BM + wr * 64 + fr, pn = u.pn;
        if (pn < 40) { const int t = pn >> 3; const size_t hs = (size_t)M * 128; bf16_t* O = base + (size_t)t * M * 2048 + (size_t)(2 * (pn & 7)) * hs; const int col0 = wc * 32 + 8 * fq;
            if (t == 0) store<1>(acc, O, 128, row0, col0, hs); else if (t == 1) store_v(acc, O, row0, col0, (pn & 7) * 4 + wc, fq, hs); else store<0>(acc, O, 128, row0, col0, hs); }
        else { const int t = (pn - 40) >> 4; bf16_t* O = base + (size_t)5 * M * 2048 + (size_t)t * M * 4096; const int col0 = ((pn - 40) & 15) * BM + wc * 32 + 8 * fq;
            store<2>(acc, O, 4096, row0, col0, HALF); }
    }
};
struct EpiQKV {
    static constexpr bool PERM = true;
    bf16_t* base; int M; float sc; unsigned char* ga8; unsigned char* gb8;
    __device__ __forceinline__ void store_gate(const f32x4 (&acc)[2][2][4][2], unsigned char* O8, int T, int wr, int wc, int fr, int fq) const {
#pragma unroll
        for (int ai = 0; ai < 2; ++ai)
#pragma unroll
            for (int m = 0; m < 4; ++m)
#pragma unroll
                for (int bj = 0; bj < 2; ++bj) { const f32x4 v0 = sigm4(acc[ai][bj][m][0] * sc), v1 = sigm4(acc[ai][bj][m][1] * sc);
                    *(u32x2*)(O8 + lane_tile_idx(T, wr, wc, fr, fq, ai, m, bj) * 8) = (u32x2){pack_u8x4(v0), pack_u8x4(v1)}; }
    }
    __device__ __forceinline__ bool keep(const Unit&) const { return false; }
    template <int ACT> __device__ __forceinline__ void store(const f32x4 (&acc)[2][2][4][2], bf16_t* O, int ldc, int row0, int col0, size_t bjs) const {
#pragma unroll
        for (int ai = 0; ai < 2; ++ai)
#pragma unroll
            for (int m = 0; m < 4; ++m) { bf16_t* rowp = O + (size_t)(row0 + ai * HALF + m * 16) * ldc + col0;
#pragma unroll
                for (int bj = 0; bj < 2; ++bj) { f32x4 v0 = acc[ai][bj][m][0] * sc, v1 = acc[ai][bj][m][1] * sc;
                    if (ACT == 2) { v0 = sigm4(v0); v1 = sigm4(v1); }
                    *(u32x4*)(rowp + bj * bjs) = pack8(v0, v1); } }
    }
    __device__ __forceinline__ void operator()(f32x4 (&acc)[2][2][4][2], const Unit& u, int wr, int wc, int fr, int fq) const {
        const int row0 = u.pm * BM + wr * 64 + fr;
        if (u.pn < 40) store<0>(acc, base + (size_t)(u.pn >> 3) * M * 2048 + (size_t)(2 * (u.pn & 7)) * M * 128, 128, row0, wc * 32 + 8 * fq, (size_t)M * 128);
        else store_gate(acc, u.pn < 56 ? ga8 : gb8, u.pm * 16 + ((u.pn - 40) & 15), wr, wc, fr, fq);
    }
};
struct EpiTB {
    static constexpr bool PERM = true;
    const unsigned char* GB; bf16_t* T; float sc;
    __device__ __forceinline__ bool keep(const Unit&) const { return false; }
    __device__ __forceinline__ void operator()(f32x4 (&acc)[2][2][4][2], const Unit& u, int wr, int wc, int fr, int fq) const {
        const int row0 = u.pm * BM + wr * 64 + fr, col0 = u.pn * BM + wc * 32 + 8 * fq;
#pragma unroll
        for (int ai = 0; ai < 2; ++ai)
#pragma unroll
            for (int m = 0; m < 4; ++m) { const size_t off = (size_t)(row0 + ai * HALF + m * 16) * 4096 + col0;
#pragma unroll
                for (int bj = 0; bj < 2; ++bj) { const u32x2 b = *(const u32x2*)(GB + off + bj * HALF);
                    const f32x4 s0 = unpack_u8x4(b.x) * sc, s1 = unpack_u8x4(b.y) * sc;
                    *(u32x4*)(T + off + bj * HALF) = pack8(acc[ai][bj][m][0] * s0, acc[ai][bj][m][1] * s1); } }
    }
};
struct EpiMergeA {
    static constexpr bool PERM = true;
    const unsigned char* GA; const bf16_t* T; bf16_t* O;
    __device__ __forceinline__ bool keep(const Unit&) const { return false; }
    __device__ __forceinline__ void operator()(f32x4 (&acc)[2][2][4][2], const Unit& u, int wr, int wc, int fr, int fq) const {
        const int row0 = u.pm * BM + wr * 64 + fr, col0 = u.pn * BM + wc * 32 + 8 * fq;
#pragma unroll
        for (int ai = 0; ai < 2; ++ai)
#pragma unroll
            for (int m = 0; m < 4; ++m) { const size_t off = (size_t)(row0 + ai * HALF + m * 16) * 4096 + col0;
#pragma unroll
                for (int bj = 0; bj < 2; ++bj) { const u32x2 a = *(const u32x2*)(GA + off + bj * HALF); const u32x4 t = *(const u32x4*)(T + off + bj * HALF);
                    const f32x4 s0 = unpack_u8x4(a.x) * (1.f / 255.f), s1 = unpack_u8x4(a.y) * (1.f / 255.f);
                    const f32x4 t0 = (f32x4){bf_lo(t.x), bf_hi(t.x), bf_lo(t.y), bf_hi(t.y)}, t1 = (f32x4){bf_lo(t.z), bf_hi(t.z), bf_lo(t.w), bf_hi(t.w)};
                    *(u32x4*)(O + off + bj * HALF) = pack8(acc[ai][bj][m][0] * s0 + t0, acc[ai][bj][m][1] * s1 + t1); } }
    }
};
struct EpiMix {
    static constexpr bool PERM = true;
    const unsigned char* GA; const unsigned char* GB; bf16_t* O; float c;
    __device__ __forceinline__ bool keep(const Unit& u) const { return u.sub == 0; }
    __device__ __forceinline__ void operator()(f32x4 (&acc)[2][2][4][2], const Unit& u, int wr, int wc, int fr, int fq) const {
        const int row0 = u.pm * BM + wr * 64 + fr, col0 = u.pn * BM + wc * 32 + 8 * fq;
        if (u.sub == 0) {
#pragma unroll
            for (int ai = 0; ai < 2; ++ai)
#pragma unroll
                for (int m = 0; m < 4; ++m) { const size_t off = (size_t)(row0 + ai * HALF + m * 16) * 4096 + col0;
#pragma unroll
                    for (int bj = 0; bj < 2; ++bj) { const size_t gi = lane_tile_idx(u.pm * 16 + u.pn, wr, wc, fr, fq, ai, m, bj) * 8; (void)off; const u32x2 a = *(const u32x2*)(GA + gi), b = *(const u32x2*)(GB + gi);
                        f32x4 a0 = __builtin_elementwise_max(unpack_u8x4(a.x), (f32x4){9.5367431640625e-7f, 9.5367431640625e-7f, 9.5367431640625e-7f, 9.5367431640625e-7f});
                        f32x4 a1 = __builtin_elementwise_max(unpack_u8x4(a.y), (f32x4){9.5367431640625e-7f, 9.5367431640625e-7f, 9.5367431640625e-7f, 9.5367431640625e-7f});
                        const f32x4 r0 = (f32x4){__builtin_amdgcn_rcpf(a0[0]), __builtin_amdgcn_rcpf(a0[1]), __builtin_amdgcn_rcpf(a0[2]), __builtin_amdgcn_rcpf(a0[3])};
                        const f32x4 r1 = (f32x4){__builtin_amdgcn_rcpf(a1[0]), __builtin_amdgcn_rcpf(a1[1]), __builtin_amdgcn_rcpf(a1[2]), __builtin_amdgcn_rcpf(a1[3])};
                        acc[ai][bj][m][0] = acc[ai][bj][m][0] * (unpack_u8x4(b.x) * c) * r0; acc[ai][bj][m][1] = acc[ai][bj][m][1] * (unpack_u8x4(b.y) * c) * r1; } }
        } else {
#pragma unroll
            for (int ai = 0; ai < 2; ++ai)
#pragma unroll
                for (int m = 0; m < 4; ++m) { const size_t off = (size_t)(row0 + ai * HALF + m * 16) * 4096 + col0;
#pragma unroll
                    for (int bj = 0; bj < 2; ++bj) { const u32x2 a = *(const u32x2*)(GA + lane_tile_idx(u.pm * 16 + u.pn, wr, wc, fr, fq, ai, m, bj) * 8);
                        const f32x4 a0 = __builtin_elementwise_max(unpack_u8x4(a.x), (f32x4){9.5367431640625e-7f, 9.5367431640625e-7f, 9.5367431640625e-7f, 9.5367431640625e-7f}) * (1.f / 255.f);
                        const f32x4 a1 = __builtin_elementwise_max(unpack_u8x4(a.y), (f32x4){9.5367431640625e-7f, 9.5367431640625e-7f, 9.5367431640625e-7f, 9.5367431640625e-7f}) * (1.f / 255.f);
                        *(u32x4*)((char*)O + blk_off(row0 + ai * HALF + m * 16, (col0 + bj * HALF) * 2, 8192)) = pack8(acc[ai][bj][m][0] * a0, acc[ai][bj][m][1] * a1); (void)off; } }
        }
    }
};
__device__ __forceinline__ float sb_lo(unsigned w) { return fmaxf(bf_lo(w), 8.673617379884035e-19f); }
__device__ __forceinline__ float sb_hi(unsigned w) { return fmaxf(bf_hi(w), 8.673617379884035e-19f); }
struct EpiMerge {
    static constexpr bool PERM = true;
    const bf16_t* GA; const bf16_t* GB; bf16_t* O;
    __device__ __forceinline__ bool keep(const Unit& u) const { return u.sub == 0; }
    __device__ __forceinline__ void operator()(f32x4 (&acc)[2][2][4][2], const Unit& u, int wr, int wc, int fr, int fq) const {
        const int row0 = u.pm * BM + wr * 64 + fr, col0 = u.pn * BM + wc * 32 + 8 * fq;
        if (u.sub == 0) {
#pragma unroll
            for (int ai = 0; ai < 2; ++ai)
#pragma unroll
                for (int m = 0; m < 4; ++m) { const size_t off = (size_t)(row0 + ai * HALF + m * 16) * 4096 + col0;
#pragma unroll
                    for (int bj = 0; bj < 2; ++bj) { const u32x4 a = *(const u32x4*)(GA + off + bj * HALF), b = *(const u32x4*)(GB + off + bj * HALF);
                        f32x4 r0, r1;
                        r0[0] = bf_lo(a.x) * __builtin_amdgcn_rcpf(sb_lo(b.x)); r0[1] = bf_hi(a.x) * __builtin_amdgcn_rcpf(sb_hi(b.x));
                        r0[2] = bf_lo(a.y) * __builtin_amdgcn_rcpf(sb_lo(b.y)); r0[3] = bf_hi(a.y) * __builtin_amdgcn_rcpf(sb_hi(b.y));
                        r1[0] = bf_lo(a.z) * __builtin_amdgcn_rcpf(sb_lo(b.z)); r1[1] = bf_hi(a.z) * __builtin_amdgcn_rcpf(sb_hi(b.z));
                        r1[2] = bf_lo(a.w) * __builtin_amdgcn_rcpf(sb_lo(b.w)); r1[3] = bf_hi(a.w) * __builtin_amdgcn_rcpf(sb_hi(b.w));
                        acc[ai][bj][m][0] *= r0; acc[ai][bj][m][1] *= r1; } }
        } else {
#pragma unroll
            for (int ai = 0; ai < 2; ++ai)
#pragma unroll
                for (int m = 0; m < 4; ++m) { const size_t off = (size_t)(row0 + ai * HALF + m * 16) * 4096 + col0;
#pragma unroll
                    for (int bj = 0; bj < 2; ++bj) { const u32x4 b = *(const u32x4*)(GB + off + bj * HALF);
                        const f32x4 s0 = (f32x4){sb_lo(b.x), sb_hi(b.x), sb_lo(b.y), sb_hi(b.y)}, s1 = (f32x4){sb_lo(b.z), sb_hi(b.z), sb_lo(b.w), sb_hi(b.w)};
                        *(u32x4*)(O + off + bj * HALF) = pack8(acc[ai][bj][m][0] * s0, acc[ai][bj][m][1] * s1); } }
        }
    }
};
struct EpiResF32 {
    static constexpr bool PERM = false;
    const float* res; float* out;
    __device__ __forceinline__ bool keep(const Unit&) const { return false; }
    __device__ __forceinline__ void operator()(f32x4 (&acc)[2][2][4][2], const Unit& u, int wr, int wc, int fr, int fq) const {
        const int row0 = u.pm * BM + wr * 64 + fr, col0 = u.pn * BM + wc * 32 + 4 * fq;
#pragma unroll
        for (int ai = 0; ai < 2; ++ai)
#pragma unroll
            for (int m = 0; m < 4; ++m) { const size_t off = (size_t)(row0 + ai * HALF + m * 16) * 4096 + col0;
#pragma unroll
                for (int bj = 0; bj < 2; ++bj)
#pragma unroll
                    for (int n = 0; n < 2; ++n) { const f32x4 r = *(const f32x4*)(res + off + bj * HALF + n * 16); *(f32x4*)(out + off + bj * HALF + n * 16) = r + acc[ai][bj][m][n]; } }
    }
};
struct EpiResH16 {
    static constexpr bool PERM = true;
    const bf16_t* h16; float* out;
    __device__ __forceinline__ bool keep(const Unit&) const { return false; }
    __device__ __forceinline__ void operator()(f32x4 (&acc)[2][2][4][2], const Unit& u, int wr, int wc, int fr, int fq) const {
        const int row0 = u.pm * BM + wr * 64 + fr, col0 = u.pn * BM + wc * 32 + 8 * fq;
#pragma unroll
        for (int ai = 0; ai < 2; ++ai)
#pragma unroll
            for (int m = 0; m < 4; ++m) { const size_t off = (size_t)(row0 + ai * HALF + m * 16) * 4096 + col0;
#pragma unroll
                for (int bj = 0; bj < 2; ++bj) { const u32x4 hb = *(const u32x4*)(h16 + lane_tile_idx(u.pm * 16 + u.pn, wr, wc, fr, fq, ai, m, bj) * 8);
                    const f32x4 h0 = (f32x4){bf_lo(hb.x), bf_hi(hb.x), bf_lo(hb.y), bf_hi(hb.y)}, h1 = (f32x4){bf_lo(hb.z), bf_hi(hb.z), bf_lo(hb.w), bf_hi(hb.w)};
                    *(f32x4*)(out + off + bj * HALF) = h0 + acc[ai][bj][m][0]; *(f32x4*)(out + off + bj * HALF + 4) = h1 + acc[ai][bj][m][1]; } }
    }
};
struct EpiOutNorm {
    static constexpr bool PERM = true;
    const float* x; bf16_t* h16; bf16_t* HN; const float* g2; float* part;
    __device__ __forceinline__ bool keep(const Unit&) const { return false; }
    __device__ __forceinline__ void operator()(f32x4 (&acc)[2][2][4][2], const Unit& u, int wr, int wc, int fr, int fq) const {
        const int row0 = u.pm * BM + wr * 64 + fr, col0 = u.pn * BM + wc * 32 + 8 * fq;
        f32x4 gg[2][2];
#pragma unroll
        for (int bj = 0; bj < 2; ++bj)
#pragma unroll
            for (int n = 0; n < 2; ++n) gg[bj][n] = *(const f32x4*)(g2 + col0 + bj * HALF + 4 * n);
#pragma unroll
        for (int ai = 0; ai < 2; ++ai)
#pragma unroll
            for (int m = 0; m < 4; ++m) { const int row = row0 + ai * HALF + m * 16; const size_t off = (size_t)row * 4096 + col0; float ss = 0.f;
#pragma unroll
                for (int bj = 0; bj < 2; ++bj) { const f32x4 x0 = *(const f32x4*)(x + off + bj * HALF), x1 = *(const f32x4*)(x + off + bj * HALF + 4);
                    const f32x4 h0 = x0 + acc[ai][bj][m][0], h1 = x1 + acc[ai][bj][m][1];
                    *(u32x4*)(h16 + lane_tile_idx(u.pm * 16 + u.pn, wr, wc, fr, fq, ai, m, bj) * 8) = pack8(h0, h1);
                    ss += ((h0[0] * h0[0] + h0[1] * h0[1]) + (h0[2] * h0[2] + h0[3] * h0[3])) + ((h1[0] * h1[0] + h1[1] * h1[1]) + (h1[2] * h1[2] + h1[3] * h1[3]));
                    *(u32x4*)((char*)HN + blk_off(row, (col0 + bj * HALF) * 2, 8192)) = pack8(h0 * gg[bj][0], h1 * gg[bj][1]); }
                ss += __shfl_xor(ss, 16); ss += __shfl_xor(ss, 32);
                if (fq == 0) part[(size_t)row * 64 + u.pn * 4 + wc] = ss; }
    }
};
struct EpiSwiglu {
    static constexpr bool PERM = true; static constexpr int NST = 4;
    bf16_t* O; int ldc; const PG8_LAS float* rstd; int fm;
    __device__ __forceinline__ bool keep(const Unit&) const { return false; }
    template <int AI> __device__ __forceinline__ void half(const f32x4 (&acc)[2][2][4][2], const Unit& u, int wr, int wc, int fr, int fq) const {
        const int row0 = u.pm * BM + wr * 64 + fr, col0 = u.pn * HALF + wc * 32 + 8 * fq, rl0 = (u.pm - fm) * BM + wr * 64 + fr;
#pragma unroll
        for (int m = 0; m < 4; ++m) { bf16_t* rowp = (bf16_t*)((char*)O + blk_off(row0 + AI * HALF + m * 16, col0 * 2, ldc * 2)); const float r = rstd[rl0 + AI * HALF + m * 16];
            const f32x4 g0 = acc[AI][0][m][0] * r, g1 = acc[AI][0][m][1] * r;
            const f32x4 v0 = g0 * sigm4(g0) * (acc[AI][1][m][0] * r), v1 = g1 * sigm4(g1) * (acc[AI][1][m][1] * r);
            __builtin_nontemporal_store(pack8(v0, v1), (u32x4*)rowp); }
    }
    __device__ __forceinline__ void operator()(f32x4 (&acc)[2][2][4][2], const Unit& u, int wr, int wc, int fr, int fq) const { half<0>(acc, u, wr, wc, fr, fq); half<1>(acc, u, wr, wc, fr, fq); }
};

template <class Epi, class Sched, bool ALIGN_EPI, bool SP2>
__device__ __forceinline__ void gemm_phase(PG8_LAS unsigned char* lds, const int K, const Sched& S, const Epi& E) {
    const int tid = opaque_tid(), wid = __builtin_amdgcn_readfirstlane(tid >> 6), lane = tid & 63, wr = wid >> 2, wc = wid & 3, fr = lane & 15, fq = lane >> 4;
    const int nt = K / BK;
    unsigned voffA[2], voffB[2];
#pragma unroll
    for (int i = 0; i < 2; ++i) { int R, C; stage_rc(tid * 16 + i * 8192, R, C); const int Rb = Epi::PERM ? ((R & ~31) + perm32(R & 31)) : R;
        voffA[i] = voffB[i] = (unsigned)(tid * 16 + i * 8192); (void)R; (void)C; (void)Rb; }
    const size_t kstep = 32768;
    const size_t hstep = (size_t)HALF * 128;
    const unsigned ldsw = (unsigned)wid * 1024u;
    const int aoff = lds_byte(wr * 64 + fr, fq * 8), boff = lds_byte(wc * 32 + fr, fq * 8);
#define PG8_SA(b, h) (((b) * 2 + (h)) * HTB)
#define PG8_SB(b, h) ((4 + (b) * 2 + (h)) * HTB)
#define PG8_STAGE(bufoff, gbase, voff) do { _Pragma("unroll") for (int _i = 0; _i < 2; ++_i) \
        __builtin_amdgcn_global_load_lds((const unsigned*)((const char*)(gbase) + (voff)[_i]), (PG8_LAS unsigned*)(lds + (bufoff) + ldsw + _i * 8192), 16, 0, 0); } while (0)
#define PG8_LDA(dst, b, h) do { _Pragma("unroll") for (int m = 0; m < 4; ++m) _Pragma("unroll") for (int k = 0; k < 2; ++k) dst[m][k] = *(const PG8_LAS bf16x8*)(lds + PG8_SA(b, h) + aoff + m * 2048 + k * 1024); } while (0)
#define PG8_LDB(dst, b, h) do { _Pragma("unroll") for (int n = 0; n < 2; ++n) _Pragma("unroll") for (int k = 0; k < 2; ++k) dst[n][k] = *(const PG8_LAS bf16x8*)(lds + PG8_SB(b, h) + boff + n * 2048 + k * 1024); } while (0)
#define PG8_MMA(ai, bj, At, Bt) do { __builtin_amdgcn_s_setprio(1); _Pragma("unroll") for (int m = 0; m < 4; ++m) _Pragma("unroll") for (int n = 0; n < 2; ++n) _Pragma("unroll") for (int k = 0; k < 2; ++k) \
        acc[ai][bj][m][n] = __builtin_amdgcn_mfma_f32_16x16x32_bf16(Bt[n][k], At[m][k], acc[ai][bj][m][n], 0, 0, 0); __builtin_amdgcn_s_setprio(0); } while (0)
#define PG8_WAIT_V(n) asm volatile("s_waitcnt vmcnt(" #n ")" ::: "memory")
#define PG8_WAIT_L(n) asm volatile("s_waitcnt lgkmcnt(" #n ")" ::: "memory")
#define PG8_BAR __builtin_amdgcn_s_barrier()
#define PG8_SCHED __builtin_amdgcn_sched_barrier(0)
    Unit cur, nxt; int ui = 0;
    if (!S.next(0, cur)) return;
    f32x4 acc[2][2][4][2];
#pragma unroll
    for (int a = 0; a < 2; ++a)
#pragma unroll
        for (int b = 0; b < 2; ++b)
#pragma unroll
            for (int m = 0; m < 4; ++m)
#pragma unroll
                for (int n = 0; n < 2; ++n) acc[a][b][m][n] = (f32x4){0.f, 0.f, 0.f, 0.f};
    bf16x8 At[4][2], B0[2][2], B1[2][2];
    const char* cA; const char* cB; S.ptrs(cur, cA, cB);
    if constexpr (SP2) {
        PG8_STAGE(PG8_SB(0, 0), cB, voffB); PG8_STAGE(PG8_SB(0, 1), cB + hstep, voffB); PG8_STAGE(PG8_SA(0, 0), cA, voffA); PG8_STAGE(PG8_SA(0, 1), cA + hstep, voffA);
        if (wr == 1) PG8_BAR;
        PG8_WAIT_V(2); PG8_BAR;
        PG8_STAGE(PG8_SB(1, 0), cB + kstep, voffB); PG8_STAGE(PG8_SA(1, 0), cA + kstep, voffA); PG8_STAGE(PG8_SB(1, 1), cB + hstep + kstep, voffB);
        PG8_WAIT_V(6); PG8_BAR;
    } else {
        PG8_STAGE(PG8_SB(0, 0), cB, voffB); PG8_STAGE(PG8_SA(0, 0), cA, voffA); PG8_STAGE(PG8_SB(0, 1), cB + hstep, voffB); PG8_STAGE(PG8_SA(0, 1), cA + hstep, voffA);
        if (wr == 1) PG8_BAR;
        PG8_WAIT_V(4); PG8_BAR;
        PG8_STAGE(PG8_SB(1, 0), cB + kstep, voffB); PG8_STAGE(PG8_SA(1, 0), cA + kstep, voffA); PG8_STAGE(PG8_SB(1, 1), cB + hstep + kstep, voffB);
        PG8_WAIT_V(6); PG8_BAR;
    }
    for (;;) {
        const bool has_next = S.next(ui + 1, nxt);
        const char* nA = cA; const char* nB = cB; if (has_next) S.ptrs(nxt, nA, nB);
        for (int t = 0; t < nt; t += 2) {
            const bool last = (t == nt - 2);
            const char* a1 = cA + (size_t)(t + 1) * kstep;
            const char* a2 = last ? nA : cA + (size_t)(t + 2) * kstep; const char* b2 = last ? nB : cB + (size_t)(t + 2) * kstep;
            const char* a3 = a2 + kstep; const char* b3 = b2 + kstep;
            if constexpr (SP2) {
            PG8_LDB(B0, 0, 0); PG8_LDB(B1, 0, 1); PG8_SCHED; PG8_LDA(At, 0, 0); PG8_STAGE(PG8_SA(1, 1), a1 + hstep, voffA);
            PG8_WAIT_V(8); PG8_WAIT_L(0); PG8_BAR; PG8_MMA(0, 0, At, B0); PG8_MMA(0, 1, At, B1); PG8_BAR; PG8_SCHED;
            PG8_LDA(At, 0, 1); PG8_STAGE(PG8_SB(0, 0), b2, voffB); PG8_STAGE(PG8_SB(0, 1), b2 + hstep, voffB); PG8_STAGE(PG8_SA(0, 0), a2, voffA);
            PG8_WAIT_V(8); PG8_WAIT_L(0); PG8_BAR; PG8_MMA(1, 0, At, B0); PG8_MMA(1, 1, At, B1); PG8_BAR; PG8_SCHED;
            PG8_LDB(B0, 1, 0); PG8_LDB(B1, 1, 1); PG8_SCHED; PG8_LDA(At, 1, 0); PG8_STAGE(PG8_SA(0, 1), a2 + hstep, voffA);
            PG8_WAIT_V(8); PG8_WAIT_L(0); PG8_BAR; PG8_MMA(0, 0, At, B0); PG8_MMA(0, 1, At, B1); PG8_BAR; PG8_SCHED;
            PG8_LDA(At, 1, 1); PG8_STAGE(PG8_SB(1, 0), b3, voffB); PG8_STAGE(PG8_SB(1, 1), b3 + hstep, voffB); PG8_STAGE(PG8_SA(1, 0), a3, voffA);
            PG8_WAIT_V(8); PG8_WAIT_L(0); PG8_BAR; PG8_MMA(1, 0, At, B0); PG8_MMA(1, 1, At, B1); PG8_BAR; PG8_SCHED;
            } else {
            PG8_LDB(B0, 0, 0); PG8_SCHED; PG8_LDA(At, 0, 0); PG8_STAGE(PG8_SA(1, 1), a1 + hstep, voffA);
            PG8_WAIT_L(8); PG8_BAR; PG8_WAIT_L(0); PG8_MMA(0, 0, At, B0); PG8_BAR; PG8_SCHED;
            PG8_LDB(B1, 0, 1); PG8_STAGE(PG8_SB(0, 0), b2, voffB);
            PG8_BAR; PG8_WAIT_L(0); PG8_MMA(0, 1, At, B1); PG8_BAR;
            PG8_LDA(At, 0, 1); PG8_STAGE(PG8_SA(0, 0), a2, voffA);
            PG8_BAR; PG8_WAIT_L(0); PG8_MMA(1, 0, At, B0); PG8_BAR; PG8_SCHED;
            PG8_STAGE(PG8_SB(0, 1), b2 + hstep, voffB);
            PG8_WAIT_V(6); PG8_BAR; PG8_MMA(1, 1, At, B1); PG8_BAR;
            PG8_LDB(B0, 1, 0); PG8_SCHED; PG8_LDA(At, 1, 0); PG8_STAGE(PG8_SA(0, 1), a2 + hstep, voffA);
            PG8_WAIT_L(8); PG8_BAR; PG8_WAIT_L(0); PG8_MMA(0, 0, At, B0); PG8_BAR; PG8_SCHED;
            PG8_LDB(B1, 1, 1); PG8_STAGE(PG8_SB(1, 0), b3, voffB);
            PG8_BAR; PG8_WAIT_L(0); PG8_MMA(0, 1, At, B1); PG8_BAR;
            PG8_LDA(At, 1, 1); PG8_STAGE(PG8_SA(1, 0), a3, voffA);
            PG8_BAR; PG8_WAIT_L(0); PG8_MMA(1, 0, At, B0); PG8_BAR; PG8_SCHED;
            PG8_STAGE(PG8_SB(1, 1), b3 + hstep, voffB);
            PG8_WAIT_V(6); PG8_BAR; PG8_MMA(1, 1, At, B1); PG8_BAR;
            }
        }
        if constexpr (ALIGN_EPI) { if (wr == 0) PG8_BAR; }
        E(acc, cur, wr, wc, fr, fq);
        if (!has_next) break;
        if (!E.keep(cur)) {
#pragma unroll
            for (int a = 0; a < 2; ++a)
#pragma unroll
                for (int b = 0; b < 2; ++b)
#pragma unroll
                    for (int m = 0; m < 4; ++m)
#pragma unroll
                        for (int n = 0; n < 2; ++n) acc[a][b][m][n] = (f32x4){0.f, 0.f, 0.f, 0.f};
        }
        cur = nxt; cA = nA; cB = nB; ++ui;
        if constexpr (ALIGN_EPI) { if (wr == 1) PG8_BAR; }
    }
    PG8_WAIT_V(0);
    if constexpr (!ALIGN_EPI) { if (wr == 0) PG8_BAR; }
    PG8_BAR;
#undef PG8_SA
#undef PG8_SB
#undef PG8_STAGE
#undef PG8_LDA
#undef PG8_LDB
#undef PG8_MMA
#undef PG8_WAIT_V
#undef PG8_WAIT_L
#undef PG8_BAR
#undef PG8_SCHED
}

typedef int i32x4 __attribute__((ext_vector_type(4)));
typedef int i32x8 __attribute__((ext_vector_type(8)));
template <class Epi, class Sched>
__device__ __forceinline__ void gemm_phase_f8(PG8_LAS unsigned char* lds, const int K, const Sched& S, const Epi& E) {
    const int tid = opaque_tid(), wid = __builtin_amdgcn_readfirstlane(tid >> 6), lane = tid & 63, wr = wid >> 2, wc = wid & 3, fr = lane & 15, fq = lane >> 4;
    const int nt = K / 128;
    unsigned voffA[2], voffB[2];
#pragma unroll
    for (int i = 0; i < 2; ++i) { int R, C; stage_rc(tid * 16 + i * 8192, R, C); const int Rb = Epi::PERM ? ((R & ~31) + perm32(R & 31)) : R;
        voffA[i] = voffB[i] = (unsigned)(tid * 16 + i * 8192); (void)R; (void)C; (void)Rb; }
    const size_t kstep = 32768;
    const size_t hstep = (size_t)HALF * 128;
    const unsigned ldsw = (unsigned)wid * 1024u;
    const int aoff = lds_byte(wr * 64 + fr, fq * 16), boff = lds_byte(wc * 32 + fr, fq * 16);
#define PG8_SA(b, h) (((b) * 2 + (h)) * HTB)
#define PG8_SB(b, h) ((4 + (b) * 2 + (h)) * HTB)
#define PG8_STAGE(bufoff, gbase, voff) do { _Pragma("unroll") for (int _i = 0; _i < 2; ++_i) \
        __builtin_amdgcn_global_load_lds((const unsigned*)((const char*)(gbase) + (voff)[_i]), (PG8_LAS unsigned*)(lds + (bufoff) + ldsw + _i * 8192), 16, 0, 0); } while (0)
#define PG8_LD8(dst, off) do { const i32x4 _lo = *(const PG8_LAS i32x4*)(lds + (off)), _hi = *(const PG8_LAS i32x4*)(lds + (off) + 16); dst = __builtin_shufflevector(_lo, _hi, 0, 1, 2, 3, 4, 5, 6, 7); } while (0)
#define PG8_LDA(dst, b, h) do { _Pragma("unroll") for (int m = 0; m < 4; ++m) PG8_LD8(dst[m], PG8_SA(b, h) + aoff + m * 2048); } while (0)
#define PG8_LDB(dst, b, h) do { _Pragma("unroll") for (int n = 0; n < 2; ++n) PG8_LD8(dst[n], PG8_SB(b, h) + boff + n * 2048); } while (0)
#define PG8_MMA(ai, bj, At, Bt) do { __builtin_amdgcn_s_setprio(1); _Pragma("unroll") for (int m = 0; m < 4; ++m) _Pragma("unroll") for (int n = 0; n < 2; ++n) \
        asm volatile("v_mfma_scale_f32_16x16x128_f8f6f4 %0, %1, %2, %0, %3, %3 op_sel_hi:[0,0,0]" : "+v"(acc[ai][bj][m][n]) : "v"(Bt[n]), "v"(At[m]), "v"(f8_unit_scale)); __builtin_amdgcn_s_setprio(0); } while (0)
#define PG8_WAIT_V(n) asm volatile("s_waitcnt vmcnt(" #n ")" ::: "memory")
#define PG8_WAIT_L(n) asm volatile("s_waitcnt lgkmcnt(" #n ")" ::: "memory")
#define PG8_BAR __builtin_amdgcn_s_barrier()
#define PG8_SCHED __builtin_amdgcn_sched_barrier(0)
    Unit cur, nxt; int ui = 0;
    if (!S.next(0, cur)) return;
    f32x4 acc[2][2][4][2];
#pragma unroll
    for (int a = 0; a < 2; ++a)
#pragma unroll
        for (int b = 0; b < 2; ++b)
#pragma unroll
            for (int m = 0; m < 4; ++m)
#pragma unroll
                for (int n = 0; n < 2; ++n) acc[a][b][m][n] = (f32x4){0.f, 0.f, 0.f, 0.f};
    i32x8 At[4], B0[2], B1[2];
    const int f8_unit_scale = 0x7f7f7f7f;
    const char* cA; const char* cB; S.ptrs(cur, cA, cB);
    PG8_STAGE(PG8_SB(0, 0), cB, voffB); PG8_STAGE(PG8_SB(0, 1), cB + hstep, voffB); PG8_STAGE(PG8_SA(0, 0), cA, voffA); PG8_STAGE(PG8_SA(0, 1), cA + hstep, voffA);
    if (wr == 1) PG8_BAR;
    PG8_WAIT_V(2); PG8_BAR;
    PG8_STAGE(PG8_SB(1, 0), cB + kstep, voffB); PG8_STAGE(PG8_SA(1, 0), cA + kstep, voffA); PG8_STAGE(PG8_SB(1, 1), cB + hstep + kstep, voffB);
    PG8_WAIT_V(6); PG8_BAR;
    for (;;) {
        const bool has_next = S.next(ui + 1, nxt);
        const char* nA = cA; const char* nB = cB; if (has_next) S.ptrs(nxt, nA, nB);
        for (int t = 0; t < nt; t += 2) {
            const bool last = (t == nt - 2);
            const char* a1 = cA + (size_t)(t + 1) * kstep;
            const char* a2 = last ? nA : cA + (size_t)(t + 2) * kstep; const char* b2 = last ? nB : cB + (size_t)(t + 2) * kstep;
            const char* a3 = a2 + kstep; const char* b3 = b2 + kstep;
            PG8_LDB(B0, 0, 0); PG8_LDB(B1, 0, 1); PG8_SCHED; PG8_LDA(At, 0, 0); PG8_STAGE(PG8_SA(1, 1), a1 + hstep, voffA);
            PG8_WAIT_V(8); PG8_WAIT_L(0); PG8_BAR; PG8_MMA(0, 0, At, B0); PG8_MMA(0, 1, At, B1); PG8_BAR; PG8_SCHED;
            PG8_LDA(At, 0, 1); PG8_STAGE(PG8_SB(0, 0), b2, voffB); PG8_STAGE(PG8_SB(0, 1), b2 + hstep, voffB); PG8_STAGE(PG8_SA(0, 0), a2, voffA);
            PG8_WAIT_V(8); PG8_WAIT_L(0); PG8_BAR; PG8_MMA(1, 0, At, B0); PG8_MMA(1, 1, At, B1); PG8_BAR; PG8_SCHED;
            PG8_LDB(B0, 1, 0); PG8_LDB(B1, 1, 1); PG8_SCHED; PG8_LDA(At, 1, 0); PG8_STAGE(PG8_SA(0, 1), a2 + hstep, voffA);
            PG8_WAIT_V(8); PG8_WAIT_L(0); PG8_BAR; PG8_MMA(0, 0, At, B0); PG8_MMA(0, 1, At, B1); PG8_BAR; PG8_SCHED;
            PG8_LDA(At, 1, 1); PG8_STAGE(PG8_SB(1, 0), b3, voffB); PG8_STAGE(PG8_SB(1, 1), b3 + hstep, voffB); PG8_STAGE(PG8_SA(1, 0), a3, voffA);
            PG8_WAIT_V(8); PG8_WAIT_L(0); PG8_BAR; PG8_MMA(1, 0, At, B0); PG8_MMA(1, 1, At, B1); PG8_BAR; PG8_SCHED;
        }
        if (wr == 0) PG8_BAR;
        { const int t2 = opaque_tid(), w2 = __builtin_amdgcn_readfirstlane(t2 >> 6); E(acc, cur, w2 >> 2, w2 & 3, t2 & 15, (t2 & 63) >> 4); }
        if (!has_next) break;
#pragma unroll
        for (int a = 0; a < 2; ++a)
#pragma unroll
            for (int b = 0; b < 2; ++b)
#pragma unroll
                for (int m = 0; m < 4; ++m)
#pragma unroll
                    for (int n = 0; n < 2; ++n) acc[a][b][m][n] = (f32x4){0.f, 0.f, 0.f, 0.f};
        cur = nxt; cA = nA; cB = nB; ++ui;
        if (wr == 1) PG8_BAR;
    }
    PG8_WAIT_V(0);
    PG8_BAR;
#undef PG8_SA
#undef PG8_SB
#undef PG8_STAGE
#undef PG8_LD8
#undef PG8_LDA
#undef PG8_LDB
#undef PG8_MMA
#undef PG8_WAIT_V
#undef PG8_WAIT_L
#undef PG8_BAR
#undef PG8_SCHED
}

template <class Epi, class Sched>
__device__ __forceinline__ void gemm_phase_mix(PG8_LAS unsigned char* lds, const int P, const int nt8, const int nt16, const Sched& S, const Epi& E) {
    const int tid = opaque_tid(), wid = __builtin_amdgcn_readfirstlane(tid >> 6), lane = tid & 63, wr = wid >> 2, wc = wid & 3, fr = lane & 15, fq = lane >> 4;
    unsigned voffA[2], voffB[2];
#pragma unroll
    for (int i = 0; i < 2; ++i) { int R, C; stage_rc(tid * 16 + i * 8192, R, C); const int Rb = Epi::PERM ? ((R & ~31) + perm32(R & 31)) : R;
        voffA[i] = voffB[i] = (unsigned)(tid * 16 + i * 8192); (void)R; (void)C; (void)Rb; }
    const size_t kstep = 32768;
    const size_t hstep = (size_t)HALF * 128;
    const unsigned ldsw = (unsigned)wid * 1024u;
#define PG8_SA(b, h) (((b) * 2 + (h)) * HTB)
#define PG8_SB(b, h) ((4 + (b) * 2 + (h)) * HTB)
#define PG8_STAGE(bufoff, gbase, voff) do { _Pragma("unroll") for (int _i = 0; _i < 2; ++_i) \
        __builtin_amdgcn_global_load_lds((const unsigned*)((const char*)(gbase) + (voff)[_i]), (PG8_LAS unsigned*)(lds + (bufoff) + ldsw + _i * 8192), 16, 0, 0); } while (0)
#define PG8_LD8(dst, off) do { const i32x4 _lo = *(const PG8_LAS i32x4*)(lds + (off)), _hi = *(const PG8_LAS i32x4*)(lds + (off) + 16); dst = __builtin_shufflevector(_lo, _hi, 0, 1, 2, 3, 4, 5, 6, 7); } while (0)
#define PG8_LDA8(dst, b, h) do { _Pragma("unroll") for (int m = 0; m < 4; ++m) PG8_LD8(dst[m], PG8_SA(b, h) + aoff8 + m * 2048); } while (0)
#define PG8_LDB8(dst, b, h) do { _Pragma("unroll") for (int n = 0; n < 2; ++n) PG8_LD8(dst[n], (PG8_SB(b, h) - 65536) + boff8 + n * 2048); } while (0)
#define PG8_MMA8(ai, bj, At, Bt) do { __builtin_amdgcn_s_setprio(1); _Pragma("unroll") for (int m = 0; m < 4; ++m) _Pragma("unroll") for (int n = 0; n < 2; ++n) \
        asm volatile("v_mfma_scale_f32_16x16x128_f8f6f4 %0, %1, %2, %0, %3, %3 op_sel_hi:[0,0,0]" : "+v"(acc[ai][bj][m][n]) : "v"(Bt[n]), "v"(At[m]), "v"(f8_unit_scale)); __builtin_amdgcn_s_setprio(0); } while (0)
#define PG8_LDA16(dst, b, h) do { _Pragma("unroll") for (int m = 0; m < 4; ++m) _Pragma("unroll") for (int k = 0; k < 2; ++k) dst[m][k] = *(const PG8_LAS bf16x8*)(lds + PG8_SA(b, h) + aoff16 + m * 2048 + k * 1024); } while (0)
#define PG8_LDB16(dst, b, h) do { _Pragma("unroll") for (int n = 0; n < 2; ++n) _Pragma("unroll") for (int k = 0; k < 2; ++k) dst[n][k] = *(const PG8_LAS bf16x8*)(lds + (PG8_SB(b, h) - 65536) + boff16 + n * 2048 + k * 1024); } while (0)
#define PG8_MMA16(ai, bj, At, Bt) do { __builtin_amdgcn_s_setprio(1); _Pragma("unroll") for (int k = 0; k < 2; ++k) _Pragma("unroll") for (int m = 0; m < 4; ++m) _Pragma("unroll") for (int n = 0; n < 2; ++n) \
        asm volatile("v_mfma_f32_16x16x32_bf16 %0, %1, %2, %0" : "+v"(acc[ai][bj][m][n]) : "v"(Bt[n][k]), "v"(At[m][k])); __builtin_amdgcn_s_setprio(0); } while (0)
#define PG8_WAIT_V(n) asm volatile("s_waitcnt vmcnt(" #n ")" ::: "memory")
#define PG8_WAIT_L(n) asm volatile("s_waitcnt lgkmcnt(" #n ")" ::: "memory")
#define PG8_BAR __builtin_amdgcn_s_barrier()
#define PG8_SCHED __builtin_amdgcn_sched_barrier(0)
#define PG8_KPAIR(LDA_, LDB_, MMA_, At_, B0_, B1_) do { \
            LDB_(B0_, 0, 0); LDB_(B1_, 0, 1); PG8_SCHED; LDA_(At_, 0, 0); PG8_STAGE(PG8_SA(1, 1), a1 + hstep, voffA); \
            PG8_WAIT_V(8); PG8_WAIT_L(0); PG8_BAR; MMA_(0, 0, At_, B0_); MMA_(0, 1, At_, B1_); PG8_BAR; PG8_SCHED; \
            LDA_(At_, 0, 1); PG8_STAGE(PG8_SB(0, 0), b2, voffB); PG8_STAGE(PG8_SB(0, 1), b2 + hstep, voffB); PG8_STAGE(PG8_SA(0, 0), a2, voffA); \
            PG8_WAIT_V(8); PG8_WAIT_L(0); PG8_BAR; MMA_(1, 0, At_, B0_); MMA_(1, 1, At_, B1_); PG8_BAR; PG8_SCHED; \
            LDB_(B0_, 1, 0); LDB_(B1_, 1, 1); PG8_SCHED; LDA_(At_, 1, 0); PG8_STAGE(PG8_SA(0, 1), a2 + hstep, voffA); \
            PG8_WAIT_V(8); PG8_WAIT_L(0); PG8_BAR; MMA_(0, 0, At_, B0_); MMA_(0, 1, At_, B1_); PG8_BAR; PG8_SCHED; \
            LDA_(At_, 1, 1); PG8_STAGE(PG8_SB(1, 0), b3, voffB); PG8_STAGE(PG8_SB(1, 1), b3 + hstep, voffB); PG8_STAGE(PG8_SA(1, 0), a3, voffA); \
            PG8_WAIT_V(8); PG8_WAIT_L(0); PG8_BAR; MMA_(1, 0, At_, B0_); MMA_(1, 1, At_, B1_); PG8_BAR; PG8_SCHED; } while (0)
    Unit cur, nxt; int ui = 0;
    if (!S.o.tile(0, cur)) return;
    f32x4 acc[2][2][4][2];
#pragma unroll
    for (int a = 0; a < 2; ++a)
#pragma unroll
        for (int b = 0; b < 2; ++b)
#pragma unroll
            for (int m = 0; m < 4; ++m)
#pragma unroll
                for (int n = 0; n < 2; ++n) acc[a][b][m][n] = (f32x4){0.f, 0.f, 0.f, 0.f};
    const int f8_unit_scale = 0x7f7f7f7f;
    const char* c8A = S.A0 + (size_t)cur.pm * S.tstep8; const char* c8B = S.B0 + (size_t)cur.pn * S.tstep8;
    PG8_STAGE(PG8_SB(0, 0), c8B, voffB); PG8_STAGE(PG8_SB(0, 1), c8B + hstep, voffB); PG8_STAGE(PG8_SA(0, 0), c8A, voffA); PG8_STAGE(PG8_SA(0, 1), c8A + hstep, voffA);
    if (wr == 1) PG8_BAR;
    PG8_WAIT_V(2); PG8_BAR;
    PG8_STAGE(PG8_SB(1, 0), c8B + kstep, voffB); PG8_STAGE(PG8_SA(1, 0), c8A + kstep, voffA); PG8_STAGE(PG8_SB(1, 1), c8B + hstep + kstep, voffB);
    PG8_WAIT_V(6); PG8_BAR;
    for (;;) {
        const bool has_next = S.o.tile(ui + 1, nxt);
        const char* c16A = S.A1 + (size_t)cur.pm * S.tstep; const char* c16B = S.B1 + (size_t)cur.pn * S.tstep;
        {   i32x8 At[4], B0[2], B1[2];
            const int t8 = opaque_tid(); int aoff8 = lds_byte(((t8 >> 8) & 1) * 64 + (t8 & 15), ((t8 & 63) >> 4) * 16), boff8 = lds_byte(((t8 >> 6) & 3) * 32 + (t8 & 15), ((t8 & 63) >> 4) * 16) + 65536;
            asm volatile("" : "+v"(aoff8), "+v"(boff8));
            for (int t = 0; t < nt8; t += 2) { const bool last = (t == nt8 - 2);
                const char* a1 = c8A + (size_t)(t + 1) * kstep;
                const char* a2 = last ? c16A : c8A + (size_t)(t + 2) * kstep; const char* b2 = last ? c16B : c8B + (size_t)(t + 2) * kstep;
                const char* a3 = a2 + kstep; const char* b3 = b2 + kstep;
                PG8_KPAIR(PG8_LDA8, PG8_LDB8, PG8_MMA8, At, B0, B1); } }
        if (wr == 0) PG8_BAR;
        { const int t2 = opaque_tid(), w2 = __builtin_amdgcn_readfirstlane(t2 >> 6); cur.sub = 0; E(acc, cur, w2 >> 2, w2 & 3, t2 & 15, (t2 & 63) >> 4); }
        if (wr == 1) PG8_BAR;
        const char* n8A = c8A; const char* n8B = c8B; if (has_next) { n8A = S.A0 + (size_t)nxt.pm * S.tstep8; n8B = S.B0 + (size_t)nxt.pn * S.tstep8; }
        {   bf16x8 At[4][2], B0[2][2], B1[2][2];
            const int t6 = opaque_tid(); int aoff16 = lds_byte(((t6 >> 8) & 1) * 64 + (t6 & 15), ((t6 & 63) >> 4) * 8), boff16 = lds_byte(((t6 >> 6) & 3) * 32 + (t6 & 15), ((t6 & 63) >> 4) * 8) + 65536;
            asm volatile("" : "+v"(aoff16), "+v"(boff16));
            for (int t = 0; t < nt16; t += 2) { const bool last = (t == nt16 - 2);
                const char* a1 = c16A + (size_t)(t + 1) * kstep;
                const char* a2 = last ? n8A : c16A + (size_t)(t + 2) * kstep; const char* b2 = last ? n8B : c16B + (size_t)(t + 2) * kstep;
                const char* a3 = a2 + kstep; const char* b3 = b2 + kstep;
                PG8_KPAIR(PG8_LDA16, PG8_LDB16, PG8_MMA16, At, B0, B1); } }
        if (wr == 0) PG8_BAR;
        { const int t2 = opaque_tid(), w2 = __builtin_amdgcn_readfirstlane(t2 >> 6); cur.sub = 1; E(acc, cur, w2 >> 2, w2 & 3, t2 & 15, (t2 & 63) >> 4); }
        if (!has_next) break;
#pragma unroll
        for (int a = 0; a < 2; ++a)
#pragma unroll
            for (int b = 0; b < 2; ++b)
#pragma unroll
                for (int m = 0; m < 4; ++m)
#pragma unroll
                    for (int n = 0; n < 2; ++n) acc[a][b][m][n] = (f32x4){0.f, 0.f, 0.f, 0.f};
        cur = nxt; c8A = n8A; c8B = n8B; ++ui;
        if (wr == 1) PG8_BAR;
    }
    PG8_WAIT_V(0);
    PG8_BAR;
#undef PG8_SA
#undef PG8_SB
#undef PG8_STAGE
#undef PG8_LD8
#undef PG8_LDA8
#undef PG8_LDB8
#undef PG8_MMA8
#undef PG8_LDA16
#undef PG8_LDB16
#undef PG8_MMA16
#undef PG8_KPAIR
#undef PG8_WAIT_V
#undef PG8_WAIT_L
#undef PG8_BAR
#undef PG8_SCHED
}
}

constexpr int NWAVES = 8;
constexpr int N_LAUNCHES = MK_N_LAUNCHES;
constexpr int PER_PHASE = 8;
constexpr int M = 16384, D = 4096, NIN = 18432, GMW = 2048, NAW = 2048, DFF = 11008, NGU = 2 * DFF;
constexpr float F8_ASCALE = 16.f, F8_WSCALE = 1024.f, F8_UNSCALE = 1.f / (16.f * 1024.f), F8_YSCALE = 64.f, F8_YUNSCALE = 1.f / (64.f * 1024.f);
constexpr int GRID_W = 64, GRID_H = M / GRID_W, NHEAD = 16, HD = 128, CHUNK = 128, NGROUP = 16;
constexpr float RMS_EPS = 1e-6f, LN_EPS = 1e-5f;

constexpr size_t MiB = 1u << 20;
constexpr size_t WS_CTL = 0, CTL_ZERO_BYTES = 1 * MiB;
constexpr size_t WS_WSB = 1 * MiB;
constexpr size_t WS_WIN = 4 * MiB;
constexpr size_t WS_WOA = 148 * MiB, WS_WOB = 164 * MiB;
constexpr size_t WS_WOUT = 180 * MiB;
constexpr size_t WS_RA = 212 * MiB;
constexpr size_t WS_YA = WS_RA, WS_YB = WS_RA + 64 * MiB;
constexpr size_t WS_RB = 340 * MiB;
constexpr size_t WS_U = WS_RB, WS_V = WS_RB + 64 * MiB, WS_Q = WS_RB + 128 * MiB, WS_K = WS_RB + 192 * MiB, WS_VV = WS_RB + 256 * MiB, WS_GA = WS_RB + 320 * MiB, WS_GB = WS_RB + 448 * MiB;
constexpr size_t WS_TB = WS_Q;
constexpr size_t WS_MRG = WS_RB;
constexpr size_t WS_ACT = WS_RB;
constexpr size_t WS_H16 = WS_WIN;
constexpr size_t WS_WQKV8 = WS_WIN + 32 * MiB;
constexpr size_t WS_XN8 = 916 * MiB;
constexpr size_t WS_WGU = 916 * MiB;
constexpr size_t WS_WD = 1088 * MiB;
constexpr size_t WS_PART = 1174 * MiB;
constexpr size_t WS_END = 1178 * MiB;
static_assert(WS_GB + (size_t)M * D * 2 == WS_WGU && WS_WGU + (size_t)NGU * D * 2 == WS_WD && WS_WD + (size_t)D * DFF * 2 == WS_PART && WS_PART + (size_t)M * 64 * 4 == WS_END && WS_ACT + (size_t)M * DFF * 2 <= WS_WGU, "d_ws map");
constexpr int CW_BAR = 4096;
constexpr int RING_BYTES = 131072;
constexpr int LDSCTL_OFF = RING_BYTES, MISC_OFF = LDSCTL_OFF + 320;
constexpr int LDS_BYTES = 147456;

#define GAS __attribute__((address_space(1)))
#define LAS __attribute__((address_space(3)))
typedef unsigned short bf16;
typedef unsigned v4u __attribute__((ext_vector_type(4)));
typedef unsigned v2u __attribute__((ext_vector_type(2)));
typedef float f32x4 __attribute__((ext_vector_type(4)));
typedef float f32x2 __attribute__((ext_vector_type(2)));
typedef short bf16x8 __attribute__((ext_vector_type(8)));
typedef GAS unsigned gu32;
#define RLX_AGENT __ATOMIC_RELAXED, __HIP_MEMORY_SCOPE_AGENT
#define LDS_WAIT() asm volatile("s_waitcnt lgkmcnt(0)" ::: "memory")
#define VM_WAIT() asm volatile("s_waitcnt vmcnt(0)" ::: "memory")
__device__ __forceinline__ unsigned f2bf(float f) { unsigned u = __builtin_bit_cast(unsigned, f); return (u + 0x7fffu + ((u >> 16) & 1u)) >> 16; }
__device__ __forceinline__ unsigned pk2(float lo, float hi) { return pg8::cvt_pk_bf16(lo, hi); }
__device__ __forceinline__ float bflo(unsigned w) { return __uint_as_float(w << 16); }
__device__ __forceinline__ float bfhi(unsigned w) { return __uint_as_float(w & 0xffff0000u); }

#define XB_TMO      128
#define XB_XCNT(j)  (256  + 64 * (j))
#define XB_XSUB(j)  (1280 + 64 * (j))
#define XB_XGEN(j)  (2304 + 64 * (j))
#define XB_TOP      3328
#define XB_TOPGEN   3392
#define XCD_BAR_WORDS 3456
#define XB_SPIN_CAP (1u << 20)

__device__ __forceinline__ unsigned xb_ld(unsigned* p)              { return __hip_atomic_load(p, __ATOMIC_RELAXED, __HIP_MEMORY_SCOPE_AGENT); }
__device__ __forceinline__ unsigned xb_add(unsigned* p, unsigned v) { return __hip_atomic_fetch_add(p, v, __ATOMIC_RELAXED, __HIP_MEMORY_SCOPE_AGENT); }
__device__ __forceinline__ unsigned xb_xcc_id() { return (unsigned)__builtin_amdgcn_s_getreg((3 << 11) | 20) & 0xFu; }
#define XB_SPIN(cond, bar) do { unsigned _sp = 0; while (cond) { __builtin_amdgcn_s_sleep(1); \
    if ((++_sp & 255u) == 0u) { if (xb_ld(&(bar)[XB_TMO])) break; if (_sp > XB_SPIN_CAP) { atomicAdd(&(bar)[XB_TMO], 1u); break; } } } } while (0)

struct XcdBarrier {
    unsigned* bar; unsigned x;
    volatile LAS unsigned* st;
};
__device__ __forceinline__ XcdBarrier xcd_barrier_post(unsigned* bar, volatile LAS unsigned* st) {
    XcdBarrier b; b.bar = bar; b.x = xb_xcc_id(); b.st = st;
    if (threadIdx.x == 0) (void)xb_add(&bar[XB_XCNT(b.x)], 1u);
    return b;
}
__device__ __forceinline__ void xcd_barrier_complete(unsigned* bar, unsigned x, unsigned& nloc, unsigned& nx) {
    const unsigned G = gridDim.x * gridDim.y * gridDim.z;
    unsigned sum, cnt, mine, sp = 0u;
    for (;;) {
        sum = 0u; cnt = 0u; mine = 0u;
#pragma unroll
        for (unsigned j = 0; j < 16; ++j) { const unsigned c = xb_ld(&bar[XB_XCNT(j)]); sum += c; cnt += (c > 0u) ? 1u : 0u; mine = (j == x) ? c : mine; }
        if (sum == G) break;
        __builtin_amdgcn_s_sleep(1);
        if ((++sp & 255u) == 0u) { if (xb_ld(&bar[XB_TMO])) break; if (sp > XB_SPIN_CAP) { atomicAdd(&bar[XB_TMO], 1u); break; } }
    }
    nloc = mine > 0u ? mine : 1u; nx = cnt > 0u ? cnt : 1u;
}
__device__ __forceinline__ void xcd_barrier(const XcdBarrier& b) {
    asm volatile("s_waitcnt vmcnt(0)" ::: "memory");
    __syncthreads();
    if (threadIdx.x == 0) {
        unsigned* bar = b.bar;
        __builtin_amdgcn_s_waitcnt(0);
        unsigned nloc = b.st[0], nx = b.st[1];
        if (nloc == 0u) { xcd_barrier_complete(bar, b.x, nloc, nx); b.st[0] = nloc; b.st[1] = nx; }
        const unsigned old = xb_add(&bar[XB_XSUB(b.x)], 1u);
        const unsigned gen = old / nloc;
        if (old + 1u == (gen + 1u) * nloc) {
            __builtin_amdgcn_fence(__ATOMIC_RELEASE, "agent");
            asm volatile("s_waitcnt vmcnt(0)" ::: "memory");
            const unsigned og = xb_add(&bar[XB_TOP], 1u);
            const unsigned tg = og / nx;
            if (og + 1u == (tg + 1u) * nx) xb_add(&bar[XB_TOPGEN], 1u);
            else XB_SPIN(xb_ld(&bar[XB_TOPGEN]) == tg, bar);
            __builtin_amdgcn_fence(__ATOMIC_ACQUIRE, "agent");
            xb_add(&bar[XB_XGEN(b.x)], 1u);
            asm volatile("s_waitcnt vmcnt(0)" ::: "memory");
        } else {
            XB_SPIN(xb_ld(&bar[XB_XGEN(b.x)]) == gen, bar);
            __builtin_amdgcn_fence(__ATOMIC_ACQUIRE, "agent");
            asm volatile("s_waitcnt vmcnt(0)" ::: "memory");
        }
    }
    __syncthreads();
}

struct Frame {
    LAS unsigned char* lds;
    volatile LAS unsigned* MISC;
    gu32* ctl;
    int tid, lane, wave;
    int vcu, G;
    unsigned char* ws;
    const float *x, *norm1_g, *w_in, *gm_ln_g, *gm_ln_b, *gm_w_s, *gm_b_s, *q_gain, *k_gain, *na_rpb, *w_o_gm, *w_o_na, *w_out, *norm2_g, *w_ff_gate, *w_ff_up, *w_ff_down;
    float* out;
};
template <int O> __device__ __forceinline__ float xor_lane(float v) {
    if constexpr (O < 32) return __builtin_bit_cast(float, __builtin_amdgcn_ds_swizzle(__builtin_bit_cast(int, v), (O << 10) | 0x1f));
    else return __shfl_xor(v, 32);
}
__device__ __forceinline__ float wave_sum(float v) {
    v += xor_lane<1>(v); v += xor_lane<2>(v); v += xor_lane<4>(v); v += xor_lane<8>(v); v += xor_lane<16>(v); v += xor_lane<32>(v);
    return v;
}
struct TrRegs { f32x4 v[8]; };
__device__ __forceinline__ void tr_load(TrRegs& R, const float* W, int ldw, int k0, int n0, int lane) {
    const GAS float* src = (const GAS float*)W + (size_t)(k0 + 8 * (lane >> 3)) * ldw + n0 + 4 * (lane & 7);
#pragma unroll
    for (int e = 0; e < 8; ++e) R.v[e] = *(const GAS f32x4*)(src + (size_t)e * ldw);
}
__device__ __forceinline__ void tr_store(const TrRegs& R, bf16* blk, int nloc, int lane) {
#pragma unroll
    for (int i = 0; i < 4; ++i) { v4u o; o.x = pk2(R.v[0][i], R.v[1][i]); o.y = pk2(R.v[2][i], R.v[3][i]); o.z = pk2(R.v[4][i], R.v[5][i]); o.w = pk2(R.v[6][i], R.v[7][i]);
        *(GAS v4u*)((GAS char*)blk + pg8::img_off_w(nloc + 4 * (lane & 7) + i, 8 * (lane >> 3))) = o; }
}
__device__ __forceinline__ unsigned pk4_fp8(float a, float b, float c, float d) {
    a = fminf(fmaxf(a, -448.f), 448.f); b = fminf(fmaxf(b, -448.f), 448.f); c = fminf(fmaxf(c, -448.f), 448.f); d = fminf(fmaxf(d, -448.f), 448.f);
    unsigned w = 0u; w = __builtin_amdgcn_cvt_pk_fp8_f32(a, b, w, false); w = __builtin_amdgcn_cvt_pk_fp8_f32(c, d, w, true); return w;
}
__device__ __forceinline__ void tr_store8(const TrRegs& R, unsigned char* blk8, int nloc, int khalf, int lane, float sc) {
#pragma unroll
    for (int i = 0; i < 4; ++i) { v2u o; o.x = pk4_fp8(R.v[0][i] * sc, R.v[1][i] * sc, R.v[2][i] * sc, R.v[3][i] * sc); o.y = pk4_fp8(R.v[4][i] * sc, R.v[5][i] * sc, R.v[6][i] * sc, R.v[7][i] * sc);
        *(GAS v2u*)((GAS unsigned char*)blk8 + pg8::img_off_w(nloc + 4 * (lane & 7) + i, khalf * 32 + 4 * (lane >> 3))) = o; }
}
__device__ __forceinline__ size_t blkw(int n0, int kb, int K) { return ((size_t)(n0 >> 8) * (K >> 6) + kb) * 16384; }
__device__ __forceinline__ size_t blkw8(int n0, int kb, int K) { return ((size_t)(n0 >> 8) * (K >> 7) + (kb >> 1)) * 32768; }
__device__ __forceinline__ void tr_matrix(Frame& F, int lane, const float* W, int K, int N, bf16* WT) {
    const int gw = F.vcu * NWAVES + F.wave, NGW = F.G * NWAVES, nblk = N / 32, nitems = (K / 64) * nblk;
    for (int it = gw; it < nitems; it += 2 * NGW) { const int it2 = it + NGW; const bool two = it2 < nitems; TrRegs A, B;
        const int kb = it / nblk, nb = it % nblk, kb2 = two ? it2 / nblk : kb, nb2 = two ? it2 % nblk : nb;
        tr_load(A, W, N, 64 * kb, 32 * nb, lane); tr_load(B, W, N, 64 * kb2, 32 * nb2, lane);
        tr_store(A, WT + blkw(32 * nb, kb, K), (32 * nb) & 255, lane); if (two) tr_store(B, WT + blkw(32 * nb2, kb2, K), (32 * nb2) & 255, lane); }
}
constexpr int FF_ITEMS_GU = (D / 64) * (DFF / 32), FF_ITEMS_D = (DFF / 64) * (D / 32), FF_ITEMS = 2 * FF_ITEMS_GU + FF_ITEMS_D;
constexpr int FF_ITEMS_P2 = 2 * FF_ITEMS_GU;
struct FillItem { const float* src; bf16* dst; int ldw, ldk, k0, n0; };
__device__ __forceinline__ FillItem ff_item(Frame& F, int it) {
    it = it < FF_ITEMS ? it : FF_ITEMS - 1; FillItem I;
    if (it < 2 * FF_ITEMS_GU) { const int up = it >= FF_ITEMS_GU, r = up ? it - FF_ITEMS_GU : it, nblk = DFF / 32, kb = r / nblk, n0 = 32 * (r - kb * nblk);
        I.src = up ? F.w_ff_up : F.w_ff_gate; I.ldw = DFF; I.k0 = 64 * kb; I.n0 = n0; I.ldk = D;
        const int drow = 256 * (n0 >> 7) + (n0 & 127) + (up ? 128 : 0); I.dst = (bf16*)(F.ws + WS_WGU) + blkw(drow, kb, D); I.ldk = drow & 255; }
    else { const int r = it - 2 * FF_ITEMS_GU, nblk = D / 32, kb = r / nblk, n0 = 32 * (r - kb * nblk);
        I.src = F.w_ff_down; I.ldw = D; I.k0 = 64 * kb; I.n0 = n0; I.ldk = n0 & 255; I.dst = (bf16*)(F.ws + WS_WD) + blkw(n0, kb, DFF); }
    return I;
}
__device__ __forceinline__ void rms_row_to_bf16(int lane, const float* xrow, const float* gain, bf16* obase, unsigned char* obase8, int m) {
    const GAS f32x4* xr = (const GAS f32x4*)xrow + lane;
    f32x4 v[16]; float s = 0.f;
#pragma unroll
    for (int j = 0; j < 16; ++j) { v[j] = xr[64 * j]; s += (v[j].x * v[j].x + v[j].y * v[j].y) + (v[j].z * v[j].z + v[j].w * v[j].w); }
    const float rstd = 1.f / sqrtf(wave_sum(s) * (1.f / D) + RMS_EPS);
    const GAS f32x4* gr = (const GAS f32x4*)gain + lane;
#pragma unroll
    for (int j = 0; j < 16; ++j) { const f32x4 g = gr[64 * j]; const float y0 = v[j].x * rstd * g.x, y1 = v[j].y * rstd * g.y, y2 = v[j].z * rstd * g.z, y3 = v[j].w * rstd * g.w;
        v2u o; o.x = pk2(y0, y1); o.y = pk2(y2, y3); *(GAS v2u*)((GAS char*)obase + pg8::blk_off(m, 8 * lane + 512 * j, 2 * D)) = o;
        *(GAS unsigned*)((GAS unsigned char*)obase8 + pg8::blk_off(m, 4 * lane + 256 * j, D)) = pk4_fp8(y0 * F8_ASCALE, y1 * F8_ASCALE, y2 * F8_ASCALE, y3 * F8_ASCALE); }
}

#ifndef MK_STAGGER_US
#define MK_STAGGER_US 0
#endif
__device__ __forceinline__ void stagger(int us_per_group) {
    const int grp = ((int)blockIdx.x >> 3) & 3;
    if (grp && us_per_group) { const unsigned long long t0 = __builtin_amdgcn_s_memrealtime(), dt = (unsigned long long)(grp * us_per_group) * 100ull;
        while (__builtin_amdgcn_s_memrealtime() - t0 < dt) __builtin_amdgcn_s_sleep(16); }
}
__device__ __forceinline__ void p0_prologue(Frame& F) {
    const int lane = opaque_tid() & 63;
    {
        const int gw0 = F.vcu * NWAVES + F.wave, NGW0 = F.G * NWAVES, nblk = NIN / 32, nitems = (D / 64) * nblk; bf16* WT = (bf16*)(F.ws + WS_WIN); unsigned char* W8 = F.ws + WS_WQKV8;
        for (int it = gw0; it < nitems; it += NGW0) { const int kb = it / nblk, n0 = 32 * (it - kb * nblk); TrRegs R; tr_load(R, F.w_in, NIN, 64 * kb, n0, lane);
            if (n0 >= 4096) tr_store8(R, W8 + blkw8(n0 - 4096, kb, D), (n0 - 4096) & 255, kb & 1, lane, F8_WSCALE);
            else tr_store(R, WT + blkw(n0, kb, D), n0 & 255, lane); } }
    tr_matrix(F, lane, F.w_o_gm, GMW, D, (bf16*)(F.ws + WS_WOA));
    {
        const int gw0 = F.vcu * NWAVES + F.wave, NGW0 = F.G * NWAVES, nblk = D / 32, nitems = (NAW / 64) * nblk; unsigned char* W8 = F.ws + WS_WOB;
        for (int it = gw0; it < nitems; it += NGW0) { const int kb = it / nblk, n0 = 32 * (it - kb * nblk); TrRegs R; tr_load(R, F.w_o_na, D, 64 * kb, n0, lane);
            tr_store8(R, W8 + blkw8(n0, kb, NAW), n0 & 255, kb & 1, lane, F8_WSCALE); } }
    tr_matrix(F, lane, F.w_out, D, D, (bf16*)(F.ws + WS_WOUT));
    const int gw = F.vcu * NWAVES + F.wave, NGW = F.G * NWAVES;
    { bf16* wsb = (bf16*)(F.ws + WS_WSB);
      for (int i = gw * 64 + lane; i < NGROUP * CHUNK * CHUNK / 4; i += NGW * 64) { const f32x4 v = ((const GAS f32x4*)F.gm_w_s)[i]; v2u o; o.x = pk2(v.x, v.y); o.y = pk2(v.z, v.w); ((GAS v2u*)wsb)[i] = o; } }
    bf16* XN = (bf16*)(F.ws + WS_RA);
    for (int m = gw; m < M; m += NGW) rms_row_to_bf16(lane, F.x + (size_t)m * D, F.norm1_g, XN, F.ws + WS_XN8, m);
}
typedef short s16x4 __attribute__((ext_vector_type(4)));
constexpr int GM_WP = 272, GM_VP = 288;
constexpr int GM_V_OFF = 128 * GM_WP, GM_ST_OFF = GM_V_OFF + 128 * GM_VP;
__device__ __forceinline__ void gmlp_unit(Frame& F, int chunk, int half) {
    LAS unsigned char* Wl = F.lds; LAS unsigned char* Vt = F.lds + GM_V_OFF; LAS f32x2* st = (LAS f32x2*)(F.lds + GM_ST_OFF);
    const bf16* U = (const bf16*)(F.ws + WS_U); const bf16* V = (const bf16*)(F.ws + WS_V); bf16* YA = (bf16*)(F.ws + WS_YA); const bf16* WSB = (const bf16*)(F.ws + WS_WSB);
    const int tid = opaque_tid();
    const int tok0 = chunk * CHUNK, lane = tid & 63, fr = lane & 15, fq = lane >> 4, q4 = fr >> 2, p4 = lane & 3;
    const int srow = tid >> 4, sch = tid & 15;
    const int g_first = half * (NGROUP / 2);
    v4u Wr[4], Vr[4]; f32x4 lg[2], lb[2];
#define GM_PREFETCH(g_) do { _Pragma("unroll") for (int q = 0; q < 4; ++q) { Wr[q] = *(const GAS v4u*)(WSB + (size_t)(g_) * CHUNK * CHUNK + (srow + 32 * q) * CHUNK + sch * 8); \
        Vr[q] = *(const GAS v4u*)(V + ((size_t)(g_) * M + tok0 + srow + 32 * q) * 128 + sch * 8); } \
        lg[0] = *(const GAS f32x4*)(F.gm_ln_g + (g_) * 128 + sch * 8); lg[1] = *(const GAS f32x4*)(F.gm_ln_g + (g_) * 128 + sch * 8 + 4); \
        lb[0] = *(const GAS f32x4*)(F.gm_ln_b + (g_) * 128 + sch * 8); lb[1] = *(const GAS f32x4*)(F.gm_ln_b + (g_) * 128 + sch * 8 + 4); } while (0)
    GM_PREFETCH(g_first);
    __syncthreads();
    { const GAS f32x4* p = (const GAS f32x4*)((const float*)(F.ws + WS_PART) + (size_t)(tok0 + (tid >> 2)) * 64 + (tid & 3) * 16); float sm = 0.f, sq = 0.f;
#pragma unroll
      for (int i = 0; i < 4; ++i) { const f32x4 v = p[i]; sm += v.x + v.z; sq += v.y + v.w; }
      sm += xor_lane<1>(sm); sm += xor_lane<2>(sm); sq += xor_lane<1>(sq); sq += xor_lane<2>(sq);
      const float mean = sm * (1.f / GMW), var = fmaxf(sq * (1.f / GMW) - mean * mean, 0.f);
      if ((tid & 3) == 0) st[tid >> 2] = (f32x2){mean, 1.f / sqrtf(var + LN_EPS)}; }
    const int wi = F.wave >> 1, wc2 = F.wave & 1;
#pragma unroll 1
    for (int gi = 0; gi < NGROUP / 2; ++gi) { const int g = g_first + gi;
        __syncthreads();
#pragma unroll
        for (int q = 0; q < 4; ++q) { const int row = srow + 32 * q;
            *(LAS v4u*)(Wl + row * GM_WP + sch * 16) = Wr[q];
            const v4u w = Vr[q]; const f32x2 ms = st[row]; v4u o;
            o.x = pk2((bflo(w.x) - ms.x) * ms.y * lg[0].x + lb[0].x, (bfhi(w.x) - ms.x) * ms.y * lg[0].y + lb[0].y); o.y = pk2((bflo(w.y) - ms.x) * ms.y * lg[0].z + lb[0].z, (bfhi(w.y) - ms.x) * ms.y * lg[0].w + lb[0].w);
            o.z = pk2((bflo(w.z) - ms.x) * ms.y * lg[1].x + lb[1].x, (bfhi(w.z) - ms.x) * ms.y * lg[1].y + lb[1].y); o.w = pk2((bflo(w.w) - ms.x) * ms.y * lg[1].z + lb[1].z, (bfhi(w.w) - ms.x) * ms.y * lg[1].w + lb[1].w);
            *(LAS v4u*)(Vt + row * GM_VP + sch * 16) = o; }
        if (gi + 1 < NGROUP / 2) GM_PREFETCH(g + 1);
        v4u uu[2][2]; float bs[2];
#pragma unroll
        for (int it = 0; it < 2; ++it) { const int i = 32 * wi + 16 * it + fr; bs[it] = F.gm_b_s[g * CHUNK + i];
#pragma unroll
            for (int t = 0; t < 2; ++t) uu[it][t] = *(const GAS v4u*)(U + ((size_t)g * M + tok0 + i) * 128 + 64 * wc2 + 32 * t + 8 * fq); }
        __syncthreads();
        f32x4 acc[4][2];
#pragma unroll
        for (int ct = 0; ct < 4; ++ct)
#pragma unroll
            for (int it = 0; it < 2; ++it) acc[ct][it] = (f32x4){0.f, 0.f, 0.f, 0.f};
#pragma unroll
        for (int kk = 0; kk < 8; ++kk) { s16x4 vf[4], wf[2];
#pragma unroll
            for (int ct = 0; ct < 4; ++ct) vf[ct] = __builtin_amdgcn_ds_read_tr16_b64_v4i16((LAS s16x4*)(Vt + (16 * kk + 4 * fq + q4) * GM_VP + (64 * wc2 + 32 * (ct >> 1) + 8 * p4 + 4 * (ct & 1)) * 2));
#pragma unroll
            for (int it = 0; it < 2; ++it) wf[it] = *(const LAS s16x4*)(Wl + (32 * wi + 16 * it + fr) * GM_WP + (16 * kk + 4 * fq) * 2);
#pragma unroll
            for (int ct = 0; ct < 4; ++ct)
#pragma unroll
                for (int it = 0; it < 2; ++it) acc[ct][it] = __builtin_amdgcn_mfma_f32_16x16x16bf16_1k(vf[ct], wf[it], acc[ct][it], 0, 0, 0); }
#pragma unroll
        for (int it = 0; it < 2; ++it) { const int i = 32 * wi + 16 * it + fr;
#pragma unroll
            for (int t = 0; t < 2; ++t) { const v4u u4 = uu[it][t]; const f32x4 a0 = acc[2 * t][it], a1 = acc[2 * t + 1][it]; const float b = bs[it]; v4u o;
                o.x = pk2((a0[0] + b) * bflo(u4.x), (a0[1] + b) * bfhi(u4.x)); o.y = pk2((a0[2] + b) * bflo(u4.y), (a0[3] + b) * bfhi(u4.y));
                o.z = pk2((a1[0] + b) * bflo(u4.z), (a1[1] + b) * bfhi(u4.z)); o.w = pk2((a1[2] + b) * bflo(u4.w), (a1[3] + b) * bfhi(u4.w));
                *(GAS v4u*)((GAS char*)YA + pg8::blk_off(tok0 + i, (g * 128 + 64 * wc2 + 32 * t + 8 * fq) * 2, 2 * GMW)) = o; } }
    }
#undef GM_PREFETCH
    __syncthreads();
}

constexpr int NA_KP = 272, NA_VP = 288;
constexpr int NA_KS = 64 * NA_KP, NA_SLOT = NA_KS + 64 * NA_VP, NA_RPB_OFF = 2 * NA_SLOT, NA_ROWS = 11;
constexpr float LOG2E = 1.4426950408889634f;
template <bool FILL> __device__ __forceinline__ void na_unit(Frame& F, int pq, int h, float cbound, int fill_it, int fill_stride) {
    LAS unsigned char* ring = F.lds; LAS float* rpbL = (LAS float*)(F.lds + NA_RPB_OFF);
    const bf16* Q = (const bf16*)(F.ws + WS_Q); const bf16* Kt = (const bf16*)(F.ws + WS_K); const bf16* Vv = (const bf16*)(F.ws + WS_VV);
    const int tid = opaque_tid();
    const int lane = tid & 63, wave = __builtin_amdgcn_readfirstlane(tid >> 6), fr = lane & 15, g = lane >> 4, q4 = fr >> 2, p4 = lane & 3;
    const int R0 = 4 * pq, r = R0 + (wave >> 1), half = wave & 1, kb0 = half;
    int b0 = R0 - 4; b0 = b0 < 0 ? 0 : (b0 > GRID_H - 8 ? GRID_H - 8 : b0);
    int rs = r - 4; rs = rs < 0 ? 0 : (rs > GRID_H - 8 ? GRID_H - 8 : rs);
    int c[2], cs[2];
#pragma unroll
    for (int tt = 0; tt < 2; ++tt) { c[tt] = 32 * half + 16 * tt + fr; int x = c[tt] - 8; cs[tt] = x < 0 ? 0 : (x > GRID_W - 16 ? GRID_W - 16 : x); }
    const int skey = tid >> 4, sdch = tid & 15;
    __syncthreads();
    for (int i = tid; i < 15 * 31; i += 512) rpbL[i] = __builtin_amdgcn_exp2f(F.na_rpb[h * 465 + i] * LOG2E);
    v4u RK[2][2], RV[2][2];
    TrRegs FR; FillItem FI;
#define NA_LOAD(s_) do { int kr_ = b0 + (s_); kr_ = kr_ > GRID_H - 1 ? GRID_H - 1 : kr_; _Pragma("unroll") for (int q2 = 0; q2 < 2; ++q2) { \
        const size_t o_ = ((size_t)h * M + kr_ * GRID_W + skey + 32 * q2) * HD + sdch * 8; RK[(s_) & 1][q2] = *(const GAS v4u*)(Kt + o_); RV[(s_) & 1][q2] = *(const GAS v4u*)(Vv + o_); } } while (0)
    NA_LOAD(0); NA_LOAD(1);
    bf16x8 Qf[2][4];
#pragma unroll
    for (int tt = 0; tt < 2; ++tt) { const size_t tq = (size_t)(r * GRID_W + c[tt]); v4u qw[4]; float ss = 0.f;
#pragma unroll
      for (int ks = 0; ks < 4; ++ks) { qw[ks] = *(const GAS v4u*)(Q + ((size_t)h * M + tq) * HD + 32 * ks + 8 * g);
          const float a0 = bflo(qw[ks].x), a1 = bfhi(qw[ks].x), a2 = bflo(qw[ks].y), a3 = bfhi(qw[ks].y), a4 = bflo(qw[ks].z), a5 = bfhi(qw[ks].z), a6 = bflo(qw[ks].w), a7 = bfhi(qw[ks].w);
          ss += (a0 * a0 + a1 * a1) + (a2 * a2 + a3 * a3) + (a4 * a4 + a5 * a5) + (a6 * a6 + a7 * a7); }
      ss += xor_lane<16>(ss); ss += xor_lane<32>(ss);
      const float rq = (1.f / sqrtf(ss * (1.f / HD) + RMS_EPS)) * 0.08838834764831845f * LOG2E;
#pragma unroll
      for (int ks = 0; ks < 4; ++ks) { const f32x4 g0 = *(const GAS f32x4*)(F.q_gain + 32 * ks + 8 * g), g1 = *(const GAS f32x4*)(F.q_gain + 32 * ks + 8 * g + 4);
          v4u o; o.x = pk2(bflo(qw[ks].x) * rq * g0.x, bfhi(qw[ks].x) * rq * g0.y); o.y = pk2(bflo(qw[ks].y) * rq * g0.z, bfhi(qw[ks].y) * rq * g0.w);
          o.z = pk2(bflo(qw[ks].z) * rq * g1.x, bfhi(qw[ks].z) * rq * g1.y); o.w = pk2(bflo(qw[ks].w) * rq * g1.z, bfhi(qw[ks].w) * rq * g1.w);
          Qf[tt][ks] = __builtin_bit_cast(bf16x8, o); } }
    const f32x4 kg0 = *(const GAS f32x4*)(F.k_gain + sdch * 8), kg1 = *(const GAS f32x4*)(F.k_gain + sdch * 8 + 4);
    f32x4 O[2][8]; float lsum[2] = {0.f, 0.f};
#pragma unroll
    for (int tt = 0; tt < 2; ++tt)
#pragma unroll
        for (int db = 0; db < 8; ++db) O[tt][db] = (f32x4){0.f, 0.f, 0.f, 0.f};
#pragma unroll
    for (int s = 0; s < NA_ROWS; ++s) { LAS unsigned char* slot = ring + (s & 1) * NA_SLOT;
#pragma unroll
        for (int q2 = 0; q2 < 2; ++q2) { const v4u w = RK[s & 1][q2];
            const float a0 = bflo(w.x), a1 = bfhi(w.x), a2 = bflo(w.y), a3 = bfhi(w.y), a4 = bflo(w.z), a5 = bfhi(w.z), a6 = bflo(w.w), a7 = bfhi(w.w);
            float ss = (a0 * a0 + a1 * a1) + (a2 * a2 + a3 * a3) + (a4 * a4 + a5 * a5) + (a6 * a6 + a7 * a7);
            ss += xor_lane<1>(ss); ss += xor_lane<2>(ss); ss += xor_lane<4>(ss); ss += xor_lane<8>(ss);
            const float rk = 1.f / sqrtf(ss * (1.f / HD) + RMS_EPS);
            v4u o; o.x = pk2(a0 * rk * kg0.x, a1 * rk * kg0.y); o.y = pk2(a2 * rk * kg0.z, a3 * rk * kg0.w); o.z = pk2(a4 * rk * kg1.x, a5 * rk * kg1.y); o.w = pk2(a6 * rk * kg1.z, a7 * rk * kg1.w);
            *(LAS v4u*)(slot + (skey + 32 * q2) * NA_KP + sdch * 16) = o;
            *(LAS v4u*)(slot + NA_KS + (skey + 32 * q2) * NA_VP + sdch * 16) = RV[s & 1][q2]; }
        if (s + 2 < NA_ROWS) NA_LOAD(s + 2);
        if constexpr (FILL) { if (s > 0) tr_store(FR, FI.dst, FI.ldk, lane); FI = ff_item(F, fill_it + s * fill_stride); tr_load(FR, FI.src, FI.ldw, FI.k0, FI.n0, lane); }
        __syncthreads();
        const int kr = b0 + s;
        if (kr >= rs && kr <= rs + 7) {
            f32x4 S[2][3];
#pragma unroll
            for (int tt = 0; tt < 2; ++tt)
#pragma unroll
                for (int b = 0; b < 3; ++b) S[tt][b] = (f32x4){-cbound, -cbound, -cbound, -cbound};
#pragma unroll
            for (int b = 0; b < 3; ++b)
#pragma unroll
                for (int ks = 0; ks < 4; ++ks) { const bf16x8 a = *(const LAS bf16x8*)(slot + (16 * (kb0 + b) + fr) * NA_KP + (32 * ks + 8 * g) * 2);
#pragma unroll
                    for (int tt = 0; tt < 2; ++tt) S[tt][b] = __builtin_amdgcn_mfma_f32_16x16x32_bf16(a, Qf[tt][ks], S[tt][b], 0, 0, 0); }
            s16x4 pf[2][3];
#pragma unroll
            for (int tt = 0; tt < 2; ++tt) { const int rbase = (kr - r + 7) * 31 + 15 - c[tt];
#pragma unroll
                for (int b = 0; b < 3; ++b) { float pv[4];
#pragma unroll
                    for (int i = 0; i < 4; ++i) { const int kc = 16 * (kb0 + b) + 4 * g + i; const bool ok = (kc >= cs[tt]) && (kc <= cs[tt] + 15);
                        int idx = rbase + kc; idx = ok ? idx : 0; const float e = __builtin_amdgcn_exp2f(S[tt][b][i]) * rpbL[idx]; pv[i] = ok ? e : 0.f; lsum[tt] += pv[i]; }
                    v2u pw; pw.x = pk2(pv[0], pv[1]); pw.y = pk2(pv[2], pv[3]); pf[tt][b] = __builtin_bit_cast(s16x4, pw); } }
#pragma unroll
            for (int b = 0; b < 3; ++b)
#pragma unroll
                for (int db = 0; db < 8; ++db) { const s16x4 vf = __builtin_amdgcn_ds_read_tr16_b64_v4i16((LAS s16x4*)(slot + NA_KS + (16 * (kb0 + b) + 4 * g + q4) * NA_VP + (32 * (db >> 1) + 8 * p4 + 4 * (db & 1)) * 2));
#pragma unroll
                    for (int tt = 0; tt < 2; ++tt) O[tt][db] = __builtin_amdgcn_mfma_f32_16x16x16bf16_1k(vf, pf[tt][b], O[tt][db], 0, 0, 0); }
        }
    }
#undef NA_LOAD
    if constexpr (FILL) tr_store(FR, FI.dst, FI.ldk, lane);
#pragma unroll
    for (int tt = 0; tt < 2; ++tt) { float l = lsum[tt]; l += xor_lane<16>(l); l += xor_lane<32>(l); const float inv = 1.f / l;
        const float inv8 = inv * F8_YSCALE;
        GAS unsigned char* ybase = (GAS unsigned char*)(F.ws + WS_YB); const int tokr = r * GRID_W + c[tt];
#pragma unroll
        for (int t = 0; t < 4; ++t) { const f32x4 a0 = O[tt][2 * t], a1 = O[tt][2 * t + 1]; v2u o;
            o.x = pk4_fp8(a0[0] * inv8, a0[1] * inv8, a0[2] * inv8, a0[3] * inv8); o.y = pk4_fp8(a1[0] * inv8, a1[1] * inv8, a1[2] * inv8, a1[3] * inv8);
            *(GAS v2u*)(ybase + pg8::blk_off(tokr, h * HD + 8 * g + 32 * t, NAW)) = o; } }
}

struct Args { const float* in[17]; float* out; unsigned char* ws; int ph_lo, ph_hi, li, pad; };
__global__ void __launch_bounds__(NWAVES * 64, 2) fwd_kernel(Args args) {
    extern __shared__ __attribute__((aligned(16))) unsigned char lds[];
    Frame F;
    F.lds = (LAS unsigned char*)lds;
    F.MISC = (volatile LAS unsigned*)(F.lds + MISC_OFF);
    F.tid = threadIdx.x; F.lane = F.tid & 63; F.wave = __builtin_amdgcn_readfirstlane(F.tid >> 6);
    F.G = gridDim.x; { const int bx = blockIdx.x; F.vcu = (F.G % 8 == 0) ? (bx % 8) * (F.G / 8) + bx / 8 : bx; }
    F.ws = args.ws; F.ctl = (gu32*)(args.ws + WS_CTL);
    F.x = args.in[0]; F.norm1_g = args.in[1]; F.w_in = args.in[2]; F.gm_ln_g = args.in[3]; F.gm_ln_b = args.in[4]; F.gm_w_s = args.in[5]; F.gm_b_s = args.in[6];
    F.q_gain = args.in[7]; F.k_gain = args.in[8]; F.na_rpb = args.in[9]; F.w_o_gm = args.in[10]; F.w_o_na = args.in[11]; F.w_out = args.in[12]; F.norm2_g = args.in[13];
    F.w_ff_gate = args.in[14]; F.w_ff_up = args.in[15]; F.w_ff_down = args.in[16]; F.out = args.out;
    for (int u = F.tid; u < (LDS_BYTES - LDSCTL_OFF) / 4; u += NWAVES * 64) ((LAS unsigned*)(F.lds + LDSCTL_OFF))[u] = 0u;
    __syncthreads();
    XcdBarrier bar; bar.bar = (unsigned*)(F.ctl + CW_BAR); bar.x = 0; bar.st = nullptr;
    if (N_LAUNCHES != PER_PHASE) bar = xcd_barrier_post((unsigned*)(F.ctl + CW_BAR), F.MISC + 8);
#define GRID_BAR() do { if (N_LAUNCHES != PER_PHASE) xcd_barrier(bar); } while (0)
    const int lo = args.ph_lo, hi = args.ph_hi < MK_STOP_AFTER + 1 ? args.ph_hi : MK_STOP_AFTER + 1;
#define IN(k) (lo <= (k) && (k) < hi)
#define BOTH(k) (IN(k) && IN((k) + 1))
    const int bx = (int)blockIdx.x;

    if (IN(0)) { _Pragma("unroll") for (int rep = 0; rep < NREP(0); ++rep) { p0_prologue(F); if (BOTH(0)) GRID_BAR(); } }

    if (IN(1)) _Pragma("unroll") for (int rep = 0; rep < NREP(1); ++rep) {
        { pg8::SchedP1a S; S.o.init(M, 16 * 256, F.G, bx); S.A = (const char*)(F.ws + WS_RA); S.B = (const char*)(F.ws + WS_WIN); S.tstep = (size_t)256 * D * 2;
          pg8::EpiProj E{(bf16*)(F.ws + WS_RB), M, 1.f, (float*)(F.ws + WS_PART)};
          stagger(MK_STAGGER_US); pg8::gemm_phase<pg8::EpiProj, pg8::SchedP1a, true, true>(F.lds, D, S, E); }
        { pg8::SchedP1b S; S.o.init(M, 56 * 256, F.G, bx); S.A8 = (const char*)(F.ws + WS_XN8); S.B8 = (const char*)(F.ws + WS_WQKV8); S.tstep8 = (size_t)256 * D;
          pg8::EpiQKV E{(bf16*)(F.ws + WS_RB), M, F8_UNSCALE, F.ws + WS_GA, F.ws + WS_GB};
          pg8::gemm_phase_f8<pg8::EpiQKV, pg8::SchedP1b>(F.lds, D, S, E); }
        if (BOTH(1)) GRID_BAR();
    }
    if (IN(2)) _Pragma("unroll") for (int rep = 0; rep < NREP(2); ++rep) {
        for (int u = bx; u < 2 * (M / CHUNK); u += F.G) gmlp_unit(F, u >> 1, u & 1);
#if defined(MK_PROBE_NA)
        for (int rep = 0; rep < args.pad + 2; ++rep)
#endif
        float cbound;
        { const int ln = opaque_tid() & 63; float mq = fmaxf(fabsf(F.q_gain[2 * ln]), fabsf(F.q_gain[2 * ln + 1])), mk = fmaxf(fabsf(F.k_gain[2 * ln]), fabsf(F.k_gain[2 * ln + 1]));
          mq = fmaxf(mq, xor_lane<1>(mq)); mq = fmaxf(mq, xor_lane<2>(mq)); mq = fmaxf(mq, xor_lane<4>(mq)); mq = fmaxf(mq, xor_lane<8>(mq)); mq = fmaxf(mq, xor_lane<16>(mq)); mq = fmaxf(mq, xor_lane<32>(mq));
          mk = fmaxf(mk, xor_lane<1>(mk)); mk = fmaxf(mk, xor_lane<2>(mk)); mk = fmaxf(mk, xor_lane<4>(mk)); mk = fmaxf(mk, xor_lane<8>(mk)); mk = fmaxf(mk, xor_lane<16>(mk)); mk = fmaxf(mk, xor_lane<32>(mk));
          cbound = 11.313708498984761f * 1.01f * LOG2E * mq * mk; }
        {
            const int gwv = F.vcu * NWAVES + F.wave, NGW = F.G * NWAVES, per_wave = (FF_ITEMS_P2 + NGW - 1) / NGW, nfill = (per_wave + NA_ROWS - 1) / NA_ROWS; int ui = 0, done = 0;
            for (int u = F.vcu; u < (GRID_H / 4) * NHEAD; u += F.G, ++ui) {
                if (ui < nfill) { na_unit<true>(F, u & (GRID_H / 4 - 1), u >> 6, cbound, gwv + done * NGW, NGW); done += NA_ROWS; }
                else na_unit<false>(F, u & (GRID_H / 4 - 1), u >> 6, cbound, 0, 0); }
            const int ln = opaque_tid() & 63;
            for (int it = gwv + done * NGW; it < FF_ITEMS_P2; it += NGW) { TrRegs R; const FillItem I = ff_item(F, it); tr_load(R, I.src, I.ldw, I.k0, I.n0, ln); tr_store(R, I.dst, I.ldk, ln); }
        }
        if (BOTH(2)) GRID_BAR();
    }
    if (IN(3)) _Pragma("unroll") for (int rep = 0; rep < NREP(3); ++rep) {
        { pg8::SchedMerge S; S.o.init(M, D, F.G, bx); S.A0 = (const char*)(F.ws + WS_YB); S.B0 = (const char*)(F.ws + WS_WOB); S.A1 = (const char*)(F.ws + WS_YA); S.B1 = (const char*)(F.ws + WS_WOA); S.tstep = (size_t)256 * GMW * 2; S.tstep8 = (size_t)256 * NAW;
          pg8::EpiMix E{F.ws + WS_GA, F.ws + WS_GB, (bf16*)(F.ws + WS_MRG), F8_YUNSCALE};
          stagger(MK_STAGGER_US); pg8::gemm_phase_mix<pg8::EpiMix, pg8::SchedMerge>(F.lds, 0, NAW / 128, GMW / 64, S, E); }
        if (BOTH(3)) GRID_BAR();
    }
    if (IN(4)) _Pragma("unroll") for (int rep = 0; rep < NREP(4); ++rep) {
        pg8::SchedPlain S; S.o.init(M, D, F.G, bx); S.A = (const char*)(F.ws + WS_MRG); S.B = (const char*)(F.ws + WS_WOUT); S.tstep = (size_t)256 * D * 2;
        pg8::EpiOutNorm E{F.x, (bf16*)(F.ws + WS_H16), (bf16*)(F.ws + WS_RA), F.norm2_g, (float*)(F.ws + WS_PART)};
        stagger(MK_STAGGER_US); pg8::gemm_phase<pg8::EpiOutNorm, pg8::SchedPlain, true, true>(F.lds, D, S, E);
        if (BOTH(4)) GRID_BAR();
    }
    if (IN(6)) _Pragma("unroll") for (int rep = 0; rep < NREP(6); ++rep) {
        pg8::SchedPlain S; S.o.init(M, NGU, F.G, bx); S.A = (const char*)(F.ws + WS_RA); S.B = (const char*)(F.ws + WS_WGU); S.tstep = (size_t)256 * D * 2;
        LAS float* rtab = (LAS float*)(F.lds + 135168); const int fm = 8 * (bx & 7);
        { const int t5 = opaque_tid(); const float* part = (const float*)(F.ws + WS_PART);
          for (int r = t5; r < 2048; r += NWAVES * 64) { const GAS f32x4* p = (const GAS f32x4*)(part + (size_t)(fm * 256 + r) * 64); float sacc = 0.f;
#pragma unroll
              for (int j = 0; j < 16; ++j) { const f32x4 v = p[j]; sacc += (v.x + v.y) + (v.z + v.w); }
              rtab[r] = 1.f / sqrtf(sacc * (1.f / D) + RMS_EPS); }
          __syncthreads(); }
        pg8::EpiSwiglu E{(bf16*)(F.ws + WS_ACT), DFF, rtab, fm};
        stagger(MK_STAGGER_US); pg8::gemm_phase<pg8::EpiSwiglu, pg8::SchedPlain, true, true>(F.lds, D, S, E);
        {
            const int rem = S.o.nwg % F.G, first = rem, nidle = rem ? F.G - rem : F.G;
            if (bx >= first || rem == 0) { const int ln = opaque_tid() & 63, w0 = ((rem ? bx - first : bx) * NWAVES + F.wave), NW = nidle * NWAVES;
                for (int it = FF_ITEMS_P2 + w0; it < FF_ITEMS; it += 2 * NW) { const int it2 = it + NW; TrRegs Ra, Rb; const FillItem Ia = ff_item(F, it), Ib = ff_item(F, it2);
                    tr_load(Ra, Ia.src, Ia.ldw, Ia.k0, Ia.n0, ln); tr_load(Rb, Ib.src, Ib.ldw, Ib.k0, Ib.n0, ln); tr_store(Ra, Ia.dst, Ia.ldk, ln); tr_store(Rb, Ib.dst, Ib.ldk, ln); } } }
        if (BOTH(6)) GRID_BAR();
    }
    if (IN(7)) {
        pg8::SchedPlain S; S.o.init(M, D, F.G, bx); S.A = (const char*)(F.ws + WS_ACT); S.B = (const char*)(F.ws + WS_WD); S.tstep = (size_t)256 * DFF * 2;
        pg8::EpiResH16 E{(const bf16*)(F.ws + WS_H16), F.out};
        stagger(MK_STAGGER_US); pg8::gemm_phase<pg8::EpiResH16, pg8::SchedPlain, true, true>(F.lds, DFF, S, E);
    }

#if MK_STOP_AFTER < 4
    {
        GRID_BAR();
        const bf16* pU = (const bf16*)(F.ws + WS_U); const bf16* pV = (const bf16*)(F.ws + WS_V); const bf16* pQ = (const bf16*)(F.ws + WS_Q); const bf16* pK = (const bf16*)(F.ws + WS_K); const bf16* pVV = (const bf16*)(F.ws + WS_VV);
        const bf16* pGA = (const bf16*)(F.ws + WS_GA); const bf16* pGB = (const bf16*)(F.ws + WS_GB); const bf16* pYA = (const bf16*)(F.ws + WS_YA); const bf16* pYB = (const bf16*)(F.ws + WS_YB); const bf16* pM = (const bf16*)(F.ws + WS_MRG);
        for (size_t i = (size_t)bx * 512 + F.tid; i < (size_t)M * D; i += (size_t)F.G * 512) { const size_t m = i >> 12; const int c = (int)(i & 4095), c2 = c & 2047; float v;
            if (MK_STOP_AFTER == 1) v = 0.f * bflo(pGA[i]) + 0.f * bflo(pGB[i]) + 8.f * bflo(((const bf16*)(F.ws + WS_WOA))[(m & 4095) * 2048 + c2]) + 9.f * bflo(((const bf16*)(F.ws + WS_WOB))[(m & 4095) * 2048 + c2]) + 10.f * bflo(((const bf16*)(F.ws + WS_WOUT))[(m & 4095) * 4096 + c]);
            else if (MK_STOP_AFTER == 2) v = c < 2048 ? bflo(pYA[m * 2048 + c2]) : bflo(pYB[m * 2048 + c2]);
            else if (MK_STOP_AFTER == 3) v = bflo(pM[i]);
            else v = F.x[i];
            F.out[i] = v; }
    }
#endif
#if defined(MK_PROBE_P7)
    {
        GRID_BAR();
        pg8::SchedPlain S; S.o.init(M, D, F.G, bx); S.A = (const char*)(F.ws + WS_ACT); S.B = (const char*)(F.ws + WS_WD); S.tstep = (size_t)256 * DFF * 2;
        pg8::EpiResF32 E{F.out, (float*)(F.ws + WS_END)};
        pg8::gemm_phase<pg8::EpiResF32, pg8::SchedPlain, true, true>(F.lds, DFF, S, E);
    }
#endif
#undef IN
#undef BOTH
#undef GRID_BAR
}

extern "C" void kernel_launch(void* const* d_in, const int* in_sizes, int n_in, void* d_out, int out_size, void* d_ws, size_t ws_size, hipStream_t stream) {
    static int grid = 0;
    if (grid == 0) {
        if (n_in != 17 || in_sizes[0] != M * D || out_size != M * D || ws_size < WS_END) { fprintf(stderr, "kernel_launch: unexpected shapes/workspace (n_in %d, in0 %d, out %d, ws %zu < %zu); nothing launched\n", n_in, n_in > 0 ? in_sizes[0] : -1, out_size, ws_size, (size_t)WS_END); grid = -1; return; }
        int dev = 0, cus = 0, per_cu = 0;
        if (hipGetDevice(&dev) != hipSuccess || hipDeviceGetAttribute(&cus, hipDeviceAttributeMultiprocessorCount, dev) != hipSuccess) { grid = -1; return; }
        if (hipFuncSetAttribute((const void*)fwd_kernel, hipFuncAttributeMaxDynamicSharedMemorySize, LDS_BYTES) != hipSuccess) { fprintf(stderr, "kernel_launch: hipFuncSetAttribute failed\n"); grid = -1; return; }
        if (hipOccupancyMaxActiveBlocksPerMultiprocessor(&per_cu, (const void*)fwd_kernel, NWAVES * 64, LDS_BYTES) != hipSuccess || per_cu < 1) fprintf(stderr, "kernel_launch: occupancy query reports %d\n", per_cu);
        (void)hipGetLastError();
        grid = cus - cus % 8;
    }
    if (grid < 0) return;
    if (hipMemsetAsync((char*)d_ws + WS_CTL, 0, CTL_ZERO_BYTES, stream) != hipSuccess) return;
    Args a{};
    for (int i = 0; i < 17; ++i) a.in[i] = (const float*)d_in[i];
    a.out = (float*)d_out; a.ws = (unsigned char*)d_ws;
    for (int li = 0; li < N_LAUNCHES; ++li) {
        if (N_LAUNCHES == PER_PHASE) { a.ph_lo = li; a.ph_hi = li + 1; } else { a.ph_lo = 0; a.ph_hi = PER_PHASE; }
        a.li = li; a.pad = 0;
        hipLaunchKernelGGL(fwd_kernel, dim3(grid), dim3(NWAVES * 64), LDS_BYTES, stream, a);
        const hipError_t le = hipPeekAtLastError();
        if (le != hipSuccess) { fprintf(stderr, "kernel_launch: launch %d failed: %s\n", li, hipGetErrorName(le)); break; }
    }
}
```

```cpp
#include <hip/hip_runtime.h>
#include <cstdio>
#include <cstdint>

#ifndef MK_N_LAUNCHES
#define MK_N_LAUNCHES 1
#endif
#ifndef MK_REPEAT
#define MK_REPEAT 0
#endif
#define NREP(k) (((MK_REPEAT >> (k)) & 1) + 1)
#ifndef MK_STOP_AFTER
#define MK_STOP_AFTER 7
#endif

__device__ __forceinline__ int opaque_tid() { int t = (int)threadIdx.x; asm volatile("" : "+v"(t)); return t; }
namespace pg8 {
#define PG8_LAS __attribute__((address_space(3)))
typedef unsigned short bf16_t;
typedef short bf16x8 __attribute__((ext_vector_type(8)));
typedef float f32x4 __attribute__((ext_vector_type(4)));
typedef float f32x2 __attribute__((ext_vector_type(2)));
typedef unsigned u32x4 __attribute__((ext_vector_type(4)));
typedef unsigned u32x2 __attribute__((ext_vector_type(2)));
constexpr int BM = 256, BK = 64, HALF = 128, HTB = HALF * BK * 2  , STAGE_BYTES = 8 * HTB, NXCD = 8, WGM = 8;

__host__ __device__ __forceinline__ int lds_byte(int r, int c) { const int st = (r >> 4) * 2 + (c >> 5), rr = r & 15, cc = c & 31, ob = rr * 64 + cc * 2; return st * 1024 + (ob ^ (((ob >> 9) & 1) << 5)); }
__host__ __device__ __forceinline__ void stage_rc(int b, int& R, int& C) { const int st = b / 1024, sb = b % 1024, swz = sb ^ (((sb >> 9) & 1) << 5); R = (st >> 1) * 16 + swz / 64; C = (st & 1) * 32 + (swz % 64) / 2; }
__host__ __device__ __forceinline__ int perm32(int rho) { const int n = rho >> 4, i = rho & 15; return 8 * (i >> 2) + 4 * n + (i & 3); }

__host__ __device__ __forceinline__ int invperm32(int w) { return 16 * ((w >> 2) & 1) + 4 * (w >> 3) + (w & 3); }
__host__ __device__ __forceinline__ size_t blk_off(int row, int kb, int KB) { return ((size_t)(row >> 8) * (KB >> 7) + (kb >> 7)) * 32768 + ((row >> 7) & 1) * 16384 + lds_byte(row & 127, (kb & 127) >> 1) + (kb & 1); }
__host__ __device__ __forceinline__ int img_off_w(int nloc, int c) { const int w = nloc & 127; return (nloc >> 7) * 16384 + lds_byte((w & ~31) + invperm32(w & 31), c); }
struct Unit { int pm, pn, sub; };

struct StaticOrder {
    int nM, nN, nwg, G, c;
    __host__ __device__ void init(int M, int N, int G_, int c_) { nM = M / BM; nN = N / BM; nwg = nM * nN; G = G_; c = c_; }
    __host__ __device__ bool tile(int i, Unit& u) const {
        const long L = (long)i * G + c; if (L >= nwg) return false;
        int wgid = (int)L; { const int q = nwg / NXCD, r = nwg % NXCD, xcd = wgid % NXCD, off = wgid / NXCD; wgid = (xcd < r ? xcd * (q + 1) : r * (q + 1) + (xcd - r) * q) + off; }
        const int nig = WGM * nN, gid = wgid / nig, fm = gid * WGM, gsz = (nM - fm) < WGM ? (nM - fm) : WGM;
        u.pm = fm + ((wgid % nig) % gsz); u.pn = (wgid % nig) / gsz; u.sub = 0; return true;
    }
};
struct SchedPlain {
    StaticOrder o; const char* A; const char* B; size_t tstep;
    __device__ __forceinline__ bool next(int i, Unit& u) const { return o.tile(i, u); }
    __device__ __forceinline__ void ptrs(const Unit& u, const char*& a, const char*& b) const { a = A + (size_t)u.pm * tstep; b = B + (size_t)u.pn * tstep; }
};
struct SchedP1a {
    StaticOrder o; const char* A; const char* B; size_t tstep;
    __device__ __forceinline__ bool next(int i, Unit& u) const { const bool ok = o.tile(i, u); u.pn = u.pn < 16 ? u.pn : u.pn + 24; return ok; }
    __device__ __forceinline__ void ptrs(const Unit& u, const char*& a, const char*& b) const { a = A + (size_t)u.pm * tstep; b = B + (size_t)u.pn * tstep; }
};
struct SchedP1b {
    StaticOrder o; const char* A8; const char* B8; size_t tstep8;
    __device__ __forceinline__ bool next(int i, Unit& u) const { const bool ok = o.tile(i, u); u.sub = u.pn; u.pn = u.pn + 16; return ok; }
    __device__ __forceinline__ void ptrs(const Unit& u, const char*& a, const char*& b) const { a = A8 + (size_t)u.pm * tstep8; b = B8 + (size_t)u.sub * tstep8; }
};
struct SchedMerge {
    StaticOrder o; const char* A0; const char* B0; const char* A1; const char* B1; size_t tstep; size_t tstep8;
    __device__ __forceinline__ bool next(int i, Unit& u) const { const bool ok = o.tile(i >> 1, u); u.sub = i & 1; return ok; }
    __device__ __forceinline__ void ptrs(const Unit& u, const char*& a, const char*& b) const { a = (u.sub ? A1 : A0) + (size_t)u.pm * tstep; b = (u.sub ? B1 : B0) + (size_t)u.pn * tstep; }
};

typedef __bf16 bf16x2v __attribute__((ext_vector_type(2)));
__device__ __forceinline__ unsigned cvt_pk_bf16(float lo, float hi) { const bf16x2v v = __builtin_convertvector((f32x2){lo, hi}, bf16x2v); return __builtin_bit_cast(unsigned, v); }
__device__ __forceinline__ float bf_lo(unsigned w) { return __uint_as_float(w << 16); }
__device__ __forceinline__ float bf_hi(unsigned w) { return __uint_as_float(w & 0xffff0000u); }
__device__ __forceinline__ f32x2 gelu_pk(f32x2 v) {
    const f32x2 av = __builtin_elementwise_abs(v), d = av * 0.2316418882f + 1.0f;
    f32x2 t; t.x = __builtin_amdgcn_rcpf(d.x); t.y = __builtin_amdgcn_rcpf(d.y);
    f32x2 q = t * 0.5307027145f + (-0.7265760135f); q = q * t + 0.7107068705f; q = q * t + (-0.142248368f); q = q * t + 0.127414796f; q = q * t;
    const f32x2 s = (v * v) * (-0.72134752044f);
    f32x2 e; e.x = __builtin_amdgcn_exp2f(s.x); e.y = __builtin_amdgcn_exp2f(s.y);
    const f32x2 m = v * (q * e), r = v - m;
    f32x2 o; o.x = v.x < 0.f ? m.x : r.x; o.y = v.y < 0.f ? m.y : r.y; return o;
}
__device__ __forceinline__ float sigmoid_f(float x) { return __builtin_amdgcn_rcpf(1.0f + __builtin_amdgcn_exp2f(x * -1.44269504089f)); }
__device__ __forceinline__ f32x4 gelu4(f32x4 v) { const f32x2 a = gelu_pk((f32x2){v[0], v[1]}), b = gelu_pk((f32x2){v[2], v[3]}); return (f32x4){a.x, a.y, b.x, b.y}; }
__device__ __forceinline__ f32x4 sigm4(f32x4 v) { return (f32x4){sigmoid_f(v[0]), sigmoid_f(v[1]), sigmoid_f(v[2]), sigmoid_f(v[3])}; }
__device__ __forceinline__ u32x4 pack8(f32x4 v0, f32x4 v1) { u32x4 w; w.x = cvt_pk_bf16(v0[0], v0[1]); w.y = cvt_pk_bf16(v0[2], v0[3]); w.z = cvt_pk_bf16(v1[0], v1[1]); w.w = cvt_pk_bf16(v1[2], v1[3]); return w; }

__device__ __forceinline__ size_t lane_tile_idx(int T, int wr, int wc, int fr, int fq, int ai, int m, int bj) { return ((size_t)T * 128 + (((wr * 4 + wc) * 2 + ai) * 4 + m) * 2 + bj) * 64 + fr + 16 * fq; }
__device__ __forceinline__ unsigned pack_u8x4(f32x4 v) { const f32x4 q = v * 255.f + 0.5f; return (unsigned)q[0] | ((unsigned)q[1] << 8) | ((unsigned)q[2] << 16) | ((unsigned)q[3] << 24); }
__device__ __forceinline__ f32x4 unpack_u8x4(unsigned w) { return (f32x4){(float)(w & 0xffu), (float)((w >> 8) & 0xffu), (float)((w >> 16) & 0xffu), (float)(w >> 24)}; }
struct EpiProj {
    static constexpr bool PERM = true;
    bf16_t* base; int M; float qkv_scale;
    float* vstat;
    __device__ __forceinline__ void store_v(const f32x4 (&acc)[2][2][4][2], bf16_t* O, int row0, int col0, int slice, int fq, size_t bjs) const {
#pragma unroll
        for (int ai = 0; ai < 2; ++ai)
#pragma unroll
            for (int m = 0; m < 4; ++m) { const int row = row0 + ai * HALF + m * 16; bf16_t* rowp = O + (size_t)row * 128 + col0; float s = 0.f, s2 = 0.f;
#pragma unroll
                for (int bj = 0; bj < 2; ++bj) { const f32x4 v0 = gelu4(acc[ai][bj][m][0]), v1 = gelu4(acc[ai][bj][m][1]);
                    s += ((v0[0] + v0[1]) + (v0[2] + v0[3])) + ((v1[0] + v1[1]) + (v1[2] + v1[3]));
                    s2 += ((v0[0] * v0[0] + v0[1] * v0[1]) + (v0[2] * v0[2] + v0[3] * v0[3])) + ((v1[0] * v1[0] + v1[1] * v1[1]) + (v1[2] * v1[2] + v1[3] * v1[3]));
                    *(u32x4*)(rowp + bj * bjs) = pack8(v0, v1); }
                s += __shfl_xor(s, 16); s += __shfl_xor(s, 32); s2 += __shfl_xor(s2, 16); s2 += __shfl_xor(s2, 32);
                if (fq == 0) *(f32x2*)(vstat + (size_t)row * 64 + 2 * slice) = (f32x2){s, s2}; }
    }
    __device__ __forceinline__ bool keep(const Unit&) const { return false; }
    template <int ACT> __device__ __forceinline__ void store(const f32x4 (&acc)[2][2][4][2], bf16_t* O, int ldc, int row0, int col0, size_t bjs) const {
#pragma unroll
        for (int ai = 0; ai < 2; ++ai)
#pragma unroll
            for (int m = 0; m < 4; ++m) { bf16_t* rowp = O + (size_t)(row0 + ai * HALF + m * 16) * ldc + col0;
#pragma unroll
                for (int bj = 0; bj < 2; ++bj) { f32x4 v0 = acc[ai][bj][m][0], v1 = acc[ai][bj][m][1];
                    if (ACT == 0) { v0 = v0 * qkv_scale; v1 = v1 * qkv_scale; }
                    if (ACT == 1) { v0 = gelu4(v0); v1 = gelu4(v1); }
                    if (ACT == 2) { v0 = sigm4(v0); v1 = sigm4(v1); }
                    *(u32x4*)(rowp + bj * bjs) = pack8(v0, v1); } }
    }
    __device__ __forceinline__ void operator()(f32x4 (&acc)[2][2][4][2], const Unit& u, int wr, int wc, int fr, int fq) const {
        const int row0 = u.pm * BM + wr * 64 + fr, pn = u.pn;
        if (pn < 40) { const int t = pn >> 3; const size_t hs = (size_t)M * 128; bf16_t* O = base + (size_t)t * M * 2048 + (size_t)(2 * (pn & 7)) * hs; const int col0 = wc * 32 + 8 * fq;
            if (t == 0) store<1>(acc, O, 128, row0, col0, hs); else if (t == 1) store_v(acc, O, row0, col0, (pn & 7) * 4 + wc, fq, hs); else store<0>(acc, O, 128, row0, col0, hs); }
        else { const int t = (pn - 40) >> 4; bf16_t* O = base + (size_t)5 * M * 2048 + (size_t)t * M * 4096; const int col0 = ((pn - 40) & 15) * BM + wc * 32 + 8 * fq;
            store<2>(acc, O, 4096, row0, col0, HALF); }
    }
};
struct EpiQKV {
    static constexpr bool PERM = true;
    bf16_t* base; int M; float sc; unsigned char* ga8; unsigned char* gb8;
    __device__ __forceinline__ void store_gate(const f32x4 (&acc)[2][2][4][2], unsigned char* O8, int T, int wr, int wc, int fr, int fq) const {
#pragma unroll
        for (int ai = 0; ai < 2; ++ai)
#pragma unroll
            for (int m = 0; m < 4; ++m)
#pragma unroll
                for (int bj = 0; bj < 2; ++bj) { const f32x4 v0 = sigm4(acc[ai][bj][m][0] * sc), v1 = sigm4(acc[ai][bj][m][1] * sc);
                    *(u32x2*)(O8 + lane_tile_idx(T, wr, wc, fr, fq, ai, m, bj) * 8) = (u32x2){pack_u8x4(v0), pack_u8x4(v1)}; }
    }
    __device__ __forceinline__ bool keep(const Unit&) const { return false; }
    template <int ACT> __device__ __forceinline__ void store(const f32x4 (&acc)[2][2][4][2], bf16_t* O, int ldc, int row0, int col0, size_t bjs) const {
#pragma unroll
        for (int ai = 0; ai < 2; ++ai)
#pragma unroll
            for (int m = 0; m < 4; ++m) { bf16_t* rowp = O + (size_t)(row0 + ai * HALF + m * 16) * ldc + col0;
#pragma unroll
                for (int bj = 0; bj < 2; ++bj) { f32x4 v0 = acc[ai][bj][m][0] * sc, v1 = acc[ai][bj][m][1] * sc;
                    if (ACT == 2) { v0 = sigm4(v0); v1 = sigm4(v1); }
                    *(u32x4*)(rowp + bj * bjs) = pack8(v0, v1); } }
    }
    __device__ __forceinline__ void operator()(f32x4 (&acc)[2][2][4][2], const Unit& u, int wr, int wc, int fr, int fq) const {
        const int row0 = u.pm * BM + wr * 64 + fr;
        if (u.pn < 40) store<0>(acc, base + (size_t)(u.pn >> 3) * M * 2048 + (size_t)(2 * (u.pn & 7)) * M * 128, 128, row0, wc * 32 + 8 * fq, (size_t)M * 128);
        else store_gate(acc, u.pn < 56 ? ga8 : gb8, u.pm * 16 + ((u.pn - 40) & 15), wr, wc, fr, fq);
    }
};
struct EpiTB {
    static constexpr bool PERM = true;
    const unsigned char* GB; bf16_t* T; float sc;
    __device__ __forceinline__ bool keep(const Unit&) const { return false; }
    __device__ __forceinline__ void operator()(f32x4 (&acc)[2][2][4][2], const Unit& u, int wr, int wc, int fr, int fq) const {
        const int row0 = u.pm * BM + wr * 64 + fr, col0 = u.pn * BM + wc * 32 + 8 * fq;
#pragma unroll
        for (int ai = 0; ai < 2; ++ai)
#pragma unroll
            for (int m = 0; m < 4; ++m) { const size_t off = (size_t)(row0 + ai * HALF + m * 16) * 4096 + col0;
#pragma unroll
                for (int bj = 0; bj < 2; ++bj) { const u32x2 b = *(const u32x2*)(GB + off + bj * HALF);
                    const f32x4 s0 = unpack_u8x4(b.x) * sc, s1 = unpack_u8x4(b.y) * sc;
                    *(u32x4*)(T + off + bj * HALF) = pack8(acc[ai][bj][m][0] * s0, acc[ai][bj][m][1] * s1); } }
    }
};
struct EpiMergeA {
    static constexpr bool PERM = true;
    const unsigned char* GA; const bf16_t* T; bf16_t* O;
    __device__ __forceinline__ bool keep(const Unit&) const { return false; }
    __device__ __forceinline__ void operator()(f32x4 (&acc)[2][2][4][2], const Unit& u, int wr, int wc, int fr, int fq) const {
        const int row0 = u.pm * BM + wr * 64 + fr, col0 = u.pn * BM + wc * 32 + 8 * fq;
#pragma unroll
        for (int ai = 0; ai < 2; ++ai)
#pragma unroll
            for (int m = 0; m < 4; ++m) { const size_t off = (size_t)(row0 + ai * HALF + m * 16) * 4096 + col0;
#pragma unroll
                for (int bj = 0; bj < 2; ++bj) { const u32x2 a = *(const u32x2*)(GA + off + bj * HALF); const u32x4 t = *(const u32x4*)(T + off + bj * HALF);
                    const f32x4 s0 = unpack_u8x4(a.x) * (1.f / 255.f), s1 = unpack_u8x4(a.y) * (1.f / 255.f);
                    const f32x4 t0 = (f32x4){bf_lo(t.x), bf_hi(t.x), bf_lo(t.y), bf_hi(t.y)}, t1 = (f32x4){bf_lo(t.z), bf_hi(t.z), bf_lo(t.w), bf_hi(t.w)};
                    *(u32x4*)(O + off + bj * HALF) = pack8(acc[ai][bj][m][0] * s0 + t0, acc[ai][bj][m][1] * s1 + t1); } }
    }
};
struct EpiMix {
    static constexpr bool PERM = true;
    const unsigned char* GA; const unsigned char* GB; bf16_t* O; float c;
    __device__ __forceinline__ bool keep(const Unit& u) const { return u.sub == 0; }
    __device__ __forceinline__ void operator()(f32x4 (&acc)[2][2][4][2], const Unit& u, int wr, int wc, int fr, int fq) const {
        const int row0 = u.pm * BM + wr * 64 + fr, col0 = u.pn * BM + wc * 32 + 8 * fq;
        if (u.sub == 0) {
#pragma unroll
            for (int ai = 0; ai < 2; ++ai)
#pragma unroll
                for (int m = 0; m < 4; ++m) { const size_t off = (size_t)(row0 + ai * HALF + m * 16) * 4096 + col0;
#pragma unroll
                    for (int bj = 0; bj < 2; ++bj) { const size_t gi = lane_tile_idx(u.pm * 16 + u.pn, wr, wc, fr, fq, ai, m, bj) * 8; (void)off; const u32x2 a = *(const u32x2*)(GA + gi), b = *(const u32x2*)(GB + gi);
                        f32x4 a0 = __builtin_elementwise_max(unpack_u8x4(a.x), (f32x4){9.5367431640625e-7f, 9.5367431640625e-7f, 9.5367431640625e-7f, 9.5367431640625e-7f});
                        f32x4 a1 = __builtin_elementwise_max(unpack_u8x4(a.y), (f32x4){9.5367431640625e-7f, 9.5367431640625e-7f, 9.5367431640625e-7f, 9.5367431640625e-7f});
                        const f32x4 r0 = (f32x4){__builtin_amdgcn_rcpf(a0[0]), __builtin_amdgcn_rcpf(a0[1]), __builtin_amdgcn_rcpf(a0[2]), __builtin_amdgcn_rcpf(a0[3])};
                        const f32x4 r1 = (f32x4){__builtin_amdgcn_rcpf(a1[0]), __builtin_amdgcn_rcpf(a1[1]), __builtin_amdgcn_rcpf(a1[2]), __builtin_amdgcn_rcpf(a1[3])};
                        acc[ai][bj][m][0] = acc[ai][bj][m][0] * (unpack_u8x4(b.x) * c) * r0; acc[ai][bj][m][1] = acc[ai][bj][m][1] * (unpack_u8x4(b.y) * c) * r1; } }
        } else {
#pragma unroll
            for (int ai = 0; ai < 2; ++ai)
#pragma unroll
                for (int m = 0; m < 4; ++m) { const size_t off = (size_t)(row0 + ai * HALF + m * 16) * 4096 + col0;
#pragma unroll
                    for (int bj = 0; bj < 2; ++bj) { const u32x2 a = *(const u32x2*)(GA + lane_tile_idx(u.pm * 16 + u.pn, wr, wc, fr, fq, ai, m, bj) * 8);
                        const f32x4 a0 = __builtin_elementwise_max(unpack_u8x4(a.x), (f32x4){9.5367431640625e-7f, 9.5367431640625e-7f, 9.5367431640625e-7f, 9.5367431640625e-7f}) * (1.f / 255.f);
                        const f32x4 a1 = __builtin_elementwise_max(unpack_u8x4(a.y), (f32x4){9.5367431640625e-7f, 9.5367431640625e-7f, 9.5367431640625e-7f, 9.5367431640625e-7f}) * (1.f / 255.f);
                        *(u32x4*)((char*)O + blk_off(row0 + ai * HALF + m * 16, (col0 + bj * HALF) * 2, 8192)) = pack8(acc[ai][bj][m][0] * a0, acc[ai][bj][m][1] * a1); (void)off; } }
        }
    }
};
__device__ __forceinline__ float sb_lo(unsigned w) { return fmaxf(bf_lo(w), 8.673617379884035e-19f); }
__device__ __forceinline__ float sb_hi(unsigned w) { return fmaxf(bf_hi(w), 8.673617379884035e-19f); }
struct EpiMerge {
    static constexpr bool PERM = true;
    const bf16_t* GA; const bf16_t* GB; bf16_t* O;
    __device__ __forceinline__ bool keep(const Unit& u) const { return u.sub == 0; }
    __device__ __forceinline__ void operator()(f32x4 (&acc)[2][2][4][2], const Unit& u, int wr, int wc, int fr, int fq) const {
        const int row0 = u.pm * BM + wr * 64 + fr, col0 = u.pn * BM + wc * 32 + 8 * fq;
        if (u.sub == 0) {
#pragma unroll
            for (int ai = 0; ai < 2; ++ai)
#pragma unroll
                for (int m = 0; m < 4; ++m) { const size_t off = (size_t)(row0 + ai * HALF + m * 16) * 4096 + col0;
#pragma unroll
                    for (int bj = 0; bj < 2; ++bj) { const u32x4 a = *(const u32x4*)(GA + off + bj * HALF), b = *(const u32x4*)(GB + off + bj * HALF);
                        f32x4 r0, r1;
                        r0[0] = bf_lo(a.x) * __builtin_amdgcn_rcpf(sb_lo(b.x)); r0[1] = bf_hi(a.x) * __builtin_amdgcn_rcpf(sb_hi(b.x));
                        r0[2] = bf_lo(a.y) * __builtin_amdgcn_rcpf(sb_lo(b.y)); r0[3] = bf_hi(a.y) * __builtin_amdgcn_rcpf(sb_hi(b.y));
                        r1[0] = bf_lo(a.z) * __builtin_amdgcn_rcpf(sb_lo(b.z)); r1[1] = bf_hi(a.z) * __builtin_amdgcn_rcpf(sb_hi(b.z));
                        r1[2] = bf_lo(a.w) * __builtin_amdgcn_rcpf(sb_lo(b.w)); r1[3] = bf_hi(a.w) * __builtin_amdgcn_rcpf(sb_hi(b.w));
                        acc[ai][bj][m][0] *= r0; acc[ai][bj][m][1] *= r1; } }
        } else {
#pragma unroll
            for (int ai = 0; ai < 2; ++ai)
#pragma unroll
                for (int m = 0; m < 4; ++m) { const size_t off = (size_t)(row0 + ai * HALF + m * 16) * 4096 + col0;
#pragma unroll
                    for (int bj = 0; bj < 2; ++bj) { const u32x4 b = *(const u32x4*)(GB + off + bj * HALF);
                        const f32x4 s0 = (f32x4){sb_lo(b.x), sb_hi(b.x), sb_lo(b.y), sb_hi(b.y)}, s1 = (f32x4){sb_lo(b.z), sb_hi(b.z), sb_lo(b.w), sb_hi(b.w)};
                        *(u32x4*)(O + off + bj * HALF) = pack8(acc[ai][bj][m][0] * s0, acc[ai][bj][m][1] * s1); } }
        }
    }
};
struct EpiResF32 {
    static constexpr bool PERM = false;
    const float* res; float* out;
    __device__ __forceinline__ bool keep(const Unit&) const { return false; }
    __device__ __forceinline__ void operator()(f32x4 (&acc)[2][2][4][2], const Unit& u, int wr, int wc, int fr, int fq) const {
        const int row0 = u.pm * BM + wr * 64 + fr, col0 = u.pn * BM + wc * 32 + 4 * fq;
#pragma unroll
        for (int ai = 0; ai < 2; ++ai)
#pragma unroll
            for (int m = 0; m < 4; ++m) { const size_t off = (size_t)(row0 + ai * HALF + m * 16) * 4096 + col0;
#pragma unroll
                for (int bj = 0; bj < 2; ++bj)
#pragma unroll
                    for (int n = 0; n < 2; ++n) { const f32x4 r = *(const f32x4*)(res + off + bj * HALF + n * 16); *(f32x4*)(out + off + bj * HALF + n * 16) = r + acc[ai][bj][m][n]; } }
    }
};
struct EpiResH16 {
    static constexpr bool PERM = true;
    const bf16_t* h16; float* out;
    __device__ __forceinline__ bool keep(const Unit&) const { return false; }
    __device__ __forceinline__ void operator()(f32x4 (&acc)[2][2][4][2], const Unit& u, int wr, int wc, int fr, int fq) const {
        const int row0 = u.pm * BM + wr * 64 + fr, col0 = u.pn * BM + wc * 32 + 8 * fq;
#pragma unroll
        for (int ai = 0; ai < 2; ++ai)
#pragma unroll
            for (int m = 0; m < 4; ++m) { const size_t off = (size_t)(row0 + ai * HALF + m * 16) * 4096 + col0;
#pragma unroll
                for (int bj = 0; bj < 2; ++bj) { const u32x4 hb = *(const u32x4*)(h16 + lane_tile_idx(u.pm * 16 + u.pn, wr, wc, fr, fq, ai, m, bj) * 8);
                    const f32x4 h0 = (f32x4){bf_lo(hb.x), bf_hi(hb.x), bf_lo(hb.y), bf_hi(hb.y)}, h1 = (f32x4){bf_lo(hb.z), bf_hi(hb.z), bf_lo(hb.w), bf_hi(hb.w)};
                    *(f32x4*)(out + off + bj * HALF) = h0 + acc[ai][bj][m][0]; *(f32x4*)(out + off + bj * HALF + 4) = h1 + acc[ai][bj][m][1]; } }
    }
};
struct EpiOutNorm {
    static constexpr bool PERM = true;
    const float* x; bf16_t* h16; bf16_t* HN; const float* g2; float* part;
    __device__ __forceinline__ bool keep(const Unit&) const { return false; }
    __device__ __forceinline__ void operator()(f32x4 (&acc)[2][2][4][2], const Unit& u, int wr, int wc, int fr, int fq) const {
        const int row0 = u.pm * BM + wr * 64 + fr, col0 = u.pn * BM + wc * 32 + 8 * fq;
        f32x4 gg[2][2];
#pragma unroll
        for (int bj = 0; bj < 2; ++bj)
#pragma unroll
            for (int n = 0; n < 2; ++n) gg[bj][n] = *(const f32x4*)(g2 + col0 + bj * HALF + 4 * n);
#pragma unroll
        for (int ai = 0; ai < 2; ++ai)
#pragma unroll
            for (int m = 0; m < 4; ++m) { const int row = row0 + ai * HALF + m * 16; const size_t off = (size_t)row * 4096 + col0; float ss = 0.f;
#pragma unroll
                for (int bj = 0; bj < 2; ++bj) { const f32x4 x0 = *(const f32x4*)(x + off + bj * HALF), x1 = *(const f32x4*)(x + off + bj * HALF + 4);
                    const f32x4 h0 = x0 + acc[ai][bj][m][0], h1 = x1 + acc[ai][bj][m][1];
                    *(u32x4*)(h16 + lane_tile_idx(u.pm * 16 + u.pn, wr, wc, fr, fq, ai, m, bj) * 8) = pack8(h0, h1);
                    ss += ((h0[0] * h0[0] + h0[1] * h0[1]) + (h0[2] * h0[2] + h0[3] * h0[3])) + ((h1[0] * h1[0] + h1[1] * h1[1]) + (h1[2] * h1[2] + h1[3] * h1[3]));
                    *(u32x4*)((char*)HN + blk_off(row, (col0 + bj * HALF) * 2, 8192)) = pack8(h0 * gg[bj][0], h1 * gg[bj][1]); }
                ss += __shfl_xor(ss, 16); ss += __shfl_xor(ss, 32);
                if (fq == 0) part[(size_t)row * 64 + u.pn * 4 + wc] = ss; }
    }
};
struct EpiSwiglu {
    static constexpr bool PERM = true; static constexpr int NST = 4;
    bf16_t* O; int ldc; const PG8_LAS float* rstd; int fm;
    __device__ __forceinline__ bool keep(const Unit&) const { return false; }
    template <int AI> __device__ __forceinline__ void half(const f32x4 (&acc)[2][2][4][2], const Unit& u, int wr, int wc, int fr, int fq) const {
        const int row0 = u.pm * BM + wr * 64 + fr, col0 = u.pn * HALF + wc * 32 + 8 * fq, rl0 = (u.pm - fm) * BM + wr * 64 + fr;
#pragma unroll
        for (int m = 0; m < 4; ++m) { bf16_t* rowp = (bf16_t*)((char*)O + blk_off(row0 + AI * HALF + m * 16, col0 * 2, ldc * 2)); const float r = rstd[rl0 + AI * HALF + m * 16];
            const f32x4 g0 = acc[AI][0][m][0] * r, g1 = acc[AI][0][m][1] * r;
            const f32x4 v0 = g0 * sigm4(g0) * (acc[AI][1][m][0] * r), v1 = g1 * sigm4(g1) * (acc[AI][1][m][1] * r);
            *(u32x4*)rowp = pack8(v0, v1); }
    }
    __device__ __forceinline__ void operator()(f32x4 (&acc)[2][2][4][2], const Unit& u, int wr, int wc, int fr, int fq) const { half<0>(acc, u, wr, wc, fr, fq); half<1>(acc, u, wr, wc, fr, fq); }
};

template <class Epi, class Sched, bool ALIGN_EPI, bool SP2>
__device__ __forceinline__ void gemm_phase(PG8_LAS unsigned char* lds, const int K, const Sched& S, const Epi& E) {
    const int tid = opaque_tid(), wid = __builtin_amdgcn_readfirstlane(tid >> 6), lane = tid & 63, wr = wid >> 2, wc = wid & 3, fr = lane & 15, fq = lane >> 4;
    const int nt = K / BK;
    unsigned voffA[2], voffB[2];
#pragma unroll
    for (int i = 0; i < 2; ++i) { int R, C; stage_rc(tid * 16 + i * 8192, R, C); const int Rb = Epi::PERM ? ((R & ~31) + perm32(R & 31)) : R;
        voffA[i] = voffB[i] = (unsigned)(tid * 16 + i * 8192); (void)R; (void)C; (void)Rb; }
    const size_t kstep = 32768;
    const size_t hstep = (size_t)HALF * 128;
    const unsigned ldsw = (unsigned)wid * 1024u;
    const int aoff = lds_byte(wr * 64 + fr, fq * 8), boff = lds_byte(wc * 32 + fr, fq * 8);
#define PG8_SA(b, h) (((b) * 2 + (h)) * HTB)
#define PG8_SB(b, h) ((4 + (b) * 2 + (h)) * HTB)
#define PG8_STAGE(bufoff, gbase, voff) do { _Pragma("unroll") for (int _i = 0; _i < 2; ++_i) \
        __builtin_amdgcn_global_load_lds((const unsigned*)((const char*)(gbase) + (voff)[_i]), (PG8_LAS unsigned*)(lds + (bufoff) + ldsw + _i * 8192), 16, 0, 0); } while (0)
#define PG8_LDA(dst, b, h) do { _Pragma("unroll") for (int m = 0; m < 4; ++m) _Pragma("unroll") for (int k = 0; k < 2; ++k) dst[m][k] = *(const PG8_LAS bf16x8*)(lds + PG8_SA(b, h) + aoff + m * 2048 + k * 1024); } while (0)
#define PG8_LDB(dst, b, h) do { _Pragma("unroll") for (int n = 0; n < 2; ++n) _Pragma("unroll") for (int k = 0; k < 2; ++k) dst[n][k] = *(const PG8_LAS bf16x8*)(lds + PG8_SB(b, h) + boff + n * 2048 + k * 1024); } while (0)
#define PG8_MMA(ai, bj, At, Bt) do { __builtin_amdgcn_s_setprio(1); _Pragma("unroll") for (int m = 0; m < 4; ++m) _Pragma("unroll") for (int n = 0; n < 2; ++n) _Pragma("unroll") for (int k = 0; k < 2; ++k) \
        acc[ai][bj][m][n] = __builtin_amdgcn_mfma_f32_16x16x32_bf16(Bt[n][k], At[m][k], acc[ai][bj][m][n], 0, 0, 0); __builtin_amdgcn_s_setprio(0); } while (0)
#define PG8_WAIT_V(n) asm volatile("s_waitcnt vmcnt(" #n ")" ::: "memory")
#define PG8_WAIT_L(n) asm volatile("s_waitcnt lgkmcnt(" #n ")" ::: "memory")
#define PG8_BAR __builtin_amdgcn_s_barrier()
#define PG8_SCHED __builtin_amdgcn_sched_barrier(0)
    Unit cur, nxt; int ui = 0;
    if (!S.next(0, cur)) return;
    f32x4 acc[2][2][4][2];
#pragma unroll
    for (int a = 0; a < 2; ++a)
#pragma unroll
        for (int b = 0; b < 2; ++b)
#pragma unroll
            for (int m = 0; m < 4; ++m)
#pragma unroll
                for (int n = 0; n < 2; ++n) acc[a][b][m][n] = (f32x4){0.f, 0.f, 0.f, 0.f};
    bf16x8 At[4][2], B0[2][2], B1[2][2];
    const char* cA; const char* cB; S.ptrs(cur, cA, cB);
    if constexpr (SP2) {
        PG8_STAGE(PG8_SB(0, 0), cB, voffB); PG8_STAGE(PG8_SB(0, 1), cB + hstep, voffB); PG8_STAGE(PG8_SA(0, 0), cA, voffA); PG8_STAGE(PG8_SA(0, 1), cA + hstep, voffA);
        if (wr == 1) PG8_BAR;
        PG8_WAIT_V(2); PG8_BAR;
        PG8_STAGE(PG8_SB(1, 0), cB + kstep, voffB); PG8_STAGE(PG8_SA(1, 0), cA + kstep, voffA); PG8_STAGE(PG8_SB(1, 1), cB + hstep + kstep, voffB);
        PG8_WAIT_V(6); PG8_BAR;
    } else {
        PG8_STAGE(PG8_SB(0, 0), cB, voffB); PG8_STAGE(PG8_SA(0, 0), cA, voffA); PG8_STAGE(PG8_SB(0, 1), cB + hstep, voffB); PG8_STAGE(PG8_SA(0, 1), cA + hstep, voffA);
        if (wr == 1) PG8_BAR;
        PG8_WAIT_V(4); PG8_BAR;
        PG8_STAGE(PG8_SB(1, 0), cB + kstep, voffB); PG8_STAGE(PG8_SA(1, 0), cA + kstep, voffA); PG8_STAGE(PG8_SB(1, 1), cB + hstep + kstep, voffB);
        PG8_WAIT_V(6); PG8_BAR;
    }
    for (;;) {
        const bool has_next = S.next(ui + 1, nxt);
        const char* nA = cA; const char* nB = cB; if (has_next) S.ptrs(nxt, nA, nB);
        for (int t = 0; t < nt; t += 2) {
            const bool last = (t == nt - 2);
            const char* a1 = cA + (size_t)(t + 1) * kstep;
            const char* a2 = last ? nA : cA + (size_t)(t + 2) * kstep; const char* b2 = last ? nB : cB + (size_t)(t + 2) * kstep;
            const char* a3 = a2 + kstep; const char* b3 = b2 + kstep;
            if constexpr (SP2) {
            PG8_LDB(B0, 0, 0); PG8_LDB(B1, 0, 1); PG8_SCHED; PG8_LDA(At, 0, 0); PG8_STAGE(PG8_SA(1, 1), a1 + hstep, voffA);
            PG8_WAIT_V(8); PG8_WAIT_L(0); PG8_BAR; PG8_MMA(0, 0, At, B0); PG8_MMA(0, 1, At, B1); PG8_BAR; PG8_SCHED;
            PG8_LDA(At, 0, 1); PG8_STAGE(PG8_SB(0, 0), b2, voffB); PG8_STAGE(PG8_SB(0, 1), b2 + hstep, voffB); PG8_STAGE(PG8_SA(0, 0), a2, voffA);
            PG8_WAIT_V(8); PG8_WAIT_L(0); PG8_BAR; PG8_MMA(1, 0, At, B0); PG8_MMA(1, 1, At, B1); PG8_BAR; PG8_SCHED;
            PG8_LDB(B0, 1, 0); PG8_LDB(B1, 1, 1); PG8_SCHED; PG8_LDA(At, 1, 0); PG8_STAGE(PG8_SA(0, 1), a2 + hstep, voffA);
            PG8_WAIT_V(8); PG8_WAIT_L(0); PG8_BAR; PG8_MMA(0, 0, At, B0); PG8_MMA(0, 1, At, B1); PG8_BAR; PG8_SCHED;
            PG8_LDA(At, 1, 1); PG8_STAGE(PG8_SB(1, 0), b3, voffB); PG8_STAGE(PG8_SB(1, 1), b3 + hstep, voffB); PG8_STAGE(PG8_SA(1, 0), a3, voffA);
            PG8_WAIT_V(8); PG8_WAIT_L(0); PG8_BAR; PG8_MMA(1, 0, At, B0); PG8_MMA(1, 1, At, B1); PG8_BAR; PG8_SCHED;
            } else {
            PG8_LDB(B0, 0, 0); PG8_SCHED; PG8_LDA(At, 0, 0); PG8_STAGE(PG8_SA(1, 1), a1 + hstep, voffA);
            PG8_WAIT_L(8); PG8_BAR; PG8_WAIT_L(0); PG8_MMA(0, 0, At, B0); PG8_BAR; PG8_SCHED;
            PG8_LDB(B1, 0, 1); PG8_STAGE(PG8_SB(0, 0), b2, voffB);
            PG8_BAR; PG8_WAIT_L(0); PG8_MMA(0, 1, At, B1); PG8_BAR;
            PG8_LDA(At, 0, 1); PG8_STAGE(PG8_SA(0, 0), a2, voffA);
            PG8_BAR; PG8_WAIT_L(0); PG8_MMA(1, 0, At, B0); PG8_BAR; PG8_SCHED;
            PG8_STAGE(PG8_SB(0, 1), b2 + hstep, voffB);
            PG8_WAIT_V(6); PG8_BAR; PG8_MMA(1, 1, At, B1); PG8_BAR;
            PG8_LDB(B0, 1, 0); PG8_SCHED; PG8_LDA(At, 1, 0); PG8_STAGE(PG8_SA(0, 1), a2 + hstep, voffA);
            PG8_WAIT_L(8); PG8_BAR; PG8_WAIT_L(0); PG8_MMA(0, 0, At, B0); PG8_BAR; PG8_SCHED;
            PG8_LDB(B1, 1, 1); PG8_STAGE(PG8_SB(1, 0), b3, voffB);
            PG8_BAR; PG8_WAIT_L(0); PG8_MMA(0, 1, At, B1); PG8_BAR;
            PG8_LDA(At, 1, 1); PG8_STAGE(PG8_SA(1, 0), a3, voffA);
            PG8_BAR; PG8_WAIT_L(0); PG8_MMA(1, 0, At, B0); PG8_BAR; PG8_SCHED;
            PG8_STAGE(PG8_SB(1, 1), b3 + hstep, voffB);
            PG8_WAIT_V(6); PG8_BAR; PG8_MMA(1, 1, At, B1); PG8_BAR;
            }
        }
        if constexpr (ALIGN_EPI) { if (wr == 0) PG8_BAR; }
        E(acc, cur, wr, wc, fr, fq);
        if (!has_next) break;
        if (!E.keep(cur)) {
#pragma unroll
            for (int a = 0; a < 2; ++a)
#pragma unroll
                for (int b = 0; b < 2; ++b)
#pragma unroll
                    for (int m = 0; m < 4; ++m)
#pragma unroll
                        for (int n = 0; n < 2; ++n) acc[a][b][m][n] = (f32x4){0.f, 0.f, 0.f, 0.f};
        }
        cur = nxt; cA = nA; cB = nB; ++ui;
        if constexpr (ALIGN_EPI) { if (wr == 1) PG8_BAR; }
    }
    PG8_WAIT_V(0);
    if constexpr (!ALIGN_EPI) { if (wr == 0) PG8_BAR; }
    PG8_BAR;
#undef PG8_SA
#undef PG8_SB
#undef PG8_STAGE
#undef PG8_LDA
#undef PG8_LDB
#undef PG8_MMA
#undef PG8_WAIT_V
#undef PG8_WAIT_L
#undef PG8_BAR
#undef PG8_SCHED
}

typedef int i32x4 __attribute__((ext_vector_type(4)));
typedef int i32x8 __attribute__((ext_vector_type(8)));
template <class Epi, class Sched>
__device__ __forceinline__ void gemm_phase_f8(PG8_LAS unsigned char* lds, const int K, const Sched& S, const Epi& E) {
    const int tid = opaque_tid(), wid = __builtin_amdgcn_readfirstlane(tid >> 6), lane = tid & 63, wr = wid >> 2, wc = wid & 3, fr = lane & 15, fq = lane >> 4;
    const int nt = K / 128;
    unsigned voffA[2], voffB[2];
#pragma unroll
    for (int i = 0; i < 2; ++i) { int R, C; stage_rc(tid * 16 + i * 8192, R, C); const int Rb = Epi::PERM ? ((R & ~31) + perm32(R & 31)) : R;
        voffA[i] = voffB[i] = (unsigned)(tid * 16 + i * 8192); (void)R; (void)C; (void)Rb; }
    const size_t kstep = 32768;
    const size_t hstep = (size_t)HALF * 128;
    const unsigned ldsw = (unsigned)wid * 1024u;
    const int aoff = lds_byte(wr * 64 + fr, fq * 16), boff = lds_byte(wc * 32 + fr, fq * 16);
#define PG8_SA(b, h) (((b) * 2 + (h)) * HTB)
#define PG8_SB(b, h) ((4 + (b) * 2 + (h)) * HTB)
#define PG8_STAGE(bufoff, gbase, voff) do { _Pragma("unroll") for (int _i = 0; _i < 2; ++_i) \
        __builtin_amdgcn_global_load_lds((const unsigned*)((const char*)(gbase) + (voff)[_i]), (PG8_LAS unsigned*)(lds + (bufoff) + ldsw + _i * 8192), 16, 0, 0); } while (0)
#define PG8_LD8(dst, off) do { const i32x4 _lo = *(const PG8_LAS i32x4*)(lds + (off)), _hi = *(const PG8_LAS i32x4*)(lds + (off) + 16); dst = __builtin_shufflevector(_lo, _hi, 0, 1, 2, 3, 4, 5, 6, 7); } while (0)
#define PG8_LDA(dst, b, h) do { _Pragma("unroll") for (int m = 0; m < 4; ++m) PG8_LD8(dst[m], PG8_SA(b, h) + aoff + m * 2048); } while (0)
#define PG8_LDB(dst, b, h) do { _Pragma("unroll") for (int n = 0; n < 2; ++n) PG8_LD8(dst[n], PG8_SB(b, h) + boff + n * 2048); } while (0)
#define PG8_MMA(ai, bj, At, Bt) do { __builtin_amdgcn_s_setprio(1); _Pragma("unroll") for (int m = 0; m < 4; ++m) _Pragma("unroll") for (int n = 0; n < 2; ++n) \
        asm volatile("v_mfma_scale_f32_16x16x128_f8f6f4 %0, %1, %2, %0, %3, %3 op_sel_hi:[0,0,0]" : "+v"(acc[ai][bj][m][n]) : "v"(Bt[n]), "v"(At[m]), "v"(f8_unit_scale)); __builtin_amdgcn_s_setprio(0); } while (0)
#define PG8_WAIT_V(n) asm volatile("s_waitcnt vmcnt(" #n ")" ::: "memory")
#define PG8_WAIT_L(n) asm volatile("s_waitcnt lgkmcnt(" #n ")" ::: "memory")
#define PG8_BAR __builtin_amdgcn_s_barrier()
#define PG8_SCHED __builtin_amdgcn_sched_barrier(0)
    Unit cur, nxt; int ui = 0;
    if (!S.next(0, cur)) return;
    f32x4 acc[2][2][4][2];
#pragma unroll
    for (int a = 0; a < 2; ++a)
#pragma unroll
        for (int b = 0; b < 2; ++b)
#pragma unroll
            for (int m = 0; m < 4; ++m)
#pragma unroll
                for (int n = 0; n < 2; ++n) acc[a][b][m][n] = (f32x4){0.f, 0.f, 0.f, 0.f};
    i32x8 At[4], B0[2], B1[2];
    const int f8_unit_scale = 0x7f7f7f7f;
    const char* cA; const char* cB; S.ptrs(cur, cA, cB);
    PG8_STAGE(PG8_SB(0, 0), cB, voffB); PG8_STAGE(PG8_SB(0, 1), cB + hstep, voffB); PG8_STAGE(PG8_SA(0, 0), cA, voffA); PG8_STAGE(PG8_SA(0, 1), cA + hstep, voffA);
    if (wr == 1) PG8_BAR;
    PG8_WAIT_V(2); PG8_BAR;
    PG8_STAGE(PG8_SB(1, 0), cB + kstep, voffB); PG8_STAGE(PG8_SA(1, 0), cA + kstep, voffA); PG8_STAGE(PG8_SB(1, 1), cB + hstep + kstep, voffB);
    PG8_WAIT_V(6); PG8_BAR;
    for (;;) {
        const bool has_next = S.next(ui + 1, nxt);
        const char* nA = cA; const char* nB = cB; if (has_next) S.ptrs(nxt, nA, nB);
        for (int t = 0; t < nt; t += 2) {
            const bool last = (t == nt - 2);
            const char* a1 = cA + (size_t)(t + 1) * kstep;
            const char* a2 = last ? nA : cA + (size_t)(t + 2) * kstep; const char* b2 = last ? nB : cB + (size_t)(t + 2) * kstep;
            const char* a3 = a2 + kstep; const char* b3 = b2 + kstep;
            PG8_LDB(B0, 0, 0); PG8_LDB(B1, 0, 1); PG8_SCHED; PG8_LDA(At, 0, 0); PG8_STAGE(PG8_SA(1, 1), a1 + hstep, voffA);
            PG8_WAIT_V(8); PG8_WAIT_L(0); PG8_BAR; PG8_MMA(0, 0, At, B0); PG8_MMA(0, 1, At, B1); PG8_BAR; PG8_SCHED;
            PG8_LDA(At, 0, 1); PG8_STAGE(PG8_SB(0, 0), b2, voffB); PG8_STAGE(PG8_SB(0, 1), b2 + hstep, voffB); PG8_STAGE(PG8_SA(0, 0), a2, voffA);
            PG8_WAIT_V(8); PG8_WAIT_L(0); PG8_BAR; PG8_MMA(1, 0, At, B0); PG8_MMA(1, 1, At, B1); PG8_BAR; PG8_SCHED;
            PG8_LDB(B0, 1, 0); PG8_LDB(B1, 1, 1); PG8_SCHED; PG8_LDA(At, 1, 0); PG8_STAGE(PG8_SA(0, 1), a2 + hstep, voffA);
            PG8_WAIT_V(8); PG8_WAIT_L(0); PG8_BAR; PG8_MMA(0, 0, At, B0); PG8_MMA(0, 1, At, B1); PG8_BAR; PG8_SCHED;
            PG8_LDA(At, 1, 1); PG8_STAGE(PG8_SB(1, 0), b3, voffB); PG8_STAGE(PG8_SB(1, 1), b3 + hstep, voffB); PG8_STAGE(PG8_SA(1, 0), a3, voffA);
            PG8_WAIT_V(8); PG8_WAIT_L(0); PG8_BAR; PG8_MMA(1, 0, At, B0); PG8_MMA(1, 1, At, B1); PG8_BAR; PG8_SCHED;
        }
        if (wr == 0) PG8_BAR;
        { const int t2 = opaque_tid(), w2 = __builtin_amdgcn_readfirstlane(t2 >> 6); E(acc, cur, w2 >> 2, w2 & 3, t2 & 15, (t2 & 63) >> 4); }
        if (!has_next) break;
#pragma unroll
        for (int a = 0; a < 2; ++a)
#pragma unroll
            for (int b = 0; b < 2; ++b)
#pragma unroll
                for (int m = 0; m < 4; ++m)
#pragma unroll
                    for (int n = 0; n < 2; ++n) acc[a][b][m][n] = (f32x4){0.f, 0.f, 0.f, 0.f};
        cur = nxt; cA = nA; cB = nB; ++ui;
        if (wr == 1) PG8_BAR;
    }
    PG8_WAIT_V(0);
    PG8_BAR;
#undef PG8_SA
#undef PG8_SB
#undef PG8_STAGE
#undef PG8_LD8
#undef PG8_LDA
#undef PG8_LDB
#undef PG8_MMA
#undef PG8_WAIT_V
#undef PG8_WAIT_L
#undef PG8_BAR
#undef PG8_SCHED
}

template <class Epi, class Sched>
__device__ __forceinline__ void gemm_phase_mix(PG8_LAS unsigned char* lds, const int P, const int nt8, const int nt16, const Sched& S, const Epi& E) {
    const int tid = opaque_tid(), wid = __builtin_amdgcn_readfirstlane(tid >> 6), lane = tid & 63, wr = wid >> 2, wc = wid & 3, fr = lane & 15, fq = lane >> 4;
    unsigned voffA[2], voffB[2];
#pragma unroll
    for (int i = 0; i < 2; ++i) { int R, C; stage_rc(tid * 16 + i * 8192, R, C); const int Rb = Epi::PERM ? ((R & ~31) + perm32(R & 31)) : R;
        voffA[i] = voffB[i] = (unsigned)(tid * 16 + i * 8192); (void)R; (void)C; (void)Rb; }
    const size_t kstep = 32768;
    const size_t hstep = (size_t)HALF * 128;
    const unsigned ldsw = (unsigned)wid * 1024u;
#define PG8_SA(b, h) (((b) * 2 + (h)) * HTB)
#define PG8_SB(b, h) ((4 + (b) * 2 + (h)) * HTB)
#define PG8_STAGE(bufoff, gbase, voff) do { _Pragma("unroll") for (int _i = 0; _i < 2; ++_i) \
        __builtin_amdgcn_global_load_lds((const unsigned*)((const char*)(gbase) + (voff)[_i]), (PG8_LAS unsigned*)(lds + (bufoff) + ldsw + _i * 8192), 16, 0, 0); } while (0)
#define PG8_LD8(dst, off) do { const i32x4 _lo = *(const PG8_LAS i32x4*)(lds + (off)), _hi = *(const PG8_LAS i32x4*)(lds + (off) + 16); dst = __builtin_shufflevector(_lo, _hi, 0, 1, 2, 3, 4, 5, 6, 7); } while (0)
#define PG8_LDA8(dst, b, h) do { _Pragma("unroll") for (int m = 0; m < 4; ++m) PG8_LD8(dst[m], PG8_SA(b, h) + aoff8 + m * 2048); } while (0)
#define PG8_LDB8(dst, b, h) do { _Pragma("unroll") for (int n = 0; n < 2; ++n) PG8_LD8(dst[n], (PG8_SB(b, h) - 65536) + boff8 + n * 2048); } while (0)
#define PG8_MMA8(ai, bj, At, Bt) do { __builtin_amdgcn_s_setprio(1); _Pragma("unroll") for (int m = 0; m < 4; ++m) _Pragma("unroll") for (int n = 0; n < 2; ++n) \
        asm volatile("v_mfma_scale_f32_16x16x128_f8f6f4 %0, %1, %2, %0, %3, %3 op_sel_hi:[0,0,0]" : "+v"(acc[ai][bj][m][n]) : "v"(Bt[n]), "v"(At[m]), "v"(f8_unit_scale)); __builtin_amdgcn_s_setprio(0); } while (0)
#define PG8_LDA16(dst, b, h) do { _Pragma("unroll") for (int m = 0; m < 4; ++m) _Pragma("unroll") for (int k = 0; k < 2; ++k) dst[m][k] = *(const PG8_LAS bf16x8*)(lds + PG8_SA(b, h) + aoff16 + m * 2048 + k * 1024); } while (0)
#define PG8_LDB16(dst, b, h) do { _Pragma("unroll") for (int n = 0; n < 2; ++n) _Pragma("unroll") for (int k = 0; k < 2; ++k) dst[n][k] = *(const PG8_LAS bf16x8*)(lds + (PG8_SB(b, h) - 65536) + boff16 + n * 2048 + k * 1024); } while (0)
#define PG8_MMA16(ai, bj, At, Bt) do { __builtin_amdgcn_s_setprio(1); _Pragma("unroll") for (int k = 0; k < 2; ++k) _Pragma("unroll") for (int m = 0; m < 4; ++m) _Pragma("unroll") for (int n = 0; n < 2; ++n) \
        asm volatile("v_mfma_f32_16x16x32_bf16 %0, %1, %2, %0" : "+v"(acc[ai][bj][m][n]) : "v"(Bt[n][k]), "v"(At[m][k])); __builtin_amdgcn_s_setprio(0); } while (0)
#define PG8_WAIT_V(n) asm volatile("s_waitcnt vmcnt(" #n ")" ::: "memory")
#define PG8_WAIT_L(n) asm volatile("s_waitcnt lgkmcnt(" #n ")" ::: "memory")
#define PG8_BAR __builtin_amdgcn_s_barrier()
#define PG8_SCHED __builtin_amdgcn_sched_barrier(0)
#define PG8_KPAIR(LDA_, LDB_, MMA_, At_, B0_, B1_) do { \
            LDB_(B0_, 0, 0); LDB_(B1_, 0, 1); PG8_SCHED; LDA_(At_, 0, 0); PG8_STAGE(PG8_SA(1, 1), a1 + hstep, voffA); \
            PG8_WAIT_V(8); PG8_WAIT_L(0); PG8_BAR; MMA_(0, 0, At_, B0_); MMA_(0, 1, At_, B1_); PG8_BAR; PG8_SCHED; \
            LDA_(At_, 0, 1); PG8_STAGE(PG8_SB(0, 0), b2, voffB); PG8_STAGE(PG8_SB(0, 1), b2 + hstep, voffB); PG8_STAGE(PG8_SA(0, 0), a2, voffA); \
            PG8_WAIT_V(8); PG8_WAIT_L(0); PG8_BAR; MMA_(1, 0, At_, B0_); MMA_(1, 1, At_, B1_); PG8_BAR; PG8_SCHED; \
            LDB_(B0_, 1, 0); LDB_(B1_, 1, 1); PG8_SCHED; LDA_(At_, 1, 0); PG8_STAGE(PG8_SA(0, 1), a2 + hstep, voffA); \
            PG8_WAIT_V(8); PG8_WAIT_L(0); PG8_BAR; MMA_(0, 0, At_, B0_); MMA_(0, 1, At_, B1_); PG8_BAR; PG8_SCHED; \
            LDA_(At_, 1, 1); PG8_STAGE(PG8_SB(1, 0), b3, voffB); PG8_STAGE(PG8_SB(1, 1), b3 + hstep, voffB); PG8_STAGE(PG8_SA(1, 0), a3, voffA); \
            PG8_WAIT_V(8); PG8_WAIT_L(0); PG8_BAR; MMA_(1, 0, At_, B0_); MMA_(1, 1, At_, B1_); PG8_BAR; PG8_SCHED; } while (0)
    Unit cur, nxt; int ui = 0;
    if (!S.o.tile(0, cur)) return;
    f32x4 acc[2][2][4][2];
#pragma unroll
    for (int a = 0; a < 2; ++a)
#pragma unroll
        for (int b = 0; b < 2; ++b)
#pragma unroll
            for (int m = 0; m < 4; ++m)
#pragma unroll
                for (int n = 0; n < 2; ++n) acc[a][b][m][n] = (f32x4){0.f, 0.f, 0.f, 0.f};
    const int f8_unit_scale = 0x7f7f7f7f;
    const char* c8A = S.A0 + (size_t)cur.pm * S.tstep8; const char* c8B = S.B0 + (size_t)cur.pn * S.tstep8;
    PG8_STAGE(PG8_SB(0, 0), c8B, voffB); PG8_STAGE(PG8_SB(0, 1), c8B + hstep, voffB); PG8_STAGE(PG8_SA(0, 0), c8A, voffA); PG8_STAGE(PG8_SA(0, 1), c8A + hstep, voffA);
    if (wr == 1) PG8_BAR;
    PG8_WAIT_V(2); PG8_BAR;
    PG8_STAGE(PG8_SB(1, 0), c8B + kstep, voffB); PG8_STAGE(PG8_SA(1, 0), c8A + kstep, voffA); PG8_STAGE(PG8_SB(1, 1), c8B + hstep + kstep, voffB);
    PG8_WAIT_V(6); PG8_BAR;
    for (;;) {
        const bool has_next = S.o.tile(ui + 1, nxt);
        const char* c16A = S.A1 + (size_t)cur.pm * S.tstep; const char* c16B = S.B1 + (size_t)cur.pn * S.tstep;
        {   i32x8 At[4], B0[2], B1[2];
            const int t8 = opaque_tid(); int aoff8 = lds_byte(((t8 >> 8) & 1) * 64 + (t8 & 15), ((t8 & 63) >> 4) * 16), boff8 = lds_byte(((t8 >> 6) & 3) * 32 + (t8 & 15), ((t8 & 63) >> 4) * 16) + 65536;
            asm volatile("" : "+v"(aoff8), "+v"(boff8));
            for (int t = 0; t < nt8; t += 2) { const bool last = (t == nt8 - 2);
                const char* a1 = c8A + (size_t)(t + 1) * kstep;
                const char* a2 = last ? c16A : c8A + (size_t)(t + 2) * kstep; const char* b2 = last ? c16B : c8B + (size_t)(t + 2) * kstep;
                const char* a3 = a2 + kstep; const char* b3 = b2 + kstep;
                PG8_KPAIR(PG8_LDA8, PG8_LDB8, PG8_MMA8, At, B0, B1); } }
        if (wr == 0) PG8_BAR;
        { const int t2 = opaque_tid(), w2 = __builtin_amdgcn_readfirstlane(t2 >> 6); cur.sub = 0; E(acc, cur, w2 >> 2, w2 & 3, t2 & 15, (t2 & 63) >> 4); }
        if (wr == 1) PG8_BAR;
        const char* n8A = c8A; const char* n8B = c8B; if (has_next) { n8A = S.A0 + (size_t)nxt.pm * S.tstep8; n8B = S.B0 + (size_t)nxt.pn * S.tstep8; }
        {   bf16x8 At[4][2], B0[2][2], B1[2][2];
            const int t6 = opaque_tid(); int aoff16 = lds_byte(((t6 >> 8) & 1) * 64 + (t6 & 15), ((t6 & 63) >> 4) * 8), boff16 = lds_byte(((t6 >> 6) & 3) * 32 + (t6 & 15), ((t6 & 63) >> 4) * 8) + 65536;
            asm volatile("" : "+v"(aoff16), "+v"(boff16));
            for (int t = 0; t < nt16; t += 2) { const bool last = (t == nt16 - 2);
                const char* a1 = c16A + (size_t)(t + 1) * kstep;
                const char* a2 = last ? n8A : c16A + (size_t)(t + 2) * kstep; const char* b2 = last ? n8B : c16B + (size_t)(t + 2) * kstep;
                const char* a3 = a2 + kstep; const char* b3 = b2 + kstep;
                PG8_KPAIR(PG8_LDA16, PG8_LDB16, PG8_MMA16, At, B0, B1); } }
        if (wr == 0) PG8_BAR;
        { const int t2 = opaque_tid(), w2 = __builtin_amdgcn_readfirstlane(t2 >> 6); cur.sub = 1; E(acc, cur, w2 >> 2, w2 & 3, t2 & 15, (t2 & 63) >> 4); }
        if (!has_next) break;
#pragma unroll
        for (int a = 0; a < 2; ++a)
#pragma unroll
            for (int b = 0; b < 2; ++b)
#pragma unroll
                for (int m = 0; m < 4; ++m)
#pragma unroll
                    for (int n = 0; n < 2; ++n) acc[a][b][m][n] = (f32x4){0.f, 0.f, 0.f, 0.f};
        cur = nxt; c8A = n8A; c8B = n8B; ++ui;
        if (wr == 1) PG8_BAR;
    }
    PG8_WAIT_V(0);
    PG8_BAR;
#undef PG8_SA
#undef PG8_SB
#undef PG8_STAGE
#undef PG8_LD8
#undef PG8_LDA8
#undef PG8_LDB8
#undef PG8_MMA8
#undef PG8_LDA16
#undef PG8_LDB16
#undef PG8_MMA16
#undef PG8_KPAIR
#undef PG8_WAIT_V
#undef PG8_WAIT_L
#undef PG8_BAR
#undef PG8_SCHED
}
}

constexpr int NWAVES = 8;
constexpr int N_LAUNCHES = MK_N_LAUNCHES;
constexpr int PER_PHASE = 8;
constexpr int M = 16384, D = 4096, NIN = 18432, GMW = 2048, NAW = 2048, DFF = 11008, NGU = 2 * DFF;
constexpr float F8_ASCALE = 16.f, F8_WSCALE = 1024.f, F8_UNSCALE = 1.f / (16.f * 1024.f), F8_YSCALE = 64.f, F8_YUNSCALE = 1.f / (64.f * 1024.f);
constexpr int GRID_W = 64, GRID_H = M / GRID_W, NHEAD = 16, HD = 128, CHUNK = 128, NGROUP = 16;
constexpr float RMS_EPS = 1e-6f, LN_EPS = 1e-5f;

constexpr size_t MiB = 1u << 20;
constexpr size_t WS_CTL = 0, CTL_ZERO_BYTES = 1 * MiB;
constexpr size_t WS_WSB = 1 * MiB;
constexpr size_t WS_WIN = 4 * MiB;
constexpr size_t WS_WOA = 148 * MiB, WS_WOB = 164 * MiB;
constexpr size_t WS_WOUT = 180 * MiB;
constexpr size_t WS_RA = 212 * MiB;
constexpr size_t WS_YA = WS_RA, WS_YB = WS_RA + 64 * MiB;
constexpr size_t WS_RB = 340 * MiB;
constexpr size_t WS_U = WS_RB, WS_V = WS_RB + 64 * MiB, WS_Q = WS_RB + 128 * MiB, WS_K = WS_RB + 192 * MiB, WS_VV = WS_RB + 256 * MiB, WS_GA = WS_RB + 320 * MiB, WS_GB = WS_RB + 448 * MiB;
constexpr size_t WS_TB = WS_Q;
constexpr size_t WS_MRG = WS_RB;
constexpr size_t WS_ACT = WS_RB;
constexpr size_t WS_H16 = WS_WIN;
constexpr size_t WS_WQKV8 = WS_WIN + 32 * MiB;
constexpr size_t WS_XN8 = 916 * MiB;
constexpr size_t WS_WGU = 916 * MiB;
constexpr size_t WS_WD = 1088 * MiB;
constexpr size_t WS_PART = 1174 * MiB;
constexpr size_t WS_END = 1178 * MiB;
static_assert(WS_GB + (size_t)M * D * 2 == WS_WGU && WS_WGU + (size_t)NGU * D * 2 == WS_WD && WS_WD + (size_t)D * DFF * 2 == WS_PART && WS_PART + (size_t)M * 64 * 4 == WS_END && WS_ACT + (size_t)M * DFF * 2 <= WS_WGU, "d_ws map");
constexpr int CW_BAR = 4096;
constexpr int RING_BYTES = 131072;
constexpr int LDSCTL_OFF = RING_BYTES, MISC_OFF = LDSCTL_OFF + 320;
constexpr int LDS_BYTES = 147456;

#define GAS __attribute__((address_space(1)))
#define LAS __attribute__((address_space(3)))
typedef unsigned short bf16;
typedef unsigned v4u __attribute__((ext_vector_type(4)));
typedef unsigned v2u __attribute__((ext_vector_type(2)));
typedef float f32x4 __attribute__((ext_vector_type(4)));
typedef float f32x2 __attribute__((ext_vector_type(2)));
typedef short bf16x8 __attribute__((ext_vector_type(8)));
typedef GAS unsigned gu32;
#define RLX_AGENT __ATOMIC_RELAXED, __HIP_MEMORY_SCOPE_AGENT
#define LDS_WAIT() asm volatile("s_waitcnt lgkmcnt(0)" ::: "memory")
#define VM_WAIT() asm volatile("s_waitcnt vmcnt(0)" ::: "memory")
__device__ __forceinline__ unsigned f2bf(float f) { unsigned u = __builtin_bit_cast(unsigned, f); return (u + 0x7fffu + ((u >> 16) & 1u)) >> 16; }
__device__ __forceinline__ unsigned pk2(float lo, float hi) { return pg8::cvt_pk_bf16(lo, hi); }
__device__ __forceinline__ float bflo(unsigned w) { return __uint_as_float(w << 16); }
__device__ __forceinline__ float bfhi(unsigned w) { return __uint_as_float(w & 0xffff0000u); }

#define XB_TMO      128
#define XB_XCNT(j)  (256  + 64 * (j))
#define XB_XSUB(j)  (1280 + 64 * (j))
#define XB_XGEN(j)  (2304 + 64 * (j))
#define XB_TOP      3328
#define XB_TOPGEN   3392
#define XCD_BAR_WORDS 3456
#define XB_SPIN_CAP (1u << 20)

__device__ __forceinline__ unsigned xb_ld(unsigned* p)              { return __hip_atomic_load(p, __ATOMIC_RELAXED, __HIP_MEMORY_SCOPE_AGENT); }
__device__ __forceinline__ unsigned xb_add(unsigned* p, unsigned v) { return __hip_atomic_fetch_add(p, v, __ATOMIC_RELAXED, __HIP_MEMORY_SCOPE_AGENT); }
__device__ __forceinline__ unsigned xb_xcc_id() { return (unsigned)__builtin_amdgcn_s_getreg((3 << 11) | 20) & 0xFu; }
#define XB_SPIN(cond, bar) do { unsigned _sp = 0; while (cond) { __builtin_amdgcn_s_sleep(1); \
    if ((++_sp & 255u) == 0u) { if (xb_ld(&(bar)[XB_TMO])) break; if (_sp > XB_SPIN_CAP) { atomicAdd(&(bar)[XB_TMO], 1u); break; } } } } while (0)

struct XcdBarrier {
    unsigned* bar; unsigned x;
    volatile LAS unsigned* st;
};
__device__ __forceinline__ XcdBarrier xcd_barrier_post(unsigned* bar, volatile LAS unsigned* st) {
    XcdBarrier b; b.bar = bar; b.x = xb_xcc_id(); b.st = st;
    if (threadIdx.x == 0) (void)xb_add(&bar[XB_XCNT(b.x)], 1u);
    return b;
}
__device__ __forceinline__ void xcd_barrier_complete(unsigned* bar, unsigned x, unsigned& nloc, unsigned& nx) {
    const unsigned G = gridDim.x * gridDim.y * gridDim.z;
    unsigned sum, cnt, mine, sp = 0u;
    for (;;) {
        sum = 0u; cnt = 0u; mine = 0u;
#pragma unroll
        for (unsigned j = 0; j < 16; ++j) { const unsigned c = xb_ld(&bar[XB_XCNT(j)]); sum += c; cnt += (c > 0u) ? 1u : 0u; mine = (j == x) ? c : mine; }
        if (sum == G) break;
        __builtin_amdgcn_s_sleep(1);
        if ((++sp & 255u) == 0u) { if (xb_ld(&bar[XB_TMO])) break; if (sp > XB_SPIN_CAP) { atomicAdd(&bar[XB_TMO], 1u); break; } }
    }
    nloc = mine > 0u ? mine : 1u; nx = cnt > 0u ? cnt : 1u;
}
__device__ __forceinline__ void xcd_barrier(const XcdBarrier& b) {
    asm volatile("s_waitcnt vmcnt(0)" ::: "memory");
    __syncthreads();
    if (threadIdx.x == 0) {
        unsigned* bar = b.bar;
        __builtin_amdgcn_s_waitcnt(0);
        unsigned nloc = b.st[0], nx = b.st[1];
        if (nloc == 0u) { xcd_barrier_complete(bar, b.x, nloc, nx); b.st[0] = nloc; b.st[1] = nx; }
        const unsigned old = xb_add(&bar[XB_XSUB(b.x)], 1u);
        const unsigned gen = old / nloc;
        if (old + 1u == (gen + 1u) * nloc) {
            __builtin_amdgcn_fence(__ATOMIC_RELEASE, "agent");
            asm volatile("s_waitcnt vmcnt(0)" ::: "memory");
            const unsigned og = xb_add(&bar[XB_TOP], 1u);
            const unsigned tg = og / nx;
            if (og + 1u == (tg + 1u) * nx) xb_add(&bar[XB_TOPGEN], 1u);
            else XB_SPIN(xb_ld(&bar[XB_TOPGEN]) == tg, bar);
            __builtin_amdgcn_fence(__ATOMIC_ACQUIRE, "agent");
            xb_add(&bar[XB_XGEN(b.x)], 1u);
            asm volatile("s_waitcnt vmcnt(0)" ::: "memory");
        } else {
            XB_SPIN(xb_ld(&bar[XB_XGEN(b.x)]) == gen, bar);
            __builtin_amdgcn_fence(__ATOMIC_ACQUIRE, "agent");
            asm volatile("s_waitcnt vmcnt(0)" ::: "memory");
        }
    }
    __syncthreads();
}

struct Frame {
    LAS unsigned char* lds;
    volatile LAS unsigned* MISC;
    gu32* ctl;
    int tid, lane, wave;
    int vcu, G;
    unsigned char* ws;
    const float *x, *norm1_g, *w_in, *gm_ln_g, *gm_ln_b, *gm_w_s, *gm_b_s, *q_gain, *k_gain, *na_rpb, *w_o_gm, *w_o_na, *w_out, *norm2_g, *w_ff_gate, *w_ff_up, *w_ff_down;
    float* out;
};
template <int O> __device__ __forceinline__ float xor_lane(float v) {
    if constexpr (O < 32) return __builtin_bit_cast(float, __builtin_amdgcn_ds_swizzle(__builtin_bit_cast(int, v), (O << 10) | 0x1f));
    else return __shfl_xor(v, 32);
}
__device__ __forceinline__ float wave_sum(float v) {
    v += xor_lane<1>(v); v += xor_lane<2>(v); v += xor_lane<4>(v); v += xor_lane<8>(v); v += xor_lane<16>(v); v += xor_lane<32>(v);
    return v;
}
struct TrRegs { f32x4 v[8]; };
__device__ __forceinline__ void tr_load(TrRegs& R, const float* W, int ldw, int k0, int n0, int lane) {
    const GAS float* src = (const GAS float*)W + (size_t)(k0 + 8 * (lane >> 3)) * ldw + n0 + 4 * (lane & 7);
#pragma unroll
    for (int e = 0; e < 8; ++e) R.v[e] = *(const GAS f32x4*)(src + (size_t)e * ldw);
}
__device__ __forceinline__ void tr_load_half(TrRegs& R, const float* W, int ldw, int k0, int n0, int lane, int h) {
    const GAS float* src = (const GAS float*)W + (size_t)(k0 + 8 * (lane >> 3) + 4 * h) * ldw + n0 + 4 * (lane & 7);
#pragma unroll
    for (int e = 0; e < 4; ++e) R.v[4 * h + e] = *(const GAS f32x4*)(src + (size_t)e * ldw);
}
__device__ __forceinline__ void tr_store(const TrRegs& R, bf16* blk, int nloc, int lane) {
#pragma unroll
    for (int i = 0; i < 4; ++i) { v4u o; o.x = pk2(R.v[0][i], R.v[1][i]); o.y = pk2(R.v[2][i], R.v[3][i]); o.z = pk2(R.v[4][i], R.v[5][i]); o.w = pk2(R.v[6][i], R.v[7][i]);
        *(GAS v4u*)((GAS char*)blk + pg8::img_off_w(nloc + 4 * (lane & 7) + i, 8 * (lane >> 3))) = o; }
}
__device__ __forceinline__ unsigned pk4_fp8(float a, float b, float c, float d) {
    a = fminf(fmaxf(a, -448.f), 448.f); b = fminf(fmaxf(b, -448.f), 448.f); c = fminf(fmaxf(c, -448.f), 448.f); d = fminf(fmaxf(d, -448.f), 448.f);
    unsigned w = 0u; w = __builtin_amdgcn_cvt_pk_fp8_f32(a, b, w, false); w = __builtin_amdgcn_cvt_pk_fp8_f32(c, d, w, true); return w;
}
__device__ __forceinline__ void tr_store8(const TrRegs& R, unsigned char* blk8, int nloc, int khalf, int lane, float sc) {
#pragma unroll
    for (int i = 0; i < 4; ++i) { v2u o; o.x = pk4_fp8(R.v[0][i] * sc, R.v[1][i] * sc, R.v[2][i] * sc, R.v[3][i] * sc); o.y = pk4_fp8(R.v[4][i] * sc, R.v[5][i] * sc, R.v[6][i] * sc, R.v[7][i] * sc);
        *(GAS v2u*)((GAS unsigned char*)blk8 + pg8::img_off_w(nloc + 4 * (lane & 7) + i, khalf * 32 + 4 * (lane >> 3))) = o; }
}
__device__ __forceinline__ size_t blkw(int n0, int kb, int K) { return ((size_t)(n0 >> 8) * (K >> 6) + kb) * 16384; }
__device__ __forceinline__ size_t blkw8(int n0, int kb, int K) { return ((size_t)(n0 >> 8) * (K >> 7) + (kb >> 1)) * 32768; }
__device__ __forceinline__ void tr_matrix(Frame& F, int lane, const float* W, int K, int N, bf16* WT) {
    const int gw = F.vcu * NWAVES + F.wave, NGW = F.G * NWAVES, nblk = N / 32, nitems = (K / 64) * nblk;
    for (int it = gw; it < nitems; it += 2 * NGW) { const int it2 = it + NGW; const bool two = it2 < nitems; TrRegs A, B;
        const int kb = it / nblk, nb = it % nblk, kb2 = two ? it2 / nblk : kb, nb2 = two ? it2 % nblk : nb;
        tr_load(A, W, N, 64 * kb, 32 * nb, lane); tr_load(B, W, N, 64 * kb2, 32 * nb2, lane);
        tr_store(A, WT + blkw(32 * nb, kb, K), (32 * nb) & 255, lane); if (two) tr_store(B, WT + blkw(32 * nb2, kb2, K), (32 * nb2) & 255, lane); }
}
constexpr int FF_ITEMS_GU = (D / 64) * (DFF / 32), FF_ITEMS_D = (DFF / 64) * (D / 32), FF_ITEMS = 2 * FF_ITEMS_GU + FF_ITEMS_D;
constexpr int FF_ITEMS_P2 = 2 * FF_ITEMS_GU;
struct FillItem { const float* src; bf16* dst; int ldw, ldk, k0, n0; };
__device__ __forceinline__ FillItem ff_item(Frame& F, int it) {
    it = it < FF_ITEMS ? it : FF_ITEMS - 1; FillItem I;
    if (it < 2 * FF_ITEMS_GU) { const int up = it >= FF_ITEMS_GU, r = up ? it - FF_ITEMS_GU : it, nblk = DFF / 32, kb = r / nblk, n0 = 32 * (r - kb * nblk);
        I.src = up ? F.w_ff_up : F.w_ff_gate; I.ldw = DFF; I.k0 = 64 * kb; I.n0 = n0; I.ldk = D;
        const int drow = 256 * (n0 >> 7) + (n0 & 127) + (up ? 128 : 0); I.dst = (bf16*)(F.ws + WS_WGU) + blkw(drow, kb, D); I.ldk = drow & 255; }
    else { const int r = it - 2 * FF_ITEMS_GU, nblk = D / 32, kb = r / nblk, n0 = 32 * (r - kb * nblk);
        I.src = F.w_ff_down; I.ldw = D; I.k0 = 64 * kb; I.n0 = n0; I.ldk = n0 & 255; I.dst = (bf16*)(F.ws + WS_WD) + blkw(n0, kb, DFF); }
    return I;
}
__device__ __forceinline__ void rms_row_to_bf16(int lane, const float* xrow, const float* gain, bf16* obase, unsigned char* obase8, int m) {
    const GAS f32x4* xr = (const GAS f32x4*)xrow + lane;
    f32x4 v[16]; float s = 0.f;
#pragma unroll
    for (int j = 0; j < 16; ++j) { v[j] = xr[64 * j]; s += (v[j].x * v[j].x + v[j].y * v[j].y) + (v[j].z * v[j].z + v[j].w * v[j].w); }
    const float rstd = 1.f / sqrtf(wave_sum(s) * (1.f / D) + RMS_EPS);
    const GAS f32x4* gr = (const GAS f32x4*)gain + lane;
#pragma unroll
    for (int j = 0; j < 16; ++j) { const f32x4 g = gr[64 * j]; const float y0 = v[j].x * rstd * g.x, y1 = v[j].y * rstd * g.y, y2 = v[j].z * rstd * g.z, y3 = v[j].w * rstd * g.w;
        v2u o; o.x = pk2(y0, y1); o.y = pk2(y2, y3); *(GAS v2u*)((GAS char*)obase + pg8::blk_off(m, 8 * lane + 512 * j, 2 * D)) = o;
        *(GAS unsigned*)((GAS unsigned char*)obase8 + pg8::blk_off(m, 4 * lane + 256 * j, D)) = pk4_fp8(y0 * F8_ASCALE, y1 * F8_ASCALE, y2 * F8_ASCALE, y3 * F8_ASCALE); }
}

#ifndef MK_STAGGER_US
#define MK_STAGGER_US 0
#endif
__device__ __forceinline__ void stagger(int us_per_group) {
    const int grp = ((int)blockIdx.x >> 3) & 3;
    if (grp && us_per_group) { const unsigned long long t0 = __builtin_amdgcn_s_memrealtime(), dt = (unsigned long long)(grp * us_per_group) * 100ull;
        while (__builtin_amdgcn_s_memrealtime() - t0 < dt) __builtin_amdgcn_s_sleep(16); }
}
__device__ __forceinline__ void p0_prologue(Frame& F) {
    const int lane = opaque_tid() & 63;
    {
        const int gw0 = F.vcu * NWAVES + F.wave, NGW0 = F.G * NWAVES, nblk = NIN / 32, nitems = (D / 64) * nblk; bf16* WT = (bf16*)(F.ws + WS_WIN); unsigned char* W8 = F.ws + WS_WQKV8;
        for (int it = gw0; it < nitems; it += NGW0) { const int kb = it / nblk, n0 = 32 * (it - kb * nblk); TrRegs R; tr_load(R, F.w_in, NIN, 64 * kb, n0, lane);
            if (n0 >= 4096) tr_store8(R, W8 + blkw8(n0 - 4096, kb, D), (n0 - 4096) & 255, kb & 1, lane, F8_WSCALE);
            else tr_store(R, WT + blkw(n0, kb, D), n0 & 255, lane); } }
    tr_matrix(F, lane, F.w_o_gm, GMW, D, (bf16*)(F.ws + WS_WOA));
    {
        const int gw0 = F.vcu * NWAVES + F.wave, NGW0 = F.G * NWAVES, nblk = D / 32, nitems = (NAW / 64) * nblk; unsigned char* W8 = F.ws + WS_WOB;
        for (int it = gw0; it < nitems; it += NGW0) { const int kb = it / nblk, n0 = 32 * (it - kb * nblk); TrRegs R; tr_load(R, F.w_o_na, D, 64 * kb, n0, lane);
            tr_store8(R, W8 + blkw8(n0, kb, NAW), n0 & 255, kb & 1, lane, F8_WSCALE); } }
    tr_matrix(F, lane, F.w_out, D, D, (bf16*)(F.ws + WS_WOUT));
    const int gw = F.vcu * NWAVES + F.wave, NGW = F.G * NWAVES;
    { bf16* wsb = (bf16*)(F.ws + WS_WSB);
      for (int i = gw * 64 + lane; i < NGROUP * CHUNK * CHUNK / 4; i += NGW * 64) { const f32x4 v = ((const GAS f32x4*)F.gm_w_s)[i]; v2u o; o.x = pk2(v.x, v.y); o.y = pk2(v.z, v.w); ((GAS v2u*)wsb)[i] = o; } }
    bf16* XN = (bf16*)(F.ws + WS_RA);
    for (int m = gw; m < M; m += NGW) rms_row_to_bf16(lane, F.x + (size_t)m * D, F.norm1_g, XN, F.ws + WS_XN8, m);
}
typedef short s16x4 __attribute__((ext_vector_type(4)));
constexpr int GM_WP = 272, GM_VP = 288;
constexpr int GM_V_OFF = 128 * GM_WP, GM_ST_OFF = GM_V_OFF + 128 * GM_VP;
__device__ __forceinline__ void gmlp_unit(Frame& F, int chunk, int half) {
    LAS unsigned char* Wl = F.lds; LAS unsigned char* Vt = F.lds + GM_V_OFF; LAS f32x2* st = (LAS f32x2*)(F.lds + GM_ST_OFF);
    const bf16* U = (const bf16*)(F.ws + WS_U); const bf16* V = (const bf16*)(F.ws + WS_V); bf16* YA = (bf16*)(F.ws + WS_YA); const bf16* WSB = (const bf16*)(F.ws + WS_WSB);
    const int tid = opaque_tid();
    const int tok0 = chunk * CHUNK, lane = tid & 63, fr = lane & 15, fq = lane >> 4, q4 = fr >> 2, p4 = lane & 3;
    const int srow = tid >> 4, sch = tid & 15;
    const int g_first = half * (NGROUP / 2);
    v4u Wr[4], Vr[4]; f32x4 lg[2], lb[2];
#define GM_PREFETCH(g_) do { _Pragma("unroll") for (int q = 0; q < 4; ++q) { Wr[q] = *(const GAS v4u*)(WSB + (size_t)(g_) * CHUNK * CHUNK + (srow + 32 * q) * CHUNK + sch * 8); \
        Vr[q] = *(const GAS v4u*)(V + ((size_t)(g_) * M + tok0 + srow + 32 * q) * 128 + sch * 8); } \
        lg[0] = *(const GAS f32x4*)(F.gm_ln_g + (g_) * 128 + sch * 8); lg[1] = *(const GAS f32x4*)(F.gm_ln_g + (g_) * 128 + sch * 8 + 4); \
        lb[0] = *(const GAS f32x4*)(F.gm_ln_b + (g_) * 128 + sch * 8); lb[1] = *(const GAS f32x4*)(F.gm_ln_b + (g_) * 128 + sch * 8 + 4); } while (0)
    GM_PREFETCH(g_first);
    __syncthreads();
    { const GAS f32x4* p = (const GAS f32x4*)((const float*)(F.ws + WS_PART) + (size_t)(tok0 + (tid >> 2)) * 64 + (tid & 3) * 16); float sm = 0.f, sq = 0.f;
#pragma unroll
      for (int i = 0; i < 4; ++i) { const f32x4 v = p[i]; sm += v.x + v.z; sq += v.y + v.w; }
      sm += xor_lane<1>(sm); sm += xor_lane<2>(sm); sq += xor_lane<1>(sq); sq += xor_lane<2>(sq);
      const float mean = sm * (1.f / GMW), var = fmaxf(sq * (1.f / GMW) - mean * mean, 0.f);
      if ((tid & 3) == 0) st[tid >> 2] = (f32x2){mean, 1.f / sqrtf(var + LN_EPS)}; }
    const int wi = F.wave >> 1, wc2 = F.wave & 1;
#pragma unroll 1
    for (int gi = 0; gi < NGROUP / 2; ++gi) { const int g = g_first + gi;
        __syncthreads();
#pragma unroll
        for (int q = 0; q < 4; ++q) { const int row = srow + 32 * q;
            *(LAS v4u*)(Wl + row * GM_WP + sch * 16) = Wr[q];
            const v4u w = Vr[q]; const f32x2 ms = st[row]; v4u o;
            o.x = pk2((bflo(w.x) - ms.x) * ms.y * lg[0].x + lb[0].x, (bfhi(w.x) - ms.x) * ms.y * lg[0].y + lb[0].y); o.y = pk2((bflo(w.y) - ms.x) * ms.y * lg[0].z + lb[0].z, (bfhi(w.y) - ms.x) * ms.y * lg[0].w + lb[0].w);
            o.z = pk2((bflo(w.z) - ms.x) * ms.y * lg[1].x + lb[1].x, (bfhi(w.z) - ms.x) * ms.y * lg[1].y + lb[1].y); o.w = pk2((bflo(w.w) - ms.x) * ms.y * lg[1].z + lb[1].z, (bfhi(w.w) - ms.x) * ms.y * lg[1].w + lb[1].w);
            *(LAS v4u*)(Vt + row * GM_VP + sch * 16) = o; }
        if (gi + 1 < NGROUP / 2) GM_PREFETCH(g + 1);
        v4u uu[2][2]; float bs[2];
#pragma unroll
        for (int it = 0; it < 2; ++it) { const int i = 32 * wi + 16 * it + fr; bs[it] = F.gm_b_s[g * CHUNK + i];
#pragma unroll
            for (int t = 0; t < 2; ++t) uu[it][t] = *(const GAS v4u*)(U + ((size_t)g * M + tok0 + i) * 128 + 64 * wc2 + 32 * t + 8 * fq); }
        __syncthreads();
        f32x4 acc[4][2];
#pragma unroll
        for (int ct = 0; ct < 4; ++ct)
#pragma unroll
            for (int it = 0; it < 2; ++it) acc[ct][it] = (f32x4){0.f, 0.f, 0.f, 0.f};
#pragma unroll
        for (int kk = 0; kk < 8; ++kk) { s16x4 vf[4], wf[2];
#pragma unroll
            for (int ct = 0; ct < 4; ++ct) vf[ct] = __builtin_amdgcn_ds_read_tr16_b64_v4i16((LAS s16x4*)(Vt + (16 * kk + 4 * fq + q4) * GM_VP + (64 * wc2 + 32 * (ct >> 1) + 8 * p4 + 4 * (ct & 1)) * 2));
#pragma unroll
            for (int it = 0; it < 2; ++it) wf[it] = *(const LAS s16x4*)(Wl + (32 * wi + 16 * it + fr) * GM_WP + (16 * kk + 4 * fq) * 2);
#pragma unroll
            for (int ct = 0; ct < 4; ++ct)
#pragma unroll
                for (int it = 0; it < 2; ++it) acc[ct][it] = __builtin_amdgcn_mfma_f32_16x16x16bf16_1k(vf[ct], wf[it], acc[ct][it], 0, 0, 0); }
#pragma unroll
        for (int it = 0; it < 2; ++it) { const int i = 32 * wi + 16 * it + fr;
#pragma unroll
            for (int t = 0; t < 2; ++t) { const v4u u4 = uu[it][t]; const f32x4 a0 = acc[2 * t][it], a1 = acc[2 * t + 1][it]; const float b = bs[it]; v4u o;
                o.x = pk2((a0[0] + b) * bflo(u4.x), (a0[1] + b) * bfhi(u4.x)); o.y = pk2((a0[2] + b) * bflo(u4.y), (a0[3] + b) * bfhi(u4.y));
                o.z = pk2((a1[0] + b) * bflo(u4.z), (a1[1] + b) * bfhi(u4.z)); o.w = pk2((a1[2] + b) * bflo(u4.w), (a1[3] + b) * bfhi(u4.w));
                *(GAS v4u*)((GAS char*)YA + pg8::blk_off(tok0 + i, (g * 128 + 64 * wc2 + 32 * t + 8 * fq) * 2, 2 * GMW)) = o; } }
    }
#undef GM_PREFETCH
    __syncthreads();
}

constexpr int NA_KP = 272, NA_VP = 288;
constexpr int NA_KS = 64 * NA_KP, NA_SLOT = NA_KS + 64 * NA_VP, NA_RPB_OFF = 2 * NA_SLOT, NA_ROWS = 11;
constexpr float LOG2E = 1.4426950408889634f;
template <bool FILL> __device__ __forceinline__ void na_unit(Frame& F, int pq, int h, float cbound, int fill_it, int fill_stride) {
    LAS unsigned char* ring = F.lds; LAS float* rpbL = (LAS float*)(F.lds + NA_RPB_OFF);
    const bf16* Q = (const bf16*)(F.ws + WS_Q); const bf16* Kt = (const bf16*)(F.ws + WS_K); const bf16* Vv = (const bf16*)(F.ws + WS_VV);
    const int tid = opaque_tid();
    const int lane = tid & 63, wave = __builtin_amdgcn_readfirstlane(tid >> 6), fr = lane & 15, g = lane >> 4, q4 = fr >> 2, p4 = lane & 3;
    const int R0 = 4 * pq, r = R0 + (wave >> 1), half = wave & 1, kb0 = half;
    int b0 = R0 - 4; b0 = b0 < 0 ? 0 : (b0 > GRID_H - 8 ? GRID_H - 8 : b0);
    int rs = r - 4; rs = rs < 0 ? 0 : (rs > GRID_H - 8 ? GRID_H - 8 : rs);
    int c[2], cs[2];
#pragma unroll
    for (int tt = 0; tt < 2; ++tt) { c[tt] = 32 * half + 16 * tt + fr; int x = c[tt] - 8; cs[tt] = x < 0 ? 0 : (x > GRID_W - 16 ? GRID_W - 16 : x); }
    const int skey = tid >> 4, sdch = tid & 15;
    __syncthreads();
    for (int i = tid; i < 15 * 31; i += 512) rpbL[i] = __builtin_amdgcn_exp2f(F.na_rpb[h * 465 + i] * LOG2E);
    v4u RK[2][2], RV[2][2];
    TrRegs FR; FillItem FI;
#define NA_LOAD(s_) do { int kr_ = b0 + (s_); kr_ = kr_ > GRID_H - 1 ? GRID_H - 1 : kr_; _Pragma("unroll") for (int q2 = 0; q2 < 2; ++q2) { \
        const size_t o_ = ((size_t)h * M + kr_ * GRID_W + skey + 32 * q2) * HD + sdch * 8; RK[(s_) & 1][q2] = *(const GAS v4u*)(Kt + o_); RV[(s_) & 1][q2] = *(const GAS v4u*)(Vv + o_); } } while (0)
    NA_LOAD(0); NA_LOAD(1);
    bf16x8 Qf[2][4];
#pragma unroll
    for (int tt = 0; tt < 2; ++tt) { const size_t tq = (size_t)(r * GRID_W + c[tt]); v4u qw[4]; float ss = 0.f;
#pragma unroll
      for (int ks = 0; ks < 4; ++ks) { qw[ks] = *(const GAS v4u*)(Q + ((size_t)h * M + tq) * HD + 32 * ks + 8 * g);
          const float a0 = bflo(qw[ks].x), a1 = bfhi(qw[ks].x), a2 = bflo(qw[ks].y), a3 = bfhi(qw[ks].y), a4 = bflo(qw[ks].z), a5 = bfhi(qw[ks].z), a6 = bflo(qw[ks].w), a7 = bfhi(qw[ks].w);
          ss += (a0 * a0 + a1 * a1) + (a2 * a2 + a3 * a3) + (a4 * a4 + a5 * a5) + (a6 * a6 + a7 * a7); }
      ss += xor_lane<16>(ss); ss += xor_lane<32>(ss);
      const float rq = (1.f / sqrtf(ss * (1.f / HD) + RMS_EPS)) * 0.08838834764831845f * LOG2E;
#pragma unroll
      for (int ks = 0; ks < 4; ++ks) { const f32x4 g0 = *(const GAS f32x4*)(F.q_gain + 32 * ks + 8 * g), g1 = *(const GAS f32x4*)(F.q_gain + 32 * ks + 8 * g + 4);
          v4u o; o.x = pk2(bflo(qw[ks].x) * rq * g0.x, bfhi(qw[ks].x) * rq * g0.y); o.y = pk2(bflo(qw[ks].y) * rq * g0.z, bfhi(qw[ks].y) * rq * g0.w);
          o.z = pk2(bflo(qw[ks].z) * rq * g1.x, bfhi(qw[ks].z) * rq * g1.y); o.w = pk2(bflo(qw[ks].w) * rq * g1.z, bfhi(qw[ks].w) * rq * g1.w);
          Qf[tt][ks] = __builtin_bit_cast(bf16x8, o); } }
    const f32x4 kg0 = *(const GAS f32x4*)(F.k_gain + sdch * 8), kg1 = *(const GAS f32x4*)(F.k_gain + sdch * 8 + 4);
    f32x4 O[2][8]; float lsum[2] = {0.f, 0.f};
#pragma unroll
    for (int tt = 0; tt < 2; ++tt)
#pragma unroll
        for (int db = 0; db < 8; ++db) O[tt][db] = (f32x4){0.f, 0.f, 0.f, 0.f};
#pragma unroll
    for (int s = 0; s < NA_ROWS; ++s) { LAS unsigned char* slot = ring + (s & 1) * NA_SLOT;
#pragma unroll
        for (int q2 = 0; q2 < 2; ++q2) { const v4u w = RK[s & 1][q2];
            const float a0 = bflo(w.x), a1 = bfhi(w.x), a2 = bflo(w.y), a3 = bfhi(w.y), a4 = bflo(w.z), a5 = bfhi(w.z), a6 = bflo(w.w), a7 = bfhi(w.w);
            float ss = (a0 * a0 + a1 * a1) + (a2 * a2 + a3 * a3) + (a4 * a4 + a5 * a5) + (a6 * a6 + a7 * a7);
            ss += xor_lane<1>(ss); ss += xor_lane<2>(ss); ss += xor_lane<4>(ss); ss += xor_lane<8>(ss);
            const float rk = 1.f / sqrtf(ss * (1.f / HD) + RMS_EPS);
            v4u o; o.x = pk2(a0 * rk * kg0.x, a1 * rk * kg0.y); o.y = pk2(a2 * rk * kg0.z, a3 * rk * kg0.w); o.z = pk2(a4 * rk * kg1.x, a5 * rk * kg1.y); o.w = pk2(a6 * rk * kg1.z, a7 * rk * kg1.w);
            *(LAS v4u*)(slot + (skey + 32 * q2) * NA_KP + sdch * 16) = o;
            *(LAS v4u*)(slot + NA_KS + (skey + 32 * q2) * NA_VP + sdch * 16) = RV[s & 1][q2]; }
        if (s + 2 < NA_ROWS) NA_LOAD(s + 2);
        if constexpr (FILL) {
            if ((s & 1) == 0) { if (s > 0) tr_store(FR, FI.dst, FI.ldk, lane); if (s + 1 < NA_ROWS) { FI = ff_item(F, fill_it + (s >> 1) * fill_stride); tr_load_half(FR, FI.src, FI.ldw, FI.k0, FI.n0, lane, 0); } }
            else tr_load_half(FR, FI.src, FI.ldw, FI.k0, FI.n0, lane, 1); }
        __syncthreads();
        const int kr = b0 + s;
        if (kr >= rs && kr <= rs + 7) {
            f32x4 S[2][3];
#pragma unroll
            for (int tt = 0; tt < 2; ++tt)
#pragma unroll
                for (int b = 0; b < 3; ++b) S[tt][b] = (f32x4){-cbound, -cbound, -cbound, -cbound};
#pragma unroll
            for (int b = 0; b < 3; ++b)
#pragma unroll
                for (int ks = 0; ks < 4; ++ks) { const bf16x8 a = *(const LAS bf16x8*)(slot + (16 * (kb0 + b) + fr) * NA_KP + (32 * ks + 8 * g) * 2);
#pragma unroll
                    for (int tt = 0; tt < 2; ++tt) S[tt][b] = __builtin_amdgcn_mfma_f32_16x16x32_bf16(a, Qf[tt][ks], S[tt][b], 0, 0, 0); }
            s16x4 pf[2][3];
#pragma unroll
            for (int tt = 0; tt < 2; ++tt) { const int rbase = (kr - r + 7) * 31 + 15 - c[tt];
#pragma unroll
                for (int b = 0; b < 3; ++b) { float pv[4];
#pragma unroll
                    for (int i = 0; i < 4; ++i) { const int kc = 16 * (kb0 + b) + 4 * g + i; const bool ok = (kc >= cs[tt]) && (kc <= cs[tt] + 15);
                        int idx = rbase + kc; idx = ok ? idx : 0; const float e = __builtin_amdgcn_exp2f(S[tt][b][i]) * rpbL[idx]; pv[i] = ok ? e : 0.f; lsum[tt] += pv[i]; }
                    v2u pw; pw.x = pk2(pv[0], pv[1]); pw.y = pk2(pv[2], pv[3]); pf[tt][b] = __builtin_bit_cast(s16x4, pw); } }
#pragma unroll
            for (int b = 0; b < 3; ++b)
#pragma unroll
                for (int db = 0; db < 8; ++db) { const s16x4 vf = __builtin_amdgcn_ds_read_tr16_b64_v4i16((LAS s16x4*)(slot + NA_KS + (16 * (kb0 + b) + 4 * g + q4) * NA_VP + (32 * (db >> 1) + 8 * p4 + 4 * (db & 1)) * 2));
#pragma unroll
                    for (int tt = 0; tt < 2; ++tt) O[tt][db] = __builtin_amdgcn_mfma_f32_16x16x16bf16_1k(vf, pf[tt][b], O[tt][db], 0, 0, 0); }
        }
    }
#undef NA_LOAD
#pragma unroll
    for (int tt = 0; tt < 2; ++tt) { float l = lsum[tt]; l += xor_lane<16>(l); l += xor_lane<32>(l); const float inv = 1.f / l;
        const float inv8 = inv * F8_YSCALE;
        GAS unsigned char* ybase = (GAS unsigned char*)(F.ws + WS_YB); const int tokr = r * GRID_W + c[tt];
#pragma unroll
        for (int t = 0; t < 4; ++t) { const f32x4 a0 = O[tt][2 * t], a1 = O[tt][2 * t + 1]; v2u o;
            o.x = pk4_fp8(a0[0] * inv8, a0[1] * inv8, a0[2] * inv8, a0[3] * inv8); o.y = pk4_fp8(a1[0] * inv8, a1[1] * inv8, a1[2] * inv8, a1[3] * inv8);
            *(GAS v2u*)(ybase + pg8::blk_off(tokr, h * HD + 8 * g + 32 * t, NAW)) = o; } }
}

struct Args { const float* in[17]; float* out; unsigned char* ws; int ph_lo, ph_hi, li, pad; };
__global__ void __launch_bounds__(NWAVES * 64, 2) fwd_kernel(Args args) {
    extern __shared__ __attribute__((aligned(16))) unsigned char lds[];
    Frame F;
    F.lds = (LAS unsigned char*)lds;
    F.MISC = (volatile LAS unsigned*)(F.lds + MISC_OFF);
    F.tid = threadIdx.x; F.lane = F.tid & 63; F.wave = __builtin_amdgcn_readfirstlane(F.tid >> 6);
    F.G = gridDim.x; { const int bx = blockIdx.x; F.vcu = (F.G % 8 == 0) ? (bx % 8) * (F.G / 8) + bx / 8 : bx; }
    F.ws = args.ws; F.ctl = (gu32*)(args.ws + WS_CTL);
    F.x = args.in[0]; F.norm1_g = args.in[1]; F.w_in = args.in[2]; F.gm_ln_g = args.in[3]; F.gm_ln_b = args.in[4]; F.gm_w_s = args.in[5]; F.gm_b_s = args.in[6];
    F.q_gain = args.in[7]; F.k_gain = args.in[8]; F.na_rpb = args.in[9]; F.w_o_gm = args.in[10]; F.w_o_na = args.in[11]; F.w_out = args.in[12]; F.norm2_g = args.in[13];
    F.w_ff_gate = args.in[14]; F.w_ff_up = args.in[15]; F.w_ff_down = args.in[16]; F.out = args.out;
    for (int u = F.tid; u < (LDS_BYTES - LDSCTL_OFF) / 4; u += NWAVES * 64) ((LAS unsigned*)(F.lds + LDSCTL_OFF))[u] = 0u;
    __syncthreads();
    XcdBarrier bar; bar.bar = (unsigned*)(F.ctl + CW_BAR); bar.x = 0; bar.st = nullptr;
    if (N_LAUNCHES != PER_PHASE) bar = xcd_barrier_post((unsigned*)(F.ctl + CW_BAR), F.MISC + 8);
#define GRID_BAR() do { if (N_LAUNCHES != PER_PHASE) xcd_barrier(bar); } while (0)
    const int lo = args.ph_lo, hi = args.ph_hi < MK_STOP_AFTER + 1 ? args.ph_hi : MK_STOP_AFTER + 1;
#define IN(k) (lo <= (k) && (k) < hi)
#define BOTH(k) (IN(k) && IN((k) + 1))
    const int bx = (int)blockIdx.x;

    if (IN(0)) { _Pragma("unroll") for (int rep = 0; rep < NREP(0); ++rep) { p0_prologue(F); if (BOTH(0)) GRID_BAR(); } }

    if (IN(1)) _Pragma("unroll") for (int rep = 0; rep < NREP(1); ++rep) {
        { pg8::SchedP1a S; S.o.init(M, 16 * 256, F.G, bx); S.A = (const char*)(F.ws + WS_RA); S.B = (const char*)(F.ws + WS_WIN); S.tstep = (size_t)256 * D * 2;
          pg8::EpiProj E{(bf16*)(F.ws + WS_RB), M, 1.f, (float*)(F.ws + WS_PART)};
          stagger(MK_STAGGER_US); pg8::gemm_phase<pg8::EpiProj, pg8::SchedP1a, true, true>(F.lds, D, S, E); }
        { pg8::SchedP1b S; S.o.init(M, 56 * 256, F.G, bx); S.A8 = (const char*)(F.ws + WS_XN8); S.B8 = (const char*)(F.ws + WS_WQKV8); S.tstep8 = (size_t)256 * D;
          pg8::EpiQKV E{(bf16*)(F.ws + WS_RB), M, F8_UNSCALE, F.ws + WS_GA, F.ws + WS_GB};
          pg8::gemm_phase_f8<pg8::EpiQKV, pg8::SchedP1b>(F.lds, D, S, E); }
        if (BOTH(1)) GRID_BAR();
    }
    if (IN(2)) _Pragma("unroll") for (int rep = 0; rep < NREP(2); ++rep) {
        for (int u = bx; u < 2 * (M / CHUNK); u += F.G) gmlp_unit(F, u >> 1, u & 1);
#if defined(MK_PROBE_NA)
        for (int rep = 0; rep < args.pad + 2; ++rep)
#endif
        float cbound;
        { const int ln = opaque_tid() & 63; float mq = fmaxf(fabsf(F.q_gain[2 * ln]), fabsf(F.q_gain[2 * ln + 1])), mk = fmaxf(fabsf(F.k_gain[2 * ln]), fabsf(F.k_gain[2 * ln + 1]));
          mq = fmaxf(mq, xor_lane<1>(mq)); mq = fmaxf(mq, xor_lane<2>(mq)); mq = fmaxf(mq, xor_lane<4>(mq)); mq = fmaxf(mq, xor_lane<8>(mq)); mq = fmaxf(mq, xor_lane<16>(mq)); mq = fmaxf(mq, xor_lane<32>(mq));
          mk = fmaxf(mk, xor_lane<1>(mk)); mk = fmaxf(mk, xor_lane<2>(mk)); mk = fmaxf(mk, xor_lane<4>(mk)); mk = fmaxf(mk, xor_lane<8>(mk)); mk = fmaxf(mk, xor_lane<16>(mk)); mk = fmaxf(mk, xor_lane<32>(mk));
          cbound = 11.313708498984761f * 1.01f * LOG2E * mq * mk; }
        {
            const int gwv = F.vcu * NWAVES + F.wave, NGW = F.G * NWAVES, per_wave = (FF_ITEMS_P2 + NGW - 1) / NGW, NA_FILL = NA_ROWS / 2, nfill = (per_wave + NA_FILL - 1) / NA_FILL; int ui = 0, done = 0;
            for (int u = F.vcu; u < (GRID_H / 4) * NHEAD; u += F.G, ++ui) {
                if (ui < nfill) { na_unit<true>(F, u & (GRID_H / 4 - 1), u >> 6, cbound, gwv + done * NGW, NGW); done += NA_FILL; }
                else na_unit<false>(F, u & (GRID_H / 4 - 1), u >> 6, cbound, 0, 0); }
            const int ln = opaque_tid() & 63;
            for (int it = gwv + done * NGW; it < FF_ITEMS_P2; it += NGW) { TrRegs R; const FillItem I = ff_item(F, it); tr_load(R, I.src, I.ldw, I.k0, I.n0, ln); tr_store(R, I.dst, I.ldk, ln); }
        }
        if (BOTH(2)) GRID_BAR();
    }
    if (IN(3)) _Pragma("unroll") for (int rep = 0; rep < NREP(3); ++rep) {
        { pg8::SchedMerge S; S.o.init(M, D, F.G, bx); S.A0 = (const char*)(F.ws + WS_YB); S.B0 = (const char*)(F.ws + WS_WOB); S.A1 = (const char*)(F.ws + WS_YA); S.B1 = (const char*)(F.ws + WS_WOA); S.tstep = (size_t)256 * GMW * 2; S.tstep8 = (size_t)256 * NAW;
          pg8::EpiMix E{F.ws + WS_GA, F.ws + WS_GB, (bf16*)(F.ws + WS_MRG), F8_YUNSCALE};
          stagger(MK_STAGGER_US); pg8::gemm_phase_mix<pg8::EpiMix, pg8::SchedMerge>(F.lds, 0, NAW / 128, GMW / 64, S, E); }
        if (BOTH(3)) GRID_BAR();
    }
    if (IN(4)) _Pragma("unroll") for (int rep = 0; rep < NREP(4); ++rep) {
        pg8::SchedPlain S; S.o.init(M, D, F.G, bx); S.A = (const char*)(F.ws + WS_MRG); S.B = (const char*)(F.ws + WS_WOUT); S.tstep = (size_t)256 * D * 2;
        pg8::EpiOutNorm E{F.x, (bf16*)(F.ws + WS_H16), (bf16*)(F.ws + WS_RA), F.norm2_g, (float*)(F.ws + WS_PART)};
        stagger(MK_STAGGER_US); pg8::gemm_phase<pg8::EpiOutNorm, pg8::SchedPlain, true, true>(F.lds, D, S, E);
        if (BOTH(4)) GRID_BAR();
    }
    if (IN(6)) _Pragma("unroll") for (int rep = 0; rep < NREP(6); ++rep) {
        pg8::SchedPlain S; S.o.init(M, NGU, F.G, bx); S.A = (const char*)(F.ws + WS_RA); S.B = (const char*)(F.ws + WS_WGU); S.tstep = (size_t)256 * D * 2;
        LAS float* rtab = (LAS float*)(F.lds + 135168); const int fm = 8 * (bx & 7);
        { const int t5 = opaque_tid(); const float* part = (const float*)(F.ws + WS_PART);
          for (int r = t5; r < 2048; r += NWAVES * 64) { const GAS f32x4* p = (const GAS f32x4*)(part + (size_t)(fm * 256 + r) * 64); float sacc = 0.f;
#pragma unroll
              for (int j = 0; j < 16; ++j) { const f32x4 v = p[j]; sacc += (v.x + v.y) + (v.z + v.w); }
              rtab[r] = 1.f / sqrtf(sacc * (1.f / D) + RMS_EPS); }
          __syncthreads(); }
        pg8::EpiSwiglu E{(bf16*)(F.ws + WS_ACT), DFF, rtab, fm};
        stagger(MK_STAGGER_US); pg8::gemm_phase<pg8::EpiSwiglu, pg8::SchedPlain, true, true>(F.lds, D, S, E);
        {
            const int rem = S.o.nwg % F.G, first = rem, nidle = rem ? F.G - rem : F.G;
            if (bx >= first || rem == 0) { const int ln = opaque_tid() & 63, w0 = ((rem ? bx - first : bx) * NWAVES + F.wave), NW = nidle * NWAVES;
                for (int it = FF_ITEMS_P2 + w0; it < FF_ITEMS; it += 2 * NW) { const int it2 = it + NW; TrRegs Ra, Rb; const FillItem Ia = ff_item(F, it), Ib = ff_item(F, it2);
                    tr_load(Ra, Ia.src, Ia.ldw, Ia.k0, Ia.n0, ln); tr_load(Rb, Ib.src, Ib.ldw, Ib.k0, Ib.n0, ln); tr_store(Ra, Ia.dst, Ia.ldk, ln); tr_store(Rb, Ib.dst, Ib.ldk, ln); } } }
        if (BOTH(6)) GRID_BAR();
    }
    if (IN(7)) {
        pg8::SchedPlain S; S.o.init(M, D, F.G, bx); S.A = (const char*)(F.ws + WS_ACT); S.B = (const char*)(F.ws + WS_WD); S.tstep = (size_t)256 * DFF * 2;
        pg8::EpiResH16 E{(const bf16*)(F.ws + WS_H16), F.out};
        stagger(MK_STAGGER_US); pg8::gemm_phase<pg8::EpiResH16, pg8::SchedPlain, true, true>(F.lds, DFF, S, E);
    }

#if MK_STOP_AFTER < 4
    {
        GRID_BAR();
        const bf16* pU = (const bf16*)(F.ws + WS_U); const bf16* pV = (const bf16*)(F.ws + WS_V); const bf16* pQ = (const bf16*)(F.ws + WS_Q); const bf16* pK = (const bf16*)(F.ws + WS_K); const bf16* pVV = (const bf16*)(F.ws + WS_VV);
        const bf16* pGA = (const bf16*)(F.ws + WS_GA); const bf16* pGB = (const bf16*)(F.ws + WS_GB); const bf16* pYA = (const bf16*)(F.ws + WS_YA); const bf16* pYB = (const bf16*)(F.ws + WS_YB); const bf16* pM = (const bf16*)(F.ws + WS_MRG);
        for (size_t i = (size_t)bx * 512 + F.tid; i < (size_t)M * D; i += (size_t)F.G * 512) { const size_t m = i >> 12; const int c = (int)(i & 4095), c2 = c & 2047; float v;
            if (MK_STOP_AFTER == 1) v = 0.f * bflo(pGA[i]) + 0.f * bflo(pGB[i]) + 8.f * bflo(((const bf16*)(F.ws + WS_WOA))[(m & 4095) * 2048 + c2]) + 9.f * bflo(((const bf16*)(F.ws + WS_WOB))[(m & 4095) * 2048 + c2]) + 10.f * bflo(((const bf16*)(F.ws + WS_WOUT))[(m & 4095) * 4096 + c]);
            else if (MK_STOP_AFTER == 2) v = c < 2048 ? bflo(pYA[m * 2048 + c2]) : bflo(pYB[m * 2048 + c2]);
            else if (MK_STOP_AFTER == 3) v = bflo(pM[i]);
            else v = F.x[i];
            F.out[i] = v; }
    }
#endif
#if defined(MK_PROBE_P7)
    {
        GRID_BAR();
        pg8::SchedPlain S; S.o.init(M, D, F.G, bx); S.A = (const char*)(F.ws + WS_ACT); S.B = (const char*)(F.ws + WS_WD); S.tstep = (size_t)256 * DFF * 2;
        pg8::EpiResF32 E{F.out, (float*)(F.ws + WS_END)};
        pg8::gemm_phase<pg8::EpiResF32, pg8::SchedPlain, true, true>(F.lds, DFF, S, E);
    }
#endif
#undef IN
#undef BOTH
#undef GRID_BAR
}

extern "C" void kernel_launch(void* const* d_in, const int* in_sizes, int n_in, void* d_out, int out_size, void* d_ws, size_t ws_size, hipStream_t stream) {
    static int grid = 0;
    if (grid == 0) {
        if (n_in != 17 || in_sizes[0] != M * D || out_size != M * D || ws_size < WS_END) { fprintf(stderr, "kernel_launch: unexpected shapes/workspace (n_in %d, in0 %d, out %d, ws %zu < %zu); nothing launched\n", n_in, n_in > 0 ? in_sizes[0] : -1, out_size, ws_size, (size_t)WS_END); grid = -1; return; }
        int dev = 0, cus = 0, per_cu = 0;
        if (hipGetDevice(&dev) != hipSuccess || hipDeviceGetAttribute(&cus, hipDeviceAttributeMultiprocessorCount, dev) != hipSuccess) { grid = -1; return; }
        if (hipFuncSetAttribute((const void*)fwd_kernel, hipFuncAttributeMaxDynamicSharedMemorySize, LDS_BYTES) != hipSuccess) { fprintf(stderr, "kernel_launch: hipFuncSetAttribute failed\n"); grid = -1; return; }
        if (hipOccupancyMaxActiveBlocksPerMultiprocessor(&per_cu, (const void*)fwd_kernel, NWAVES * 64, LDS_BYTES) != hipSuccess || per_cu < 1) fprintf(stderr, "kernel_launch: occupancy query reports %d\n", per_cu);
        (void)hipGetLastError();
        grid = cus - cus % 8;
    }
    if (grid < 0) return;
    if (hipMemsetAsync((char*)d_ws + WS_CTL, 0, CTL_ZERO_BYTES, stream) != hipSuccess) return;
    Args a{};
    for (int i = 0; i < 17; ++i) a.in[i] = (const float*)d_in[i];
    a.out = (float*)d_out; a.ws = (unsigned char*)d_ws;
    for (int li = 0; li < N_LAUNCHES; ++li) {
        if (N_LAUNCHES == PER_PHASE) { a.ph_lo = li; a.ph_hi = li + 1; } else { a.ph_lo = 0; a.ph_hi = PER_PHASE; }
        a.li = li; a.pad = 0;
        hipLaunchKernelGGL(fwd_kernel, dim3(grid), dim3(NWAVES * 64), LDS_BYTES, stream, a);
        const hipError_t le = hipPeekAtLastError();
        if (le != hipSuccess) { fprintf(stderr, "kernel_launch: launch %d failed: %s\n", li, hipGetErrorName(le)); break; }
    }
}
```
